# Optimizing an MI355X kernel written in HIP

```python
import math
import jax, jax.numpy as jnp
from jax import lax
import numpy as np

D_MODEL = 1024
BATCH = 32
SEQ = 2048
DEPTH = 2

CTX_LEN = 256
GRID_W = 64
EPS = 1e-6

N_HEADS = 8
HEAD_DIM = 64
V_DIM = 2 * HEAD_DIM
Q_WIDTH = N_HEADS * 2 * HEAD_DIM
K_WIDTH = N_HEADS * 2 * HEAD_DIM
V_WIDTH = N_HEADS * V_DIM
ATTN_WIDTH = V_WIDTH
Q_BLOCK = 128
ROPE_THETA = 10000.0
AXIS_DIM = HEAD_DIM // 2
ROPE_PAIRS = AXIS_DIM // 2

POOL_WINDOWS = (2, 4, 8, 16)
POOL_GROUPS = len(POOL_WINDOWS)
POOL_WIDTH = 512
POOL_GROUP_DIM = POOL_WIDTH // POOL_GROUPS

N_BRANCHES = 2

OFF_POOL = 0
OFF_Q = OFF_POOL + POOL_WIDTH
OFF_K = OFF_Q + Q_WIDTH
OFF_V = OFF_K + K_WIDTH
OFF_G = OFF_V + V_WIDTH
IN_WIDTH = OFF_G + N_BRANCHES * D_MODEL

D_FF = 2752
N_EXPERTS = 8
TOP_K = 2
D_FF_EXPERT = 1408
N_DENSE = (DEPTH + 1) // 2
N_MOE = DEPTH // 2

kernel_name = "hybrid_pool_diffattn_moe_dit"


def rms_norm(x, g):
    xf = x.astype(jnp.float32)
    y = xf * lax.rsqrt(jnp.mean(xf * xf, axis=-1, keepdims=True) + EPS)
    return (y * g.astype(jnp.float32)).astype(x.dtype)


def modulate(h, shift, scale):
    return h * (1 + scale) + shift


def lambda_init(layer):
    return 0.8 - 0.6 * math.exp(-0.3 * layer)


def axial_rope_tables(L, dtype):
    rows = L // GRID_W
    row = jnp.repeat(jnp.arange(rows, dtype=jnp.float32), GRID_W)
    col = jnp.tile(jnp.arange(GRID_W, dtype=jnp.float32), rows)
    inv = ROPE_THETA ** (-jnp.arange(ROPE_PAIRS, dtype=jnp.float32) * 2.0 / AXIS_DIM)
    ang = jnp.stack([row[:, None] * inv, col[:, None] * inv], axis=1)
    return jnp.cos(ang).astype(dtype), jnp.sin(ang).astype(dtype)


def apply_axial_rope(u, cos, sin):
    shp = u.shape
    ur = u.reshape(shp[:-1] + (2, 2, ROPE_PAIRS))
    a, b = ur[..., 0, :], ur[..., 1, :]
    cs, sn = cos[:, None, None], sin[:, None, None]
    out = jnp.stack([a * cs - b * sn, a * sn + b * cs], axis=-2)
    return out.reshape(shp)


def centred_pool_minus_self(u):
    L = u.shape[1]
    uf = u.astype(jnp.float32)
    cs = jnp.concatenate([jnp.zeros_like(uf[:, :1]), jnp.cumsum(uf, axis=1)], axis=1)
    t = np.arange(L)
    means = []
    for g, w in enumerate(POOL_WINDOWS):
        lo = np.clip(t - w // 2, 0, L)
        hi = np.clip(t + w // 2, 0, L)
        cnt = (hi - lo).astype(np.float32)[None, :, None]
        csg = cs[..., g * POOL_GROUP_DIM:(g + 1) * POOL_GROUP_DIM]
        means.append((csg[:, hi] - csg[:, lo]) / cnt)
    return (jnp.concatenate(means, axis=-1) - uf).astype(u.dtype)


def pool_branch(u, pool_w_l, pool_scale_l):
    B, L, _ = u.shape
    m = centred_pool_minus_self(u).reshape(B, L, POOL_GROUPS, POOL_GROUP_DIM)
    y = jnp.einsum('blgc,gcd->blgd', m, pool_w_l).reshape(B, L, POOL_WIDTH)
    return y * pool_scale_l


def split_heads_q(zq):
    B, L, _ = zq.shape
    return zq.reshape(B, L, N_HEADS, 2, HEAD_DIM)


def split_heads_v(zv):
    B, L, _ = zv.shape
    return zv.reshape(B, L, N_HEADS, V_DIM)


def diff_attend(q, k, v, lam):
    s = jnp.einsum('bqhmd,bkhmd->bhmqk', q, k).astype(jnp.float32)
    p = jax.nn.softmax(s, axis=-1)
    a = p[:, :, 0] - lam * p[:, :, 1]
    return jnp.einsum('bhqk,bkhe->bqhe', a.astype(v.dtype), v)


def latent_attention(q, k_all, v_all, lam):
    B, L = q.shape[:2]
    nb = L // Q_BLOCK
    qb = q.reshape(B, nb, Q_BLOCK, N_HEADS, 2, HEAD_DIM).swapaxes(0, 1)
    ob = lax.map(lambda qq: diff_attend(qq, k_all, v_all, lam), qb)
    return ob.swapaxes(0, 1).reshape(B, L, N_HEADS, V_DIM)


def head_norm(o, g, lam0):
    B, L = o.shape[:2]
    return (rms_norm(o, g) * (1.0 - lam0)).reshape(B, L, ATTN_WIDTH)


def merge_branches(z, pool_y, attn_y, w_pool_proj_l, w_attn_proj_l, w_out_l):
    g = jax.nn.sigmoid(z[..., OFF_G:].astype(jnp.float32)).astype(z.dtype)
    g_pool, g_attn = g[..., :D_MODEL], g[..., D_MODEL:]
    y = g_pool * (pool_y @ w_pool_proj_l) + g_attn * (attn_y @ w_attn_proj_l)
    return y @ w_out_l


def swiglu(t, w1, w3, w2):
    return (jax.nn.silu(t @ w1) * (t @ w3)) @ w2


def moe_swiglu(h, w_router, we1, we3, we2):
    B, L, D = h.shape
    t = h.reshape(B * L, D)
    logits = (t @ w_router).astype(jnp.float32)
    top_v, top_i = lax.top_k(logits, TOP_K)
    wts = jax.nn.softmax(top_v, axis=-1)
    gate = jnp.sum(jax.nn.one_hot(top_i, N_EXPERTS, dtype=jnp.float32) * wts[..., None], axis=1)
    out = jnp.zeros((B * L, D), jnp.float32)
    for e in range(N_EXPERTS):
        out = out + gate[:, e:e + 1] * swiglu(t, we1[e], we3[e], we2[e]).astype(jnp.float32)
    return out.astype(h.dtype).reshape(B, L, D)


def channel_mixer(l, h, ffn_w1, ffn_w3, ffn_w2, router_w, moe_w1, moe_w3, moe_w2):
    if l % 2 == 0:
        i = l // 2
        B, L, D = h.shape
        return swiglu(h.reshape(B * L, D), ffn_w1[i], ffn_w3[i], ffn_w2[i]).reshape(B, L, D)
    i = l // 2
    return moe_swiglu(h, router_w[i], moe_w1[i], moe_w3[i], moe_w2[i])


def setup_inputs(seed: int = 0) -> dict:
    key = jax.random.key(seed)
    ks = iter(jax.random.split(key, 32))

    def nrm(shape, scale):
        return jax.random.normal(next(ks), shape, jnp.float32) * scale

    D = D_MODEL
    return {
        "x": nrm((BATCH, SEQ, D), 1.0),
        "c": nrm((BATCH, D), 1.0),
        "ctx": nrm((BATCH, CTX_LEN, D), 1.0),
        "c_ctx": nrm((D,), 1.0),
        "w_mod": nrm((DEPTH, D, 6 * D), 0.5 * D ** -0.5),
        "b_mod": nrm((DEPTH, 6 * D), 0.02),
        "norm1_g": 1.0 + nrm((DEPTH, D), 0.02),
        "norm2_g": 1.0 + nrm((DEPTH, D), 0.02),
        "w_in": nrm((DEPTH, D, IN_WIDTH), D ** -0.5),
        "pool_w": nrm((DEPTH, POOL_GROUPS, POOL_GROUP_DIM, POOL_GROUP_DIM), POOL_GROUP_DIM ** -0.5),
        "pool_scale": 1.0 + nrm((DEPTH, POOL_WIDTH), 0.1),
        "lam_q1": nrm((DEPTH, HEAD_DIM), 0.1),
        "lam_k1": nrm((DEPTH, HEAD_DIM), 0.1),
        "lam_q2": nrm((DEPTH, HEAD_DIM), 0.1),
        "lam_k2": nrm((DEPTH, HEAD_DIM), 0.1),
        "subln_g": 1.0 + nrm((DEPTH, V_DIM), 0.02),
        "w_pool_proj": nrm((DEPTH, POOL_WIDTH, D), POOL_WIDTH ** -0.5),
        "w_attn_proj": nrm((DEPTH, ATTN_WIDTH, D), ATTN_WIDTH ** -0.5),
        "w_out": nrm((DEPTH, D, D), D ** -0.5),
        "ffn_w1": nrm((N_DENSE, D, D_FF), D ** -0.5),
        "ffn_w3": nrm((N_DENSE, D, D_FF), D ** -0.5),
        "ffn_w2": nrm((N_DENSE, D_FF, D), D_FF ** -0.5),
        "router_w": nrm((N_MOE, D, N_EXPERTS), D ** -0.5),
        "moe_w1": nrm((N_MOE, N_EXPERTS, D, D_FF_EXPERT), D ** -0.5),
        "moe_w3": nrm((N_MOE, N_EXPERTS, D, D_FF_EXPERT), D ** -0.5),
        "moe_w2": nrm((N_MOE, N_EXPERTS, D_FF_EXPERT, D), D_FF_EXPERT ** -0.5),
        "final_g": 1.0 + nrm((D,), 0.02),
    }


def reference(x, c, ctx, c_ctx, w_mod, b_mod, norm1_g, norm2_g, w_in, pool_w, pool_scale,
              lam_q1, lam_k1, lam_q2, lam_k2, subln_g, w_pool_proj, w_attn_proj, w_out,
              ffn_w1, ffn_w3, ffn_w2, router_w, moe_w1, moe_w3, moe_w2, final_g):
    L = x.shape[1]
    cos, sin = axial_rope_tables(L, x.dtype)
    q_scale = HEAD_DIM ** -0.5
    xc = ctx
    s_lat = jax.nn.silu(c)
    s_ctx = jax.nn.silu(c_ctx)
    for l in range(DEPTH):
        last = l == DEPTH - 1
        lam0 = lambda_init(l)
        lam = (jnp.exp(jnp.sum(lam_q1[l].astype(jnp.float32) * lam_k1[l].astype(jnp.float32)))
               - jnp.exp(jnp.sum(lam_q2[l].astype(jnp.float32) * lam_k2[l].astype(jnp.float32)))
               + lam0)
        mod = jnp.split((s_lat @ w_mod[l] + b_mod[l])[:, None, :], 6, axis=-1)
        modc = jnp.split(s_ctx @ w_mod[l] + b_mod[l], 6, axis=-1)

        h = modulate(rms_norm(x, norm1_g[l]), mod[0], mod[1])
        hc = modulate(rms_norm(xc, norm1_g[l]), modc[0], modc[1])
        z = h @ w_in[l]
        if last:
            kvc = hc @ w_in[l][:, OFF_K:OFF_G]
            kc, vc = kvc[..., :K_WIDTH], kvc[..., K_WIDTH:]
        else:
            zc = hc @ w_in[l]
            kc, vc = zc[..., OFF_K:OFF_V], zc[..., OFF_V:OFF_G]
        kc_h = split_heads_q(kc)
        vc_h = split_heads_v(vc)

        q = apply_axial_rope(split_heads_q(z[..., OFF_Q:OFF_K]), cos, sin) * q_scale
        k = apply_axial_rope(split_heads_q(z[..., OFF_K:OFF_V]), cos, sin)
        v = split_heads_v(z[..., OFF_V:OFF_G])
        k_all = jnp.concatenate([kc_h, k], axis=1)
        v_all = jnp.concatenate([vc_h, v], axis=1)
        attn_y = head_norm(latent_attention(q, k_all, v_all, lam), subln_g[l], lam0)
        pool_y = pool_branch(z[..., OFF_POOL:OFF_Q], pool_w[l], pool_scale[l])
        x = x + mod[2] * merge_branches(z, pool_y, attn_y, w_pool_proj[l], w_attn_proj[l], w_out[l])

        if not last:
            qc = split_heads_q(zc[..., OFF_Q:OFF_K]) * q_scale
            attn_yc = head_norm(diff_attend(qc, kc_h, vc_h, lam), subln_g[l], lam0)
            pool_yc = pool_branch(zc[..., OFF_POOL:OFF_Q], pool_w[l], pool_scale[l])
            xc = xc + modc[2] * merge_branches(zc, pool_yc, attn_yc, w_pool_proj[l], w_attn_proj[l], w_out[l])

        h2 = modulate(rms_norm(x, norm2_g[l]), mod[3], mod[4])
        x = x + mod[5] * channel_mixer(l, h2, ffn_w1, ffn_w3, ffn_w2, router_w, moe_w1, moe_w3, moe_w2)
        if not last:
            h2c = modulate(rms_norm(xc, norm2_g[l]), modc[3], modc[4])
            xc = xc + modc[5] * channel_mixer(l, h2c, ffn_w1, ffn_w3, ffn_w2, router_w, moe_w1, moe_w3, moe_w2)
    return rms_norm(x, final_g)
```

```cpp
#include <hip/hip_runtime.h>
#include <cstdio>
#include <cstdint>

#define LAS __attribute__((address_space(3)))
#define GAS __attribute__((address_space(1)))
typedef unsigned short bf16_t;
typedef short bf16x8 __attribute__((ext_vector_type(8)));
typedef float f32x4 __attribute__((ext_vector_type(4)));
typedef float f32x16 __attribute__((ext_vector_type(16)));
typedef unsigned u32x4 __attribute__((ext_vector_type(4)));
typedef unsigned u32x2 __attribute__((ext_vector_type(2)));
typedef float f32x2_t __attribute__((ext_vector_type(2)));
typedef __bf16 bf16x2_t __attribute__((ext_vector_type(2)));

#ifndef MK_ONE_LAUNCH
#define MK_ONE_LAUNCH 0
#endif

constexpr int D = 1024, NB = 32, SEQ = 2048, CTXL = 256, LTOK = SEQ + CTXL, NTOK = NB * LTOK, NRT = NTOK / 256;
constexpr int NLAT = NB * SEQ;
constexpr int NH = 8, VD = 128;
constexpr int FF = 2752, FFP = 2816, NE = 8, FFE = 1408;
constexpr int MODW = 6 * D;
constexpr float EPS = 1e-6f;
constexpr float LOG2E = 1.4426950408889634f;
constexpr float QSCALE = 0.125f * LOG2E;
constexpr int NWAVES = 8, NTHR = 512;

constexpr size_t MiB = 1u << 20;
constexpr size_t WS_CTL = 0, CTL_ZERO_BYTES = 65536;
constexpr size_t WS_MOD = 65536;
constexpr size_t WS_TAB = 1703936;
constexpr size_t WS_XC = 2 * MiB;
constexpr size_t WS_W = 34 * MiB;
constexpr size_t WS_WZ = WS_W, WS_WV = WS_W + 18 * MiB, WS_WEFF = WS_W + 22 * MiB, WS_WAP = WS_W + 24 * MiB, WS_WOUT = WS_W + 28 * MiB, WS_WUP0 = WS_W + 32 * MiB, WS_WDN0 = WS_W + 43 * MiB;
constexpr size_t WS_H = 83 * MiB, WS_U = 227 * MiB, WS_Q = 299 * MiB, WS_K = 443 * MiB, WS_VT = 587 * MiB, WS_G = 731 * MiB, WS_END = 1019 * MiB;
constexpr size_t WS_M = WS_H, WS_AY = WS_Q, WS_Y = WS_K, WS_PG = WS_VT, WS_HID = WS_U;
constexpr size_t WS_HS = WS_U, WS_YM = WS_U, WS_HIDM = 487 * MiB, WS_WUPE = 845 * MiB, WS_WDNE = 889 * MiB, WS_LIST = 911 * MiB, WS_WTS = 913 * MiB;
static_assert(WS_WDN0 + (size_t)D * FFP * 2 <= WS_H, "weights");
static_assert(WS_HID + (size_t)NTOK * FFP * 2 <= WS_END, "hid");
static_assert(WS_HIDM + (size_t)133120 * FFE * 2 <= WS_WUPE, "hidm");
constexpr int CW_BAR = 1024, CW_CNT = 8192;

constexpr int LDS_BYTES = 163840;
constexpr int LDS_CTRL = LDS_BYTES - 256;

__device__ __forceinline__ unsigned cvtpk(float lo, float hi) { f32x2_t v = {lo, hi}; bf16x2_t b = __builtin_convertvector(v, bf16x2_t); return __builtin_bit_cast(unsigned, b); }
__device__ __forceinline__ float bflo(unsigned w) { return __uint_as_float(w << 16); }
__device__ __forceinline__ float bfhi(unsigned w) { return __uint_as_float(w & 0xffff0000u); }
__device__ __forceinline__ u32x4 pack8(const f32x4 a, const f32x4 b) { u32x4 w; w.x = cvtpk(a[0], a[1]); w.y = cvtpk(a[2], a[3]); w.z = cvtpk(b[0], b[1]); w.w = cvtpk(b[2], b[3]); return w; }
__device__ __forceinline__ float wave_sum(float v) {
#pragma unroll
    for (int o = 1; o < 64; o <<= 1) v += __shfl_xor(v, o);
    return v;
}
__device__ __forceinline__ float pair_sum(float v) { auto rr = __builtin_amdgcn_permlane32_swap(__float_as_uint(v), __float_as_uint(v), false, false); return __uint_as_float(rr[0]) + __uint_as_float(rr[1]); }
__device__ __forceinline__ float pair_max(float v) { auto rr = __builtin_amdgcn_permlane32_swap(__float_as_uint(v), __float_as_uint(v), false, false); return fmaxf(__uint_as_float(rr[0]), __uint_as_float(rr[1])); }
__device__ __forceinline__ float fast_sigmoid(float x) { return __builtin_amdgcn_rcpf(1.f + __builtin_amdgcn_exp2f(-LOG2E * x)); }
#define LDS_WAIT() asm volatile("s_waitcnt lgkmcnt(0)" ::: "memory")
__device__ __forceinline__ int opaque_tid() { int t = threadIdx.x; asm volatile("" : "+v"(t)); return t; }

#define XB_TMO      128
#define XB_XCNT(j)  (256  + 64 * (j))
#define XB_XSUB(j)  (1280 + 64 * (j))
#define XB_XGEN(j)  (2304 + 64 * (j))
#define XB_TOP      3328
#define XB_TOPGEN   3392
#define XCD_BAR_WORDS 3456
#define XB_SPIN_CAP (1u << 22)
__device__ __forceinline__ unsigned xb_ld(unsigned* p)              { return __hip_atomic_load(p, __ATOMIC_RELAXED, __HIP_MEMORY_SCOPE_AGENT); }
__device__ __forceinline__ unsigned xb_add(unsigned* p, unsigned v) { return __hip_atomic_fetch_add(p, v, __ATOMIC_RELAXED, __HIP_MEMORY_SCOPE_AGENT); }
__device__ __forceinline__ unsigned xb_xcc_id() { return (unsigned)__builtin_amdgcn_s_getreg((3 << 11) | 20) & 0xFu; }
#define XB_SPIN(cond, bar) do { unsigned _sp = 0; while (cond) { __builtin_amdgcn_s_sleep(1); \
    if ((++_sp & 255u) == 0u) { if (xb_ld(&(bar)[XB_TMO])) break; if (_sp > XB_SPIN_CAP) { atomicAdd(&(bar)[XB_TMO], 1u); break; } } } } while (0)
struct XcdBarrier { unsigned* bar; unsigned x; volatile LAS unsigned* st; };
__device__ __forceinline__ XcdBarrier xcd_barrier_post(unsigned* bar, volatile LAS unsigned* st) {
    XcdBarrier b; b.bar = bar; b.x = xb_xcc_id(); b.st = st;
    if (threadIdx.x == 0) (void)xb_add(&bar[XB_XCNT(b.x)], 1u);
    return b;
}
__device__ __forceinline__ void xcd_barrier_complete(unsigned* bar, unsigned x, unsigned& nloc, unsigned& nx) {
    const unsigned G = gridDim.x * gridDim.y * gridDim.z;
    unsigned sum, cnt, mine, sp = 0u;
    for (;;) {
        sum = 0u; cnt = 0u; mine = 0u;
#pragma unroll
        for (unsigned j = 0; j < 16; ++j) { const unsigned c = xb_ld(&bar[XB_XCNT(j)]); sum += c; cnt += (c > 0u) ? 1u : 0u; mine = (j == x) ? c : mine; }
        if (sum == G) break;
        __builtin_amdgcn_s_sleep(1);
        if ((++sp & 255u) == 0u) { if (xb_ld(&bar[XB_TMO])) break; if (sp > XB_SPIN_CAP) { atomicAdd(&bar[XB_TMO], 1u); break; } }
    }
    nloc = mine > 0u ? mine : 1u; nx = cnt > 0u ? cnt : 1u;
}
__device__ __forceinline__ void xcd_barrier(const XcdBarrier& b) {
    asm volatile("s_waitcnt vmcnt(0)" ::: "memory");
    __syncthreads();
    if (threadIdx.x == 0) {
        unsigned* bar = b.bar;
        __builtin_amdgcn_s_waitcnt(0);
        unsigned nloc = b.st[0], nx = b.st[1];
        if (nloc == 0u) { xcd_barrier_complete(bar, b.x, nloc, nx); b.st[0] = nloc; b.st[1] = nx; }
        const unsigned old = xb_add(&bar[XB_XSUB(b.x)], 1u);
        const unsigned gen = old / nloc;
        if (old + 1u == (gen + 1u) * nloc) {
            __builtin_amdgcn_fence(__ATOMIC_RELEASE, "agent");
            asm volatile("s_waitcnt vmcnt(0)" ::: "memory");
            const unsigned og = xb_add(&bar[XB_TOP], 1u);
            const unsigned tg = og / nx;
            if (og + 1u == (tg + 1u) * nx) xb_add(&bar[XB_TOPGEN], 1u);
            else XB_SPIN(xb_ld(&bar[XB_TOPGEN]) == tg, bar);
            __builtin_amdgcn_fence(__ATOMIC_ACQUIRE, "agent");
            xb_add(&bar[XB_XGEN(b.x)], 1u);
            asm volatile("s_waitcnt vmcnt(0)" ::: "memory");
        } else {
            XB_SPIN(xb_ld(&bar[XB_XGEN(b.x)]) == gen, bar);
            __builtin_amdgcn_fence(__ATOMIC_ACQUIRE, "agent");
            asm volatile("s_waitcnt vmcnt(0)" ::: "memory");
        }
    }
    __syncthreads();
}

namespace pg8 {
constexpr int BM = 256, BK = 64, HALF = 128, HTB = HALF * BK * 2, NXCD = 8, WGM = 8;
__host__ __device__ __forceinline__ int lds_byte(int r, int c) { const int st = (r >> 4) * 2 + (c >> 5), rr = r & 15, cc = c & 31, ob = rr * 64 + cc * 2; return st * 1024 + (ob ^ (((ob >> 9) & 1) << 5)); }
__host__ __device__ __forceinline__ void stage_rc(int b, int& R, int& C) { const int st = b / 1024, sb = b % 1024, swz = sb ^ (((sb >> 9) & 1) << 5); R = (st >> 1) * 16 + swz / 64; C = (st & 1) * 32 + (swz % 64) / 2; }
__host__ __device__ __forceinline__ int perm32(int rho) { const int n = rho >> 4, i = rho & 15; return 8 * (i >> 2) + 4 * n + (i & 3); }
struct Unit { int pm, pn, kind; };
struct GridMap {
    int nM, nN, nwg;
    __device__ __forceinline__ void init(int nM_, int nN_) { nM = nM_; nN = nN_; nwg = nM_ * nN_; }
    __device__ __forceinline__ void map(int L, int& pm, int& pn) const {
        int wgid = L; { const int q = nwg / NXCD, r = nwg % NXCD, xcd = wgid % NXCD, off = wgid / NXCD; wgid = (xcd < r ? xcd * (q + 1) : r * (q + 1) + (xcd - r) * q) + off; }
        const int nig = WGM * nN, gid = wgid / nig, fm = gid * WGM, gsz = (nM - fm) < WGM ? (nM - fm) : WGM;
        pm = fm + ((wgid % nig) % gsz); pn = (wgid % nig) / gsz;
    }
};
template <class Epi, class Sched>
__device__ __forceinline__ void gemm_phase(LAS unsigned char* lds, const int K, const Sched& S, const Epi& E) {
    const int tid = opaque_tid(), wid = __builtin_amdgcn_readfirstlane(tid >> 6), lane = tid & 63, wr = wid >> 2, wc = wid & 3, fr = lane & 15, fq = lane >> 4;
    const int nt = K / BK;
    unsigned voffA[2], voffB[2];
#pragma unroll
    for (int i = 0; i < 2; ++i) { int R, C; stage_rc(tid * 16 + i * 8192, R, C); const int Rb = (R & ~31) + perm32(R & 31);
        voffA[i] = (unsigned)(R * K + C) * 2u; voffB[i] = (unsigned)(Rb * K + C) * 2u; }
    const size_t kstep = (size_t)(BK * 2);
    const size_t hstep = (size_t)HALF * K * 2;
    const unsigned ldsw = (unsigned)wid * 1024u;
    const int aoff = lds_byte(wr * 64 + fr, fq * 8), boff = lds_byte(wc * 32 + fr, fq * 8);
#define PG8_SA(b, h) (((b) * 2 + (h)) * HTB)
#define PG8_SB(b, h) ((4 + (b) * 2 + (h)) * HTB)
#define PG8_STAGE(bufoff, gbase, voff) do { _Pragma("unroll") for (int _i = 0; _i < 2; ++_i) \
        __builtin_amdgcn_global_load_lds((const unsigned*)((const char*)(gbase) + (voff)[_i]), (LAS unsigned*)(lds + (bufoff) + ldsw + _i * 8192), 16, 0, 0); } while (0)
#define PG8_LDA(dst, b, h) do { _Pragma("unroll") for (int m = 0; m < 4; ++m) _Pragma("unroll") for (int k = 0; k < 2; ++k) dst[m][k] = *(const LAS bf16x8*)(lds + PG8_SA(b, h) + aoff + m * 2048 + k * 1024); } while (0)
#define PG8_LDB(dst, b, h) do { _Pragma("unroll") for (int n = 0; n < 2; ++n) _Pragma("unroll") for (int k = 0; k < 2; ++k) dst[n][k] = *(const LAS bf16x8*)(lds + PG8_SB(b, h) + boff + n * 2048 + k * 1024); } while (0)
#define PG8_MMA(ai, bj, At, Bt) do { __builtin_amdgcn_s_setprio(1); _Pragma("unroll") for (int m = 0; m < 4; ++m) _Pragma("unroll") for (int n = 0; n < 2; ++n) _Pragma("unroll") for (int k = 0; k < 2; ++k) \
        acc[ai][bj][m][n] = __builtin_amdgcn_mfma_f32_16x16x32_bf16(Bt[n][k], At[m][k], acc[ai][bj][m][n], 0, 0, 0); __builtin_amdgcn_s_setprio(0); } while (0)
#define PG8_WAIT_V(n) asm volatile("s_waitcnt vmcnt(" #n ")" ::: "memory")
#define PG8_WAIT_L(n) asm volatile("s_waitcnt lgkmcnt(" #n ")" ::: "memory")
#define PG8_BAR __builtin_amdgcn_s_barrier()
#define PG8_SCHED __builtin_amdgcn_sched_barrier(0)
    Unit cur, nxt; int ui = 0;
    if (!S.next(0, cur)) return;
    f32x4 acc[2][2][4][2];
#pragma unroll
    for (int a = 0; a < 2; ++a)
#pragma unroll
        for (int b = 0; b < 2; ++b)
#pragma unroll
            for (int m = 0; m < 4; ++m)
#pragma unroll
                for (int n = 0; n < 2; ++n) acc[a][b][m][n] = (f32x4){0.f, 0.f, 0.f, 0.f};
    bf16x8 At[4][2], B0[2][2], B1[2][2];
    const char* cA = S.abase(cur); const char* cB = S.bbase(cur);
    PG8_STAGE(PG8_SB(0, 0), cB, voffB); PG8_STAGE(PG8_SB(0, 1), cB + hstep, voffB); PG8_STAGE(PG8_SA(0, 0), cA, voffA); PG8_STAGE(PG8_SA(0, 1), cA + hstep, voffA);
    if (wr == 1) PG8_BAR;
    PG8_WAIT_V(2); PG8_BAR;
    PG8_STAGE(PG8_SB(1, 0), cB + kstep, voffB); PG8_STAGE(PG8_SA(1, 0), cA + kstep, voffA); PG8_STAGE(PG8_SB(1, 1), cB + hstep + kstep, voffB);
    PG8_WAIT_V(6); PG8_BAR;
    for (;;) {
        const bool has_next = S.next(ui + 1, nxt);
        const char* nA = has_next ? S.abase(nxt) : cA; const char* nB = has_next ? S.bbase(nxt) : cB;
        for (int t = 0; t < nt; t += 2) {
            const bool last = (t == nt - 2);
            const char* a1 = cA + (size_t)(t + 1) * kstep;
            const char* a2 = last ? nA : cA + (size_t)(t + 2) * kstep; const char* b2 = last ? nB : cB + (size_t)(t + 2) * kstep;
            const char* a3 = a2 + kstep; const char* b3 = b2 + kstep;
            PG8_LDB(B0, 0, 0); PG8_LDB(B1, 0, 1); PG8_SCHED; PG8_LDA(At, 0, 0); PG8_STAGE(PG8_SA(1, 1), a1 + hstep, voffA);
            PG8_WAIT_V(8); PG8_WAIT_L(0); PG8_BAR; PG8_MMA(0, 0, At, B0); PG8_MMA(0, 1, At, B1); PG8_BAR; PG8_SCHED;
            PG8_LDA(At, 0, 1); PG8_STAGE(PG8_SB(0, 0), b2, voffB); PG8_STAGE(PG8_SB(0, 1), b2 + hstep, voffB); PG8_STAGE(PG8_SA(0, 0), a2, voffA);
            PG8_WAIT_V(8); PG8_WAIT_L(0); PG8_BAR; PG8_MMA(1, 0, At, B0); PG8_MMA(1, 1, At, B1); PG8_BAR; PG8_SCHED;
            PG8_LDB(B0, 1, 0); PG8_LDB(B1, 1, 1); PG8_SCHED; PG8_LDA(At, 1, 0); PG8_STAGE(PG8_SA(0, 1), a2 + hstep, voffA);
            PG8_WAIT_V(8); PG8_WAIT_L(0); PG8_BAR; PG8_MMA(0, 0, At, B0); PG8_MMA(0, 1, At, B1); PG8_BAR; PG8_SCHED;
            PG8_LDA(At, 1, 1); PG8_STAGE(PG8_SB(1, 0), b3, voffB); PG8_STAGE(PG8_SB(1, 1), b3 + hstep, voffB); PG8_STAGE(PG8_SA(1, 0), a3, voffA);
            PG8_WAIT_V(8); PG8_WAIT_L(0); PG8_BAR; PG8_MMA(1, 0, At, B0); PG8_MMA(1, 1, At, B1); PG8_BAR; PG8_SCHED;
        }
        if (wr == 0) PG8_BAR;
        E(acc, cur, wr, wc, fr, fq);
        if (!has_next) break;
#pragma unroll
        for (int a = 0; a < 2; ++a)
#pragma unroll
            for (int b = 0; b < 2; ++b)
#pragma unroll
                for (int m = 0; m < 4; ++m)
#pragma unroll
                    for (int n = 0; n < 2; ++n) acc[a][b][m][n] = (f32x4){0.f, 0.f, 0.f, 0.f};
        cur = nxt; cA = nA; cB = nB; ++ui;
        if (wr == 1) PG8_BAR;
    }
    PG8_WAIT_V(0);
    PG8_BAR;
#undef PG8_SA
#undef PG8_SB
#undef PG8_STAGE
#undef PG8_LDA
#undef PG8_LDB
#undef PG8_MMA
#undef PG8_WAIT_V
#undef PG8_WAIT_L
#undef PG8_BAR
#undef PG8_SCHED
}
}
using pg8::Unit;
typedef const f32x4 (&AccRef)[2][2][4][2];

struct Frame {
    LAS unsigned char* lds;
    unsigned char* ws;
    unsigned* ctl;
    const float* const* in;
    float* out;
    int tid, lane, wave, vcu, G;
};

constexpr size_t TS1024 = (size_t)256 * 1024 * 2;

struct ZSched {
    int G, c, last, n0, n1; const char *H, *WZ, *WV; pg8::GridMap g0, g1, g2;
    __device__ __forceinline__ void init(int G_, int c_, int last_, const void* H_, const void* WZ_, const void* WV_) {
        G = G_; c = c_; last = last_; H = (const char*)H_; WZ = (const char*)WZ_; WV = (const char*)WV_;
        if (last) { g0.init(256, 18); g1.init(32, 4); } else { g0.init(NRT, 18); g1.init(0, 4); }
        g2.init(4, NRT); n0 = g0.nwg; n1 = g1.nwg;
    }
    __device__ __forceinline__ bool next(int i, Unit& u) const {
        int L = i * G + c, a, b;
        if (L < n0) { g0.map(L, a, b); u.kind = 0; u.pm = last ? (a >> 3) * 9 + 1 + (a & 7) : a; u.pn = b; return true; }
        L -= n0;
        if (L < n1) { g1.map(L, a, b); u.kind = 0; u.pm = a * 9; u.pn = 6 + b; return true; }
        L -= n1;
        if (L < g2.nwg) { g2.map(L, a, b); u.kind = 1; u.pm = a; u.pn = b; return true; }
        return false;
    }
    __device__ __forceinline__ const char* abase(const Unit& u) const { return (u.kind ? WV : H) + (size_t)u.pm * TS1024; }
    __device__ __forceinline__ const char* bbase(const Unit& u) const { return (u.kind ? H : WZ) + (size_t)u.pn * TS1024; }
};
struct ZEpi {
    bf16_t *U, *Q, *KB, *G, *VT; const float *COS, *SIN;
    __device__ __forceinline__ void operator()(AccRef acc, const Unit& u, int wr, int wc, int fr, int fq) const {
        if (u.kind == 1) {
            const int b = u.pn / 9, jt = u.pn - b * 9;
            bf16_t* base = VT + ((size_t)b * 1024 + u.pm * 256 + wr * 64 + fr) * LTOK + jt * 256 + wc * 32 + 8 * fq;
#pragma unroll
            for (int ai = 0; ai < 2; ++ai)
#pragma unroll
                for (int m = 0; m < 4; ++m) { bf16_t* rowp = base + (size_t)(ai * 128 + m * 16) * LTOK;
#pragma unroll
                    for (int bj = 0; bj < 2; ++bj) *(u32x4*)(rowp + bj * 128) = pack8(acc[ai][bj][m][0], acc[ai][bj][m][1]); }
            return;
        }
        const int pn = u.pn; const size_t row0 = (size_t)u.pm * 256 + wr * 64 + fr; const int cin = wc * 32 + 8 * fq;
        if (pn < 2) {
#pragma unroll
            for (int ai = 0; ai < 2; ++ai)
#pragma unroll
                for (int m = 0; m < 4; ++m) { bf16_t* rowp = U + (row0 + ai * 128 + m * 16) * 512 + pn * 256 + cin;
#pragma unroll
                    for (int bj = 0; bj < 2; ++bj) *(u32x4*)(rowp + bj * 128) = pack8(acc[ai][bj][m][0], acc[ai][bj][m][1]); }
        } else if (pn < 10) {
            const bool isq = pn < 6; bf16_t* dst = isq ? Q : KB; const int ct = isq ? pn - 2 : pn - 6; const float sc = isq ? QSCALE : 1.f;
            const int jt = u.pm % 9; const bool lat = jt != 0; const int axis = wc & 1;
#pragma unroll
            for (int ai = 0; ai < 2; ++ai)
#pragma unroll
                for (int m = 0; m < 4; ++m) {
                    const int pos = axis ? (16 * m + fr) : (((jt - 1) * 4 + 2 * ai + wr) & 63);
                    f32x4 c4 = *(const f32x4*)(COS + pos * 16 + 4 * fq), s4 = *(const f32x4*)(SIN + pos * 16 + 4 * fq);
                    if (!lat) { c4 = (f32x4){1.f, 1.f, 1.f, 1.f}; s4 = (f32x4){0.f, 0.f, 0.f, 0.f}; }
                    bf16_t* rowp = dst + (row0 + ai * 128 + m * 16) * 1024 + ct * 256 + cin;
#pragma unroll
                    for (int bj = 0; bj < 2; ++bj) { const f32x4 a = acc[ai][bj][m][0], b = acc[ai][bj][m][1];
                        const f32x4 ra = (a * c4 - b * s4) * sc, rb = (a * s4 + b * c4) * sc;
                        *(u32x4*)(rowp + bj * 128) = pack8(ra, rb); }
                }
        } else {
            const int ct = pn - 10;
#pragma unroll
            for (int ai = 0; ai < 2; ++ai)
#pragma unroll
                for (int m = 0; m < 4; ++m) { bf16_t* rowp = G + (row0 + ai * 128 + m * 16) * 2048 + ct * 256 + cin;
#pragma unroll
                    for (int bj = 0; bj < 2; ++bj) { f32x4 a = acc[ai][bj][m][0], b = acc[ai][bj][m][1];
#pragma unroll
                        for (int j = 0; j < 4; ++j) { a[j] = fast_sigmoid(a[j]); b[j] = fast_sigmoid(b[j]); }
                        *(u32x4*)(rowp + bj * 128) = pack8(a, b); } }
        }
    }
};

struct PlainSched {
    int G, c, latonly; const char *A, *B; size_t ats, bts; pg8::GridMap g;
    __device__ __forceinline__ void init(int G_, int c_, int latonly_, int nN, const void* A_, const void* B_, int K) {
        G = G_; c = c_; latonly = latonly_; A = (const char*)A_; B = (const char*)B_; ats = bts = (size_t)256 * K * 2; g.init(latonly_ ? 256 : NRT, nN);
    }
    __device__ __forceinline__ bool next(int i, Unit& u) const {
        const int L = i * G + c; if (L >= g.nwg) return false; int a, b; g.map(L, a, b);
        u.kind = 0; u.pm = latonly ? (a >> 3) * 9 + 1 + (a & 7) : a; u.pn = b; return true;
    }
    __device__ __forceinline__ const char* abase(const Unit& u) const { return A + (size_t)u.pm * ats; }
    __device__ __forceinline__ const char* bbase(const Unit& u) const { return B + (size_t)u.pn * bts; }
};
__device__ __forceinline__ void unpack8(const u32x4 w, f32x4& a, f32x4& b) { a = (f32x4){bflo(w.x), bfhi(w.x), bflo(w.y), bfhi(w.y)}; b = (f32x4){bflo(w.z), bfhi(w.z), bflo(w.w), bfhi(w.w)}; }
template <bool SECOND> struct MergeEpi {
    bf16_t* O; const bf16_t* P; const bf16_t* Gt;
    __device__ __forceinline__ void operator()(AccRef acc, const Unit& u, int wr, int wc, int fr, int fq) const {
        const size_t row0 = (size_t)u.pm * 256 + wr * 64 + fr; const int col0 = u.pn * 256 + wc * 32 + 8 * fq;
#pragma unroll
        for (int ai = 0; ai < 2; ++ai)
#pragma unroll
            for (int m = 0; m < 4; ++m) { const size_t r = row0 + ai * 128 + m * 16;
#pragma unroll
                for (int bj = 0; bj < 2; ++bj) { const int c = col0 + bj * 128;
                    f32x4 g0, g1; unpack8(*(const u32x4*)(Gt + r * 2048 + (SECOND ? 1024 : 0) + c), g0, g1);
                    f32x4 v0 = g0 * acc[ai][bj][m][0], v1 = g1 * acc[ai][bj][m][1];
                    if (SECOND) { f32x4 p0, p1; unpack8(*(const u32x4*)(P + r * 1024 + c), p0, p1); v0 += p0; v1 += p1; }
                    *(u32x4*)(O + r * 1024 + c) = pack8(v0, v1); } }
    }
};
struct ResEpi {
    const float *latsrc, *ctxsrc; float *latdst, *ctxdst; const float* mod; int goff;
    __device__ __forceinline__ void operator()(AccRef acc, const Unit& u, int wr, int wc, int fr, int fq) const {
        const int b = u.pm / 9, jt = u.pm - b * 9;
        const size_t rb = jt ? ((size_t)b * SEQ + (jt - 1) * 256) : (size_t)b * CTXL;
        const float* src = (jt ? latsrc : ctxsrc) + (rb + wr * 64 + fr) * D; float* dst = (jt ? latdst : ctxdst) + (rb + wr * 64 + fr) * D;
        const float* gate = mod + (size_t)(jt ? b : 32) * MODW + goff;
        const int col0 = u.pn * 256 + wc * 32 + 8 * fq;
        f32x4 gv[2][2];
#pragma unroll
        for (int bj = 0; bj < 2; ++bj)
#pragma unroll
            for (int n = 0; n < 2; ++n) gv[bj][n] = *(const f32x4*)(gate + col0 + bj * 128 + 4 * n);
#pragma unroll
        for (int ai = 0; ai < 2; ++ai)
#pragma unroll
            for (int m = 0; m < 4; ++m) { const size_t ro = (size_t)(ai * 128 + m * 16) * D + col0;
#pragma unroll
                for (int bj = 0; bj < 2; ++bj)
#pragma unroll
                    for (int n = 0; n < 2; ++n) { const f32x4 x = *(const f32x4*)(src + ro + bj * 128 + 4 * n);
                        *(f32x4*)(dst + ro + bj * 128 + 4 * n) = x + gv[bj][n] * acc[ai][bj][m][n]; } }
    }
};
struct UpEpi {
    bf16_t* O; int ld;
    __device__ __forceinline__ void operator()(AccRef acc, const Unit& u, int wr, int wc, int fr, int fq) const {
        const size_t row0 = (size_t)u.pm * 256 + wr * 64 + fr; const int col0 = u.pn * 128 + wc * 32 + 8 * fq;
#pragma unroll
        for (int ai = 0; ai < 2; ++ai)
#pragma unroll
            for (int m = 0; m < 4; ++m) { f32x4 v[2];
#pragma unroll
                for (int n = 0; n < 2; ++n) { const f32x4 g = acc[ai][0][m][n], w = acc[ai][1][m][n];
#pragma unroll
                    for (int j = 0; j < 4; ++j) v[n][j] = g[j] * fast_sigmoid(g[j]) * w[j]; }
                *(u32x4*)(O + (row0 + ai * 128 + m * 16) * ld + col0) = pack8(v[0], v[1]); }
    }
};
struct MoeInfo {
    int cnt[NE], tb[NE + 1];
    __device__ __forceinline__ void load(const unsigned* cw) {
        int t = 0;
#pragma unroll
        for (int e = 0; e < NE; ++e) { const int c = (int)__hip_atomic_load(cw + CW_CNT + 64 * e, __ATOMIC_RELAXED, __HIP_MEMORY_SCOPE_AGENT); cnt[e] = c; tb[e] = t; t += (c + 255) >> 8; }
        tb[NE] = t;
    }
    __device__ __forceinline__ void lookup(int rt, int& e, int& t0, int& ce) const { e = 0; t0 = 0; ce = cnt[0];
#pragma unroll
        for (int k = 1; k < NE; ++k) { const bool ge = rt >= tb[k]; e = ge ? k : e; t0 = ge ? tb[k] : t0; ce = ge ? cnt[k] : ce; } }
};
struct MoeSched {
    int G, c, nN; const char *A, *B; size_t ats, bts, bes; MoeInfo mi; pg8::GridMap g;
    __device__ __forceinline__ void init(int G_, int c_, int nN_, const void* A_, const void* B_, int K, int Nrows, const MoeInfo& mi_) {
        G = G_; c = c_; nN = nN_; A = (const char*)A_; B = (const char*)B_; ats = bts = (size_t)256 * K * 2; bes = (size_t)Nrows * K * 2; mi = mi_; g.init(mi_.tb[NE], nN_);
    }
    __device__ __forceinline__ bool next(int i, Unit& u) const {
        const int L = i * G + c; if (L >= g.nwg) return false; int a, b; g.map(L, a, b); u.pm = a; u.pn = b; int t0, ce; mi.lookup(a, u.kind, t0, ce); return true;
    }
    __device__ __forceinline__ const char* abase(const Unit& u) const { return A + (size_t)u.pm * ats; }
    __device__ __forceinline__ const char* bbase(const Unit& u) const { return B + (size_t)u.kind * bes + (size_t)u.pn * bts; }
};
struct MoeDownEpi {
    bf16_t* YM; const unsigned* LIST; const float* WTS; MoeInfo mi;
    __device__ __forceinline__ void operator()(AccRef acc, const Unit& u, int wr, int wc, int fr, int fq) const {
        int e, t0, ce; mi.lookup(u.pm, e, t0, ce); const int slot0 = (u.pm - t0) * 256 + wr * 64 + fr;
        const int col0 = u.pn * 256 + wc * 32 + 8 * fq;
#pragma unroll
        for (int ai = 0; ai < 2; ++ai)
#pragma unroll
            for (int m = 0; m < 4; ++m) { const int slot = slot0 + ai * 128 + m * 16;
                if (slot < ce) { const unsigned ent = LIST[(size_t)e * NLAT + slot]; const float wt = WTS[ent];
                    bf16_t* rowp = YM + ((size_t)(ent & 1u) * NLAT + (ent >> 1)) * D + col0;
#pragma unroll
                    for (int bj = 0; bj < 2; ++bj) *(u32x4*)(rowp + bj * 128) = pack8(acc[ai][bj][m][0] * wt, acc[ai][bj][m][1] * wt); } }
    }
};

namespace att {
constexpr int BUFB = 32768, EXCH = 65536;
constexpr float THR = 6.f;
__device__ __forceinline__ void attn_unit(LAS unsigned char* lds, const bf16_t* Q, const bf16_t* K, const bf16_t* VT, bf16_t* AY, int b, int h, size_t qrow0, int nkt, float lam, float osc, const float* subg) {
    const int tid = opaque_tid(), lane = tid & 63, ql = lane & 31, hh = lane >> 5; const int w = __builtin_amdgcn_readfirstlane(tid >> 6); const int map = w >> 2, qb = w & 3;
    const size_t qrow = qrow0 + 32 * qb + ql;
    bf16x8 qf[4];
#pragma unroll
    for (int ks = 0; ks < 4; ++ks) qf[ks] = *(const bf16x8*)(Q + qrow * 1024 + (h * 2 + map) * 64 + 16 * ks + 8 * hh);
    const int prow = lane >> 3, pc = lane & 7;
    const int krow = 8 * w + prow, kc = pc ^ ((krow >> 1) & 7);
    const bf16_t* ksrc0 = K + ((size_t)b * LTOK + krow) * 1024 + (h * 2) * 64 + kc * 8;
    const bf16_t* ksrc1 = ksrc0 + 64;
    const int e0 = 16 * w + prow, e1 = e0 + 8;
    const bf16_t* vsrc0 = VT + ((size_t)b * 1024 + h * 128 + e0) * LTOK + (pc ^ ((e0 >> 1) & 7)) * 8;
    const bf16_t* vsrc1 = VT + ((size_t)b * 1024 + h * 128 + e1) * LTOK + (pc ^ ((e1 >> 1) & 7)) * 8;
#define ATT_DMA(t, BO) do { \
        __builtin_amdgcn_global_load_lds((const unsigned*)(ksrc0 + (size_t)(t) * 64 * 1024), (LAS unsigned*)(lds + (BO) + w * 1024), 16, 0, 0); \
        __builtin_amdgcn_global_load_lds((const unsigned*)(ksrc1 + (size_t)(t) * 64 * 1024), (LAS unsigned*)(lds + (BO) + 8192 + w * 1024), 16, 0, 0); \
        __builtin_amdgcn_global_load_lds((const unsigned*)(vsrc0 + (size_t)(t) * 64), (LAS unsigned*)(lds + (BO) + 16384 + w * 2048), 16, 0, 0); \
        __builtin_amdgcn_global_load_lds((const unsigned*)(vsrc1 + (size_t)(t) * 64), (LAS unsigned*)(lds + (BO) + 16384 + w * 2048 + 1024), 16, 0, 0); } while (0)
    const int rp = (ql & ~12) | ((ql & 4) << 1) | ((ql & 8) >> 1);
    const int xk = (rp >> 1) & 7, xv = (ql >> 1) & 7;
    const LAS unsigned char* kbase = lds + map * 8192 + rp * 128;
    const LAS unsigned char* vbase = lds + 16384 + ql * 128;
    int kof[4], vof[4];
#pragma unroll
    for (int i = 0; i < 4; ++i) { kof[i] = ((2 * i + hh) ^ xk) << 4; vof[i] = ((2 * i + hh) ^ xv) << 4; }
    f32x16 O[4];
#pragma unroll
    for (int i = 0; i < 4; ++i) O[i] = (f32x16){0.f, 0.f, 0.f, 0.f, 0.f, 0.f, 0.f, 0.f, 0.f, 0.f, 0.f, 0.f, 0.f, 0.f, 0.f, 0.f};
    float mrun = -1e30f, lrun = 0.f;
#define ATT_TILE(BO) do { \
        f32x16 S0 = (f32x16){0.f, 0.f, 0.f, 0.f, 0.f, 0.f, 0.f, 0.f, 0.f, 0.f, 0.f, 0.f, 0.f, 0.f, 0.f, 0.f}, S1 = S0; \
        _Pragma("unroll") for (int ks = 0; ks < 4; ++ks) { \
            const bf16x8 k0 = *(const LAS bf16x8*)(kbase + (BO) + kof[ks]); \
            const bf16x8 k1 = *(const LAS bf16x8*)(kbase + (BO) + 4096 + kof[ks]); \
            S0 = __builtin_amdgcn_mfma_f32_32x32x16_bf16(k0, qf[ks], S0, 0, 0, 0); \
            S1 = __builtin_amdgcn_mfma_f32_32x32x16_bf16(k1, qf[ks], S1, 0, 0, 0); } \
        float mx = fmaxf(S0[0], S1[0]); \
        _Pragma("unroll") for (int r = 1; r < 16; ++r) mx = fmaxf(mx, fmaxf(S0[r], S1[r])); \
        mx = pair_max(mx); \
        if (__any(mx > mrun + THR)) { \
            const float mn = fmaxf(mrun, mx), al = __builtin_amdgcn_exp2f(mrun - mn); lrun *= al; mrun = mn; \
            _Pragma("unroll") for (int i = 0; i < 4; ++i) _Pragma("unroll") for (int r = 0; r < 16; ++r) O[i][r] *= al; } \
        float ls = 0.f; \
        _Pragma("unroll") for (int r = 0; r < 16; ++r) { S0[r] = __builtin_amdgcn_exp2f(S0[r] - mrun); S1[r] = __builtin_amdgcn_exp2f(S1[r] - mrun); ls += S0[r] + S1[r]; } \
        lrun += ls; \
        bf16x8 pf[4]; \
        { u32x4 t0, t1, t2, t3; \
          t0.x = cvtpk(S0[0], S0[1]); t0.y = cvtpk(S0[2], S0[3]); t0.z = cvtpk(S0[4], S0[5]); t0.w = cvtpk(S0[6], S0[7]); \
          t1.x = cvtpk(S0[8], S0[9]); t1.y = cvtpk(S0[10], S0[11]); t1.z = cvtpk(S0[12], S0[13]); t1.w = cvtpk(S0[14], S0[15]); \
          t2.x = cvtpk(S1[0], S1[1]); t2.y = cvtpk(S1[2], S1[3]); t2.z = cvtpk(S1[4], S1[5]); t2.w = cvtpk(S1[6], S1[7]); \
          t3.x = cvtpk(S1[8], S1[9]); t3.y = cvtpk(S1[10], S1[11]); t3.z = cvtpk(S1[12], S1[13]); t3.w = cvtpk(S1[14], S1[15]); \
          pf[0] = __builtin_bit_cast(bf16x8, t0); pf[1] = __builtin_bit_cast(bf16x8, t1); pf[2] = __builtin_bit_cast(bf16x8, t2); pf[3] = __builtin_bit_cast(bf16x8, t3); } \
        _Pragma("unroll") for (int eb = 0; eb < 4; ++eb) _Pragma("unroll") for (int c = 0; c < 4; ++c) { \
            const bf16x8 vf = *(const LAS bf16x8*)(vbase + (BO) + eb * 4096 + vof[c]); \
            O[eb] = __builtin_amdgcn_mfma_f32_32x32x16_bf16(vf, pf[c], O[eb], 0, 0, 0); } \
    } while (0)
#define ATT_SYNC() asm volatile("s_waitcnt vmcnt(0) lgkmcnt(0)\n\ts_barrier" ::: "memory")
    ATT_DMA(0, 0);
    for (int t = 0; t < nkt; t += 2) {
        ATT_SYNC();
        ATT_DMA(t + 1, BUFB);
        ATT_TILE(0);
        ATT_SYNC();
        if (t + 2 < nkt) ATT_DMA(t + 2, 0);
        ATT_TILE(BUFB);
    }
    const float inv = 1.f / pair_sum(lrun);
    LAS float* ex = (LAS float*)(lds + EXCH) + (size_t)qb * 4096 + lane;
    if (map == 1) {
#pragma unroll
        for (int i = 0; i < 4; ++i)
#pragma unroll
            for (int r = 0; r < 16; ++r) ex[(i * 16 + r) * 64] = O[i][r] * inv;
    }
    asm volatile("s_waitcnt lgkmcnt(0)\n\ts_barrier" ::: "memory");
    if (map == 0) {
        float ss = 0.f;
#pragma unroll
        for (int i = 0; i < 4; ++i)
#pragma unroll
            for (int r = 0; r < 16; ++r) { const float y = O[i][r] * inv - lam * ex[(i * 16 + r) * 64]; O[i][r] = y; ss += y * y; }
        ss = pair_sum(ss);
        const float rs = rsqrtf(ss * (1.f / VD) + EPS) * osc;
        bf16_t* orow = AY + qrow * 1024 + h * 128;
#pragma unroll
        for (int i = 0; i < 4; ++i)
#pragma unroll
            for (int g = 0; g < 4; ++g) { const int e = 32 * i + 8 * g + 4 * hh; const f32x4 gv = *(const f32x4*)(subg + e);
                u32x2 o; o.x = cvtpk(O[i][4 * g] * rs * gv[0], O[i][4 * g + 1] * rs * gv[1]); o.y = cvtpk(O[i][4 * g + 2] * rs * gv[2], O[i][4 * g + 3] * rs * gv[3]);
                *(u32x2*)(orow + e) = o; }
    }
    asm volatile("s_waitcnt lgkmcnt(0)\n\ts_barrier" ::: "memory");
#undef ATT_DMA
#undef ATT_TILE
#undef ATT_SYNC
}
}

__device__ __forceinline__ void tr_item(const float* W, int ldw, int k0, int n0, bf16_t* WT, int ldt, int drow0, int dcol0, bool rope, LAS float* scr, int lane) {
#pragma unroll 8
    for (int i = 0; i < 32; ++i) { const int kk = 2 * i + (lane >> 5); scr[kk * 33 + (lane & 31)] = W[(size_t)(k0 + kk) * ldw + n0 + (lane & 31)]; }
    LDS_WAIT(); asm volatile("" ::: "memory");
    const int c = lane & 7;
#pragma unroll
    for (int j = 0; j < 4; ++j) { const int n = (lane >> 3) + 8 * j; const LAS float* s = scr + (8 * c) * 33 + n;
        u32x4 o; o.x = cvtpk(s[0 * 33], s[1 * 33]); o.y = cvtpk(s[2 * 33], s[3 * 33]); o.z = cvtpk(s[4 * 33], s[5 * 33]); o.w = cvtpk(s[6 * 33], s[7 * 33]);
        const int dn = rope ? (8 * ((n >> 2) & 3) + 4 * (n >> 4) + (n & 3)) : n;
        *(u32x4*)(WT + (size_t)(drow0 + n0 + dn) * ldt + dcol0 + k0 + 8 * c) = o; }
    LDS_WAIT(); asm volatile("" ::: "memory");
}

__device__ __forceinline__ void phase_prologue(Frame F) {
    F.tid = opaque_tid(); F.lane = F.tid & 63; F.wave = __builtin_amdgcn_readfirstlane(F.tid >> 6);
    const float* c = F.in[1]; const float* cctx = F.in[3]; const float* wmod = F.in[4]; const float* bmod = F.in[5];
    float* MOD = (float*)(F.ws + WS_MOD);
    for (int cb = blockIdx.x; cb < 192; cb += F.G) {
        LAS float* S = (LAS float*)F.lds;
        for (int idx = F.tid; idx < 1024 * 36; idx += NTHR) { const int k = idx / 36, bb = idx - k * 36; float v = 0.f;
            if (bb < 32) v = c[bb * 1024 + k]; else if (bb == 32) v = cctx[k];
            S[idx] = v / (1.f + expf(-v)); }
        __syncthreads();
        const int l = cb / 96, n = (cb % 96) * 64 + F.lane;
        float acc[36];
#pragma unroll
        for (int i = 0; i < 36; ++i) acc[i] = 0.f;
        const float* wp = wmod + ((size_t)l * 1024 + F.wave * 128) * MODW + n;
#pragma unroll 2
        for (int kk = 0; kk < 128; ++kk) { const float wv = wp[(size_t)kk * MODW]; const LAS f32x4* sp = (const LAS f32x4*)(S + (F.wave * 128 + kk) * 36);
#pragma unroll
            for (int q = 0; q < 9; ++q) { const f32x4 s4 = sp[q];
#pragma unroll
                for (int i = 0; i < 4; ++i) acc[4 * q + i] += s4[i] * wv; } }
        __syncthreads();
        LAS float* red = (LAS float*)F.lds;
#pragma unroll
        for (int bb = 0; bb < 33; ++bb) red[(F.wave * 33 + bb) * 64 + F.lane] = acc[bb];
        __syncthreads();
        for (int bb = F.wave; bb < 33; bb += 8) { float s = bmod[l * MODW + n];
#pragma unroll
            for (int w2 = 0; w2 < 8; ++w2) s += red[(w2 * 33 + bb) * 64 + F.lane];
            MOD[((size_t)l * 33 + bb) * MODW + n] = s; }
        __syncthreads();
    }
    __syncthreads();
    LAS float* scr = (LAS float*)(F.lds + F.wave * 8448);
    const int gw = F.vcu * NWAVES + F.wave, NGW = F.G * NWAVES;
    bf16_t* WZ = (bf16_t*)(F.ws + WS_WZ); bf16_t* WV = (bf16_t*)(F.ws + WS_WV); bf16_t* WAP = (bf16_t*)(F.ws + WS_WAP); bf16_t* WOUT = (bf16_t*)(F.ws + WS_WOUT);
    bf16_t* WUP0 = (bf16_t*)(F.ws + WS_WUP0); bf16_t* WDN0 = (bf16_t*)(F.ws + WS_WDN0);
    constexpr int I_IN = 16 * 176, I_SQ = 16 * 32, I_UP = 16 * 86, I_DN = 43 * 32;
    constexpr int NITEMS = 2 * I_IN + 4 * I_SQ + 2 * I_UP + I_DN;
    for (int it = gw; it < NITEMS; it += NGW) {
        int r = it;
        if (r < 2 * I_IN) { const int l = r / I_IN; r -= l * I_IN; const int kb = r / 176, nb = r % 176, n0 = nb * 32;
            const float* W = F.in[8] + (size_t)l * 1024 * 5632;
            if (n0 < 2560) tr_item(W, 5632, kb * 64, n0, WZ + (size_t)l * 4608 * 1024, 1024, 0, 0, n0 >= 512, scr, F.lane);
            else if (n0 < 3584) tr_item(W, 5632, kb * 64, n0, WV + (size_t)l * 1024 * 1024, 1024, -2560, 0, false, scr, F.lane);
            else tr_item(W, 5632, kb * 64, n0, WZ + (size_t)l * 4608 * 1024, 1024, -1024, 0, false, scr, F.lane);
            continue; }
        r -= 2 * I_IN;
        if (r < 4 * I_SQ) { const int q = r / I_SQ; r -= q * I_SQ; const int l = q & 1; const int kb = r / 32, nb = r % 32;
            const float* W = (q < 2 ? F.in[17] : F.in[18]) + (size_t)l * 1024 * 1024; bf16_t* dst = (q < 2 ? WAP : WOUT) + (size_t)l * 1024 * 1024;
            tr_item(W, 1024, kb * 64, nb * 32, dst, 1024, 0, 0, false, scr, F.lane); continue; }
        r -= 4 * I_SQ;
        if (r < 2 * I_UP) { const int q = r / I_UP; r -= q * I_UP; const int kb = r / 86, nb = r % 86, n0 = nb * 32;
            const float* W = q ? F.in[20] : F.in[19];
            tr_item(W, FF, kb * 64, n0, WUP0, 1024, (n0 >> 7) * 256 + q * 128 - (n0 & ~127), 0, false, scr, F.lane); continue; }
        r -= 2 * I_UP;
        { const int kb = r / 32, nb = r % 32; tr_item(F.in[21], 1024, kb * 64, nb * 32, WDN0, FFP, 0, 0, false, scr, F.lane); }
    }
    { const int gt = F.vcu * NTHR + F.tid, NT = F.G * NTHR;
      for (int i = gt; i < 128 * 128; i += NT) { const int rr = i >> 7, cc = i & 127; const int row = 21 * 256 + (rr < 64 ? 64 + rr : 192 + (rr - 64)); *(u32x4*)(WUP0 + (size_t)row * 1024 + cc * 8) = (u32x4){0u, 0u, 0u, 0u}; }
      for (int i = gt; i < 1024 * 8; i += NT) { const int row = i >> 3, cc = i & 7; *(u32x4*)(WDN0 + (size_t)row * FFP + FF + cc * 8) = (u32x4){0u, 0u, 0u, 0u}; } }
    { bf16_t* WEFF = (bf16_t*)(F.ws + WS_WEFF);
      for (int it = gw; it < 1024; it += NGW) { const int l = it >> 9, g = (it >> 7) & 3, nbk = (it >> 3) & 15, cbk = it & 7; const int n = nbk * 64 + F.lane, c0 = cbk * 16;
          const float* pw = F.in[9] + ((size_t)(l * 4 + g) * 128 + c0) * 128; const float* ps = F.in[10] + l * 512 + g * 128; const float* wpp = F.in[16] + ((size_t)l * 512 + g * 128) * 1024 + n;
          float a[16];
#pragma unroll
          for (int i = 0; i < 16; ++i) a[i] = 0.f;
          for (int d = 0; d < 128; ++d) { const float wv = wpp[(size_t)d * 1024] * ps[d];
#pragma unroll
              for (int i = 0; i < 16; ++i) a[i] += pw[i * 128 + d] * wv; }
          u32x4 o0, o1; o0.x = cvtpk(a[0], a[1]); o0.y = cvtpk(a[2], a[3]); o0.z = cvtpk(a[4], a[5]); o0.w = cvtpk(a[6], a[7]);
          o1.x = cvtpk(a[8], a[9]); o1.y = cvtpk(a[10], a[11]); o1.z = cvtpk(a[12], a[13]); o1.w = cvtpk(a[14], a[15]);
          bf16_t* dst = WEFF + ((size_t)l * 1024 + n) * 512 + g * 128 + c0; *(u32x4*)dst = o0; *(u32x4*)(dst + 8) = o1; } }
    if (blockIdx.x == 0) {
        float* COS = (float*)(F.ws + WS_TAB); float* SIN = COS + 1024; float* LAMV = SIN + 1024;
        for (int idx = F.tid; idx < 1024; idx += NTHR) { const int pos = idx >> 4, i = idx & 15; const float inv = powf(10000.f, -(float)i * (2.0f / 32.0f)); const float ang = (float)pos * inv;
            COS[idx] = cosf(ang); SIN[idx] = sinf(ang); }
        if (F.wave == 1) {
            for (int l = 0; l < 2; ++l) { const float d1 = wave_sum(F.in[11][l * 64 + F.lane] * F.in[12][l * 64 + F.lane]), d2 = wave_sum(F.in[13][l * 64 + F.lane] * F.in[14][l * 64 + F.lane]);
                const float lam0 = 0.8f - 0.6f * expf(-0.3f * (float)l);
                if (F.lane == 0) { LAMV[2 * l] = expf(d1) - expf(d2) + lam0; LAMV[2 * l + 1] = 1.f - lam0; } }
        }
    }
}

__device__ __forceinline__ void phase_normmod(Frame F, const float* lat, const float* ctx, const float* g, const float* mod, int soff, bool do_ctx, bf16_t* H) {
    F.tid = opaque_tid(); F.lane = F.tid & 63; F.wave = __builtin_amdgcn_readfirstlane(F.tid >> 6);
    const int gw = F.vcu * NWAVES + F.wave, NGW = F.G * NWAVES;
    for (int r = gw; r < NTOK; r += NGW) {
        const int b = r / LTOK, j = r - b * LTOK; const bool isc = j < CTXL;
        if (isc && !do_ctx) continue;
        const float* src = isc ? ctx + ((size_t)b * CTXL + j) * D : lat + ((size_t)b * SEQ + (j - CTXL)) * D;
        const float* mv = mod + (size_t)(isc ? 32 : b) * MODW + soff;
        const f32x4* xr = (const f32x4*)src + F.lane;
        f32x4 v[4]; float s = 0.f;
#pragma unroll
        for (int q = 0; q < 4; ++q) { v[q] = xr[64 * q]; s += (v[q][0] * v[q][0] + v[q][1] * v[q][1]) + (v[q][2] * v[q][2] + v[q][3] * v[q][3]); }
        const float rstd = rsqrtf(wave_sum(s) * (1.f / D) + EPS);
        u32x2* o8 = (u32x2*)(H + (size_t)r * D) + F.lane;
#pragma unroll
        for (int q = 0; q < 4; ++q) { const int cidx = 4 * F.lane + 256 * q; const f32x4 gg = *(const f32x4*)(g + cidx), sh = *(const f32x4*)(mv + cidx), sc = *(const f32x4*)(mv + 1024 + cidx);
            const f32x4 y = (v[q] * rstd * gg) * (sc + 1.f) + sh;
            u32x2 o; o.x = cvtpk(y[0], y[1]); o.y = cvtpk(y[2], y[3]); o8[64 * q] = o; }
    }
}

__device__ __forceinline__ void phase_pool(Frame F, const bf16_t* U, bf16_t* M, bool do_ctx) {
    F.tid = opaque_tid(); F.lane = F.tid & 63; F.wave = __builtin_amdgcn_readfirstlane(F.tid >> 6);
    const int gw = F.vcu * NWAVES + F.wave, NGW = F.G * NWAVES;
    const int half = 1 << (F.lane >> 4);
    for (int r = gw; r < NTOK; r += NGW) {
        const int b = r / LTOK, j = r - b * LTOK; const bool isc = j < CTXL;
        if (isc && !do_ctx) continue;
        const int L = isc ? CTXL : SEQ, t = isc ? j : j - CTXL; const size_t base = (size_t)b * LTOK + (isc ? 0 : CTXL);
        const int lo = max(t - half, 0), hi = min(t + half, L);
        float a[8];
#pragma unroll
        for (int i = 0; i < 8; ++i) a[i] = 0.f;
        for (int tt = lo; tt < hi; ++tt) { const u32x4 w = *(const u32x4*)(U + (base + tt) * 512 + 8 * F.lane);
            a[0] += bflo(w.x); a[1] += bfhi(w.x); a[2] += bflo(w.y); a[3] += bfhi(w.y); a[4] += bflo(w.z); a[5] += bfhi(w.z); a[6] += bflo(w.w); a[7] += bfhi(w.w); }
        const float ic = 1.f / (float)(hi - lo);
        const u32x4 w = *(const u32x4*)(U + (size_t)r * 512 + 8 * F.lane);
        u32x4 o; o.x = cvtpk(a[0] * ic - bflo(w.x), a[1] * ic - bfhi(w.x)); o.y = cvtpk(a[2] * ic - bflo(w.y), a[3] * ic - bfhi(w.y));
        o.z = cvtpk(a[4] * ic - bflo(w.z), a[5] * ic - bfhi(w.z)); o.w = cvtpk(a[6] * ic - bflo(w.w), a[7] * ic - bfhi(w.w));
        *(u32x4*)(M + (size_t)r * 512 + 8 * F.lane) = o;
    }
}

__device__ __forceinline__ void phase_router(Frame F, const float* x1, const float* g, const float* mod, bf16_t* H) {
    F.tid = opaque_tid(); F.lane = F.tid & 63; F.wave = __builtin_amdgcn_readfirstlane(F.tid >> 6);
    LAS float* WR = (LAS float*)F.lds;
    LAS int* SEL = (LAS int*)(F.lds + 32768);
    LAS float* SW = (LAS float*)(F.lds + 32768 + 2048);
    LAS int* LCNT = (LAS int*)(F.lds + 32768 + 4096);
    unsigned* LIST = (unsigned*)(F.ws + WS_LIST); float* WTS = (float*)(F.ws + WS_WTS);
    for (int i = F.tid; i < 8192; i += NTHR) WR[i] = F.in[22][i];
    for (int ch = blockIdx.x; ch < NLAT / 256; ch += F.G) {
        if (F.tid < 16) LCNT[F.tid] = 0;
        __syncthreads();
        for (int rr = F.wave; rr < 256; rr += NWAVES) {
            const int tok = ch * 256 + rr, b = tok >> 11;
            const float* mv = mod + (size_t)b * MODW + 3 * D;
            const f32x4* xr = (const f32x4*)(x1 + (size_t)tok * D) + F.lane;
            f32x4 v[4]; float s = 0.f;
#pragma unroll
            for (int q = 0; q < 4; ++q) { v[q] = xr[64 * q]; s += (v[q][0] * v[q][0] + v[q][1] * v[q][1]) + (v[q][2] * v[q][2] + v[q][3] * v[q][3]); }
            const float rstd = rsqrtf(wave_sum(s) * (1.f / D) + EPS);
            u32x2* o8 = (u32x2*)(H + ((size_t)b * LTOK + CTXL + (tok & 2047)) * D) + F.lane;
            float lg[8];
#pragma unroll
            for (int e = 0; e < 8; ++e) lg[e] = 0.f;
#pragma unroll
            for (int q = 0; q < 4; ++q) { const int cidx = 4 * F.lane + 256 * q; const f32x4 gg = *(const f32x4*)(g + cidx), sh = *(const f32x4*)(mv + cidx), sc = *(const f32x4*)(mv + 1024 + cidx);
                const f32x4 y = (v[q] * rstd * gg) * (sc + 1.f) + sh;
                u32x2 o; o.x = cvtpk(y[0], y[1]); o.y = cvtpk(y[2], y[3]); o8[64 * q] = o;
#pragma unroll
                for (int i = 0; i < 4; ++i) { const LAS f32x4* wr = (const LAS f32x4*)(WR + (cidx + i) * 8); const f32x4 w0 = wr[0], w1 = wr[1];
                    lg[0] += y[i] * w0[0]; lg[1] += y[i] * w0[1]; lg[2] += y[i] * w0[2]; lg[3] += y[i] * w0[3]; lg[4] += y[i] * w1[0]; lg[5] += y[i] * w1[1]; lg[6] += y[i] * w1[2]; lg[7] += y[i] * w1[3]; } }
#pragma unroll
            for (int e = 0; e < 8; ++e) lg[e] = wave_sum(lg[e]);
            if (F.lane == 0) {
                int e1 = 0; float v1 = lg[0];
#pragma unroll
                for (int e = 1; e < 8; ++e) if (lg[e] > v1) { v1 = lg[e]; e1 = e; }
                int e2 = 0; float v2 = -3.0e38f;
#pragma unroll
                for (int e = 0; e < 8; ++e) if (e != e1 && lg[e] > v2) { v2 = lg[e]; e2 = e; }
                const float p2 = expf(v2 - v1), w1 = 1.f / (1.f + p2);
                SEL[2 * rr] = e1; SEL[2 * rr + 1] = e2; SW[2 * rr] = w1; SW[2 * rr + 1] = p2 * w1;
            }
        }
        __syncthreads();
        int e1 = 0, e2 = 0, i1 = 0, i2 = 0;
        if (F.tid < 256) { e1 = SEL[2 * F.tid]; e2 = SEL[2 * F.tid + 1]; i1 = atomicAdd((int*)&LCNT[e1], 1); i2 = atomicAdd((int*)&LCNT[e2], 1); }
        __syncthreads();
        if (F.tid < 8) LCNT[8 + F.tid] = (int)__hip_atomic_fetch_add(F.ctl + CW_CNT + 64 * F.tid, (unsigned)LCNT[F.tid], __ATOMIC_RELAXED, __HIP_MEMORY_SCOPE_AGENT);
        __syncthreads();
        if (F.tid < 256) { const unsigned tok = (unsigned)(ch * 256 + F.tid);
            LIST[(size_t)e1 * NLAT + LCNT[8 + e1] + i1] = tok * 2u; LIST[(size_t)e2 * NLAT + LCNT[8 + e2] + i2] = tok * 2u + 1u;
            WTS[tok * 2u] = SW[2 * F.tid]; WTS[tok * 2u + 1u] = SW[2 * F.tid + 1]; }
        __syncthreads();
    }
    __syncthreads();
    LAS float* scr = (LAS float*)(F.lds + F.wave * 8448);
    const int gw = F.vcu * NWAVES + F.wave, NGW = F.G * NWAVES;
    bf16_t* WUPE = (bf16_t*)(F.ws + WS_WUPE); bf16_t* WDNE = (bf16_t*)(F.ws + WS_WDNE);
    constexpr int I_E = 16 * 44, I_D = 22 * 32;
    for (int it = gw; it < NE * (2 * I_E + I_D); it += NGW) {
        const int e = it / (2 * I_E + I_D); int r = it - e * (2 * I_E + I_D);
        if (r < 2 * I_E) { const int q = r / I_E; r -= q * I_E; const int kb = r / 44, nb = r % 44, n0 = nb * 32;
            const float* W = (q ? F.in[24] : F.in[23]) + (size_t)e * 1024 * FFE;
            tr_item(W, FFE, kb * 64, n0, WUPE + (size_t)e * 2816 * 1024, 1024, (n0 >> 7) * 256 + q * 128 - (n0 & ~127), 0, false, scr, F.lane); }
        else { r -= 2 * I_E; const int kb = r / 32, nb = r % 32;
            tr_item(F.in[25] + (size_t)e * FFE * 1024, 1024, kb * 64, nb * 32, WDNE + (size_t)e * 1024 * FFE, FFE, 0, 0, false, scr, F.lane); }
    }
}

__device__ __forceinline__ void phase_gather(Frame F, const bf16_t* H, bf16_t* HS) {
    F.tid = opaque_tid(); F.lane = F.tid & 63; F.wave = __builtin_amdgcn_readfirstlane(F.tid >> 6);
    MoeInfo mi; mi.load(F.ctl);
    const unsigned* LIST = (const unsigned*)(F.ws + WS_LIST);
    const int gw = F.vcu * NWAVES + F.wave, NGW = F.G * NWAVES; const int nrows = mi.tb[NE] * 256;
    for (int rr = gw; rr < nrows; rr += NGW) {
        const int rt = rr >> 8; int e, t0, ce; mi.lookup(rt, e, t0, ce); const int slot = rr - t0 * 256;
        u32x4 a = (u32x4){0u, 0u, 0u, 0u}, b2 = a;
        if (slot < ce) { const unsigned tok = LIST[(size_t)e * NLAT + slot] >> 1; const u32x4* src = (const u32x4*)(H + ((size_t)(tok >> 11) * LTOK + CTXL + (tok & 2047u)) * D) + F.lane; a = src[0]; b2 = src[64]; }
        u32x4* dst = (u32x4*)(HS + (size_t)rr * D) + F.lane; dst[0] = a; dst[64] = b2;
    }
}

__device__ __forceinline__ void phase_final(Frame F, float* x, const bf16_t* YM, const float* mod, const float* fg) {
    F.tid = opaque_tid(); F.lane = F.tid & 63; F.wave = __builtin_amdgcn_readfirstlane(F.tid >> 6);
    const int gw = F.vcu * NWAVES + F.wave, NGW = F.G * NWAVES;
    for (int tok = gw; tok < NLAT; tok += NGW) {
        const int b = tok >> 11; const float* gate = mod + (size_t)b * MODW + 5 * D;
        f32x4* xr = (f32x4*)(x + (size_t)tok * D) + F.lane;
        const u32x2* y0 = (const u32x2*)(YM + (size_t)tok * D) + F.lane; const u32x2* y1 = (const u32x2*)(YM + ((size_t)NLAT + tok) * D) + F.lane;
        f32x4 v[4]; float s = 0.f;
#pragma unroll
        for (int q = 0; q < 4; ++q) { const f32x4 xv = xr[64 * q]; const u32x2 a = y0[64 * q], c = y1[64 * q]; const f32x4 gg = *(const f32x4*)(gate + 4 * F.lane + 256 * q);
            const f32x4 yy = (f32x4){bflo(a.x) + bflo(c.x), bfhi(a.x) + bfhi(c.x), bflo(a.y) + bflo(c.y), bfhi(a.y) + bfhi(c.y)};
            v[q] = xv + gg * yy; s += (v[q][0] * v[q][0] + v[q][1] * v[q][1]) + (v[q][2] * v[q][2] + v[q][3] * v[q][3]); }
        const float rstd = rsqrtf(wave_sum(s) * (1.f / D) + EPS);
#pragma unroll
        for (int q = 0; q < 4; ++q) { const f32x4 gg = *(const f32x4*)(fg + 4 * F.lane + 256 * q); xr[64 * q] = v[q] * rstd * gg; }
    }
}

constexpr int N_PHASES = 19;
struct Args { const float* in[27]; float* out; unsigned char* ws; int ph_lo, ph_hi; };
__global__ void __launch_bounds__(NTHR, 2) dit_fwd(Args args) {
    extern __shared__ __attribute__((aligned(16))) unsigned char lds_raw[];
    Frame F;
    F.lds = (LAS unsigned char*)lds_raw; F.ws = args.ws; F.ctl = (unsigned*)(args.ws + WS_CTL); F.out = args.out;
    F.in = args.in;
    F.tid = threadIdx.x; F.lane = F.tid & 63; F.wave = __builtin_amdgcn_readfirstlane(F.tid >> 6);
    F.G = gridDim.x; { const int bx = blockIdx.x; F.vcu = (F.G % 8 == 0) ? (bx % 8) * (F.G / 8) + bx / 8 : bx; }
    volatile LAS unsigned* xbw = (volatile LAS unsigned*)(F.lds + LDS_CTRL);
    if (F.tid < 4) xbw[F.tid] = 0u;
    __syncthreads();
    const int lo = args.ph_lo, hi = args.ph_hi;
    XcdBarrier bar; bar.bar = F.ctl + CW_BAR; bar.x = 0; bar.st = xbw;
    if (hi - lo > 1) bar = xcd_barrier_post(F.ctl + CW_BAR, xbw);
#ifndef SITE_MASK
#define SITE_MASK 0xFFFFFFFFu
#endif
#define SITE(n) (((SITE_MASK) >> (n)) & 1u)
#define IN(k) (lo <= (k) && (k) < hi)
#define SEAM(k) do { if (IN(k) && IN((k) + 1)) xcd_barrier(bar); } while (0)

    unsigned char* ws = F.ws;
    float* MOD = (float*)(ws + WS_MOD); const float* COS = (const float*)(ws + WS_TAB); const float* SIN = COS + 1024; const float* LAMV = SIN + 1024;
    float* XC = (float*)(ws + WS_XC);
    bf16_t* H = (bf16_t*)(ws + WS_H); bf16_t* U = (bf16_t*)(ws + WS_U); bf16_t* Q = (bf16_t*)(ws + WS_Q); bf16_t* KB = (bf16_t*)(ws + WS_K); bf16_t* VT = (bf16_t*)(ws + WS_VT); bf16_t* Gt = (bf16_t*)(ws + WS_G);
    bf16_t* Mp = (bf16_t*)(ws + WS_M); bf16_t* AY = (bf16_t*)(ws + WS_AY); bf16_t* Y = (bf16_t*)(ws + WS_Y); bf16_t* PG = (bf16_t*)(ws + WS_PG); bf16_t* HID = (bf16_t*)(ws + WS_HID);
    const int c = (int)blockIdx.x;

    if (SITE(0) && IN(0)) { phase_prologue(F); } SEAM(0);
    if (SITE(1) && IN(1)) { phase_normmod(F, F.in[0], F.in[2], F.in[6], MOD, 0, true, H); } SEAM(1);

    for (int l = 0; l < 2; ++l) {
        const int pb = 2 + 8 * l; const bool last = (l == 1);
        const float* modl = MOD + (size_t)l * 33 * MODW;
        const float* latsrc = last ? F.out : F.in[0]; const float* ctxsrc = F.in[2];
        if (SITE(2) && IN(pb)) {
            ZSched S; S.init(F.G, c, last ? 1 : 0, H, ws + WS_WZ + (size_t)l * 9 * MiB, ws + WS_WV + (size_t)l * 2 * MiB);
            ZEpi E{U, Q, KB, Gt, VT, COS, SIN};
            pg8::gemm_phase(F.lds, 1024, S, E);
        } SEAM(pb);
        if (SITE(3) && IN(pb + 1)) {
            phase_pool(F, U, Mp, !last);
            const float lam = LAMV[2 * l], osc = LAMV[2 * l + 1]; const float* subg = F.in[15] + l * VD;
            for (int i = 0;; ++i) { const int L = i * F.G + F.vcu; if (L >= NB * NH * 16) break; const int bh = L >> 4, qt = L & 15, b = bh >> 3, h = bh & 7;
                att::attn_unit(F.lds, Q, KB, VT, AY, b, h, (size_t)b * LTOK + CTXL + qt * 128, 36, lam, osc, subg); }
            if (!last) for (int i = 0;; ++i) { const int L = i * F.G + F.vcu; if (L >= NB * NH * 2) break; const int bh = L >> 1, qt = L & 1, b = bh >> 3, h = bh & 7;
                att::attn_unit(F.lds, Q, KB, VT, AY, b, h, (size_t)b * LTOK + qt * 128, 4, lam, osc, subg); }
        } SEAM(pb + 1);
        if (SITE(4) && IN(pb + 2)) {
            { PlainSched S; S.init(F.G, c, last ? 1 : 0, 4, Mp, ws + WS_WEFF + (size_t)l * MiB, 512); MergeEpi<false> E{PG, nullptr, Gt}; pg8::gemm_phase(F.lds, 512, S, E); }
            { PlainSched S; S.init(F.G, c, last ? 1 : 0, 4, AY, ws + WS_WAP + (size_t)l * 2 * MiB, 1024); MergeEpi<true> E{Y, PG, Gt}; pg8::gemm_phase(F.lds, 1024, S, E); }
        } SEAM(pb + 2);
        if (SITE(5) && IN(pb + 3)) {
            PlainSched S; S.init(F.G, c, last ? 1 : 0, 4, Y, ws + WS_WOUT + (size_t)l * 2 * MiB, 1024);
            ResEpi E{latsrc, ctxsrc, F.out, XC, modl, 2 * D};
            pg8::gemm_phase(F.lds, 1024, S, E);
        } SEAM(pb + 3);
        if (!last) {
            if (SITE(6) && IN(pb + 4)) { phase_normmod(F, F.out, XC, F.in[7], modl, 3 * D, true, H); } SEAM(pb + 4);
            if (SITE(7) && IN(pb + 5)) { PlainSched S; S.init(F.G, c, 0, 22, H, ws + WS_WUP0, 1024); UpEpi E{HID, FFP}; pg8::gemm_phase(F.lds, 1024, S, E); } SEAM(pb + 5);
            if (SITE(8) && IN(pb + 6)) { PlainSched S; S.init(F.G, c, 0, 4, HID, ws + WS_WDN0, FFP); ResEpi E{F.out, XC, F.out, XC, modl, 5 * D}; pg8::gemm_phase(F.lds, FFP, S, E); } SEAM(pb + 6);
            if (SITE(9) && IN(pb + 7)) { phase_normmod(F, F.out, XC, F.in[6] + D, MOD + (size_t)33 * MODW, 0, true, H); } SEAM(pb + 7);
        } else {
            bf16_t* HS = (bf16_t*)(ws + WS_HS); bf16_t* HIDM = (bf16_t*)(ws + WS_HIDM); bf16_t* YM = (bf16_t*)(ws + WS_YM);
            if (SITE(10) && IN(pb + 4)) { phase_router(F, F.out, F.in[7] + D, modl, H); } SEAM(pb + 4);
            if (SITE(11) && IN(pb + 5)) { phase_gather(F, H, HS); } SEAM(pb + 5);
            if (SITE(12) && IN(pb + 6)) { MoeInfo mi; mi.load(F.ctl); MoeSched S; S.init(F.G, c, 11, HS, ws + WS_WUPE, 1024, 2816, mi); UpEpi E{HIDM, FFE}; pg8::gemm_phase(F.lds, 1024, S, E); } SEAM(pb + 6);
            if (SITE(13) && IN(pb + 7)) { MoeInfo mi; mi.load(F.ctl); MoeSched S; S.init(F.G, c, 4, HIDM, ws + WS_WDNE, FFE, 1024, mi);
                MoeDownEpi E{YM, (const unsigned*)(ws + WS_LIST), (const float*)(ws + WS_WTS), mi}; pg8::gemm_phase(F.lds, FFE, S, E); } SEAM(pb + 7);
            if (SITE(14) && IN(pb + 8)) { phase_final(F, F.out, YM, modl, F.in[26]); }
        }
    }
#undef IN
#undef SEAM
}

extern "C" void kernel_launch(void* const* d_in, const int* in_sizes, int n_in, void* d_out, int out_size, void* d_ws, size_t ws_size, hipStream_t stream) {
    static int grid = 0;
    if (grid == 0) {
        if (n_in != 27 || ws_size < WS_END) { fprintf(stderr, "kernel_launch: unexpected n_in %d or ws %zu\n", n_in, ws_size); grid = -1; return; }
        int dev = 0, cus = 0;
        if (hipGetDevice(&dev) != hipSuccess || hipDeviceGetAttribute(&cus, hipDeviceAttributeMultiprocessorCount, dev) != hipSuccess) { grid = -1; return; }
        if (hipFuncSetAttribute((const void*)dit_fwd, hipFuncAttributeMaxDynamicSharedMemorySize, LDS_BYTES) != hipSuccess) { fprintf(stderr, "kernel_launch: hipFuncSetAttribute failed\n"); grid = -1; return; }
        (void)hipGetLastError();
        grid = cus;
    }
    if (grid < 0) return;
    (void)hipMemsetAsync((char*)d_ws + WS_CTL, 0, CTL_ZERO_BYTES, stream);
    Args a{};
    for (int i = 0; i < 27; ++i) a.in[i] = (const float*)d_in[i];
    a.out = (float*)d_out; a.ws = (unsigned char*)d_ws;
#if MK_ONE_LAUNCH
    a.ph_lo = 0; a.ph_hi = N_PHASES;
    hipLaunchKernelGGL(dit_fwd, dim3(grid), dim3(NTHR), LDS_BYTES, stream, a);
#else
    for (int p = 0; p < N_PHASES; ++p) { a.ph_lo = p; a.ph_hi = p + 1; hipLaunchKernelGGL(dit_fwd, dim3(grid), dim3(NTHR), LDS_BYTES, stream, a); }
#endif
}
```

```cpp
#include <hip/hip_runtime.h>
#include <cstdio>
#include <cstdint>

#define LAS __attribute__((address_space(3)))
#define GAS __attribute__((address_space(1)))
typedef unsigned short bf16_t;
typedef short bf16x8 __attribute__((ext_vector_type(8)));
typedef float f32x4 __attribute__((ext_vector_type(4)));
typedef float f32x16 __attribute__((ext_vector_type(16)));
typedef unsigned u32x4 __attribute__((ext_vector_type(4)));
typedef unsigned u32x2 __attribute__((ext_vector_type(2)));
typedef float f32x2_t __attribute__((ext_vector_type(2)));
typedef __bf16 bf16x2_t __attribute__((ext_vector_type(2)));

#ifndef MK_ONE_LAUNCH
#define MK_ONE_LAUNCH 1
#endif

constexpr int D = 1024, NB = 32, SEQ = 2048, CTXL = 256, LTOK = SEQ + CTXL, NTOK = NB * LTOK, NRT = NTOK / 256;
constexpr int NLAT = NB * SEQ;
constexpr int NH = 8, VD = 128;
constexpr int FF = 2752, FFP = 2816, NE = 8, FFE = 1408;
constexpr int MODW = 6 * D;
constexpr float EPS = 1e-6f;
constexpr float LOG2E = 1.4426950408889634f;
constexpr float QSCALE = 0.125f * LOG2E;
constexpr int NWAVES = 8, NTHR = 512;

constexpr size_t MiB = 1u << 20;
constexpr size_t WS_CTL = 0, CTL_ZERO_BYTES = 65536;
constexpr size_t WS_MOD = 65536;
constexpr size_t WS_TAB = 1703936;
constexpr size_t WS_XC = 2 * MiB;
constexpr size_t WS_W = 34 * MiB;
constexpr size_t WS_WZ = WS_W, WS_WV = WS_W + 18 * MiB, WS_WEFF = WS_W + 22 * MiB, WS_WAP = WS_W + 24 * MiB, WS_WOUT = WS_W + 28 * MiB, WS_WUP0 = WS_W + 32 * MiB, WS_WDN0 = WS_W + 43 * MiB;
constexpr size_t WS_H = 83 * MiB, WS_U = 227 * MiB, WS_Q = 299 * MiB, WS_K = 443 * MiB, WS_VT = 587 * MiB, WS_G = 731 * MiB, WS_END = 1019 * MiB;
constexpr size_t WS_M = WS_H, WS_AY = WS_Q, WS_Y = WS_K, WS_PG = WS_VT, WS_HID = WS_U;
constexpr size_t WS_HS = WS_U, WS_YM = WS_U, WS_HIDM = 487 * MiB, WS_WUPE = 845 * MiB, WS_WDNE = 889 * MiB, WS_LIST = 911 * MiB, WS_WTS = 913 * MiB;
static_assert(WS_WDN0 + (size_t)D * FFP * 2 <= WS_H, "weights");
static_assert(WS_HID + (size_t)NTOK * FFP * 2 <= WS_END, "hid");
static_assert(WS_HIDM + (size_t)133120 * FFE * 2 <= WS_WUPE, "hidm");
constexpr int CW_BAR = 1024, CW_CNT = 8192;

constexpr int LDS_BYTES = 163840;
constexpr int LDS_CTRL = LDS_BYTES - 256;

__device__ __forceinline__ unsigned cvtpk(float lo, float hi) { f32x2_t v = {lo, hi}; bf16x2_t b = __builtin_convertvector(v, bf16x2_t); return __builtin_bit_cast(unsigned, b); }
__device__ __forceinline__ float bflo(unsigned w) { return __uint_as_float(w << 16); }
__device__ __forceinline__ float bfhi(unsigned w) { return __uint_as_float(w & 0xffff0000u); }
__device__ __forceinline__ u32x4 pack8(const f32x4 a, const f32x4 b) { u32x4 w; w.x = cvtpk(a[0], a[1]); w.y = cvtpk(a[2], a[3]); w.z = cvtpk(b[0], b[1]); w.w = cvtpk(b[2], b[3]); return w; }
__device__ __forceinline__ float wave_sum(float v) {
#pragma unroll
    for (int o = 1; o < 64; o <<= 1) v += __shfl_xor(v, o);
    return v;
}
__device__ __forceinline__ float pair_sum(float v) { auto rr = __builtin_amdgcn_permlane32_swap(__float_as_uint(v), __float_as_uint(v), false, false); return __uint_as_float(rr[0]) + __uint_as_float(rr[1]); }
__device__ __forceinline__ float pair_max(float v) { auto rr = __builtin_amdgcn_permlane32_swap(__float_as_uint(v), __float_as_uint(v), false, false); return fmaxf(__uint_as_float(rr[0]), __uint_as_float(rr[1])); }
__device__ __forceinline__ float fast_sigmoid(float x) { return __builtin_amdgcn_rcpf(1.f + __builtin_amdgcn_exp2f(-LOG2E * x)); }
#define LDS_WAIT() asm volatile("s_waitcnt lgkmcnt(0)" ::: "memory")
__device__ __forceinline__ int opaque_tid() { int t = threadIdx.x; asm volatile("" : "+v"(t)); return t; }

#define XB_TMO      128
#define XB_XCNT(j)  (256  + 64 * (j))
#define XB_XSUB(j)  (1280 + 64 * (j))
#define XB_XGEN(j)  (2304 + 64 * (j))
#define XB_TOP      3328
#define XB_TOPGEN   3392
#define XCD_BAR_WORDS 3456
#define XB_SPIN_CAP (1u << 22)
__device__ __forceinline__ unsigned xb_ld(unsigned* p)              { return __hip_atomic_load(p, __ATOMIC_RELAXED, __HIP_MEMORY_SCOPE_AGENT); }
__device__ __forceinline__ unsigned xb_add(unsigned* p, unsigned v) { return __hip_atomic_fetch_add(p, v, __ATOMIC_RELAXED, __HIP_MEMORY_SCOPE_AGENT); }
__device__ __forceinline__ unsigned xb_xcc_id() { return (unsigned)__builtin_amdgcn_s_getreg((3 << 11) | 20) & 0xFu; }
#define XB_SPIN(cond, bar) do { unsigned _sp = 0; while (cond) { __builtin_amdgcn_s_sleep(1); \
    if ((++_sp & 255u) == 0u) { if (xb_ld(&(bar)[XB_TMO])) break; if (_sp > XB_SPIN_CAP) { atomicAdd(&(bar)[XB_TMO], 1u); break; } } } } while (0)
struct XcdBarrier { unsigned* bar; unsigned x; volatile LAS unsigned* st; };
__device__ __forceinline__ XcdBarrier xcd_barrier_post(unsigned* bar, volatile LAS unsigned* st) {
    XcdBarrier b; b.bar = bar; b.x = xb_xcc_id(); b.st = st;
    if (threadIdx.x == 0) (void)xb_add(&bar[XB_XCNT(b.x)], 1u);
    return b;
}
__device__ __forceinline__ void xcd_barrier_complete(unsigned* bar, unsigned x, unsigned& nloc, unsigned& nx) {
    const unsigned G = gridDim.x * gridDim.y * gridDim.z;
    unsigned sum, cnt, mine, sp = 0u;
    for (;;) {
        sum = 0u; cnt = 0u; mine = 0u;
#pragma unroll
        for (unsigned j = 0; j < 16; ++j) { const unsigned c = xb_ld(&bar[XB_XCNT(j)]); sum += c; cnt += (c > 0u) ? 1u : 0u; mine = (j == x) ? c : mine; }
        if (sum == G) break;
        __builtin_amdgcn_s_sleep(1);
        if ((++sp & 255u) == 0u) { if (xb_ld(&bar[XB_TMO])) break; if (sp > XB_SPIN_CAP) { atomicAdd(&bar[XB_TMO], 1u); break; } }
    }
    nloc = mine > 0u ? mine : 1u; nx = cnt > 0u ? cnt : 1u;
}
__device__ __forceinline__ void xcd_barrier(const XcdBarrier& b) {
    asm volatile("s_waitcnt vmcnt(0)" ::: "memory");
    __syncthreads();
    if (threadIdx.x == 0) {
        unsigned* bar = b.bar;
        __builtin_amdgcn_s_waitcnt(0);
        unsigned nloc = b.st[0], nx = b.st[1];
        if (nloc == 0u) { xcd_barrier_complete(bar, b.x, nloc, nx); b.st[0] = nloc; b.st[1] = nx; }
        const unsigned old = xb_add(&bar[XB_XSUB(b.x)], 1u);
        const unsigned gen = old / nloc;
        if (old + 1u == (gen + 1u) * nloc) {
            __builtin_amdgcn_fence(__ATOMIC_RELEASE, "agent");
            asm volatile("s_waitcnt vmcnt(0)" ::: "memory");
            const unsigned og = xb_add(&bar[XB_TOP], 1u);
            const unsigned tg = og / nx;
            if (og + 1u == (tg + 1u) * nx) xb_add(&bar[XB_TOPGEN], 1u);
            else XB_SPIN(xb_ld(&bar[XB_TOPGEN]) == tg, bar);
            __builtin_amdgcn_fence(__ATOMIC_ACQUIRE, "agent");
            xb_add(&bar[XB_XGEN(b.x)], 1u);
            asm volatile("s_waitcnt vmcnt(0)" ::: "memory");
        } else {
            XB_SPIN(xb_ld(&bar[XB_XGEN(b.x)]) == gen, bar);
            __builtin_amdgcn_fence(__ATOMIC_ACQUIRE, "agent");
            asm volatile("s_waitcnt vmcnt(0)" ::: "memory");
        }
    }
    __syncthreads();
}

namespace pg8 {
constexpr int BM = 256, BK = 64, HALF = 128, HTB = HALF * BK * 2, NXCD = 8, WGM = 8;
__host__ __device__ __forceinline__ int lds_byte(int r, int c) { const int st = (r >> 4) * 2 + (c >> 5), rr = r & 15, cc = c & 31, ob = rr * 64 + cc * 2; return st * 1024 + (ob ^ (((ob >> 9) & 1) << 5)); }
__host__ __device__ __forceinline__ void stage_rc(int b, int& R, int& C) { const int st = b / 1024, sb = b % 1024, swz = sb ^ (((sb >> 9) & 1) << 5); R = (st >> 1) * 16 + swz / 64; C = (st & 1) * 32 + (swz % 64) / 2; }
__host__ __device__ __forceinline__ int perm32(int rho) { const int n = rho >> 4, i = rho & 15; return 8 * (i >> 2) + 4 * n + (i & 3); }
struct Unit { int pm, pn, kind; };
struct GridMap {
    int nM, nN, nwg;
    __device__ __forceinline__ void init(int nM_, int nN_) { nM = nM_; nN = nN_; nwg = nM_ * nN_; }
    __device__ __forceinline__ void map(int L, int& pm, int& pn) const {
        int wgid = L; { const int q = nwg / NXCD, r = nwg % NXCD, xcd = wgid % NXCD, off = wgid / NXCD; wgid = (xcd < r ? xcd * (q + 1) : r * (q + 1) + (xcd - r) * q) + off; }
        const int nig = WGM * nN, gid = wgid / nig, fm = gid * WGM, gsz = (nM - fm) < WGM ? (nM - fm) : WGM;
        pm = fm + ((wgid % nig) % gsz); pn = (wgid % nig) / gsz;
    }
};
template <class Epi, class Sched>
__device__ __forceinline__ void gemm_phase(LAS unsigned char* lds, const int K, const Sched& S, const Epi& E) {
    const int tid = opaque_tid(), wid = __builtin_amdgcn_readfirstlane(tid >> 6), lane = tid & 63, wr = wid >> 2, wc = wid & 3, fr = lane & 15, fq = lane >> 4;
    const int nt = K / BK;
    unsigned voffA[2], voffB[2];
#pragma unroll
    for (int i = 0; i < 2; ++i) { int R, C; stage_rc(tid * 16 + i * 8192, R, C); const int Rb = (R & ~31) + perm32(R & 31);
        voffA[i] = (unsigned)(R * K + C) * 2u; voffB[i] = (unsigned)(Rb * K + C) * 2u; }
    const size_t kstep = (size_t)(BK * 2);
    const size_t hstep = (size_t)HALF * K * 2;
    const unsigned ldsw = (unsigned)wid * 1024u;
    const int aoff = lds_byte(wr * 64 + fr, fq * 8), boff = lds_byte(wc * 32 + fr, fq * 8);
#define PG8_SA(b, h) (((b) * 2 + (h)) * HTB)
#define PG8_SB(b, h) ((4 + (b) * 2 + (h)) * HTB)
#define PG8_STAGE(bufoff, gbase, voff) do { _Pragma("unroll") for (int _i = 0; _i < 2; ++_i) \
        __builtin_amdgcn_global_load_lds((const unsigned*)((const char*)(gbase) + (voff)[_i]), (LAS unsigned*)(lds + (bufoff) + ldsw + _i * 8192), 16, 0, 0); } while (0)
#define PG8_LDA(dst, b, h) do { _Pragma("unroll") for (int m = 0; m < 4; ++m) _Pragma("unroll") for (int k = 0; k < 2; ++k) dst[m][k] = *(const LAS bf16x8*)(lds + PG8_SA(b, h) + aoff + m * 2048 + k * 1024); } while (0)
#define PG8_LDB(dst, b, h) do { _Pragma("unroll") for (int n = 0; n < 2; ++n) _Pragma("unroll") for (int k = 0; k < 2; ++k) dst[n][k] = *(const LAS bf16x8*)(lds + PG8_SB(b, h) + boff + n * 2048 + k * 1024); } while (0)
#define PG8_MMA(ai, bj, At, Bt) do { __builtin_amdgcn_s_setprio(1); _Pragma("unroll") for (int m = 0; m < 4; ++m) _Pragma("unroll") for (int n = 0; n < 2; ++n) _Pragma("unroll") for (int k = 0; k < 2; ++k) \
        acc[ai][bj][m][n] = __builtin_amdgcn_mfma_f32_16x16x32_bf16(Bt[n][k], At[m][k], acc[ai][bj][m][n], 0, 0, 0); __builtin_amdgcn_s_setprio(0); } while (0)
#define PG8_WAIT_V(n) asm volatile("s_waitcnt vmcnt(" #n ")" ::: "memory")
#define PG8_WAIT_L(n) asm volatile("s_waitcnt lgkmcnt(" #n ")" ::: "memory")
#define PG8_BAR __builtin_amdgcn_s_barrier()
#define PG8_SCHED __builtin_amdgcn_sched_barrier(0)
    Unit cur, nxt; int ui = 0;
    if (!S.next(0, cur)) return;
    f32x4 acc[2][2][4][2];
#pragma unroll
    for (int a = 0; a < 2; ++a)
#pragma unroll
        for (int b = 0; b < 2; ++b)
#pragma unroll
            for (int m = 0; m < 4; ++m)
#pragma unroll
                for (int n = 0; n < 2; ++n) acc[a][b][m][n] = (f32x4){0.f, 0.f, 0.f, 0.f};
    bf16x8 At[4][2], B0[2][2], B1[2][2];
    const char* cA = S.abase(cur); const char* cB = S.bbase(cur);
    PG8_STAGE(PG8_SB(0, 0), cB, voffB); PG8_STAGE(PG8_SB(0, 1), cB + hstep, voffB); PG8_STAGE(PG8_SA(0, 0), cA, voffA); PG8_STAGE(PG8_SA(0, 1), cA + hstep, voffA);
    if (wr == 1) PG8_BAR;
    PG8_WAIT_V(2); PG8_BAR;
    PG8_STAGE(PG8_SB(1, 0), cB + kstep, voffB); PG8_STAGE(PG8_SA(1, 0), cA + kstep, voffA); PG8_STAGE(PG8_SB(1, 1), cB + hstep + kstep, voffB);
    PG8_WAIT_V(6); PG8_BAR;
    for (;;) {
        const bool has_next = S.next(ui + 1, nxt);
        const char* nA = has_next ? S.abase(nxt) : cA; const char* nB = has_next ? S.bbase(nxt) : cB;
        for (int t = 0; t < nt; t += 2) {
            const bool last = (t == nt - 2);
            const char* a1 = cA + (size_t)(t + 1) * kstep;
            const char* a2 = last ? nA : cA + (size_t)(t + 2) * kstep; const char* b2 = last ? nB : cB + (size_t)(t + 2) * kstep;
            const char* a3 = a2 + kstep; const char* b3 = b2 + kstep;
            PG8_LDB(B0, 0, 0); PG8_LDB(B1, 0, 1); PG8_SCHED; PG8_LDA(At, 0, 0); PG8_STAGE(PG8_SA(1, 1), a1 + hstep, voffA);
            PG8_WAIT_V(8); PG8_WAIT_L(0); PG8_BAR; PG8_MMA(0, 0, At, B0); PG8_MMA(0, 1, At, B1); PG8_BAR; PG8_SCHED;
            PG8_LDA(At, 0, 1); PG8_STAGE(PG8_SB(0, 0), b2, voffB); PG8_STAGE(PG8_SB(0, 1), b2 + hstep, voffB); PG8_STAGE(PG8_SA(0, 0), a2, voffA);
            PG8_WAIT_V(8); PG8_WAIT_L(0); PG8_BAR; PG8_MMA(1, 0, At, B0); PG8_MMA(1, 1, At, B1); PG8_BAR; PG8_SCHED;
            PG8_LDB(B0, 1, 0); PG8_LDB(B1, 1, 1); PG8_SCHED; PG8_LDA(At, 1, 0); PG8_STAGE(PG8_SA(0, 1), a2 + hstep, voffA);
            PG8_WAIT_V(8); PG8_WAIT_L(0); PG8_BAR; PG8_MMA(0, 0, At, B0); PG8_MMA(0, 1, At, B1); PG8_BAR; PG8_SCHED;
            PG8_LDA(At, 1, 1); PG8_STAGE(PG8_SB(1, 0), b3, voffB); PG8_STAGE(PG8_SB(1, 1), b3 + hstep, voffB); PG8_STAGE(PG8_SA(1, 0), a3, voffA);
            PG8_WAIT_V(8); PG8_WAIT_L(0); PG8_BAR; PG8_MMA(1, 0, At, B0); PG8_MMA(1, 1, At, B1); PG8_BAR; PG8_SCHED;
        }
        if (wr == 0) PG8_BAR;
        E(acc, cur, wr, wc, fr, fq);
        if (!has_next) break;
#pragma unroll
        for (int a = 0; a < 2; ++a)
#pragma unroll
            for (int b = 0; b < 2; ++b)
#pragma unroll
                for (int m = 0; m < 4; ++m)
#pragma unroll
                    for (int n = 0; n < 2; ++n) acc[a][b][m][n] = (f32x4){0.f, 0.f, 0.f, 0.f};
        cur = nxt; cA = nA; cB = nB; ++ui;
        if (wr == 1) PG8_BAR;
    }
    PG8_WAIT_V(0);
    PG8_BAR;
#undef PG8_SA
#undef PG8_SB
#undef PG8_STAGE
#undef PG8_LDA
#undef PG8_LDB
#undef PG8_MMA
#undef PG8_WAIT_V
#undef PG8_WAIT_L
#undef PG8_BAR
#undef PG8_SCHED
}
}
using pg8::Unit;
typedef const f32x4 (&AccRef)[2][2][4][2];

struct Frame {
    LAS unsigned char* lds;
    unsigned char* ws;
    unsigned* ctl;
    const float* const* in;
    float* out;
    int tid, lane, wave, vcu, G;
};

constexpr size_t TS1024 = (size_t)256 * 1024 * 2;

struct ZSched {
    int G, c, last, n0, n1; const char *H, *WZ, *WV; pg8::GridMap g0, g1, g2;
    __device__ __forceinline__ void init(int G_, int c_, int last_, const void* H_, const void* WZ_, const void* WV_) {
        G = G_; c = c_; last = last_; H = (const char*)H_; WZ = (const char*)WZ_; WV = (const char*)WV_;
        if (last) { g0.init(256, 18); g1.init(32, 4); } else { g0.init(NRT, 18); g1.init(0, 4); }
        g2.init(4, NRT); n0 = g0.nwg; n1 = g1.nwg;
    }
    __device__ __forceinline__ bool next(int i, Unit& u) const {
        int L = i * G + c, a, b;
        if (L < n0) { g0.map(L, a, b); u.kind = 0; u.pm = last ? (a >> 3) * 9 + 1 + (a & 7) : a; u.pn = b; return true; }
        L -= n0;
        if (L < n1) { g1.map(L, a, b); u.kind = 0; u.pm = a * 9; u.pn = 6 + b; return true; }
        L -= n1;
        if (L < g2.nwg) { g2.map(L, a, b); u.kind = 1; u.pm = a; u.pn = b; return true; }
        return false;
    }
    __device__ __forceinline__ const char* abase(const Unit& u) const { return (u.kind ? WV : H) + (size_t)u.pm * TS1024; }
    __device__ __forceinline__ const char* bbase(const Unit& u) const { return (u.kind ? H : WZ) + (size_t)u.pn * TS1024; }
};
struct ZEpi {
    bf16_t *U, *Q, *KB, *G, *VT; const float *COS, *SIN;
    __device__ __forceinline__ void operator()(AccRef acc, const Unit& u, int wr, int wc, int fr, int fq) const {
        if (u.kind == 1) {
            const int b = u.pn / 9, jt = u.pn - b * 9;
            bf16_t* base = VT + ((size_t)b * 1024 + u.pm * 256 + wr * 64 + fr) * LTOK + jt * 256 + wc * 32 + 8 * fq;
#pragma unroll
            for (int ai = 0; ai < 2; ++ai)
#pragma unroll
                for (int m = 0; m < 4; ++m) { bf16_t* rowp = base + (size_t)(ai * 128 + m * 16) * LTOK;
#pragma unroll
                    for (int bj = 0; bj < 2; ++bj) *(u32x4*)(rowp + bj * 128) = pack8(acc[ai][bj][m][0], acc[ai][bj][m][1]); }
            return;
        }
        const int pn = u.pn; const size_t row0 = (size_t)u.pm * 256 + wr * 64 + fr; const int cin = wc * 32 + 8 * fq;
        if (pn < 2) {
#pragma unroll
            for (int ai = 0; ai < 2; ++ai)
#pragma unroll
                for (int m = 0; m < 4; ++m) { bf16_t* rowp = U + (row0 + ai * 128 + m * 16) * 512 + pn * 256 + cin;
#pragma unroll
                    for (int bj = 0; bj < 2; ++bj) *(u32x4*)(rowp + bj * 128) = pack8(acc[ai][bj][m][0], acc[ai][bj][m][1]); }
        } else if (pn < 10) {
            const bool isq = pn < 6; bf16_t* dst = isq ? Q : KB; const int ct = isq ? pn - 2 : pn - 6; const float sc = isq ? QSCALE : 1.f;
            const int jt = u.pm % 9; const bool lat = jt != 0; const int axis = wc & 1;
#pragma unroll
            for (int ai = 0; ai < 2; ++ai)
#pragma unroll
                for (int m = 0; m < 4; ++m) {
                    const int pos = axis ? (16 * m + fr) : (((jt - 1) * 4 + 2 * ai + wr) & 63);
                    f32x4 c4 = *(const f32x4*)(COS + pos * 16 + 4 * fq), s4 = *(const f32x4*)(SIN + pos * 16 + 4 * fq);
                    if (!lat) { c4 = (f32x4){1.f, 1.f, 1.f, 1.f}; s4 = (f32x4){0.f, 0.f, 0.f, 0.f}; }
                    bf16_t* rowp = dst + (row0 + ai * 128 + m * 16) * 1024 + ct * 256 + cin;
#pragma unroll
                    for (int bj = 0; bj < 2; ++bj) { const f32x4 a = acc[ai][bj][m][0], b = acc[ai][bj][m][1];
                        const f32x4 ra = (a * c4 - b * s4) * sc, rb = (a * s4 + b * c4) * sc;
                        *(u32x4*)(rowp + bj * 128) = pack8(ra, rb); }
                }
        } else {
            const int ct = pn - 10;
#pragma unroll
            for (int ai = 0; ai < 2; ++ai)
#pragma unroll
                for (int m = 0; m < 4; ++m) { bf16_t* rowp = G + (row0 + ai * 128 + m * 16) * 2048 + ct * 256 + cin;
#pragma unroll
                    for (int bj = 0; bj < 2; ++bj) { f32x4 a = acc[ai][bj][m][0], b = acc[ai][bj][m][1];
#pragma unroll
                        for (int j = 0; j < 4; ++j) { a[j] = fast_sigmoid(a[j]); b[j] = fast_sigmoid(b[j]); }
                        *(u32x4*)(rowp + bj * 128) = pack8(a, b); } }
        }
    }
};

struct PlainSched {
    int G, c, latonly; const char *A, *B; size_t ats, bts; pg8::GridMap g;
    __device__ __forceinline__ void init(int G_, int c_, int latonly_, int nN, const void* A_, const void* B_, int K) {
        G = G_; c = c_; latonly = latonly_; A = (const char*)A_; B = (const char*)B_; ats = bts = (size_t)256 * K * 2; g.init(latonly_ ? 256 : NRT, nN);
    }
    __device__ __forceinline__ bool next(int i, Unit& u) const {
        const int L = i * G + c; if (L >= g.nwg) return false; int a, b; g.map(L, a, b);
        u.kind = 0; u.pm = latonly ? (a >> 3) * 9 + 1 + (a & 7) : a; u.pn = b; return true;
    }
    __device__ __forceinline__ const char* abase(const Unit& u) const { return A + (size_t)u.pm * ats; }
    __device__ __forceinline__ const char* bbase(const Unit& u) const { return B + (size_t)u.pn * bts; }
};
__device__ __forceinline__ void unpack8(const u32x4 w, f32x4& a, f32x4& b) { a = (f32x4){bflo(w.x), bfhi(w.x), bflo(w.y), bfhi(w.y)}; b = (f32x4){bflo(w.z), bfhi(w.z), bflo(w.w), bfhi(w.w)}; }
template <bool SECOND> struct MergeEpi {
    bf16_t* O; const bf16_t* P; const bf16_t* Gt;
    __device__ __forceinline__ void operator()(AccRef acc, const Unit& u, int wr, int wc, int fr, int fq) const {
        const size_t row0 = (size_t)u.pm * 256 + wr * 64 + fr; const int col0 = u.pn * 256 + wc * 32 + 8 * fq;
#pragma unroll
        for (int ai = 0; ai < 2; ++ai)
#pragma unroll
            for (int m = 0; m < 4; ++m) { const size_t r = row0 + ai * 128 + m * 16;
#pragma unroll
                for (int bj = 0; bj < 2; ++bj) { const int c = col0 + bj * 128;
                    f32x4 g0, g1; unpack8(*(const u32x4*)(Gt + r * 2048 + (SECOND ? 1024 : 0) + c), g0, g1);
                    f32x4 v0 = g0 * acc[ai][bj][m][0], v1 = g1 * acc[ai][bj][m][1];
                    if (SECOND) { f32x4 p0, p1; unpack8(*(const u32x4*)(P + r * 1024 + c), p0, p1); v0 += p0; v1 += p1; }
                    *(u32x4*)(O + r * 1024 + c) = pack8(v0, v1); } }
    }
};
struct ResEpi {
    const float *latsrc, *ctxsrc; float *latdst, *ctxdst; const float* mod; int goff;
    __device__ __forceinline__ void operator()(AccRef acc, const Unit& u, int wr, int wc, int fr, int fq) const {
        const int b = u.pm / 9, jt = u.pm - b * 9;
        const size_t rb = jt ? ((size_t)b * SEQ + (jt - 1) * 256) : (size_t)b * CTXL;
        const float* src = (jt ? latsrc : ctxsrc) + (rb + wr * 64 + fr) * D; float* dst = (jt ? latdst : ctxdst) + (rb + wr * 64 + fr) * D;
        const float* gate = mod + (size_t)(jt ? b : 32) * MODW + goff;
        const int col0 = u.pn * 256 + wc * 32 + 8 * fq;
        f32x4 gv[2][2];
#pragma unroll
        for (int bj = 0; bj < 2; ++bj)
#pragma unroll
            for (int n = 0; n < 2; ++n) gv[bj][n] = *(const f32x4*)(gate + col0 + bj * 128 + 4 * n);
#pragma unroll
        for (int ai = 0; ai < 2; ++ai)
#pragma unroll
            for (int m = 0; m < 4; ++m) { const size_t ro = (size_t)(ai * 128 + m * 16) * D + col0;
#pragma unroll
                for (int bj = 0; bj < 2; ++bj)
#pragma unroll
                    for (int n = 0; n < 2; ++n) { const f32x4 x = *(const f32x4*)(src + ro + bj * 128 + 4 * n);
                        *(f32x4*)(dst + ro + bj * 128 + 4 * n) = x + gv[bj][n] * acc[ai][bj][m][n]; } }
    }
};
struct UpEpi {
    bf16_t* O; int ld;
    __device__ __forceinline__ void operator()(AccRef acc, const Unit& u, int wr, int wc, int fr, int fq) const {
        const size_t row0 = (size_t)u.pm * 256 + wr * 64 + fr; const int col0 = u.pn * 128 + wc * 32 + 8 * fq;
#pragma unroll
        for (int ai = 0; ai < 2; ++ai)
#pragma unroll
            for (int m = 0; m < 4; ++m) { f32x4 v[2];
#pragma unroll
                for (int n = 0; n < 2; ++n) { const f32x4 g = acc[ai][0][m][n], w = acc[ai][1][m][n];
#pragma unroll
                    for (int j = 0; j < 4; ++j) v[n][j] = g[j] * fast_sigmoid(g[j]) * w[j]; }
                *(u32x4*)(O + (row0 + ai * 128 + m * 16) * ld + col0) = pack8(v[0], v[1]); }
    }
};
struct MoeInfo {
    int cnt[NE], tb[NE + 1];
    __device__ __forceinline__ void load(const unsigned* cw) {
        int t = 0;
#pragma unroll
        for (int e = 0; e < NE; ++e) { const int c = (int)__hip_atomic_load(cw + CW_CNT + 64 * e, __ATOMIC_RELAXED, __HIP_MEMORY_SCOPE_AGENT); cnt[e] = c; tb[e] = t; t += (c + 255) >> 8; }
        tb[NE] = t;
    }
    __device__ __forceinline__ void lookup(int rt, int& e, int& t0, int& ce) const { e = 0; t0 = 0; ce = cnt[0];
#pragma unroll
        for (int k = 1; k < NE; ++k) { const bool ge = rt >= tb[k]; e = ge ? k : e; t0 = ge ? tb[k] : t0; ce = ge ? cnt[k] : ce; } }
};
struct MoeSched {
    int G, c, nN; const char *A, *B; size_t ats, bts, bes; MoeInfo mi; pg8::GridMap g;
    __device__ __forceinline__ void init(int G_, int c_, int nN_, const void* A_, const void* B_, int K, int Nrows, const MoeInfo& mi_) {
        G = G_; c = c_; nN = nN_; A = (const char*)A_; B = (const char*)B_; ats = bts = (size_t)256 * K * 2; bes = (size_t)Nrows * K * 2; mi = mi_; g.init(mi_.tb[NE], nN_);
    }
    __device__ __forceinline__ bool next(int i, Unit& u) const {
        const int L = i * G + c; if (L >= g.nwg) return false; int a, b; g.map(L, a, b); u.pm = a; u.pn = b; int t0, ce; mi.lookup(a, u.kind, t0, ce); return true;
    }
    __device__ __forceinline__ const char* abase(const Unit& u) const { return A + (size_t)u.pm * ats; }
    __device__ __forceinline__ const char* bbase(const Unit& u) const { return B + (size_t)u.kind * bes + (size_t)u.pn * bts; }
};
struct MoeDownEpi {
    bf16_t* YM; const unsigned* LIST; const float* WTS; MoeInfo mi;
    __device__ __forceinline__ void operator()(AccRef acc, const Unit& u, int wr, int wc, int fr, int fq) const {
        int e, t0, ce; mi.lookup(u.pm, e, t0, ce); const int slot0 = (u.pm - t0) * 256 + wr * 64 + fr;
        const int col0 = u.pn * 256 + wc * 32 + 8 * fq;
#pragma unroll
        for (int ai = 0; ai < 2; ++ai)
#pragma unroll
            for (int m = 0; m < 4; ++m) { const int slot = slot0 + ai * 128 + m * 16;
                if (slot < ce) { const unsigned ent = LIST[(size_t)e * NLAT + slot]; const float wt = WTS[ent];
                    bf16_t* rowp = YM + ((size_t)(ent & 1u) * NLAT + (ent >> 1)) * D + col0;
#pragma unroll
                    for (int bj = 0; bj < 2; ++bj) *(u32x4*)(rowp + bj * 128) = pack8(acc[ai][bj][m][0] * wt, acc[ai][bj][m][1] * wt); } }
    }
};

namespace att {
constexpr int BUFB = 32768, EXCH = 65536;
constexpr float THR = 6.f;
__device__ __forceinline__ void attn_unit(LAS unsigned char* lds, const bf16_t* Q, const bf16_t* K, const bf16_t* VT, bf16_t* AY, int b, int h, size_t qrow0, int nkt, float lam, float osc, const float* subg) {
    const int tid = opaque_tid(), lane = tid & 63, ql = lane & 31, hh = lane >> 5; const int w = __builtin_amdgcn_readfirstlane(tid >> 6); const int map = w >> 2, qb = w & 3;
    const size_t qrow = qrow0 + 32 * qb + ql;
    bf16x8 qf[4];
#pragma unroll
    for (int ks = 0; ks < 4; ++ks) qf[ks] = *(const bf16x8*)(Q + qrow * 1024 + (h * 2 + map) * 64 + 16 * ks + 8 * hh);
    const int prow = lane >> 3, pc = lane & 7;
    const int krow = 8 * w + prow, kc = pc ^ ((krow >> 1) & 7);
    const bf16_t* ksrc0 = K + ((size_t)b * LTOK + krow) * 1024 + (h * 2) * 64 + kc * 8;
    const bf16_t* ksrc1 = ksrc0 + 64;
    const int e0 = 16 * w + prow, e1 = e0 + 8;
    const bf16_t* vsrc0 = VT + ((size_t)b * 1024 + h * 128 + e0) * LTOK + (pc ^ ((e0 >> 1) & 7)) * 8;
    const bf16_t* vsrc1 = VT + ((size_t)b * 1024 + h * 128 + e1) * LTOK + (pc ^ ((e1 >> 1) & 7)) * 8;
#define ATT_DMA(t, BO) do { \
        __builtin_amdgcn_global_load_lds((const unsigned*)(ksrc0 + (size_t)(t) * 64 * 1024), (LAS unsigned*)(lds + (BO) + w * 1024), 16, 0, 0); \
        __builtin_amdgcn_global_load_lds((const unsigned*)(ksrc1 + (size_t)(t) * 64 * 1024), (LAS unsigned*)(lds + (BO) + 8192 + w * 1024), 16, 0, 0); \
        __builtin_amdgcn_global_load_lds((const unsigned*)(vsrc0 + (size_t)(t) * 64), (LAS unsigned*)(lds + (BO) + 16384 + w * 2048), 16, 0, 0); \
        __builtin_amdgcn_global_load_lds((const unsigned*)(vsrc1 + (size_t)(t) * 64), (LAS unsigned*)(lds + (BO) + 16384 + w * 2048 + 1024), 16, 0, 0); } while (0)
    const int rp = (ql & ~12) | ((ql & 4) << 1) | ((ql & 8) >> 1);
    const int xk = (rp >> 1) & 7, xv = (ql >> 1) & 7;
    const LAS unsigned char* kbase = lds + map * 8192 + rp * 128;
    const LAS unsigned char* vbase = lds + 16384 + ql * 128;
    int kof[4], vof[4];
#pragma unroll
    for (int i = 0; i < 4; ++i) { kof[i] = ((2 * i + hh) ^ xk) << 4; vof[i] = ((2 * i + hh) ^ xv) << 4; }
    f32x16 O[4];
#pragma unroll
    for (int i = 0; i < 4; ++i) O[i] = (f32x16){0.f, 0.f, 0.f, 0.f, 0.f, 0.f, 0.f, 0.f, 0.f, 0.f, 0.f, 0.f, 0.f, 0.f, 0.f, 0.f};
    float mrun = -1e30f, lrun = 0.f;
#define ATT_TILE(BO) do { \
        f32x16 S0 = (f32x16){0.f, 0.f, 0.f, 0.f, 0.f, 0.f, 0.f, 0.f, 0.f, 0.f, 0.f, 0.f, 0.f, 0.f, 0.f, 0.f}, S1 = S0; \
        _Pragma("unroll") for (int ks = 0; ks < 4; ++ks) { \
            const bf16x8 k0 = *(const LAS bf16x8*)(kbase + (BO) + kof[ks]); \
            const bf16x8 k1 = *(const LAS bf16x8*)(kbase + (BO) + 4096 + kof[ks]); \
            S0 = __builtin_amdgcn_mfma_f32_32x32x16_bf16(k0, qf[ks], S0, 0, 0, 0); \
            S1 = __builtin_amdgcn_mfma_f32_32x32x16_bf16(k1, qf[ks], S1, 0, 0, 0); } \
        float mx = fmaxf(S0[0], S1[0]); \
        _Pragma("unroll") for (int r = 1; r < 16; ++r) mx = fmaxf(mx, fmaxf(S0[r], S1[r])); \
        mx = pair_max(mx); \
        if (__any(mx > mrun + THR)) { \
            const float mn = fmaxf(mrun, mx), al = __builtin_amdgcn_exp2f(mrun - mn); lrun *= al; mrun = mn; \
            _Pragma("unroll") for (int i = 0; i < 4; ++i) _Pragma("unroll") for (int r = 0; r < 16; ++r) O[i][r] *= al; } \
        float ls = 0.f; \
        _Pragma("unroll") for (int r = 0; r < 16; ++r) { S0[r] = __builtin_amdgcn_exp2f(S0[r] - mrun); S1[r] = __builtin_amdgcn_exp2f(S1[r] - mrun); ls += S0[r] + S1[r]; } \
        lrun += ls; \
        bf16x8 pf[4]; \
        { u32x4 t0, t1, t2, t3; \
          t0.x = cvtpk(S0[0], S0[1]); t0.y = cvtpk(S0[2], S0[3]); t0.z = cvtpk(S0[4], S0[5]); t0.w = cvtpk(S0[6], S0[7]); \
          t1.x = cvtpk(S0[8], S0[9]); t1.y = cvtpk(S0[10], S0[11]); t1.z = cvtpk(S0[12], S0[13]); t1.w = cvtpk(S0[14], S0[15]); \
          t2.x = cvtpk(S1[0], S1[1]); t2.y = cvtpk(S1[2], S1[3]); t2.z = cvtpk(S1[4], S1[5]); t2.w = cvtpk(S1[6], S1[7]); \
          t3.x = cvtpk(S1[8], S1[9]); t3.y = cvtpk(S1[10], S1[11]); t3.z = cvtpk(S1[12], S1[13]); t3.w = cvtpk(S1[14], S1[15]); \
          pf[0] = __builtin_bit_cast(bf16x8, t0); pf[1] = __builtin_bit_cast(bf16x8, t1); pf[2] = __builtin_bit_cast(bf16x8, t2); pf[3] = __builtin_bit_cast(bf16x8, t3); } \
        _Pragma("unroll") for (int eb = 0; eb < 4; ++eb) _Pragma("unroll") for (int c = 0; c < 4; ++c) { \
            const bf16x8 vf = *(const LAS bf16x8*)(vbase + (BO) + eb * 4096 + vof[c]); \
            O[eb] = __builtin_amdgcn_mfma_f32_32x32x16_bf16(vf, pf[c], O[eb], 0, 0, 0); } \
    } while (0)
#define ATT_SYNC() asm volatile("s_waitcnt vmcnt(0) lgkmcnt(0)\n\ts_barrier" ::: "memory")
    ATT_DMA(0, 0);
    for (int t = 0; t < nkt; t += 2) {
        ATT_SYNC();
        ATT_DMA(t + 1, BUFB);
        ATT_TILE(0);
        ATT_SYNC();
        if (t + 2 < nkt) ATT_DMA(t + 2, 0);
        ATT_TILE(BUFB);
    }
    const float inv = 1.f / pair_sum(lrun);
    LAS float* ex = (LAS float*)(lds + EXCH) + (size_t)qb * 4096 + lane;
    if (map == 1) {
#pragma unroll
        for (int i = 0; i < 4; ++i)
#pragma unroll
            for (int r = 0; r < 16; ++r) ex[(i * 16 + r) * 64] = O[i][r] * inv;
    }
    asm volatile("s_waitcnt lgkmcnt(0)\n\ts_barrier" ::: "memory");
    if (map == 0) {
        float ss = 0.f;
#pragma unroll
        for (int i = 0; i < 4; ++i)
#pragma unroll
            for (int r = 0; r < 16; ++r) { const float y = O[i][r] * inv - lam * ex[(i * 16 + r) * 64]; O[i][r] = y; ss += y * y; }
        ss = pair_sum(ss);
        const float rs = rsqrtf(ss * (1.f / VD) + EPS) * osc;
        bf16_t* orow = AY + qrow * 1024 + h * 128;
#pragma unroll
        for (int i = 0; i < 4; ++i)
#pragma unroll
            for (int g = 0; g < 4; ++g) { const int e = 32 * i + 8 * g + 4 * hh; const f32x4 gv = *(const f32x4*)(subg + e);
                u32x2 o; o.x = cvtpk(O[i][4 * g] * rs * gv[0], O[i][4 * g + 1] * rs * gv[1]); o.y = cvtpk(O[i][4 * g + 2] * rs * gv[2], O[i][4 * g + 3] * rs * gv[3]);
                *(u32x2*)(orow + e) = o; }
    }
    asm volatile("s_waitcnt lgkmcnt(0)\n\ts_barrier" ::: "memory");
#undef ATT_DMA
#undef ATT_TILE
#undef ATT_SYNC
}
}

__device__ __forceinline__ void tr_item(const float* W, int ldw, int k0, int n0, bf16_t* WT, int ldt, int drow0, int dcol0, bool rope, LAS float* scr, int lane) {
#pragma unroll 8
    for (int i = 0; i < 32; ++i) { const int kk = 2 * i + (lane >> 5); scr[kk * 33 + (lane & 31)] = W[(size_t)(k0 + kk) * ldw + n0 + (lane & 31)]; }
    LDS_WAIT(); asm volatile("" ::: "memory");
    const int c = lane & 7;
#pragma unroll
    for (int j = 0; j < 4; ++j) { const int n = (lane >> 3) + 8 * j; const LAS float* s = scr + (8 * c) * 33 + n;
        u32x4 o; o.x = cvtpk(s[0 * 33], s[1 * 33]); o.y = cvtpk(s[2 * 33], s[3 * 33]); o.z = cvtpk(s[4 * 33], s[5 * 33]); o.w = cvtpk(s[6 * 33], s[7 * 33]);
        const int dn = rope ? (8 * ((n >> 2) & 3) + 4 * (n >> 4) + (n & 3)) : n;
        *(u32x4*)(WT + (size_t)(drow0 + n0 + dn) * ldt + dcol0 + k0 + 8 * c) = o; }
    LDS_WAIT(); asm volatile("" ::: "memory");
}

__device__ __forceinline__ void phase_prologue(Frame F) {
    F.tid = opaque_tid(); F.lane = F.tid & 63; F.wave = __builtin_amdgcn_readfirstlane(F.tid >> 6);
    const float* c = F.in[1]; const float* cctx = F.in[3]; const float* wmod = F.in[4]; const float* bmod = F.in[5];
    float* MOD = (float*)(F.ws + WS_MOD);
    for (int cb = blockIdx.x; cb < 192; cb += F.G) {
        LAS float* S = (LAS float*)F.lds;
        for (int idx = F.tid; idx < 1024 * 36; idx += NTHR) { const int k = idx / 36, bb = idx - k * 36; float v = 0.f;
            if (bb < 32) v = c[bb * 1024 + k]; else if (bb == 32) v = cctx[k];
            S[idx] = v / (1.f + expf(-v)); }
        __syncthreads();
        const int l = cb / 96, n = (cb % 96) * 64 + F.lane;
        float acc[36];
#pragma unroll
        for (int i = 0; i < 36; ++i) acc[i] = 0.f;
        const float* wp = wmod + ((size_t)l * 1024 + F.wave * 128) * MODW + n;
#pragma unroll 2
        for (int kk = 0; kk < 128; ++kk) { const float wv = wp[(size_t)kk * MODW]; const LAS f32x4* sp = (const LAS f32x4*)(S + (F.wave * 128 + kk) * 36);
#pragma unroll
            for (int q = 0; q < 9; ++q) { const f32x4 s4 = sp[q];
#pragma unroll
                for (int i = 0; i < 4; ++i) acc[4 * q + i] += s4[i] * wv; } }
        __syncthreads();
        LAS float* red = (LAS float*)F.lds;
#pragma unroll
        for (int bb = 0; bb < 33; ++bb) red[(F.wave * 33 + bb) * 64 + F.lane] = acc[bb];
        __syncthreads();
        for (int bb = F.wave; bb < 33; bb += 8) { float s = bmod[l * MODW + n];
#pragma unroll
            for (int w2 = 0; w2 < 8; ++w2) s += red[(w2 * 33 + bb) * 64 + F.lane];
            MOD[((size_t)l * 33 + bb) * MODW + n] = s; }
        __syncthreads();
    }
    __syncthreads();
    LAS float* scr = (LAS float*)(F.lds + F.wave * 8448);
    const int gw = F.vcu * NWAVES + F.wave, NGW = F.G * NWAVES;
    bf16_t* WZ = (bf16_t*)(F.ws + WS_WZ); bf16_t* WV = (bf16_t*)(F.ws + WS_WV); bf16_t* WAP = (bf16_t*)(F.ws + WS_WAP); bf16_t* WOUT = (bf16_t*)(F.ws + WS_WOUT);
    bf16_t* WUP0 = (bf16_t*)(F.ws + WS_WUP0); bf16_t* WDN0 = (bf16_t*)(F.ws + WS_WDN0);
    constexpr int I_IN = 16 * 176, I_SQ = 16 * 32, I_UP = 16 * 86, I_DN = 43 * 32;
    constexpr int NITEMS = 2 * I_IN + 4 * I_SQ + 2 * I_UP + I_DN;
    for (int it = gw; it < NITEMS; it += NGW) {
        int r = it;
        if (r < 2 * I_IN) { const int l = r / I_IN; r -= l * I_IN; const int kb = r / 176, nb = r % 176, n0 = nb * 32;
            const float* W = F.in[8] + (size_t)l * 1024 * 5632;
            if (n0 < 2560) tr_item(W, 5632, kb * 64, n0, WZ + (size_t)l * 4608 * 1024, 1024, 0, 0, n0 >= 512, scr, F.lane);
            else if (n0 < 3584) tr_item(W, 5632, kb * 64, n0, WV + (size_t)l * 1024 * 1024, 1024, -2560, 0, false, scr, F.lane);
            else tr_item(W, 5632, kb * 64, n0, WZ + (size_t)l * 4608 * 1024, 1024, -1024, 0, false, scr, F.lane);
            continue; }
        r -= 2 * I_IN;
        if (r < 4 * I_SQ) { const int q = r / I_SQ; r -= q * I_SQ; const int l = q & 1; const int kb = r / 32, nb = r % 32;
            const float* W = (q < 2 ? F.in[17] : F.in[18]) + (size_t)l * 1024 * 1024; bf16_t* dst = (q < 2 ? WAP : WOUT) + (size_t)l * 1024 * 1024;
            tr_item(W, 1024, kb * 64, nb * 32, dst, 1024, 0, 0, false, scr, F.lane); continue; }
        r -= 4 * I_SQ;
        if (r < 2 * I_UP) { const int q = r / I_UP; r -= q * I_UP; const int kb = r / 86, nb = r % 86, n0 = nb * 32;
            const float* W = q ? F.in[20] : F.in[19];
            tr_item(W, FF, kb * 64, n0, WUP0, 1024, (n0 >> 7) * 256 + q * 128 - (n0 & ~127), 0, false, scr, F.lane); continue; }
        r -= 2 * I_UP;
        { const int kb = r / 32, nb = r % 32; tr_item(F.in[21], 1024, kb * 64, nb * 32, WDN0, FFP, 0, 0, false, scr, F.lane); }
    }
    { const int gt = F.vcu * NTHR + F.tid, NT = F.G * NTHR;
      for (int i = gt; i < 128 * 128; i += NT) { const int rr = i >> 7, cc = i & 127; const int row = 21 * 256 + (rr < 64 ? 64 + rr : 192 + (rr - 64)); *(u32x4*)(WUP0 + (size_t)row * 1024 + cc * 8) = (u32x4){0u, 0u, 0u, 0u}; }
      for (int i = gt; i < 1024 * 8; i += NT) { const int row = i >> 3, cc = i & 7; *(u32x4*)(WDN0 + (size_t)row * FFP + FF + cc * 8) = (u32x4){0u, 0u, 0u, 0u}; } }
    { bf16_t* WEFF = (bf16_t*)(F.ws + WS_WEFF);
      for (int it = gw; it < 1024; it += NGW) { const int l = it >> 9, g = (it >> 7) & 3, nbk = (it >> 3) & 15, cbk = it & 7; const int n = nbk * 64 + F.lane, c0 = cbk * 16;
          const float* pw = F.in[9] + ((size_t)(l * 4 + g) * 128 + c0) * 128; const float* ps = F.in[10] + l * 512 + g * 128; const float* wpp = F.in[16] + ((size_t)l * 512 + g * 128) * 1024 + n;
          float a[16];
#pragma unroll
          for (int i = 0; i < 16; ++i) a[i] = 0.f;
          for (int d = 0; d < 128; ++d) { const float wv = wpp[(size_t)d * 1024] * ps[d];
#pragma unroll
              for (int i = 0; i < 16; ++i) a[i] += pw[i * 128 + d] * wv; }
          u32x4 o0, o1; o0.x = cvtpk(a[0], a[1]); o0.y = cvtpk(a[2], a[3]); o0.z = cvtpk(a[4], a[5]); o0.w = cvtpk(a[6], a[7]);
          o1.x = cvtpk(a[8], a[9]); o1.y = cvtpk(a[10], a[11]); o1.z = cvtpk(a[12], a[13]); o1.w = cvtpk(a[14], a[15]);
          bf16_t* dst = WEFF + ((size_t)l * 1024 + n) * 512 + g * 128 + c0; *(u32x4*)dst = o0; *(u32x4*)(dst + 8) = o1; } }
    if (blockIdx.x == 0) {
        float* COS = (float*)(F.ws + WS_TAB); float* SIN = COS + 1024; float* LAMV = SIN + 1024;
        for (int idx = F.tid; idx < 1024; idx += NTHR) { const int pos = idx >> 4, i = idx & 15; const float inv = powf(10000.f, -(float)i * (2.0f / 32.0f)); const float ang = (float)pos * inv;
            COS[idx] = cosf(ang); SIN[idx] = sinf(ang); }
        if (F.wave == 1) {
            for (int l = 0; l < 2; ++l) { const float d1 = wave_sum(F.in[11][l * 64 + F.lane] * F.in[12][l * 64 + F.lane]), d2 = wave_sum(F.in[13][l * 64 + F.lane] * F.in[14][l * 64 + F.lane]);
                const float lam0 = 0.8f - 0.6f * expf(-0.3f * (float)l);
                if (F.lane == 0) { LAMV[2 * l] = expf(d1) - expf(d2) + lam0; LAMV[2 * l + 1] = 1.f - lam0; } }
        }
    }
}

__device__ __forceinline__ void phase_normmod(Frame F, const float* lat, const float* ctx, const float* g, const float* mod, int soff, bool do_ctx, bf16_t* H) {
    F.tid = opaque_tid(); F.lane = F.tid & 63; F.wave = __builtin_amdgcn_readfirstlane(F.tid >> 6);
    const int gw = F.vcu * NWAVES + F.wave, NGW = F.G * NWAVES;
    for (int r = gw; r < NTOK; r += NGW) {
        const int b = r / LTOK, j = r - b * LTOK; const bool isc = j < CTXL;
        if (isc && !do_ctx) continue;
        const float* src = isc ? ctx + ((size_t)b * CTXL + j) * D : lat + ((size_t)b * SEQ + (j - CTXL)) * D;
        const float* mv = mod + (size_t)(isc ? 32 : b) * MODW + soff;
        const f32x4* xr = (const f32x4*)src + F.lane;
        f32x4 v[4]; float s = 0.f;
#pragma unroll
        for (int q = 0; q < 4; ++q) { v[q] = xr[64 * q]; s += (v[q][0] * v[q][0] + v[q][1] * v[q][1]) + (v[q][2] * v[q][2] + v[q][3] * v[q][3]); }
        const float rstd = rsqrtf(wave_sum(s) * (1.f / D) + EPS);
        u32x2* o8 = (u32x2*)(H + (size_t)r * D) + F.lane;
#pragma unroll
        for (int q = 0; q < 4; ++q) { const int cidx = 4 * F.lane + 256 * q; const f32x4 gg = *(const f32x4*)(g + cidx), sh = *(const f32x4*)(mv + cidx), sc = *(const f32x4*)(mv + 1024 + cidx);
            const f32x4 y = (v[q] * rstd * gg) * (sc + 1.f) + sh;
            u32x2 o; o.x = cvtpk(y[0], y[1]); o.y = cvtpk(y[2], y[3]); o8[64 * q] = o; }
    }
}

__device__ __forceinline__ void phase_pool(Frame F, const bf16_t* U, bf16_t* M, bool do_ctx) {
    F.tid = opaque_tid(); F.lane = F.tid & 63; F.wave = __builtin_amdgcn_readfirstlane(F.tid >> 6);
    const int gw = F.vcu * NWAVES + F.wave, NGW = F.G * NWAVES;
    const int half = 1 << (F.lane >> 4);
    for (int r = gw; r < NTOK; r += NGW) {
        const int b = r / LTOK, j = r - b * LTOK; const bool isc = j < CTXL;
        if (isc && !do_ctx) continue;
        const int L = isc ? CTXL : SEQ, t = isc ? j : j - CTXL; const size_t base = (size_t)b * LTOK + (isc ? 0 : CTXL);
        const int lo = max(t - half, 0), hi = min(t + half, L);
        float a[8];
#pragma unroll
        for (int i = 0; i < 8; ++i) a[i] = 0.f;
        for (int tt = lo; tt < hi; ++tt) { const u32x4 w = *(const u32x4*)(U + (base + tt) * 512 + 8 * F.lane);
            a[0] += bflo(w.x); a[1] += bfhi(w.x); a[2] += bflo(w.y); a[3] += bfhi(w.y); a[4] += bflo(w.z); a[5] += bfhi(w.z); a[6] += bflo(w.w); a[7] += bfhi(w.w); }
        const float ic = 1.f / (float)(hi - lo);
        const u32x4 w = *(const u32x4*)(U + (size_t)r * 512 + 8 * F.lane);
        u32x4 o; o.x = cvtpk(a[0] * ic - bflo(w.x), a[1] * ic - bfhi(w.x)); o.y = cvtpk(a[2] * ic - bflo(w.y), a[3] * ic - bfhi(w.y));
        o.z = cvtpk(a[4] * ic - bflo(w.z), a[5] * ic - bfhi(w.z)); o.w = cvtpk(a[6] * ic - bflo(w.w), a[7] * ic - bfhi(w.w));
        *(u32x4*)(M + (size_t)r * 512 + 8 * F.lane) = o;
    }
}

__device__ __forceinline__ void phase_router(Frame F, const float* x1, const float* g, const float* mod, bf16_t* H) {
    F.tid = opaque_tid(); F.lane = F.tid & 63; F.wave = __builtin_amdgcn_readfirstlane(F.tid >> 6);
    LAS float* WR = (LAS float*)F.lds;
    LAS int* SEL = (LAS int*)(F.lds + 32768);
    LAS float* SW = (LAS float*)(F.lds + 32768 + 2048);
    LAS int* LCNT = (LAS int*)(F.lds + 32768 + 4096);
    unsigned* LIST = (unsigned*)(F.ws + WS_LIST); float* WTS = (float*)(F.ws + WS_WTS);
    for (int i = F.tid; i < 8192; i += NTHR) WR[i] = F.in[22][i];
    for (int ch = blockIdx.x; ch < NLAT / 256; ch += F.G) {
        if (F.tid < 16) LCNT[F.tid] = 0;
        __syncthreads();
        for (int rr = F.wave; rr < 256; rr += NWAVES) {
            const int tok = ch * 256 + rr, b = tok >> 11;
            const float* mv = mod + (size_t)b * MODW + 3 * D;
            const f32x4* xr = (const f32x4*)(x1 + (size_t)tok * D) + F.lane;
            f32x4 v[4]; float s = 0.f;
#pragma unroll
            for (int q = 0; q < 4; ++q) { v[q] = xr[64 * q]; s += (v[q][0] * v[q][0] + v[q][1] * v[q][1]) + (v[q][2] * v[q][2] + v[q][3] * v[q][3]); }
            const float rstd = rsqrtf(wave_sum(s) * (1.f / D) + EPS);
            u32x2* o8 = (u32x2*)(H + ((size_t)b * LTOK + CTXL + (tok & 2047)) * D) + F.lane;
            float lg[8];
#pragma unroll
            for (int e = 0; e < 8; ++e) lg[e] = 0.f;
#pragma unroll
            for (int q = 0; q < 4; ++q) { const int cidx = 4 * F.lane + 256 * q; const f32x4 gg = *(const f32x4*)(g + cidx), sh = *(const f32x4*)(mv + cidx), sc = *(const f32x4*)(mv + 1024 + cidx);
                const f32x4 y = (v[q] * rstd * gg) * (sc + 1.f) + sh;
                u32x2 o; o.x = cvtpk(y[0], y[1]); o.y = cvtpk(y[2], y[3]); o8[64 * q] = o;
#pragma unroll
                for (int i = 0; i < 4; ++i) { const LAS f32x4* wr = (const LAS f32x4*)(WR + (cidx + i) * 8); const f32x4 w0 = wr[0], w1 = wr[1];
                    lg[0] += y[i] * w0[0]; lg[1] += y[i] * w0[1]; lg[2] += y[i] * w0[2]; lg[3] += y[i] * w0[3]; lg[4] += y[i] * w1[0]; lg[5] += y[i] * w1[1]; lg[6] += y[i] * w1[2]; lg[7] += y[i] * w1[3]; } }
#pragma unroll
            for (int e = 0; e < 8; ++e) lg[e] = wave_sum(lg[e]);
            if (F.lane == 0) {
                int e1 = 0; float v1 = lg[0];
#pragma unroll
                for (int e = 1; e < 8; ++e) if (lg[e] > v1) { v1 = lg[e]; e1 = e; }
                int e2 = 0; float v2 = -3.0e38f;
#pragma unroll
                for (int e = 0; e < 8; ++e) if (e != e1 && lg[e] > v2) { v2 = lg[e]; e2 = e; }
                const float p2 = expf(v2 - v1), w1 = 1.f / (1.f + p2);
                SEL[2 * rr] = e1; SEL[2 * rr + 1] = e2; SW[2 * rr] = w1; SW[2 * rr + 1] = p2 * w1;
            }
        }
        __syncthreads();
        int e1 = 0, e2 = 0, i1 = 0, i2 = 0;
        if (F.tid < 256) { e1 = SEL[2 * F.tid]; e2 = SEL[2 * F.tid + 1]; i1 = atomicAdd((int*)&LCNT[e1], 1); i2 = atomicAdd((int*)&LCNT[e2], 1); }
        __syncthreads();
        if (F.tid < 8) LCNT[8 + F.tid] = (int)__hip_atomic_fetch_add(F.ctl + CW_CNT + 64 * F.tid, (unsigned)LCNT[F.tid], __ATOMIC_RELAXED, __HIP_MEMORY_SCOPE_AGENT);
        __syncthreads();
        if (F.tid < 256) { const unsigned tok = (unsigned)(ch * 256 + F.tid);
            LIST[(size_t)e1 * NLAT + LCNT[8 + e1] + i1] = tok * 2u; LIST[(size_t)e2 * NLAT + LCNT[8 + e2] + i2] = tok * 2u + 1u;
            WTS[tok * 2u] = SW[2 * F.tid]; WTS[tok * 2u + 1u] = SW[2 * F.tid + 1]; }
        __syncthreads();
    }
    __syncthreads();
    LAS float* scr = (LAS float*)(F.lds + F.wave * 8448);
    const int gw = F.vcu * NWAVES + F.wave, NGW = F.G * NWAVES;
    bf16_t* WUPE = (bf16_t*)(F.ws + WS_WUPE); bf16_t* WDNE = (bf16_t*)(F.ws + WS_WDNE);
    constexpr int I_E = 16 * 44, I_D = 22 * 32;
    for (int it = gw; it < NE * (2 * I_E + I_D); it += NGW) {
        const int e = it / (2 * I_E + I_D); int r = it - e * (2 * I_E + I_D);
        if (r < 2 * I_E) { const int q = r / I_E; r -= q * I_E; const int kb = r / 44, nb = r % 44, n0 = nb * 32;
            const float* W = (q ? F.in[24] : F.in[23]) + (size_t)e * 1024 * FFE;
            tr_item(W, FFE, kb * 64, n0, WUPE + (size_t)e * 2816 * 1024, 1024, (n0 >> 7) * 256 + q * 128 - (n0 & ~127), 0, false, scr, F.lane); }
        else { r -= 2 * I_E; const int kb = r / 32, nb = r % 32;
            tr_item(F.in[25] + (size_t)e * FFE * 1024, 1024, kb * 64, nb * 32, WDNE + (size_t)e * 1024 * FFE, FFE, 0, 0, false, scr, F.lane); }
    }
}

__device__ __forceinline__ void phase_gather(Frame F, const bf16_t* H, bf16_t* HS) {
    F.tid = opaque_tid(); F.lane = F.tid & 63; F.wave = __builtin_amdgcn_readfirstlane(F.tid >> 6);
    MoeInfo mi; mi.load(F.ctl);
    const unsigned* LIST = (const unsigned*)(F.ws + WS_LIST);
    const int gw = F.vcu * NWAVES + F.wave, NGW = F.G * NWAVES; const int nrows = mi.tb[NE] * 256;
    for (int rr = gw; rr < nrows; rr += NGW) {
        const int rt = rr >> 8; int e, t0, ce; mi.lookup(rt, e, t0, ce); const int slot = rr - t0 * 256;
        u32x4 a = (u32x4){0u, 0u, 0u, 0u}, b2 = a;
        if (slot < ce) { const unsigned tok = LIST[(size_t)e * NLAT + slot] >> 1; const u32x4* src = (const u32x4*)(H + ((size_t)(tok >> 11) * LTOK + CTXL + (tok & 2047u)) * D) + F.lane; a = src[0]; b2 = src[64]; }
        u32x4* dst = (u32x4*)(HS + (size_t)rr * D) + F.lane; dst[0] = a; dst[64] = b2;
    }
}

__device__ __forceinline__ void phase_final(Frame F, float* x, const bf16_t* YM, const float* mod, const float* fg) {
    F.tid = opaque_tid(); F.lane = F.tid & 63; F.wave = __builtin_amdgcn_readfirstlane(F.tid >> 6);
    const int gw = F.vcu * NWAVES + F.wave, NGW = F.G * NWAVES;
    for (int tok = gw; tok < NLAT; tok += NGW) {
        const int b = tok >> 11; const float* gate = mod + (size_t)b * MODW + 5 * D;
        f32x4* xr = (f32x4*)(x + (size_t)tok * D) + F.lane;
        const u32x2* y0 = (const u32x2*)(YM + (size_t)tok * D) + F.lane; const u32x2* y1 = (const u32x2*)(YM + ((size_t)NLAT + tok) * D) + F.lane;
        f32x4 v[4]; float s = 0.f;
#pragma unroll
        for (int q = 0; q < 4; ++q) { const f32x4 xv = xr[64 * q]; const u32x2 a = y0[64 * q], c = y1[64 * q]; const f32x4 gg = *(const f32x4*)(gate + 4 * F.lane + 256 * q);
            const f32x4 yy = (f32x4){bflo(a.x) + bflo(c.x), bfhi(a.x) + bfhi(c.x), bflo(a.y) + bflo(c.y), bfhi(a.y) + bfhi(c.y)};
            v[q] = xv + gg * yy; s += (v[q][0] * v[q][0] + v[q][1] * v[q][1]) + (v[q][2] * v[q][2] + v[q][3] * v[q][3]); }
        const float rstd = rsqrtf(wave_sum(s) * (1.f / D) + EPS);
#pragma unroll
        for (int q = 0; q < 4; ++q) { const f32x4 gg = *(const f32x4*)(fg + 4 * F.lane + 256 * q); xr[64 * q] = v[q] * rstd * gg; }
    }
}

constexpr int N_PHASES = 19;
struct Args { const float* in[27]; float* out; unsigned char* ws; int ph_lo, ph_hi; };
__global__ void __launch_bounds__(NTHR, 2) dit_fwd(Args args) {
    extern __shared__ __attribute__((aligned(16))) unsigned char lds_raw[];
    Frame F;
    F.lds = (LAS unsigned char*)lds_raw; F.ws = args.ws; F.ctl = (unsigned*)(args.ws + WS_CTL); F.out = args.out;
    F.in = args.in;
    F.tid = threadIdx.x; F.lane = F.tid & 63; F.wave = __builtin_amdgcn_readfirstlane(F.tid >> 6);
    F.G = gridDim.x; { const int bx = blockIdx.x; F.vcu = (F.G % 8 == 0) ? (bx % 8) * (F.G / 8) + bx / 8 : bx; }
    volatile LAS unsigned* xbw = (volatile LAS unsigned*)(F.lds + LDS_CTRL);
    if (F.tid < 4) xbw[F.tid] = 0u;
    __syncthreads();
    const int lo = args.ph_lo, hi = args.ph_hi;
    XcdBarrier bar; bar.bar = F.ctl + CW_BAR; bar.x = 0; bar.st = xbw;
    if (hi - lo > 1) bar = xcd_barrier_post(F.ctl + CW_BAR, xbw);
#ifndef SITE_MASK
#define SITE_MASK 0xFFFFFFFFu
#endif
#define SITE(n) (((SITE_MASK) >> (n)) & 1u)
#define IN(k) (lo <= (k) && (k) < hi)
#define SEAM(k) do { if (IN(k) && IN((k) + 1)) xcd_barrier(bar); } while (0)

    unsigned char* ws = F.ws;
    float* MOD = (float*)(ws + WS_MOD); const float* COS = (const float*)(ws + WS_TAB); const float* SIN = COS + 1024; const float* LAMV = SIN + 1024;
    float* XC = (float*)(ws + WS_XC);
    bf16_t* H = (bf16_t*)(ws + WS_H); bf16_t* U = (bf16_t*)(ws + WS_U); bf16_t* Q = (bf16_t*)(ws + WS_Q); bf16_t* KB = (bf16_t*)(ws + WS_K); bf16_t* VT = (bf16_t*)(ws + WS_VT); bf16_t* Gt = (bf16_t*)(ws + WS_G);
    bf16_t* Mp = (bf16_t*)(ws + WS_M); bf16_t* AY = (bf16_t*)(ws + WS_AY); bf16_t* Y = (bf16_t*)(ws + WS_Y); bf16_t* PG = (bf16_t*)(ws + WS_PG); bf16_t* HID = (bf16_t*)(ws + WS_HID);
    const int c = (int)blockIdx.x;

    if (SITE(0) && IN(0)) { phase_prologue(F); } SEAM(0);
    if (SITE(1) && IN(1)) { phase_normmod(F, F.in[0], F.in[2], F.in[6], MOD, 0, true, H); } SEAM(1);

    for (int l = 0; l < 2; ++l) {
        const int pb = 2 + 8 * l; const bool last = (l == 1);
        const float* modl = MOD + (size_t)l * 33 * MODW;
        const float* latsrc = last ? F.out : F.in[0]; const float* ctxsrc = F.in[2];
        if (SITE(2) && IN(pb)) {
            ZSched S; S.init(F.G, c, last ? 1 : 0, H, ws + WS_WZ + (size_t)l * 9 * MiB, ws + WS_WV + (size_t)l * 2 * MiB);
            ZEpi E{U, Q, KB, Gt, VT, COS, SIN};
            pg8::gemm_phase(F.lds, 1024, S, E);
        } SEAM(pb);
        if (SITE(3) && IN(pb + 1)) {
            phase_pool(F, U, Mp, !last);
            const float lam = LAMV[2 * l], osc = LAMV[2 * l + 1]; const float* subg = F.in[15] + l * VD;
            for (int i = 0;; ++i) { const int L = i * F.G + F.vcu; if (L >= NB * NH * 16) break; const int bh = L >> 4, qt = L & 15, b = bh >> 3, h = bh & 7;
                att::attn_unit(F.lds, Q, KB, VT, AY, b, h, (size_t)b * LTOK + CTXL + qt * 128, 36, lam, osc, subg); }
            if (!last) for (int i = 0;; ++i) { const int L = i * F.G + F.vcu; if (L >= NB * NH * 2) break; const int bh = L >> 1, qt = L & 1, b = bh >> 3, h = bh & 7;
                att::attn_unit(F.lds, Q, KB, VT, AY, b, h, (size_t)b * LTOK + qt * 128, 4, lam, osc, subg); }
        } SEAM(pb + 1);
        if (SITE(4) && IN(pb + 2)) {
            { PlainSched S; S.init(F.G, c, last ? 1 : 0, 4, Mp, ws + WS_WEFF + (size_t)l * MiB, 512); MergeEpi<false> E{PG, nullptr, Gt}; pg8::gemm_phase(F.lds, 512, S, E); }
            { PlainSched S; S.init(F.G, c, last ? 1 : 0, 4, AY, ws + WS_WAP + (size_t)l * 2 * MiB, 1024); MergeEpi<true> E{Y, PG, Gt}; pg8::gemm_phase(F.lds, 1024, S, E); }
        } SEAM(pb + 2);
        if (SITE(5) && IN(pb + 3)) {
            PlainSched S; S.init(F.G, c, last ? 1 : 0, 4, Y, ws + WS_WOUT + (size_t)l * 2 * MiB, 1024);
            ResEpi E{latsrc, ctxsrc, F.out, XC, modl, 2 * D};
            pg8::gemm_phase(F.lds, 1024, S, E);
        } SEAM(pb + 3);
        if (!last) {
            if (SITE(6) && IN(pb + 4)) { phase_normmod(F, F.out, XC, F.in[7], modl, 3 * D, true, H); } SEAM(pb + 4);
            if (SITE(7) && IN(pb + 5)) { PlainSched S; S.init(F.G, c, 0, 22, H, ws + WS_WUP0, 1024); UpEpi E{HID, FFP}; pg8::gemm_phase(F.lds, 1024, S, E); } SEAM(pb + 5);
            if (SITE(8) && IN(pb + 6)) { PlainSched S; S.init(F.G, c, 0, 4, HID, ws + WS_WDN0, FFP); ResEpi E{F.out, XC, F.out, XC, modl, 5 * D}; pg8::gemm_phase(F.lds, FFP, S, E); } SEAM(pb + 6);
            if (SITE(9) && IN(pb + 7)) { phase_normmod(F, F.out, XC, F.in[6] + D, MOD + (size_t)33 * MODW, 0, true, H); } SEAM(pb + 7);
        } else {
            bf16_t* HS = (bf16_t*)(ws + WS_HS); bf16_t* HIDM = (bf16_t*)(ws + WS_HIDM); bf16_t* YM = (bf16_t*)(ws + WS_YM);
            if (SITE(10) && IN(pb + 4)) { phase_router(F, F.out, F.in[7] + D, modl, H); } SEAM(pb + 4);
            if (SITE(11) && IN(pb + 5)) { phase_gather(F, H, HS); } SEAM(pb + 5);
            if (SITE(12) && IN(pb + 6)) { MoeInfo mi; mi.load(F.ctl); MoeSched S; S.init(F.G, c, 11, HS, ws + WS_WUPE, 1024, 2816, mi); UpEpi E{HIDM, FFE}; pg8::gemm_phase(F.lds, 1024, S, E); } SEAM(pb + 6);
            if (SITE(13) && IN(pb + 7)) { MoeInfo mi; mi.load(F.ctl); MoeSched S; S.init(F.G, c, 4, HIDM, ws + WS_WDNE, FFE, 1024, mi);
                MoeDownEpi E{YM, (const unsigned*)(ws + WS_LIST), (const float*)(ws + WS_WTS), mi}; pg8::gemm_phase(F.lds, FFE, S, E); } SEAM(pb + 7);
            if (SITE(14) && IN(pb + 8)) { phase_final(F, F.out, YM, modl, F.in[26]); }
        }
    }
#undef IN
#undef SEAM
}

extern "C" void kernel_launch(void* const* d_in, const int* in_sizes, int n_in, void* d_out, int out_size, void* d_ws, size_t ws_size, hipStream_t stream) {
    static int grid = 0;
    if (grid == 0) {
        if (n_in != 27 || ws_size < WS_END) { fprintf(stderr, "kernel_launch: unexpected n_in %d or ws %zu\n", n_in, ws_size); grid = -1; return; }
        int dev = 0, cus = 0;
        if (hipGetDevice(&dev) != hipSuccess || hipDeviceGetAttribute(&cus, hipDeviceAttributeMultiprocessorCount, dev) != hipSuccess) { grid = -1; return; }
        if (hipFuncSetAttribute((const void*)dit_fwd, hipFuncAttributeMaxDynamicSharedMemorySize, LDS_BYTES) != hipSuccess) { fprintf(stderr, "kernel_launch: hipFuncSetAttribute failed\n"); grid = -1; return; }
        (void)hipGetLastError();
        grid = cus;
    }
    if (grid < 0) return;
    (void)hipMemsetAsync((char*)d_ws + WS_CTL, 0, CTL_ZERO_BYTES, stream);
    Args a{};
    for (int i = 0; i < 27; ++i) a.in[i] = (const float*)d_in[i];
    a.out = (float*)d_out; a.ws = (unsigned char*)d_ws;
#if MK_ONE_LAUNCH
    a.ph_lo = 0; a.ph_hi = N_PHASES;
    hipLaunchKernelGGL(dit_fwd, dim3(grid), dim3(NTHR), LDS_BYTES, stream, a);
#else
    for (int p = 0; p < N_PHASES; ++p) { a.ph_lo = p; a.ph_hi = p + 1; hipLaunchKernelGGL(dit_fwd, dim3(grid), dim3(NTHR), LDS_BYTES, stream, a); }
#endif
}
```

```cpp
#include <hip/hip_runtime.h>
#include <cstdio>
#include <cstdint>

#define LAS __attribute__((address_space(3)))
#define GAS __attribute__((address_space(1)))
typedef unsigned short bf16_t;
typedef short bf16x8 __attribute__((ext_vector_type(8)));
typedef float f32x4 __attribute__((ext_vector_type(4)));
typedef float f32x16 __attribute__((ext_vector_type(16)));
typedef unsigned u32x4 __attribute__((ext_vector_type(4)));
typedef unsigned u32x2 __attribute__((ext_vector_type(2)));
typedef float f32x2_t __attribute__((ext_vector_type(2)));
typedef __bf16 bf16x2_t __attribute__((ext_vector_type(2)));

#ifndef PROBE_MASK
#define PROBE_MASK 0u
#endif
#ifndef PG8_ALIGN
#define PG8_ALIGN 1
#endif
#ifndef ATT_PRIO
#define ATT_PRIO 0
#ifndef REV_ORDER
#define REV_ORDER 1
#endif
#ifndef ROW_NT
#define ROW_NT 1
#endif
#endif
#ifndef XUP
#define XUP 0
#endif
#ifndef GEMM_STAGGER
#define GEMM_STAGGER 0
#endif
#ifndef MK_ONE_LAUNCH
#define MK_ONE_LAUNCH 1
#endif

constexpr int D = 1024, NB = 32, SEQ = 2048, CTXL = 256, LTOK = SEQ + CTXL, NTOK = NB * LTOK, NRT = NTOK / 256;
constexpr int NLAT = NB * SEQ;
constexpr int NH = 8, VD = 128;
constexpr int FF = 2752, FFP = 2816, NE = 8, FFE = 1408;
constexpr int MODW = 6 * D;
constexpr float EPS = 1e-6f;
constexpr float LOG2E = 1.4426950408889634f;
constexpr float QSCALE = 0.125f * LOG2E;
constexpr int NWAVES = 8, NTHR = 512;

constexpr size_t MiB = 1u << 20;
constexpr size_t WS_CTL = 0, CTL_ZERO_BYTES = 65536;
constexpr size_t WS_MOD = 65536;
constexpr size_t WS_TAB = 1703936;
constexpr size_t WS_XC = 2 * MiB;
constexpr size_t WS_W = 34 * MiB;
constexpr size_t WS_WZ = WS_W, WS_WV = WS_W + 18 * MiB, WS_WM = WS_W + 22 * MiB, WS_WOUT = WS_W + 28 * MiB, WS_WUP0 = WS_W + 32 * MiB, WS_WDN0 = WS_W + 43 * MiB;
constexpr size_t WS_H = 83 * MiB, WS_MA = 83 * MiB, WS_U = 299 * MiB, WS_Q = 371 * MiB, WS_K = 515 * MiB, WS_VT = 659 * MiB, WS_G = 803 * MiB, WS_END = 982 * MiB;
constexpr size_t WS_Y = WS_K, WS_HID = WS_U;
constexpr size_t WS_YM = 299 * MiB, WS_HIDM = 555 * MiB, WS_WUPE = 913 * MiB, WS_WDNE = 957 * MiB, WS_LIST = 979 * MiB, WS_WTS = 981 * MiB;
constexpr int MAP = 1536;
static_assert(WS_WDN0 + (size_t)D * FFP * 2 <= WS_H, "weights");
static_assert(WS_MA + (size_t)NTOK * MAP * 2 <= WS_U && WS_G + (size_t)NTOK * 2048 <= WS_END, "ma / g");
static_assert(WS_HID + (size_t)NTOK * FFP * 2 <= WS_END, "hid");
static_assert(WS_YM + (size_t)2 * NLAT * D * 2 <= WS_HIDM && WS_HIDM + (size_t)133120 * FFE * 2 <= WS_WUPE && WS_WTS + (size_t)NLAT * 8 <= WS_END, "moe");
constexpr int CW_BAR = 1024, CW_CNT = 8192;

constexpr int N_PHASES = 18;
constexpr int LDS_BYTES = 163840;
constexpr int LDS_CTRL = LDS_BYTES - 256;

__device__ __forceinline__ unsigned cvtpk(float lo, float hi) { f32x2_t v = {lo, hi}; bf16x2_t b = __builtin_convertvector(v, bf16x2_t); return __builtin_bit_cast(unsigned, b); }
__device__ __forceinline__ float bflo(unsigned w) { return __uint_as_float(w << 16); }
__device__ __forceinline__ float bfhi(unsigned w) { return __uint_as_float(w & 0xffff0000u); }
__device__ __forceinline__ u32x4 pack8(const f32x4 a, const f32x4 b) { u32x4 w; w.x = cvtpk(a[0], a[1]); w.y = cvtpk(a[2], a[3]); w.z = cvtpk(b[0], b[1]); w.w = cvtpk(b[2], b[3]); return w; }
__device__ __forceinline__ float shx(float v, int o, int lane) { return __int_as_float(__builtin_amdgcn_ds_bpermute((lane ^ o) << 2, __float_as_int(v))); }
__device__ __forceinline__ float wave_sum(float v, int lane) {
#pragma unroll
    for (int o = 1; o < 64; o <<= 1) v += shx(v, o, lane);
    return v;
}
__device__ __forceinline__ float pair_sum(float v) { auto rr = __builtin_amdgcn_permlane32_swap(__float_as_uint(v), __float_as_uint(v), false, false); return __uint_as_float(rr[0]) + __uint_as_float(rr[1]); }
__device__ __forceinline__ float pair_max(float v) { auto rr = __builtin_amdgcn_permlane32_swap(__float_as_uint(v), __float_as_uint(v), false, false); return fmaxf(__uint_as_float(rr[0]), __uint_as_float(rr[1])); }
__device__ __forceinline__ float fast_sigmoid(float x) { return __builtin_amdgcn_rcpf(1.f + __builtin_amdgcn_exp2f(-LOG2E * x)); }
#define LDS_WAIT() asm volatile("s_waitcnt lgkmcnt(0)" ::: "memory")
__device__ __forceinline__ int opaque_tid(int wave) { unsigned z = 0u; asm volatile("" : "+v"(z)); return (wave << 6) | (int)__builtin_amdgcn_mbcnt_hi(~0u, __builtin_amdgcn_mbcnt_lo(~0u, z)); }

#define XB_TMO      128
#define XB_XCNT(j)  (256  + 64 * (j))
#define XB_XSUB(j)  (1280 + 64 * (j))
#define XB_XGEN(j)  (2304 + 64 * (j))
#define XB_TOP      3328
#define XB_TOPGEN   3392
#define XCD_BAR_WORDS 3456
#define XB_SPIN_CAP (1u << 22)
__device__ __forceinline__ unsigned xb_ld(unsigned* p)              { return __hip_atomic_load(p, __ATOMIC_RELAXED, __HIP_MEMORY_SCOPE_AGENT); }
__device__ __forceinline__ unsigned xb_add(unsigned* p, unsigned v) { return __hip_atomic_fetch_add(p, v, __ATOMIC_RELAXED, __HIP_MEMORY_SCOPE_AGENT); }
__device__ __forceinline__ unsigned xb_xcc_id() { return (unsigned)__builtin_amdgcn_s_getreg((3 << 11) | 20) & 0xFu; }
#define XB_SPIN(cond, bar) do { unsigned _sp = 0; while (cond) { __builtin_amdgcn_s_sleep(1); \
    if ((++_sp & 255u) == 0u) { if (xb_ld(&(bar)[XB_TMO])) break; if (_sp > XB_SPIN_CAP) { atomicAdd(&(bar)[XB_TMO], 1u); break; } } } } while (0)
struct XcdBarrier { unsigned* bar; unsigned x; volatile LAS unsigned* st; };
__device__ __forceinline__ XcdBarrier xcd_barrier_post(unsigned* bar, volatile LAS unsigned* st) {
    XcdBarrier b; b.bar = bar; b.x = xb_xcc_id(); b.st = st;
    if (threadIdx.x == 0) (void)xb_add(&bar[XB_XCNT(b.x)], 1u);
    return b;
}
__device__ __forceinline__ void xcd_barrier_complete(unsigned* bar, unsigned x, unsigned& nloc, unsigned& nx) {
    const unsigned G = gridDim.x * gridDim.y * gridDim.z;
    unsigned sum, cnt, mine, sp = 0u;
    for (;;) {
        sum = 0u; cnt = 0u; mine = 0u;
#pragma unroll
        for (unsigned j = 0; j < 16; ++j) { const unsigned c = xb_ld(&bar[XB_XCNT(j)]); sum += c; cnt += (c > 0u) ? 1u : 0u; mine = (j == x) ? c : mine; }
        if (sum == G) break;
        __builtin_amdgcn_s_sleep(1);
        if ((++sp & 255u) == 0u) { if (xb_ld(&bar[XB_TMO])) break; if (sp > XB_SPIN_CAP) { atomicAdd(&bar[XB_TMO], 1u); break; } }
    }
    nloc = mine > 0u ? mine : 1u; nx = cnt > 0u ? cnt : 1u;
}
__device__ __forceinline__ void xcd_barrier(const XcdBarrier& b) {
    asm volatile("s_waitcnt vmcnt(0)" ::: "memory");
    __syncthreads();
    if (threadIdx.x == 0) {
        unsigned* bar = b.bar;
        __builtin_amdgcn_s_waitcnt(0);
        unsigned nloc = b.st[0], nx = b.st[1];
        if (nloc == 0u) { xcd_barrier_complete(bar, b.x, nloc, nx); b.st[0] = nloc; b.st[1] = nx; }
        const unsigned old = xb_add(&bar[XB_XSUB(b.x)], 1u);
        const unsigned gen = old / nloc;
        if (old + 1u == (gen + 1u) * nloc) {
            __builtin_amdgcn_fence(__ATOMIC_RELEASE, "agent");
            asm volatile("s_waitcnt vmcnt(0)" ::: "memory");
            const unsigned og = xb_add(&bar[XB_TOP], 1u);
            const unsigned tg = og / nx;
            if (og + 1u == (tg + 1u) * nx) xb_add(&bar[XB_TOPGEN], 1u);
            else XB_SPIN(xb_ld(&bar[XB_TOPGEN]) == tg, bar);
            __builtin_amdgcn_fence(__ATOMIC_ACQUIRE, "agent");
            xb_add(&bar[XB_XGEN(b.x)], 1u);
            asm volatile("s_waitcnt vmcnt(0)" ::: "memory");
        } else {
            XB_SPIN(xb_ld(&bar[XB_XGEN(b.x)]) == gen, bar);
            __builtin_amdgcn_fence(__ATOMIC_ACQUIRE, "agent");
            asm volatile("s_waitcnt vmcnt(0)" ::: "memory");
        }
    }
    __syncthreads();
}

namespace pg8 {
constexpr int BM = 256, BK = 64, HALF = 128, HTB = HALF * BK * 2, NXCD = 8, WGM = 8;
__host__ __device__ __forceinline__ int lds_byte(int r, int c) { const int st = (r >> 4) * 2 + (c >> 5), rr = r & 15, cc = c & 31, ob = rr * 64 + cc * 2; return st * 1024 + (ob ^ (((ob >> 9) & 1) << 5)); }
__host__ __device__ __forceinline__ void stage_rc(int b, int& R, int& C) { const int st = b / 1024, sb = b % 1024, swz = sb ^ (((sb >> 9) & 1) << 5); R = (st >> 1) * 16 + swz / 64; C = (st & 1) * 32 + (swz % 64) / 2; }
__host__ __device__ __forceinline__ int perm32(int rho) { const int n = rho >> 4, i = rho & 15; return 8 * (i >> 2) + 4 * n + (i & 3); }
struct Unit { int pm, pn, kind; };
struct GridMap {
    int nM, nN, nwg;
    __device__ __forceinline__ void init(int nM_, int nN_) { nM = nM_; nN = nN_; nwg = nM_ * nN_; }
    __device__ __forceinline__ void map(int L, int& pm, int& pn) const {
        int wgid = L; { const int q = nwg / NXCD, r = nwg % NXCD, xcd = wgid % NXCD, off = wgid / NXCD; wgid = (xcd < r ? xcd * (q + 1) : r * (q + 1) + (xcd - r) * q) + off; }
        const int nig = WGM * nN, gid = wgid / nig, fm = gid * WGM, gsz = (nM - fm) < WGM ? (nM - fm) : WGM;
        pm = fm + ((wgid % nig) % gsz); pn = (wgid % nig) / gsz;
    }
};
template <bool GATHER = false, class Epi, class Sched>
__device__ __forceinline__ void gemm_phase(LAS unsigned char* lds, const int wv, const int K, const Sched& S, const Epi& E) {
    const int tid = opaque_tid(wv), wid = __builtin_amdgcn_readfirstlane(tid >> 6), lane = tid & 63, wr = wid >> 2, wc = wid & 3, fr = lane & 15, fq = lane >> 4;
    int nt = K / BK;
    unsigned voffA[2], voffB[2]; int RA[2];
#pragma unroll
    for (int i = 0; i < 2; ++i) { int R, C; stage_rc(tid * 16 + i * 8192, R, C); const int Rb = (R & ~31) + perm32(R & 31); RA[i] = R;
        voffA[i] = GATHER ? (unsigned)C * 2u : (unsigned)(R * K + C) * 2u; voffB[i] = (unsigned)(Rb * K + C) * 2u; }
    unsigned gC[2][2] = {{0u, 0u}, {0u, 0u}}, gN[2][2] = {{0u, 0u}, {0u, 0u}};
    const size_t kstep = (size_t)(BK * 2);
    const size_t hstep = (size_t)HALF * K * 2;
    const unsigned ldsw = (unsigned)wid * 1024u;
    const int aoff = lds_byte(wr * 64 + fr, fq * 8), boff = lds_byte(wc * 32 + fr, fq * 8);
#define PG8_SA(b, h) (((b) * 2 + (h)) * HTB)
#define PG8_SB(b, h) ((4 + (b) * 2 + (h)) * HTB)
#define PG8_STAGE(bufoff, gbase, voff) do { _Pragma("unroll") for (int _i = 0; _i < 2; ++_i) \
        __builtin_amdgcn_global_load_lds((const unsigned*)((const char*)(gbase) + (voff)[_i]), (LAS unsigned*)(lds + (bufoff) + ldsw + _i * 8192), 16, 0, 0); } while (0)
#define PG8_STAGE2(bufoff, gbase, o0, o1) do { \
        __builtin_amdgcn_global_load_lds((const unsigned*)((const char*)(gbase) + (o0)), (LAS unsigned*)(lds + (bufoff) + ldsw), 16, 0, 0); \
        __builtin_amdgcn_global_load_lds((const unsigned*)((const char*)(gbase) + (o1)), (LAS unsigned*)(lds + (bufoff) + ldsw + 8192), 16, 0, 0); } while (0)
#define PG8_LDA(dst, b, h) do { _Pragma("unroll") for (int m = 0; m < 4; ++m) _Pragma("unroll") for (int k = 0; k < 2; ++k) dst[m][k] = *(const LAS bf16x8*)(lds + PG8_SA(b, h) + aoff + m * 2048 + k * 1024); } while (0)
#define PG8_LDB(dst, b, h) do { _Pragma("unroll") for (int n = 0; n < 2; ++n) _Pragma("unroll") for (int k = 0; k < 2; ++k) dst[n][k] = *(const LAS bf16x8*)(lds + PG8_SB(b, h) + boff + n * 2048 + k * 1024); } while (0)
#define PG8_MMA(ai, bj, At, Bt) do { __builtin_amdgcn_s_setprio(1); _Pragma("unroll") for (int m = 0; m < 4; ++m) _Pragma("unroll") for (int n = 0; n < 2; ++n) _Pragma("unroll") for (int k = 0; k < 2; ++k) \
        acc[ai][bj][m][n] = __builtin_amdgcn_mfma_f32_16x16x32_bf16(Bt[n][k], At[m][k], acc[ai][bj][m][n], 0, 0, 0); __builtin_amdgcn_s_setprio(0); } while (0)
#define PG8_WAIT_V(n) asm volatile("s_waitcnt vmcnt(" #n ")" ::: "memory")
#define PG8_WAIT_L(n) asm volatile("s_waitcnt lgkmcnt(" #n ")" ::: "memory")
#define PG8_BAR __builtin_amdgcn_s_barrier()
#define PG8_SCHED __builtin_amdgcn_sched_barrier(0)
#define PG8_ITER(t) do { \
            const bool last = (t == nt - 2); \
            const char* a1 = cA + (size_t)(t + 1) * kstep; \
            const char* a2 = (last ? nA : cA + (size_t)(t + 2) * kstep); const char* b2 = last ? nB : cB + (size_t)(t + 2) * kstep; \
            const char* a3 = a2 + kstep; const char* b3 = b2 + kstep; \
            unsigned s00 = 0u, s01 = 0u, s10 = 0u, s11 = 0u; \
            if constexpr (GATHER) { s00 = last ? gN[0][0] : gC[0][0]; s01 = last ? gN[0][1] : gC[0][1]; s10 = last ? gN[1][0] : gC[1][0]; s11 = last ? gN[1][1] : gC[1][1]; } \
            PG8_LDB(B0, 0, 0); PG8_LDB(B1, 0, 1); PG8_SCHED; PG8_LDA(At, 0, 0); \
            if constexpr (GATHER) PG8_STAGE2(PG8_SA(1, 1), a1, gC[1][0], gC[1][1]); else PG8_STAGE(PG8_SA(1, 1), a1 + hstep, voffA); \
            PG8_WAIT_V(8); \
            PG8_WAIT_L(0); PG8_BAR; PG8_MMA(0, 0, At, B0); PG8_MMA(0, 1, At, B1); PG8_BAR; PG8_SCHED; \
            PG8_LDA(At, 0, 1); PG8_STAGE(PG8_SB(0, 0), b2, voffB); PG8_STAGE(PG8_SB(0, 1), b2 + hstep, voffB); \
            if constexpr (GATHER) PG8_STAGE2(PG8_SA(0, 0), a2, s00, s01); else PG8_STAGE(PG8_SA(0, 0), a2, voffA); \
            PG8_WAIT_V(8); \
            PG8_WAIT_L(0); PG8_BAR; PG8_MMA(1, 0, At, B0); PG8_MMA(1, 1, At, B1); PG8_BAR; PG8_SCHED; \
            PG8_LDB(B0, 1, 0); PG8_LDB(B1, 1, 1); PG8_SCHED; PG8_LDA(At, 1, 0); \
            if constexpr (GATHER) PG8_STAGE2(PG8_SA(0, 1), a2, s10, s11); else PG8_STAGE(PG8_SA(0, 1), a2 + hstep, voffA); \
            PG8_WAIT_V(8); PG8_WAIT_L(0); PG8_BAR; PG8_MMA(0, 0, At, B0); PG8_MMA(0, 1, At, B1); PG8_BAR; PG8_SCHED; \
            PG8_LDA(At, 1, 1); PG8_STAGE(PG8_SB(1, 0), b3, voffB); PG8_STAGE(PG8_SB(1, 1), b3 + hstep, voffB); \
            if constexpr (GATHER) PG8_STAGE2(PG8_SA(1, 0), a3, s00, s01); else PG8_STAGE(PG8_SA(1, 0), a3, voffA); \
            PG8_WAIT_V(8); PG8_WAIT_L(0); PG8_BAR; PG8_MMA(1, 0, At, B0); PG8_MMA(1, 1, At, B1); PG8_BAR; PG8_SCHED; \
        } while (0)
    Unit cur, nxt; int ui = 0;
    if (!S.next(0, cur)) return;
#if GEMM_STAGGER
    if (blockIdx.x & 1) { const unsigned long long t0s = __builtin_amdgcn_s_memrealtime(); const unsigned long long dl = ((unsigned long long)K * GEMM_STAGGER) >> 4;
        while (__builtin_amdgcn_s_memrealtime() - t0s < dl) __builtin_amdgcn_s_sleep(16); }
#endif
    f32x4 acc[2][2][4][2];
#pragma unroll
    for (int a = 0; a < 2; ++a)
#pragma unroll
        for (int b = 0; b < 2; ++b)
#pragma unroll
            for (int m = 0; m < 4; ++m)
#pragma unroll
                for (int n = 0; n < 2; ++n) acc[a][b][m][n] = (f32x4){0.f, 0.f, 0.f, 0.f};
    bf16x8 At[4][2], B0[2][2], B1[2][2];
    const char* cA = S.abase(cur); const char* cB = S.bbase(cur);
    if constexpr (Sched::VAR_NT) nt = S.ktiles(cur);
    if constexpr (GATHER) {
#pragma unroll
        for (int h = 0; h < 2; ++h)
#pragma unroll
            for (int i = 0; i < 2; ++i) gC[h][i] = S.grow(cur, h * HALF + RA[i]) + voffA[i];
    }
    PG8_STAGE(PG8_SB(0, 0), cB, voffB); PG8_STAGE(PG8_SB(0, 1), cB + hstep, voffB);
    if constexpr (GATHER) { PG8_STAGE2(PG8_SA(0, 0), cA, gC[0][0], gC[0][1]); PG8_STAGE2(PG8_SA(0, 1), cA, gC[1][0], gC[1][1]); }
    else { PG8_STAGE(PG8_SA(0, 0), cA, voffA); PG8_STAGE(PG8_SA(0, 1), cA + hstep, voffA); }
    if (wr == 1) PG8_BAR;
    PG8_WAIT_V(2); PG8_BAR;
    PG8_STAGE(PG8_SB(1, 0), cB + kstep, voffB);
    if constexpr (GATHER) PG8_STAGE2(PG8_SA(1, 0), cA + kstep, gC[0][0], gC[0][1]); else PG8_STAGE(PG8_SA(1, 0), cA + kstep, voffA);
    PG8_STAGE(PG8_SB(1, 1), cB + hstep + kstep, voffB);
    PG8_WAIT_V(6); PG8_BAR;
    for (;;) {
        const bool has_next = S.next(ui + 1, nxt);
        const char* nA = has_next ? S.abase(nxt) : cA; const char* nB = has_next ? S.bbase(nxt) : cB;
        if constexpr (GATHER) {
#pragma unroll
            for (int h = 0; h < 2; ++h)
#pragma unroll
                for (int i = 0; i < 2; ++i) gN[h][i] = has_next ? S.grow(nxt, h * HALF + RA[i]) + voffA[i] : gC[h][i];
        }
        for (int t = 0; t < nt; t += 2) PG8_ITER(t);
        if (PG8_ALIGN) { if (wr == 0) PG8_BAR; }
#if PROBE_MASK
        const unsigned long long _te0 = __builtin_amdgcn_s_memrealtime();
#endif
        bool keep = false;
        if constexpr (Epi::CHAINED) { if (cur.kind == 0) { E.mid(acc, cur, wr, wc, fr, fq); keep = true; } else E(acc, cur, wr, wc, fr, fq); } else E(acc, cur, wr, wc, fr, fq);
#if PROBE_MASK
        if (blockIdx.x == 0 && tid == 0) { asm volatile("s_waitcnt vmcnt(0)" ::: "memory"); volatile LAS unsigned long long* pacc = (volatile LAS unsigned long long*)(lds + LDS_CTRL + 64) + 21; *pacc = *pacc + (__builtin_amdgcn_s_memrealtime() - _te0); }
#endif
        if (!has_next) break;
        if (!keep) {
#pragma unroll
        for (int a = 0; a < 2; ++a)
#pragma unroll
            for (int b = 0; b < 2; ++b)
#pragma unroll
                for (int m = 0; m < 4; ++m)
#pragma unroll
                    for (int n = 0; n < 2; ++n) acc[a][b][m][n] = (f32x4){0.f, 0.f, 0.f, 0.f};
        }
        cur = nxt; cA = nA; cB = nB; ++ui;
        if constexpr (Sched::VAR_NT) nt = S.ktiles(cur);
        if constexpr (GATHER) { gC[0][0] = gN[0][0]; gC[0][1] = gN[0][1]; gC[1][0] = gN[1][0]; gC[1][1] = gN[1][1]; }
        if (PG8_ALIGN) { if (wr == 1) PG8_BAR; }
    }
    PG8_WAIT_V(0);
    if (!PG8_ALIGN) { if (wr == 0) PG8_BAR; }
    PG8_BAR;
#undef PG8_SA
#undef PG8_SB
#undef PG8_STAGE
#undef PG8_STAGE2
#undef PG8_ITER
#undef PG8_LDA
#undef PG8_LDB
#undef PG8_MMA
#undef PG8_WAIT_V
#undef PG8_WAIT_L
#undef PG8_BAR
#undef PG8_SCHED
}
}
using pg8::Unit;
typedef const f32x4 (&AccRef)[2][2][4][2];

struct Frame {
    LAS unsigned char* lds;
    unsigned char* ws;
    unsigned* ctl;
    const float* const* in;
    float* out;
    int tid, lane, wave, vcu, G, wave0;
};

#if ROW_NT
#define RLD(p) __builtin_nontemporal_load(p)
#define RST(p, v) __builtin_nontemporal_store((v), (p))
#else
#define RLD(p) (*(p))
#define RST(p, v) (*(p) = (v))
#endif
#ifndef EPI_NT
#define EPI_NT 0u
#endif
template <unsigned BIT, class T> __device__ __forceinline__ void epi_st(T* p, const T v) { if constexpr ((EPI_NT & BIT) != 0u) __builtin_nontemporal_store(v, p); else *p = v; }
constexpr size_t TS1024 = (size_t)256 * 1024 * 2;

struct ZSched {
    static constexpr bool VAR_NT = false;
    int G, c, last, n0, n1; const char *H, *WZ, *WV; pg8::GridMap g0, g1, g2;
    __device__ __forceinline__ void init(int G_, int c_, int last_, const void* H_, const void* WZ_, const void* WV_) {
        G = G_; c = c_; last = last_; H = (const char*)H_; WZ = (const char*)WZ_; WV = (const char*)WV_;
        if (last) { g0.init(256, 18); g1.init(32, 4); } else { g0.init(NRT, 18); g1.init(0, 4); }
        g2.init(4, NRT); n0 = g0.nwg; n1 = g1.nwg;
    }
    __device__ __forceinline__ bool next(int i, Unit& u) const {
        int L = i * G + c, a, b;
        if (L < n0) { g0.map(L, a, b); u.kind = 0; u.pm = last ? (a >> 3) * 9 + 1 + (a & 7) : a; u.pn = b; return true; }
        L -= n0;
        if (L < n1) { g1.map(L, a, b); u.kind = 0; u.pm = a * 9; u.pn = 6 + b; return true; }
        L -= n1;
        if (L < g2.nwg) { g2.map(L, a, b); u.kind = 1; u.pm = a; u.pn = b; return true; }
        return false;
    }
    __device__ __forceinline__ const char* abase(const Unit& u) const { return (u.kind ? WV : H) + (size_t)u.pm * TS1024; }
    __device__ __forceinline__ const char* bbase(const Unit& u) const { return (u.kind ? H : WZ) + (size_t)u.pn * TS1024; }
};
struct ZEpi {
    static constexpr bool CHAINED = false;
    bf16_t *U, *Q, *KB; unsigned char* G; bf16_t* VT; const float *COS, *SIN;
    __device__ __forceinline__ void operator()(AccRef acc, const Unit& u, int wr, int wc, int fr, int fq) const {
        if (u.kind == 1) {
            const int b = u.pn / 9, jt = u.pn - b * 9;
            bf16_t* base = VT + ((size_t)b * 1024 + u.pm * 256 + wr * 64 + fr) * LTOK + jt * 256 + wc * 32 + 8 * fq;
#pragma unroll
            for (int ai = 0; ai < 2; ++ai)
#pragma unroll
                for (int m = 0; m < 4; ++m) { bf16_t* rowp = base + (size_t)(ai * 128 + m * 16) * LTOK;
#pragma unroll
                    for (int bj = 0; bj < 2; ++bj) epi_st<1u>((u32x4*)(rowp + bj * 128), pack8(acc[ai][bj][m][0], acc[ai][bj][m][1])); }
            return;
        }
        const int pn = u.pn; const size_t row0 = (size_t)u.pm * 256 + wr * 64 + fr; const int cin = wc * 32 + 8 * fq;
        if (pn < 2) {
#pragma unroll
            for (int ai = 0; ai < 2; ++ai)
#pragma unroll
                for (int m = 0; m < 4; ++m) { bf16_t* rowp = U + (row0 + ai * 128 + m * 16) * 512 + pn * 256 + cin;
#pragma unroll
                    for (int bj = 0; bj < 2; ++bj) epi_st<2u>((u32x4*)(rowp + bj * 128), pack8(acc[ai][bj][m][0], acc[ai][bj][m][1])); }
        } else if (pn < 10) {
            const bool isq = pn < 6; bf16_t* dst = isq ? Q : KB; const int ct = isq ? pn - 2 : pn - 6; const float sc = isq ? QSCALE : 1.f;
            const int jt = u.pm % 9; const bool lat = jt != 0; const int axis = wc & 1;
#pragma unroll
            for (int ai = 0; ai < 2; ++ai) {
                f32x4 c4[4], s4[4];
#pragma unroll
                for (int m = 0; m < 4; ++m) { const int pos = axis ? (16 * m + fr) : (((jt - 1) * 4 + 2 * ai + wr) & 63);
                    c4[m] = *(const f32x4*)(COS + pos * 16 + 4 * fq); s4[m] = *(const f32x4*)(SIN + pos * 16 + 4 * fq);
                    if (!lat) { c4[m] = (f32x4){1.f, 1.f, 1.f, 1.f}; s4[m] = (f32x4){0.f, 0.f, 0.f, 0.f}; } }
                asm volatile("" ::: "memory");
#pragma unroll
                for (int m = 0; m < 4; ++m) {
                    bf16_t* rowp = dst + (row0 + ai * 128 + m * 16) * 1024 + ct * 256 + cin;
#pragma unroll
                    for (int bj = 0; bj < 2; ++bj) { const f32x4 a = acc[ai][bj][m][0], b = acc[ai][bj][m][1];
                        const f32x4 ra = (a * c4[m] - b * s4[m]) * sc, rb = (a * s4[m] + b * c4[m]) * sc;
                        epi_st<4u>((u32x4*)(rowp + bj * 128), pack8(ra, rb)); }
                }
                asm volatile("" ::: "memory");
            }
        } else {
            const int ct = pn - 10;
#pragma unroll
            for (int ai = 0; ai < 2; ++ai)
#pragma unroll
                for (int m = 0; m < 4; ++m) { unsigned char* rowp = G + (row0 + ai * 128 + m * 16) * 2048 + ct * 256 + cin;
#pragma unroll
                    for (int bj = 0; bj < 2; ++bj) { const f32x4 a = acc[ai][bj][m][0], b = acc[ai][bj][m][1]; u32x2 o; o.x = 0u; o.y = 0u;
#pragma unroll
                        for (int j = 0; j < 4; ++j) { o.x = __builtin_amdgcn_cvt_pk_u8_f32(__builtin_rintf(fast_sigmoid(a[j]) * 255.f), j, o.x); o.y = __builtin_amdgcn_cvt_pk_u8_f32(__builtin_rintf(fast_sigmoid(b[j]) * 255.f), j, o.y); }
                        epi_st<8u>((u32x2*)(rowp + bj * 128), o); } }
        }
    }
};

struct PlainSched {
    static constexpr bool VAR_NT = false;
    int G, c, latonly, rev; const char *A, *B; size_t ats, bts; pg8::GridMap g;
    __device__ __forceinline__ void init(int G_, int c_, int latonly_, int nN, const void* A_, const void* B_, int K, int rev_ = 0) {
        G = G_; c = c_; latonly = latonly_; rev = rev_; A = (const char*)A_; B = (const char*)B_; ats = bts = (size_t)256 * K * 2; g.init(latonly_ ? 256 : NRT, nN);
    }
    __device__ __forceinline__ bool next(int i, Unit& u) const {
        int L = i * G + c; if (L >= g.nwg) return false; if (rev) L = g.nwg - 1 - L; int a, b; g.map(L, a, b);
        u.kind = 0; u.pm = latonly ? (a >> 3) * 9 + 1 + (a & 7) : a; u.pn = b; return true;
    }
    __device__ __forceinline__ const char* abase(const Unit& u) const { return A + (size_t)u.pm * ats; }
    __device__ __forceinline__ const char* bbase(const Unit& u) const { return B + (size_t)u.pn * bts; }
};
struct MergeSched {
    static constexpr bool VAR_NT = true;
    int G, c, latonly; const char *A, *B; pg8::GridMap g;
    __device__ __forceinline__ void init(int G_, int c_, int latonly_, const void* A_, const void* B_) { G = G_; c = c_; latonly = latonly_; A = (const char*)A_; B = (const char*)B_; g.init(latonly_ ? 256 : NRT, 4); }
    __device__ __forceinline__ bool next(int i, Unit& u) const {
        const int L = (i >> 1) * G + c; if (L >= g.nwg) return false; int a, b; g.map(L, a, b);
        u.kind = i & 1; u.pm = latonly ? (a >> 3) * 9 + 1 + (a & 7) : a; u.pn = b; return true;
    }
    __device__ __forceinline__ int ktiles(const Unit& u) const { return u.kind ? 16 : 8; }
    __device__ __forceinline__ const char* abase(const Unit& u) const { return A + (size_t)u.pm * ((size_t)256 * MAP * 2) + (u.kind ? 1024 : 0); }
    __device__ __forceinline__ const char* bbase(const Unit& u) const { return B + (size_t)u.pn * ((size_t)256 * MAP * 2) + (u.kind ? 1024 : 0); }
};
__device__ __forceinline__ void unpack8(const u32x4 w, f32x4& a, f32x4& b) { a = (f32x4){bflo(w.x), bfhi(w.x), bflo(w.y), bfhi(w.y)}; b = (f32x4){bflo(w.z), bfhi(w.z), bflo(w.w), bfhi(w.w)}; }
__device__ __forceinline__ f32x4 ub4(unsigned w) { return (f32x4){(float)(w & 255u), (float)((w >> 8) & 255u), (float)((w >> 16) & 255u), (float)(w >> 24)}; }
struct MergeEpi {
    static constexpr bool CHAINED = true;
    bf16_t* O; const unsigned char* Gt;
    __device__ __forceinline__ void mid(f32x4 (&acc)[2][2][4][2], const Unit& u, int wr, int wc, int fr, int fq) const {
        const unsigned loff = (unsigned)((wr * 64 + fr) * 2048 + wc * 32 + 8 * fq);
#pragma unroll
        for (int ai = 0; ai < 2; ++ai) {
            u32x2 wp[4][2], wa[4][2];
#pragma unroll
            for (int m = 0; m < 4; ++m) { const unsigned char* gp = Gt + (size_t)(u.pm * 256 + ai * 128 + m * 16) * 2048 + u.pn * 256;
#pragma unroll
                for (int bj = 0; bj < 2; ++bj) { wp[m][bj] = *(const u32x2*)(gp + loff + bj * 128); wa[m][bj] = *(const u32x2*)(gp + loff + 1024 + bj * 128); } }
#pragma unroll
            for (int m = 0; m < 4; ++m)
#pragma unroll
                for (int bj = 0; bj < 2; ++bj) { const f32x4 p0 = ub4(wp[m][bj].x), p1 = ub4(wp[m][bj].y), a0 = ub4(wa[m][bj].x), a1 = ub4(wa[m][bj].y);
#pragma unroll
                    for (int j = 0; j < 4; ++j) { acc[ai][bj][m][0][j] *= p0[j] * __builtin_amdgcn_rcpf(fmaxf(a0[j], 1e-9f)); acc[ai][bj][m][1][j] *= p1[j] * __builtin_amdgcn_rcpf(fmaxf(a1[j], 1e-9f)); } }
        }
    }
    __device__ __forceinline__ void operator()(AccRef acc, const Unit& u, int wr, int wc, int fr, int fq) const {
        const unsigned cpart = (unsigned)(wc * 32 + 8 * fq), rpart = (unsigned)((wr * 64 + fr) * 2048);
        const unsigned loffg = rpart + cpart, loffy = rpart + 2u * cpart;
        u32x2 wa[2][4][2];
#pragma unroll
        for (int ai = 0; ai < 2; ++ai)
#pragma unroll
            for (int m = 0; m < 4; ++m) { const unsigned char* gp = Gt + (size_t)(u.pm * 256 + ai * 128 + m * 16) * 2048 + 1024 + u.pn * 256;
#pragma unroll
                for (int bj = 0; bj < 2; ++bj) wa[ai][m][bj] = *(const u32x2*)(gp + loffg + bj * 128); }
        asm volatile("" ::: "memory");
#pragma unroll
        for (int ai = 0; ai < 2; ++ai)
#pragma unroll
            for (int m = 0; m < 4; ++m) { char* op = (char*)(O + (size_t)(u.pm * 256 + ai * 128 + m * 16) * 1024 + u.pn * 256);
#pragma unroll
                for (int bj = 0; bj < 2; ++bj) { f32x4 a0 = ub4(wa[ai][m][bj].x), a1 = ub4(wa[ai][m][bj].y);
#pragma unroll
                    for (int j = 0; j < 4; ++j) { a0[j] = fmaxf(a0[j], 1e-9f) * (1.f / 255.f); a1[j] = fmaxf(a1[j], 1e-9f) * (1.f / 255.f); }
                    epi_st<16u>((u32x4*)(op + loffy + bj * 256), pack8(a0 * acc[ai][bj][m][0], a1 * acc[ai][bj][m][1])); } }
    }
};
struct ResEpi {
    static constexpr bool CHAINED = false;
    const float *latsrc, *ctxsrc; float *latdst, *ctxdst; const float* mod; int goff;
    __device__ __forceinline__ void operator()(AccRef acc, const Unit& u, int wr, int wc, int fr, int fq) const {
        const int b = u.pm / 9, jt = u.pm - b * 9;
        const size_t rb = jt ? ((size_t)b * SEQ + (jt - 1) * 256) : (size_t)b * CTXL;
        const float* src = (jt ? latsrc : ctxsrc) + (rb + wr * 64 + fr) * D; float* dst = (jt ? latdst : ctxdst) + (rb + wr * 64 + fr) * D;
        const float* gate = mod + (size_t)(jt ? b : 32) * MODW + goff;
        const int col0 = u.pn * 256 + wc * 32 + 8 * fq;
        f32x4 gv[2][2];
#pragma unroll
        for (int bj = 0; bj < 2; ++bj)
#pragma unroll
            for (int n = 0; n < 2; ++n) gv[bj][n] = *(const f32x4*)(gate + col0 + bj * 128 + 4 * n);
#pragma unroll
        for (int ai = 0; ai < 2; ++ai) {
            f32x4 x[4][2][2];
#pragma unroll
            for (int m = 0; m < 4; ++m)
#pragma unroll
                for (int bj = 0; bj < 2; ++bj)
#pragma unroll
                    for (int n = 0; n < 2; ++n) x[m][bj][n] = *(const f32x4*)(src + (size_t)(ai * 128 + m * 16) * D + col0 + bj * 128 + 4 * n);
            asm volatile("" ::: "memory");
#pragma unroll
            for (int m = 0; m < 4; ++m)
#pragma unroll
                for (int bj = 0; bj < 2; ++bj)
#pragma unroll
                    for (int n = 0; n < 2; ++n) epi_st<32u>((f32x4*)(dst + (size_t)(ai * 128 + m * 16) * D + col0 + bj * 128 + 4 * n), x[m][bj][n] + gv[bj][n] * acc[ai][bj][m][n]);
            asm volatile("" ::: "memory");
        }
    }
};
struct OEpi {
    static constexpr bool CHAINED = false;
    bf16_t* O; const float* mod; int goff;
    __device__ __forceinline__ void operator()(AccRef acc, const Unit& u, int wr, int wc, int fr, int fq) const {
        const int b = u.pm / 9, jt = u.pm - b * 9;
        const float* gate = mod + (size_t)(jt ? b : 32) * MODW + goff;
        const int col0 = u.pn * 256 + wc * 32 + 8 * fq;
        f32x4 gv[2][2];
#pragma unroll
        for (int bj = 0; bj < 2; ++bj)
#pragma unroll
            for (int n = 0; n < 2; ++n) gv[bj][n] = *(const f32x4*)(gate + col0 + bj * 128 + 4 * n);
        asm volatile("" ::: "memory");
        bf16_t* base = O + ((size_t)u.pm * 256 + wr * 64 + fr) * D + col0;
#pragma unroll
        for (int ai = 0; ai < 2; ++ai)
#pragma unroll
            for (int m = 0; m < 4; ++m)
#pragma unroll
                for (int bj = 0; bj < 2; ++bj) epi_st<32u>((u32x4*)(base + (size_t)(ai * 128 + m * 16) * D + bj * 128), pack8(gv[bj][0] * acc[ai][bj][m][0], gv[bj][1] * acc[ai][bj][m][1]));
    }
};
struct UpEpi {
    static constexpr bool CHAINED = false;
    bf16_t* O; int ld;
    __device__ __forceinline__ void operator()(AccRef acc, const Unit& u, int wr, int wc, int fr, int fq) const {
        const size_t row0 = (size_t)u.pm * 256 + wr * 64 + fr; const int col0 = u.pn * 128 + wc * 32 + 8 * fq;
#pragma unroll
        for (int ai = 0; ai < 2; ++ai)
#pragma unroll
            for (int m = 0; m < 4; ++m) { f32x4 v[2];
#pragma unroll
                for (int n = 0; n < 2; ++n) { const f32x4 g = acc[ai][0][m][n], w = acc[ai][1][m][n];
#pragma unroll
                    for (int j = 0; j < 4; ++j) v[n][j] = g[j] * fast_sigmoid(g[j]) * w[j]; }
                epi_st<64u>((u32x4*)(O + (row0 + ai * 128 + m * 16) * ld + col0), pack8(v[0], v[1])); }
    }
};
struct MoeInfo {
    int cnt[NE], tb[NE + 1];
    __device__ __forceinline__ void load(const unsigned* cw) {
        int t = 0;
#pragma unroll
        for (int e = 0; e < NE; ++e) { const int c = __builtin_amdgcn_readfirstlane((int)__hip_atomic_load(cw + CW_CNT + 64 * e, __ATOMIC_RELAXED, __HIP_MEMORY_SCOPE_AGENT)); cnt[e] = c; tb[e] = t; t += (c + 255) >> 8; }
        tb[NE] = t;
    }
    __device__ __forceinline__ void lookup(int rt, int& e, int& t0, int& ce) const { e = 0; t0 = 0; ce = cnt[0];
#pragma unroll
        for (int k = 1; k < NE; ++k) { const bool ge = rt >= tb[k]; e = ge ? k : e; t0 = ge ? tb[k] : t0; ce = ge ? cnt[k] : ce; } }
};
struct MoeSched {
    static constexpr bool VAR_NT = false;
    int G, c, nN, gather, rev; const char *A, *B; const unsigned* LIST; size_t ats, bts, bes; MoeInfo mi; pg8::GridMap g;
    __device__ __forceinline__ void init(int G_, int c_, int nN_, const void* A_, const void* B_, int K, int Nrows, const MoeInfo& mi_) {
        G = G_; c = c_; nN = nN_; gather = 0; rev = 0; LIST = nullptr; A = (const char*)A_; B = (const char*)B_; ats = bts = (size_t)256 * K * 2; bes = (size_t)Nrows * K * 2; mi = mi_; g.init(mi_.tb[NE], nN_);
    }
    __device__ __forceinline__ bool next(int i, Unit& u) const {
        int L = i * G + c; if (L >= g.nwg) return false; if (rev) L = g.nwg - 1 - L; int a, b; g.map(L, a, b); u.pm = a; u.pn = b; int t0, ce; mi.lookup(a, u.kind, t0, ce); return true;
    }
    __device__ __forceinline__ const char* abase(const Unit& u) const { return gather ? A : A + (size_t)u.pm * ats; }
    __device__ __forceinline__ const char* bbase(const Unit& u) const { return B + (size_t)u.kind * bes + (size_t)u.pn * bts; }
    __device__ __forceinline__ unsigned grow(const Unit& u, int row) const { int e, t0, ce; mi.lookup(u.pm, e, t0, ce); const int slot = (u.pm - t0) * 256 + row;
        unsigned tok = 0u; if (slot < ce) tok = LIST[(size_t)e * NLAT + slot] >> 1;
        return ((tok >> 11) * (unsigned)LTOK + (unsigned)CTXL + (tok & 2047u)) * (unsigned)(D * 2); }
};
struct MoeDownEpi {
    static constexpr bool CHAINED = false;
    bf16_t* YM; const unsigned* LIST; const float* WTS; MoeInfo mi;
    __device__ __forceinline__ void operator()(AccRef acc, const Unit& u, int wr, int wc, int fr, int fq) const {
        int e, t0, ce; mi.lookup(u.pm, e, t0, ce); const int slot0 = (u.pm - t0) * 256 + wr * 64 + fr;
        const int col0 = u.pn * 256 + wc * 32 + 8 * fq;
        unsigned ent[2][4]; float wt[2][4];
#pragma unroll
        for (int ai = 0; ai < 2; ++ai)
#pragma unroll
            for (int m = 0; m < 4; ++m) { const int slot = slot0 + ai * 128 + m * 16; ent[ai][m] = slot < ce ? LIST[(size_t)e * NLAT + slot] : 0xffffffffu; }
#pragma unroll
        for (int ai = 0; ai < 2; ++ai)
#pragma unroll
            for (int m = 0; m < 4; ++m) wt[ai][m] = ent[ai][m] != 0xffffffffu ? WTS[ent[ai][m]] : 0.f;
        asm volatile("" ::: "memory");
#pragma unroll
        for (int ai = 0; ai < 2; ++ai)
#pragma unroll
            for (int m = 0; m < 4; ++m) {
                if (ent[ai][m] != 0xffffffffu) { const unsigned en = ent[ai][m]; const float w8 = wt[ai][m];
                    bf16_t* rowp = YM + ((size_t)(en & 1u) * NLAT + (en >> 1)) * D + col0;
#pragma unroll
                    for (int bj = 0; bj < 2; ++bj) epi_st<128u>((u32x4*)(rowp + bj * 128), pack8(acc[ai][bj][m][0] * w8, acc[ai][bj][m][1] * w8)); } }
    }
};

namespace att {
constexpr int BUFB = 32768, EXCH = 65536;
constexpr float THR = 6.f;
#define ATT_SBAR() __builtin_amdgcn_sched_barrier(0)
#define ATT_MFMA(a, b, c) __builtin_amdgcn_mfma_f32_32x32x16_bf16(a, b, c, 0, 0, 0)
#define ATT_SYNC() asm volatile("s_waitcnt vmcnt(0) lgkmcnt(0)\n\ts_barrier" ::: "memory")
__device__ __forceinline__ void attn_unit(LAS unsigned char* lds, const bf16_t* Q, const bf16_t* K, const bf16_t* VT, bf16_t* AY, int b, int h, size_t qrow0, int nkt, float lam, float osc, const float* subg,
                                          bf16x8 (&qf)[4], bool first, bool has_next, int nb, int nh, size_t nqrow0, int wv) {
    const int tid = opaque_tid(wv), lane = tid & 63, ql = lane & 31, hh = lane >> 5; const int w = __builtin_amdgcn_readfirstlane(tid >> 6); const int map = w >> 2, qb = w & 3;
    const size_t qrow = qrow0 + 32 * qb + ql;
    if (ATT_PRIO && w >= 4) __builtin_amdgcn_s_setprio(1);
#if PROBE_MASK
    unsigned long long att_wait = 0, att_b = 0, att_a = 0;
#endif
    if (first) {
#pragma unroll
        for (int ks = 0; ks < 4; ++ks) qf[ks] = *(const bf16x8*)(Q + qrow * 1024 + (h * 2 + map) * 64 + 16 * ks + 8 * hh);
    }
    const int prow = lane >> 3, pc = lane & 7;
    const int krow = 8 * w + prow, kc = pc ^ ((krow >> 1) & 7);
    const bf16_t* ksrc0 = K + ((size_t)b * LTOK + krow) * 1024 + (h * 2) * 64 + kc * 8;
    const bf16_t* ksrc1 = ksrc0 + 64;
    const int e0 = 16 * w + prow, e1 = e0 + 8;
    const bf16_t* vsrc0 = VT + ((size_t)b * 1024 + h * 128 + e0) * LTOK + (pc ^ ((e0 >> 1) & 7)) * 8;
    const bf16_t* vsrc1 = VT + ((size_t)b * 1024 + h * 128 + e1) * LTOK + (pc ^ ((e1 >> 1) & 7)) * 8;
#define ATT_DMA_K(t, BO) do { \
        __builtin_amdgcn_global_load_lds((const unsigned*)(ksrc0 + (size_t)(t) * 64 * 1024), (LAS unsigned*)(lds + (BO) + w * 1024), 16, 0, 0); \
        __builtin_amdgcn_global_load_lds((const unsigned*)(ksrc1 + (size_t)(t) * 64 * 1024), (LAS unsigned*)(lds + (BO) + 8192 + w * 1024), 16, 0, 0); } while (0)
#define ATT_DMA_V(t, BO) do { \
        __builtin_amdgcn_global_load_lds((const unsigned*)(vsrc0 + (size_t)(t) * 64), (LAS unsigned*)(lds + (BO) + 16384 + w * 2048), 16, 0, 0); \
        __builtin_amdgcn_global_load_lds((const unsigned*)(vsrc1 + (size_t)(t) * 64), (LAS unsigned*)(lds + (BO) + 16384 + w * 2048 + 1024), 16, 0, 0); } while (0)
    const int rp = (ql & ~12) | ((ql & 4) << 1) | ((ql & 8) >> 1);
    const int xk = (rp >> 1) & 7, xv = (ql >> 1) & 7;
    const LAS unsigned char* kbase = lds + map * 8192 + rp * 128;
    const LAS unsigned char* vbase = lds + 16384 + ql * 128;
    const unsigned kaddr0 = (unsigned)(uintptr_t)kbase, vaddr0 = (unsigned)(uintptr_t)vbase;
    int kof[4], vof[4];
#pragma unroll
    for (int i = 0; i < 4; ++i) { kof[i] = ((2 * i + hh) ^ xk) << 4; vof[i] = ((2 * i + hh) ^ xv) << 4; }
#define ATT_KRD(i, RB) (*(const LAS bf16x8*)(kbase + (RB) + ((i) >> 2) * 4096 + kof[(i) & 3]))
#define ATT_VRD(g, RB) (*(const LAS bf16x8*)(vbase + (RB) + ((g) >> 2) * 4096 + vof[(g) & 3]))
    const f32x16 Z16 = (f32x16){0.f, 0.f, 0.f, 0.f, 0.f, 0.f, 0.f, 0.f, 0.f, 0.f, 0.f, 0.f, 0.f, 0.f, 0.f, 0.f};
    f32x16 O[4];
#pragma unroll
    for (int i = 0; i < 4; ++i) O[i] = Z16;
    f32x16 negm = Z16, S0, S1;
    float lrun = 0.f, ral = 1.f; bool resc = false;
    bf16x8 kf[8]; u32x4 pA[4], pB[4];
#define ATT_QK() do { \
        S0 = ATT_MFMA(kf[0], qf[0], negm); S1 = ATT_MFMA(kf[4], qf[0], negm); \
        S0 = ATT_MFMA(kf[1], qf[1], S0);   S1 = ATT_MFMA(kf[5], qf[1], S1); \
        S0 = ATT_MFMA(kf[2], qf[2], S0);   S1 = ATT_MFMA(kf[6], qf[2], S1); \
        S0 = ATT_MFMA(kf[3], qf[3], S0);   S1 = ATT_MFMA(kf[7], qf[3], S1); } while (0)
#define ATT_ROWMAX(mx) do { float _a = fmaxf(S0[0], S1[0]), _b = fmaxf(S0[1], S1[1]); \
        _Pragma("unroll") for (int r = 2; r < 16; r += 2) { _a = fmaxf(_a, fmaxf(S0[r], S1[r])); _b = fmaxf(_b, fmaxf(S0[r + 1], S1[r + 1])); } \
        mx = pair_max(fmaxf(_a, _b)); } while (0)
#define ATT_IMAX3(a, b, c) max(max((a), (b)), (c))
#define ATT_SI(i) __float_as_int(ATT_SV(i))
#define ATT_ROWMAXI(mx) do { int _a = ATT_IMAX3(ATT_SI(0), ATT_SI(1), ATT_SI(2)), _b = ATT_IMAX3(ATT_SI(3), ATT_SI(4), ATT_SI(5)); \
        _a = ATT_IMAX3(_a, ATT_SI(6), ATT_SI(7)); _b = ATT_IMAX3(_b, ATT_SI(8), ATT_SI(9)); _a = ATT_IMAX3(_a, ATT_SI(10), ATT_SI(11)); _b = ATT_IMAX3(_b, ATT_SI(12), ATT_SI(13)); \
        _a = ATT_IMAX3(_a, ATT_SI(14), ATT_SI(15)); _b = ATT_IMAX3(_b, ATT_SI(16), ATT_SI(17)); _a = ATT_IMAX3(_a, ATT_SI(18), ATT_SI(19)); _b = ATT_IMAX3(_b, ATT_SI(20), ATT_SI(21)); \
        _a = ATT_IMAX3(_a, ATT_SI(22), ATT_SI(23)); _b = ATT_IMAX3(_b, ATT_SI(24), ATT_SI(25)); _a = ATT_IMAX3(_a, ATT_SI(26), ATT_SI(27)); _b = ATT_IMAX3(_b, ATT_SI(28), ATT_SI(29)); \
        _a = ATT_IMAX3(_a, ATT_SI(30), ATT_SI(31)); _a = max(_a, _b); \
        auto _rr = __builtin_amdgcn_permlane32_swap((unsigned)_a, (unsigned)_a, false, false); mx = __int_as_float(max((int)_rr[0], (int)_rr[1])); } while (0)
#define ATT_DECIDE() do { float mx; ATT_ROWMAXI(mx); \
        if (__any(mx > THR)) { const float dl = fmaxf(mx, 0.f); \
            _Pragma("unroll") for (int r = 0; r < 16; ++r) { S0[r] -= dl; S1[r] -= dl; negm[r] -= dl; } \
            ral = __builtin_amdgcn_exp2f(-dl); lrun *= ral; resc = true; } } while (0)
#define ATT_SV(i) ((i) < 16 ? S0[(i) & 15] : S1[(i) & 15])
#define ATT_EXP2(g, PN) do { const float _e0 = __builtin_amdgcn_exp2f(ATT_SV(2 * (g))), _e1 = __builtin_amdgcn_exp2f(ATT_SV(2 * (g) + 1)); ls += _e0; ls += _e1; unsigned _w = cvtpk(_e0, _e1); asm volatile("" : "+v"(_w), "+v"(ls)); PN[(g) >> 2][(g) & 3] = _w; } while (0)
#define ATT_DSRD(dst, addr, off) asm volatile("ds_read_b128 %0, %1 offset:%2" : "=v"(dst) : "v"(addr), "i"(off))
#define ATT_NW(g, DOK) ((DOK) ? ((g) <= 8 ? 2 : (g) == 9 ? 3 : (g) == 10 ? 4 : (g) <= 13 ? 5 : (g) == 14 ? 4 : 3) : ((g) <= 13 ? 2 : (g) == 14 ? 1 : 0))
#define ATT_GAPB(g, VC, VL, PP, PN, DOK) do { \
        asm volatile("s_waitcnt lgkmcnt(%1)" : "+v"(VC) : "i"(ATT_NW(g, DOK))); \
        O[(g) >> 2] = ATT_MFMA(VC, __builtin_bit_cast(bf16x8, PP[(g) & 3]), O[(g) >> 2]); \
        if ((g) + 3 < 16) ATT_DSRD(VL, va[((g) + 3) & 3], (((g) + 3) >> 2) * 4096); \
        if ((DOK) && (g) >= 8) ATT_DSRD(kf[(g) - 8], ka[((g) - 8) & 3], (((g) - 8) >> 2) * 4096); \
        ATT_EXP2(g, PN); ATT_SBAR(); } while (0)
#define ATT_PHASEB(RBK, RB, PP, PN, DOK) do { float ls = 0.f; unsigned va[4], ka[4]; \
        _Pragma("unroll") for (int _c = 0; _c < 4; ++_c) { va[_c] = vaddr0 + (unsigned)(RB) + (unsigned)vof[_c]; ka[_c] = kaddr0 + (unsigned)(RBK) + (unsigned)kof[_c]; } \
        bf16x8 v0, v1, v2, v3; ATT_DSRD(v0, va[0], 0); ATT_DSRD(v1, va[1], 0); ATT_DSRD(v2, va[2], 0); ATT_SBAR(); \
        ATT_GAPB(0, v0, v3, PP, PN, DOK); ATT_GAPB(1, v1, v0, PP, PN, DOK); ATT_GAPB(2, v2, v1, PP, PN, DOK); ATT_GAPB(3, v3, v2, PP, PN, DOK); \
        ATT_GAPB(4, v0, v3, PP, PN, DOK); ATT_GAPB(5, v1, v0, PP, PN, DOK); ATT_GAPB(6, v2, v1, PP, PN, DOK); ATT_GAPB(7, v3, v2, PP, PN, DOK); \
        ATT_GAPB(8, v0, v3, PP, PN, DOK); ATT_GAPB(9, v1, v0, PP, PN, DOK); ATT_GAPB(10, v2, v1, PP, PN, DOK); ATT_GAPB(11, v3, v2, PP, PN, DOK); \
        ATT_GAPB(12, v0, v3, PP, PN, DOK); ATT_GAPB(13, v1, v0, PP, PN, DOK); ATT_GAPB(14, v2, v1, PP, PN, DOK); ATT_GAPB(15, v3, v2, PP, PN, DOK); \
        if (DOK) { asm volatile("s_waitcnt lgkmcnt(0)" : "+v"(kf[0]), "+v"(kf[1]), "+v"(kf[2]), "+v"(kf[3]), "+v"(kf[4]), "+v"(kf[5]), "+v"(kf[6]), "+v"(kf[7])); ATT_SBAR(); } \
        lrun += ls; } while (0)
#define ATT_RESC() do { if (resc) { _Pragma("unroll") for (int i = 0; i < 4; ++i) _Pragma("unroll") for (int r = 0; r < 16; ++r) O[i][r] *= ral; resc = false; } } while (0)
#define ATT_BUF(j) (((j) & 3) * BUFB)
#if PROBE_MASK
#define ATT_TB0() const unsigned long long _tb0 = __builtin_amdgcn_s_memrealtime(); asm volatile("s_waitcnt lgkmcnt(0)" ::: "memory")
#define ATT_TB1() const unsigned long long _tb1 = __builtin_amdgcn_s_memrealtime(); att_b += _tb1 - _tb0
#define ATT_TB2() asm volatile("" : "+v"(S0), "+v"(S1)); att_a += __builtin_amdgcn_s_memrealtime() - _tb1
#else
#define ATT_TB0() do {} while (0)
#define ATT_TB1() do {} while (0)
#define ATT_TB2() do {} while (0)
#endif
#if PROBE_MASK
#define ATT_SYNCN(N) do { const unsigned long long _t0 = __builtin_amdgcn_s_memrealtime(); asm volatile("s_waitcnt vmcnt(" #N ") lgkmcnt(0)\n\ts_barrier" ::: "memory"); att_wait += __builtin_amdgcn_s_memrealtime() - _t0; } while (0)
#else
#define ATT_SYNCN(N) asm volatile("s_waitcnt vmcnt(" #N ") lgkmcnt(0)\n\ts_barrier" ::: "memory")
#endif
#define ATT_STEP(t, PP, PN) do { \
        ATT_TB0(); { const int rbk = ATT_BUF((t) + 1), rbv = ATT_BUF((t) - 1); ATT_PHASEB(rbk, rbv, PP, PN, true); } ATT_RESC(); ATT_TB1(); ATT_QK(); ATT_DECIDE(); ATT_TB2(); } while (0)

    if (first) { ATT_DMA_K(0, 0); ATT_DMA_K(1, BUFB); ATT_DMA_V(0, 0); ATT_DMA_V(1, BUFB); }
    ATT_DMA_K(2, 2 * BUFB); ATT_DMA_K(3, 3 * BUFB);
    ATT_SYNCN(4);
#pragma unroll
    for (int i = 0; i < 8; ++i) kf[i] = ATT_KRD(i, 0);
    ATT_QK();
    { float mx; ATT_ROWMAX(mx);
#pragma unroll
      for (int r = 0; r < 16; ++r) { S0[r] -= mx; S1[r] -= mx; negm[r] = -mx; } }
    { float ls = 0.f;
#pragma unroll
      for (int i = 0; i < 8; ++i) kf[i] = ATT_KRD(i, BUFB);
#define ATT_E0(g) ATT_EXP2(g, pA)
      ATT_E0(0); ATT_E0(1); ATT_E0(2); ATT_E0(3); ATT_E0(4); ATT_E0(5); ATT_E0(6); ATT_E0(7); ATT_E0(8); ATT_E0(9); ATT_E0(10); ATT_E0(11); ATT_E0(12); ATT_E0(13); ATT_E0(14); ATT_E0(15);
#undef ATT_E0
      lrun += ls; }
    ATT_QK(); ATT_DECIDE();
    for (int t = 1; t < nkt - 1; t += 2) {
        ATT_SYNCN(0);
        if (t + 3 < nkt) ATT_DMA_K(t + 3, ATT_BUF(t + 3));
        ATT_DMA_V(t + 1, ATT_BUF(t + 1));
        if (t + 4 < nkt) ATT_DMA_K(t + 4, ATT_BUF(t));
        ATT_DMA_V(t + 2, ATT_BUF(t + 2));
        ATT_STEP(t, pA, pB);
        ATT_STEP(t + 1, pB, pA);
    }
    ATT_SYNCN(0);
    if (has_next) {
        const size_t nqrow = nqrow0 + 32 * qb + ql;
#pragma unroll
        for (int ks = 0; ks < 4; ++ks) qf[ks] = *(const bf16x8*)(Q + nqrow * 1024 + (nh * 2 + map) * 64 + 16 * ks + 8 * hh);
        const bf16_t* nk0 = K + ((size_t)nb * LTOK + krow) * 1024 + (nh * 2) * 64 + kc * 8;
        const bf16_t* nv0 = VT + ((size_t)nb * 1024 + nh * 128 + e0) * LTOK + (pc ^ ((e0 >> 1) & 7)) * 8;
        const bf16_t* nv1 = VT + ((size_t)nb * 1024 + nh * 128 + e1) * LTOK + (pc ^ ((e1 >> 1) & 7)) * 8;
#pragma unroll
        for (int j = 0; j < 2; ++j) {
            __builtin_amdgcn_global_load_lds((const unsigned*)(nk0 + (size_t)j * 64 * 1024), (LAS unsigned*)(lds + j * BUFB + w * 1024), 16, 0, 0);
            __builtin_amdgcn_global_load_lds((const unsigned*)(nk0 + 64 + (size_t)j * 64 * 1024), (LAS unsigned*)(lds + j * BUFB + 8192 + w * 1024), 16, 0, 0);
            __builtin_amdgcn_global_load_lds((const unsigned*)(nv0 + (size_t)j * 64), (LAS unsigned*)(lds + j * BUFB + 16384 + w * 2048), 16, 0, 0);
            __builtin_amdgcn_global_load_lds((const unsigned*)(nv1 + (size_t)j * 64), (LAS unsigned*)(lds + j * BUFB + 16384 + w * 2048 + 1024), 16, 0, 0); }
    }
    { const int rbv = ATT_BUF(nkt - 2); ATT_PHASEB(0, rbv, pA, pB, false); } ATT_RESC();
    { const int rbv = ATT_BUF(nkt - 1); bf16x8 v0 = ATT_VRD(0, rbv), v1 = ATT_VRD(1, rbv), v2;
#define ATT_GF(g, VC, VL) do { O[(g) >> 2] = ATT_MFMA(VC, __builtin_bit_cast(bf16x8, pB[(g) & 3]), O[(g) >> 2]); if ((g) + 2 < 16) VL = ATT_VRD((g) + 2, rbv); } while (0)
      ATT_GF(0, v0, v2); ATT_GF(1, v1, v0); ATT_GF(2, v2, v1); ATT_GF(3, v0, v2); ATT_GF(4, v1, v0); ATT_GF(5, v2, v1); ATT_GF(6, v0, v2); ATT_GF(7, v1, v0);
      ATT_GF(8, v2, v1); ATT_GF(9, v0, v2); ATT_GF(10, v1, v0); ATT_GF(11, v2, v1); ATT_GF(12, v0, v2); ATT_GF(13, v1, v0); ATT_GF(14, v2, v1); ATT_GF(15, v0, v2);
#undef ATT_GF
    }
    asm volatile("s_waitcnt lgkmcnt(0)\n\ts_barrier" ::: "memory");
    const float inv = 1.f / pair_sum(lrun);
    f32x4 sgv[4][4];
    if (map == 0) {
#pragma unroll
        for (int i = 0; i < 4; ++i)
#pragma unroll
            for (int g = 0; g < 4; ++g) sgv[i][g] = *(const f32x4*)(subg + 32 * i + 8 * g + 4 * hh);
    }
    LAS float* ex = (LAS float*)(lds + EXCH) + (size_t)qb * 4096 + lane;
    if (map == 1) {
#pragma unroll
        for (int i = 0; i < 4; ++i)
#pragma unroll
            for (int r = 0; r < 16; ++r) ex[(i * 16 + r) * 64] = O[i][r] * inv;
    }
    asm volatile("s_waitcnt lgkmcnt(0)\n\ts_barrier" ::: "memory");
    if (map == 0) {
        float ss = 0.f;
#pragma unroll
        for (int i = 0; i < 4; ++i)
#pragma unroll
            for (int r = 0; r < 16; ++r) { const float y = O[i][r] * inv - lam * ex[(i * 16 + r) * 64]; O[i][r] = y; ss += y * y; }
        ss = pair_sum(ss);
        const float rs = rsqrtf(ss * (1.f / VD) + EPS) * osc;
        bf16_t* orow = AY + qrow * MAP + 512 + h * 128;
#pragma unroll
        for (int i = 0; i < 4; ++i)
#pragma unroll
            for (int g = 0; g < 4; ++g) { const int e = 32 * i + 8 * g + 4 * hh; const f32x4 gv = sgv[i][g];
                u32x2 o; o.x = cvtpk(O[i][4 * g] * rs * gv[0], O[i][4 * g + 1] * rs * gv[1]); o.y = cvtpk(O[i][4 * g + 2] * rs * gv[2], O[i][4 * g + 3] * rs * gv[3]);
                *(u32x2*)(orow + e) = o; }
    }
    asm volatile("s_waitcnt lgkmcnt(0)\n\ts_barrier" ::: "memory");
    if (ATT_PRIO && w >= 4) __builtin_amdgcn_s_setprio(0);
#if PROBE_MASK
    if (blockIdx.x == 0 && tid == 0) { volatile LAS unsigned long long* acc = (volatile LAS unsigned long long*)(lds + LDS_CTRL + 64) + 20; acc[0] = acc[0] + att_wait; acc[2] = acc[2] + att_b; acc[3] = acc[3] + att_a; }
#endif
#undef ATT_DMA_K
#undef ATT_DMA_V
#undef ATT_KRD
#undef ATT_VRD
#undef ATT_QK
#undef ATT_ROWMAX
#undef ATT_DECIDE
#undef ATT_IMAX3
#undef ATT_SI
#undef ATT_ROWMAXI
#undef ATT_SV
#undef ATT_EXP2
#undef ATT_GAPB
#undef ATT_DSRD
#undef ATT_NW
#undef ATT_PHASEB
#undef ATT_RESC
#undef ATT_STEP
#undef ATT_BUF
#undef ATT_TB0
#undef ATT_TB1
#undef ATT_TB2
#undef ATT_SYNCN
}
#undef ATT_SBAR
#undef ATT_MFMA
#undef ATT_SYNC
}

__device__ __forceinline__ void tr_item(const float* W, int ldw, int k0, int n0, bf16_t* WT, int ldt, int drow0, int dcol0, bool rope, LAS float* scr, int lane) {
    { f32x4 v[8];
#pragma unroll
      for (int j = 0; j < 8; ++j) v[j] = RLD((const f32x4*)(W + (size_t)(k0 + 8 * j + (lane >> 3)) * ldw + n0 + 4 * (lane & 7)));
#pragma unroll
      for (int j = 0; j < 8; ++j) { LAS float* d = scr + (8 * j + (lane >> 3)) * 33 + 4 * (lane & 7); d[0] = v[j][0]; d[1] = v[j][1]; d[2] = v[j][2]; d[3] = v[j][3]; } }
    LDS_WAIT(); asm volatile("" ::: "memory");
    const int c = lane & 7;
#pragma unroll
    for (int j = 0; j < 4; ++j) { const int n = (lane >> 3) + 8 * j; const LAS float* s = scr + (8 * c) * 33 + n;
        u32x4 o; o.x = cvtpk(s[0 * 33], s[1 * 33]); o.y = cvtpk(s[2 * 33], s[3 * 33]); o.z = cvtpk(s[4 * 33], s[5 * 33]); o.w = cvtpk(s[6 * 33], s[7 * 33]);
        const int dn = rope ? (8 * ((n >> 2) & 3) + 4 * (n >> 4) + (n & 3)) : n;
        *(u32x4*)(WT + (size_t)(drow0 + n0 + dn) * ldt + dcol0 + k0 + 8 * c) = o; }
    LDS_WAIT(); asm volatile("" ::: "memory");
}

__device__ __forceinline__ void phase_prologue(Frame F) {
    F.tid = opaque_tid(F.wave0); F.lane = F.tid & 63; F.wave = __builtin_amdgcn_readfirstlane(F.tid >> 6);
    const float* c = F.in[1]; const float* cctx = F.in[3]; const float* wmod = F.in[4]; const float* bmod = F.in[5];
    float* MOD = (float*)(F.ws + WS_MOD);
    for (int cb = blockIdx.x; cb < 192; cb += F.G) {
        LAS float* S = (LAS float*)F.lds;
        for (int idx = F.tid; idx < 1024 * 36; idx += NTHR) { const int k = idx / 36, bb = idx - k * 36; float v = 0.f;
            if (bb < 32) v = c[bb * 1024 + k]; else if (bb == 32) v = cctx[k];
            S[idx] = v / (1.f + expf(-v)); }
        __syncthreads();
        const int l = cb / 96, n = (cb % 96) * 64 + F.lane;
        float acc[36];
#pragma unroll
        for (int i = 0; i < 36; ++i) acc[i] = 0.f;
        const float* wp = wmod + ((size_t)l * 1024 + F.wave * 128) * MODW + n;
#pragma unroll 8
        for (int kk = 0; kk < 128; ++kk) { const float wv = wp[(size_t)kk * MODW]; const LAS f32x4* sp = (const LAS f32x4*)(S + (F.wave * 128 + kk) * 36);
#pragma unroll
            for (int q = 0; q < 9; ++q) { const f32x4 s4 = sp[q];
#pragma unroll
                for (int i = 0; i < 4; ++i) acc[4 * q + i] += s4[i] * wv; } }
        __syncthreads();
        LAS float* red = (LAS float*)F.lds;
#pragma unroll
        for (int bb = 0; bb < 33; ++bb) red[(F.wave * 33 + bb) * 64 + F.lane] = acc[bb];
        __syncthreads();
        for (int bb = F.wave; bb < 33; bb += 8) { float s = bmod[l * MODW + n];
#pragma unroll
            for (int w2 = 0; w2 < 8; ++w2) s += red[(w2 * 33 + bb) * 64 + F.lane];
            MOD[((size_t)l * 33 + bb) * MODW + n] = s; }
        __syncthreads();
    }
    __syncthreads();
    LAS float* scr = (LAS float*)(F.lds + F.wave * 8448);
    const int gw = F.vcu * NWAVES + F.wave, NGW = F.G * NWAVES;
    bf16_t* WZ = (bf16_t*)(F.ws + WS_WZ); bf16_t* WV = (bf16_t*)(F.ws + WS_WV); bf16_t* WM = (bf16_t*)(F.ws + WS_WM); bf16_t* WOUT = (bf16_t*)(F.ws + WS_WOUT);
    bf16_t* WUP0 = (bf16_t*)(F.ws + WS_WUP0); bf16_t* WDN0 = (bf16_t*)(F.ws + WS_WDN0);
    constexpr int I_IN = 16 * 176, I_SQ = 16 * 32, I_UP = 16 * 86, I_DN = 43 * 32;
    constexpr int NITEMS = 2 * I_IN + 4 * I_SQ + 2 * I_UP + I_DN;
    for (int it = gw; it < NITEMS; it += NGW) {
        int r = it;
        if (r < 2 * I_IN) { const int l = r / I_IN; r -= l * I_IN; const int kb = r / 176, nb = r % 176, n0 = nb * 32;
            const float* W = F.in[8] + (size_t)l * 1024 * 5632;
            if (n0 < 2560) tr_item(W, 5632, kb * 64, n0, WZ + (size_t)l * 4608 * 1024, 1024, 0, 0, n0 >= 512, scr, F.lane);
            else if (n0 < 3584) tr_item(W, 5632, kb * 64, n0, WV + (size_t)l * 1024 * 1024, 1024, -2560, 0, false, scr, F.lane);
            else tr_item(W, 5632, kb * 64, n0, WZ + (size_t)l * 4608 * 1024, 1024, -1024, 0, false, scr, F.lane);
            continue; }
        r -= 2 * I_IN;
        if (r < 4 * I_SQ) { const int q = r / I_SQ; r -= q * I_SQ; const int l = q & 1; const int kb = r / 32, nb = r % 32;
            const float* W = (q < 2 ? F.in[17] : F.in[18]) + (size_t)l * 1024 * 1024;
            if (q < 2) tr_item(W, 1024, kb * 64, nb * 32, WM + (size_t)l * 1024 * MAP, MAP, 0, 512, false, scr, F.lane);
            else tr_item(W, 1024, kb * 64, nb * 32, WOUT + (size_t)l * 1024 * 1024, 1024, 0, 0, false, scr, F.lane);
            continue; }
        r -= 4 * I_SQ;
        if (r < 2 * I_UP) { const int q = r / I_UP; r -= q * I_UP; const int kb = r / 86, nb = r % 86, n0 = nb * 32;
            const float* W = q ? F.in[20] : F.in[19];
            tr_item(W, FF, kb * 64, n0, WUP0, 1024, (n0 >> 7) * 256 + q * 128 - (n0 & ~127), 0, false, scr, F.lane); continue; }
        r -= 2 * I_UP;
        { const int kb = r / 32, nb = r % 32; tr_item(F.in[21], 1024, kb * 64, nb * 32, WDN0, FFP, 0, 0, false, scr, F.lane); }
    }
    { const int gt = F.vcu * NTHR + F.tid, NT = F.G * NTHR;
      for (int i = gt; i < 128 * 128; i += NT) { const int rr = i >> 7, cc = i & 127; const int row = 21 * 256 + (rr < 64 ? 64 + rr : 192 + (rr - 64)); *(u32x4*)(WUP0 + (size_t)row * 1024 + cc * 8) = (u32x4){0u, 0u, 0u, 0u}; }
      for (int i = gt; i < 1024 * 8; i += NT) { const int row = i >> 3, cc = i & 7; *(u32x4*)(WDN0 + (size_t)row * FFP + FF + cc * 8) = (u32x4){0u, 0u, 0u, 0u}; } }
    { bf16_t* WEFF = (bf16_t*)(F.ws + WS_WM);
      for (int it = gw; it < 1024; it += NGW) { const int l = it >> 9, g = (it >> 7) & 3, nbk = (it >> 3) & 15, cbk = it & 7; const int n = nbk * 64 + F.lane, c0 = cbk * 16;
          const float* pw = F.in[9] + ((size_t)(l * 4 + g) * 128 + c0) * 128; const float* ps = F.in[10] + l * 512 + g * 128; const float* wpp = F.in[16] + ((size_t)l * 512 + g * 128) * 1024 + n;
#pragma unroll
          for (int q = 0; q < 8; ++q) { const int idx = q * 256 + 4 * F.lane; const f32x4 v = *(const f32x4*)(pw + idx), sc = *(const f32x4*)(ps + (idx & 127)); *(LAS f32x4*)(scr + idx) = v * sc; }
          LDS_WAIT(); asm volatile("" ::: "memory");
          float a[16];
#pragma unroll
          for (int i = 0; i < 16; ++i) a[i] = 0.f;
#pragma unroll 4
          for (int d = 0; d < 128; ++d) { const float wv = wpp[(size_t)d * 1024];
#pragma unroll
              for (int i = 0; i < 16; ++i) a[i] += scr[i * 128 + d] * wv; }
          u32x4 o0, o1; o0.x = cvtpk(a[0], a[1]); o0.y = cvtpk(a[2], a[3]); o0.z = cvtpk(a[4], a[5]); o0.w = cvtpk(a[6], a[7]);
          o1.x = cvtpk(a[8], a[9]); o1.y = cvtpk(a[10], a[11]); o1.z = cvtpk(a[12], a[13]); o1.w = cvtpk(a[14], a[15]);
          bf16_t* dst = WEFF + ((size_t)l * 1024 + n) * MAP + g * 128 + c0; *(u32x4*)dst = o0; *(u32x4*)(dst + 8) = o1;
          LDS_WAIT(); asm volatile("" ::: "memory"); } }
    if (blockIdx.x == 0) {
        float* COS = (float*)(F.ws + WS_TAB); float* SIN = COS + 1024; float* LAMV = SIN + 1024;
        for (int idx = F.tid; idx < 1024; idx += NTHR) { const int pos = idx >> 4, i = idx & 15; const float inv = powf(10000.f, -(float)i * (2.0f / 32.0f)); const float ang = (float)pos * inv;
            COS[idx] = cosf(ang); SIN[idx] = sinf(ang); }
        if (F.wave == 1) {
            for (int l = 0; l < 2; ++l) { const float d1 = wave_sum(F.in[11][l * 64 + F.lane] * F.in[12][l * 64 + F.lane], F.lane), d2 = wave_sum(F.in[13][l * 64 + F.lane] * F.in[14][l * 64 + F.lane], F.lane);
                const float lam0 = 0.8f - 0.6f * expf(-0.3f * (float)l);
                if (F.lane == 0) { LAMV[2 * l] = expf(d1) - expf(d2) + lam0; LAMV[2 * l + 1] = 1.f - lam0; } }
        }
    }
}

constexpr size_t XPITCH = 4096;
template <bool SRC16>
__device__ __forceinline__ void phase_normmod(Frame F, const void* lat_, const void* ctx_, const float* g, const float* mod, int soff, bool do_ctx, bf16_t* H, const bf16_t* oadd = nullptr, void* latdst_ = nullptr, void* ctxdst_ = nullptr) {
    const char* lat = (const char*)lat_; const char* ctx = (const char*)ctx_; char* latdst = (char*)latdst_; char* ctxdst = (char*)ctxdst_;
    F.tid = opaque_tid(F.wave0); F.lane = F.tid & 63; F.wave = __builtin_amdgcn_readfirstlane(F.tid >> 6);
    const int gw = F.vcu * NWAVES + F.wave, NGW = F.G * NWAVES;
    const int per = (((NTOK + NGW - 1) / NGW) + 3) & ~3;
    const int r0 = gw * per, r1 = min(r0 + per, NTOK);
    int cur_bb = -1; f32x4 gs[4], sh[4];
#pragma unroll
    for (int q = 0; q < 4; ++q) { gs[q] = (f32x4){0.f, 0.f, 0.f, 0.f}; sh[q] = gs[q]; }
    for (int r = r0; r < r1; r += 4) {
        const int b = r / LTOK, j = r - b * LTOK; const bool isc = j < CTXL;
        if (isc && !do_ctx) continue;
        const int bb = isc ? 32 : b;
        if (bb != cur_bb) { cur_bb = bb; const float* mv = mod + (size_t)bb * MODW + soff;
#pragma unroll
            for (int q = 0; q < 4; ++q) { const int cidx = 4 * F.lane + 256 * q; const f32x4 gg = *(const f32x4*)(g + cidx), sc = *(const f32x4*)(mv + 1024 + cidx); gs[q] = gg * (sc + 1.f); sh[q] = *(const f32x4*)(mv + cidx); } }
        const char* src = isc ? ctx + ((size_t)b * CTXL + j) * XPITCH : lat + ((size_t)b * SEQ + (j - CTXL)) * XPITCH;
        f32x4 v[4][4]; float s[4];
        if (SRC16) {
            u32x2 xv[4][4];
#pragma unroll
            for (int i = 0; i < 4; ++i)
#pragma unroll
                for (int q = 0; q < 4; ++q) xv[i][q] = RLD((const u32x2*)(src + (size_t)i * XPITCH) + F.lane + 64 * q);
#pragma unroll
            for (int i = 0; i < 4; ++i)
#pragma unroll
                for (int q = 0; q < 4; ++q) v[i][q] = (f32x4){bflo(xv[i][q].x), bfhi(xv[i][q].x), bflo(xv[i][q].y), bfhi(xv[i][q].y)};
        } else {
#pragma unroll
            for (int i = 0; i < 4; ++i)
#pragma unroll
                for (int q = 0; q < 4; ++q) v[i][q] = RLD((const f32x4*)(src + (size_t)i * XPITCH) + F.lane + 64 * q);
        }
        if (oadd) {
            u32x2 ov[4][4];
#pragma unroll
            for (int i = 0; i < 4; ++i)
#pragma unroll
                for (int q = 0; q < 4; ++q) ov[i][q] = RLD((const u32x2*)(oadd + (size_t)(r + i) * D) + F.lane + 64 * q);
            char* dst = isc ? ctxdst + ((size_t)b * CTXL + j) * XPITCH : latdst + ((size_t)b * SEQ + (j - CTXL)) * XPITCH;
#pragma unroll
            for (int i = 0; i < 4; ++i)
#pragma unroll
                for (int q = 0; q < 4; ++q) { v[i][q] += (f32x4){bflo(ov[i][q].x), bfhi(ov[i][q].x), bflo(ov[i][q].y), bfhi(ov[i][q].y)};
                    u32x2 xo; xo.x = cvtpk(v[i][q][0], v[i][q][1]); xo.y = cvtpk(v[i][q][2], v[i][q][3]); RST((u32x2*)(dst + (size_t)i * XPITCH) + F.lane + 64 * q, xo); }
        }
#pragma unroll
        for (int i = 0; i < 4; ++i) { float a = 0.f;
#pragma unroll
            for (int q = 0; q < 4; ++q) a += (v[i][q][0] * v[i][q][0] + v[i][q][1] * v[i][q][1]) + (v[i][q][2] * v[i][q][2] + v[i][q][3] * v[i][q][3]);
            s[i] = a; }
#pragma unroll
        for (int o = 1; o < 64; o <<= 1)
#pragma unroll
            for (int i = 0; i < 4; ++i) s[i] += shx(s[i], o, F.lane);
#pragma unroll
        for (int i = 0; i < 4; ++i) { const float rstd = rsqrtf(s[i] * (1.f / D) + EPS); u32x2* o8 = (u32x2*)(H + (size_t)(r + i) * D) + F.lane;
#pragma unroll
            for (int q = 0; q < 4; ++q) { const f32x4 y = v[i][q] * rstd * gs[q] + sh[q]; u32x2 o; o.x = cvtpk(y[0], y[1]); o.y = cvtpk(y[2], y[3]); o8[64 * q] = o; } }
    }
}

__device__ __forceinline__ void phase_pool(Frame F, const bf16_t* U, bf16_t* M, bool do_ctx) {
    F.tid = opaque_tid(F.wave0); F.lane = F.tid & 63; F.wave = __builtin_amdgcn_readfirstlane(F.tid >> 6);
    const int gw = F.vcu * NWAVES + F.wave, NGW = F.G * NWAVES;
    const int per = (((NTOK + NGW - 1) / NGW) + 3) & ~3;
    const int r0 = gw * per, r1 = min(r0 + per, NTOK);
    const int half = 1 << (F.lane >> 4);
    for (int r = r0; r < r1; r += 4) {
        const int b = r / LTOK, j = r - b * LTOK; const bool isc = j < CTXL;
        if (isc && !do_ctx) continue;
        const int L = isc ? CTXL : SEQ, t = isc ? j : j - CTXL; const size_t base = (size_t)b * LTOK + (isc ? 0 : CTXL);
        u32x4 w[19];
#pragma unroll
        for (int k = 0; k < 19; ++k) { const int tt = min(max(t - 8 + k, 0), L - 1); w[k] = *(const u32x4*)(U + (base + tt) * 512 + 8 * F.lane); }
#pragma unroll
        for (int i = 0; i < 4; ++i) {
            const int ti = t + i, lo = max(ti - half, 0), hi = min(ti + half, L);
            float a[8];
#pragma unroll
            for (int q = 0; q < 8; ++q) a[q] = 0.f;
#pragma unroll
            for (int k = i; k < i + 16; ++k) { const int tt = t - 8 + k; const float mk = (tt >= lo && tt < hi) ? 1.f : 0.f;
                a[0] += mk * bflo(w[k].x); a[1] += mk * bfhi(w[k].x); a[2] += mk * bflo(w[k].y); a[3] += mk * bfhi(w[k].y); a[4] += mk * bflo(w[k].z); a[5] += mk * bfhi(w[k].z); a[6] += mk * bflo(w[k].w); a[7] += mk * bfhi(w[k].w); }
            const float ic = 1.f / (float)(hi - lo);
            const u32x4 ws = w[8 + i];
            u32x4 o; o.x = cvtpk(a[0] * ic - bflo(ws.x), a[1] * ic - bfhi(ws.x)); o.y = cvtpk(a[2] * ic - bflo(ws.y), a[3] * ic - bfhi(ws.y));
            o.z = cvtpk(a[4] * ic - bflo(ws.z), a[5] * ic - bfhi(ws.z)); o.w = cvtpk(a[6] * ic - bflo(ws.w), a[7] * ic - bfhi(ws.w));
            *(u32x4*)(M + (size_t)(r + i) * MAP + 8 * F.lane) = o;
        }
    }
}

__device__ __forceinline__ void phase_router(Frame F, char* x1, const float* g, const float* mod, bf16_t* H, const bf16_t* oadd) {
    F.tid = opaque_tid(F.wave0); F.lane = F.tid & 63; F.wave = __builtin_amdgcn_readfirstlane(F.tid >> 6);
    LAS float* WR = (LAS float*)F.lds;
    LAS float* LG = (LAS float*)(F.lds + 32768);
    LAS int* LCNT = (LAS int*)(F.lds + 32768 + 8192);
    unsigned* LIST = (unsigned*)(F.ws + WS_LIST); float* WTS = (float*)(F.ws + WS_WTS);
    for (int i = F.tid; i < 8192; i += NTHR) WR[i] = F.in[22][i];
    for (int ch = blockIdx.x; ch < NLAT / 256; ch += F.G) {
        if (F.tid < 16) LCNT[F.tid] = 0;
        __syncthreads();
        const int bch = (ch * 256) >> 11;
        f32x4 gs[4], sh[4];
        { const float* mv = mod + (size_t)bch * MODW + 3 * D;
#pragma unroll
          for (int q = 0; q < 4; ++q) { const int cidx = 4 * F.lane + 256 * q; const f32x4 gg = *(const f32x4*)(g + cidx), sc = *(const f32x4*)(mv + 1024 + cidx); gs[q] = gg * (sc + 1.f); sh[q] = *(const f32x4*)(mv + cidx); } }
        u32x2 vn[2][4], on[2][4];
#define RT_LOAD(rb_) do { const int _t0 = ch * 256 + F.wave * 32 + (rb_); const bf16_t* _or = oadd + ((size_t)bch * LTOK + CTXL + (_t0 & 2047)) * D; \
            _Pragma("unroll") for (int i = 0; i < 2; ++i) _Pragma("unroll") for (int q = 0; q < 4; ++q) { vn[i][q] = RLD((const u32x2*)(x1 + (size_t)(_t0 + i) * XPITCH) + F.lane + 64 * q); on[i][q] = RLD((const u32x2*)(_or + (size_t)i * D) + F.lane + 64 * q); } } while (0)
        RT_LOAD(0);
        for (int rb = 0; rb < 32; rb += 2) {
            const int rr0 = F.wave * 32 + rb, tok0 = ch * 256 + rr0;
            f32x4 v[2][4]; float s[2];
#pragma unroll
            for (int i = 0; i < 2; ++i)
#pragma unroll
                for (int q = 0; q < 4; ++q) v[i][q] = (f32x4){bflo(vn[i][q].x) + bflo(on[i][q].x), bfhi(vn[i][q].x) + bfhi(on[i][q].x), bflo(vn[i][q].y) + bflo(on[i][q].y), bfhi(vn[i][q].y) + bfhi(on[i][q].y)};
            if (rb + 2 < 32) RT_LOAD(rb + 2);
#pragma unroll
            for (int i = 0; i < 2; ++i)
#pragma unroll
                for (int q = 0; q < 4; ++q) { u32x2 xo; xo.x = cvtpk(v[i][q][0], v[i][q][1]); xo.y = cvtpk(v[i][q][2], v[i][q][3]); RST((u32x2*)(x1 + (size_t)(tok0 + i) * XPITCH) + F.lane + 64 * q, xo); }
#pragma unroll
            for (int i = 0; i < 2; ++i) { float a = 0.f;
#pragma unroll
                for (int q = 0; q < 4; ++q) a += (v[i][q][0] * v[i][q][0] + v[i][q][1] * v[i][q][1]) + (v[i][q][2] * v[i][q][2] + v[i][q][3] * v[i][q][3]);
                s[i] = a; }
#pragma unroll
            for (int o = 1; o < 64; o <<= 1)
#pragma unroll
                for (int i = 0; i < 2; ++i) s[i] += shx(s[i], o, F.lane);
#pragma unroll
            for (int i = 0; i < 2; ++i) {
                const int tok = tok0 + i; const float rstd = rsqrtf(s[i] * (1.f / D) + EPS);
                u32x2* o8 = (u32x2*)(H + ((size_t)bch * LTOK + CTXL + (tok & 2047)) * D) + F.lane;
                float lg[8];
#pragma unroll
                for (int e = 0; e < 8; ++e) lg[e] = 0.f;
#pragma unroll
                for (int q = 0; q < 4; ++q) { const int cidx = 4 * F.lane + 256 * q;
                    const f32x4 y = v[i][q] * rstd * gs[q] + sh[q];
                    u32x2 o; o.x = cvtpk(y[0], y[1]); o.y = cvtpk(y[2], y[3]); o8[64 * q] = o;
#pragma unroll
                    for (int k = 0; k < 4; ++k) { const LAS f32x4* wr = (const LAS f32x4*)(WR + (cidx + k) * 8); const f32x4 w0 = wr[0], w1 = wr[1];
                        lg[0] += y[k] * w0[0]; lg[1] += y[k] * w0[1]; lg[2] += y[k] * w0[2]; lg[3] += y[k] * w0[3]; lg[4] += y[k] * w1[0]; lg[5] += y[k] * w1[1]; lg[6] += y[k] * w1[2]; lg[7] += y[k] * w1[3]; } }
                const bool b0 = F.lane & 1, b1 = F.lane & 2, b2 = F.lane & 4;
                float a4[4], a2[2], a1;
#pragma unroll
                for (int j = 0; j < 4; ++j) { const float keep = b0 ? lg[4 + j] : lg[j], send = b0 ? lg[j] : lg[4 + j]; a4[j] = keep + shx(send, 1, F.lane); }
#pragma unroll
                for (int j = 0; j < 2; ++j) { const float keep = b1 ? a4[2 + j] : a4[j], send = b1 ? a4[j] : a4[2 + j]; a2[j] = keep + shx(send, 2, F.lane); }
                { const float keep = b2 ? a2[1] : a2[0], send = b2 ? a2[0] : a2[1]; a1 = keep + shx(send, 4, F.lane); }
                a1 += shx(a1, 8, F.lane); a1 += shx(a1, 16, F.lane); a1 += shx(a1, 32, F.lane);
                if (F.lane < 8) LG[(rr0 + i) * 8 + ((F.lane & 1) * 4 + (F.lane & 2) + ((F.lane >> 2) & 1))] = a1;
            }
        }
#undef RT_LOAD
        __syncthreads();
        int e1 = 0, e2 = 0, i1 = 0, i2 = 0; float w1 = 0.f, w2 = 0.f;
        if (F.tid < 256) {
            const f32x4 l0 = *(const LAS f32x4*)(LG + F.tid * 8), l1 = *(const LAS f32x4*)(LG + F.tid * 8 + 4);
            const float lg[8] = {l0[0], l0[1], l0[2], l0[3], l1[0], l1[1], l1[2], l1[3]};
            float v1 = lg[0];
#pragma unroll
            for (int e = 1; e < 8; ++e) if (lg[e] > v1) { v1 = lg[e]; e1 = e; }
            float v2 = -3.0e38f;
#pragma unroll
            for (int e = 0; e < 8; ++e) if (e != e1 && lg[e] > v2) { v2 = lg[e]; e2 = e; }
            const float p2 = expf(v2 - v1); w1 = 1.f / (1.f + p2); w2 = p2 * w1;
            i1 = atomicAdd((int*)&LCNT[e1], 1); i2 = atomicAdd((int*)&LCNT[e2], 1); }
        __syncthreads();
        if (F.tid < 8) LCNT[8 + F.tid] = (int)__hip_atomic_fetch_add(F.ctl + CW_CNT + 64 * F.tid, (unsigned)LCNT[F.tid], __ATOMIC_RELAXED, __HIP_MEMORY_SCOPE_AGENT);
        __syncthreads();
        if (F.tid < 256) { const unsigned tok = (unsigned)(ch * 256 + F.tid);
            LIST[(size_t)e1 * NLAT + LCNT[8 + e1] + i1] = tok * 2u; LIST[(size_t)e2 * NLAT + LCNT[8 + e2] + i2] = tok * 2u + 1u;
            WTS[tok * 2u] = w1; WTS[tok * 2u + 1u] = w2; }
        __syncthreads();
    }
    __syncthreads();
    LAS float* scr = (LAS float*)(F.lds + F.wave * 8448);
    const int gw = F.vcu * NWAVES + F.wave, NGW = F.G * NWAVES;
    bf16_t* WUPE = (bf16_t*)(F.ws + WS_WUPE); bf16_t* WDNE = (bf16_t*)(F.ws + WS_WDNE);
    constexpr int I_E = 16 * 44, I_D = 22 * 32;
    for (int it = gw; it < NE * (2 * I_E + I_D); it += NGW) {
        const int e = it / (2 * I_E + I_D); int r = it - e * (2 * I_E + I_D);
        if (r < 2 * I_E) { const int q = r / I_E; r -= q * I_E; const int kb = r / 44, nb = r % 44, n0 = nb * 32;
            const float* W = (q ? F.in[24] : F.in[23]) + (size_t)e * 1024 * FFE;
            tr_item(W, FFE, kb * 64, n0, WUPE + (size_t)e * 2816 * 1024, 1024, (n0 >> 7) * 256 + q * 128 - (n0 & ~127), 0, false, scr, F.lane); }
        else { r -= 2 * I_E; const int kb = r / 32, nb = r % 32;
            tr_item(F.in[25] + (size_t)e * FFE * 1024, 1024, kb * 64, nb * 32, WDNE + (size_t)e * 1024 * FFE, FFE, 0, 0, false, scr, F.lane); }
    }
}

__device__ __forceinline__ void phase_final(Frame F, float* x, const bf16_t* YM, const float* mod, const float* fg) {
    F.tid = opaque_tid(F.wave0); F.lane = F.tid & 63; F.wave = __builtin_amdgcn_readfirstlane(F.tid >> 6);
    const int gw = F.vcu * NWAVES + F.wave, NGW = F.G * NWAVES;
    const int per = (((NLAT + NGW - 1) / NGW) + 1) & ~1;
    const int t0 = gw * per, t1 = min(t0 + per, NLAT);
    f32x4 fgv[4];
#pragma unroll
    for (int q = 0; q < 4; ++q) fgv[q] = *(const f32x4*)(fg + 4 * F.lane + 256 * q);
    for (int tok = t0; tok < t1; tok += 2) {
        const int b = tok >> 11; const float* gate = mod + (size_t)b * MODW + 5 * D;
        f32x4 xv[2][4]; u32x2 xb[2][4], ya[2][4], yc[2][4];
#pragma unroll
        for (int i = 0; i < 2; ++i)
#pragma unroll
            for (int q = 0; q < 4; ++q) { xb[i][q] = RLD((const u32x2*)((const char*)x + (size_t)(tok + i) * XPITCH) + F.lane + 64 * q);
                ya[i][q] = RLD((const u32x2*)(YM + (size_t)(tok + i) * D) + F.lane + 64 * q); yc[i][q] = RLD((const u32x2*)(YM + ((size_t)NLAT + tok + i) * D) + F.lane + 64 * q); }
        float s[2];
#pragma unroll
        for (int i = 0; i < 2; ++i) { float a = 0.f;
#pragma unroll
            for (int q = 0; q < 4; ++q) { const f32x4 gg = *(const f32x4*)(gate + 4 * F.lane + 256 * q);
                const f32x4 yy = (f32x4){bflo(ya[i][q].x) + bflo(yc[i][q].x), bfhi(ya[i][q].x) + bfhi(yc[i][q].x), bflo(ya[i][q].y) + bflo(yc[i][q].y), bfhi(ya[i][q].y) + bfhi(yc[i][q].y)};
                xv[i][q] = (f32x4){bflo(xb[i][q].x), bfhi(xb[i][q].x), bflo(xb[i][q].y), bfhi(xb[i][q].y)} + gg * yy; a += (xv[i][q][0] * xv[i][q][0] + xv[i][q][1] * xv[i][q][1]) + (xv[i][q][2] * xv[i][q][2] + xv[i][q][3] * xv[i][q][3]); }
            s[i] = a; }
#pragma unroll
        for (int o = 1; o < 64; o <<= 1)
#pragma unroll
            for (int i = 0; i < 2; ++i) s[i] += shx(s[i], o, F.lane);
#pragma unroll
        for (int i = 0; i < 2; ++i) { const float rstd = rsqrtf(s[i] * (1.f / D) + EPS);
#pragma unroll
            for (int q = 0; q < 4; ++q) RST((f32x4*)(x + (size_t)(tok + i) * D) + F.lane + 64 * q, xv[i][q] * rstd * fgv[q]); }
    }
}

struct Args { const float* in[27]; float* out; unsigned char* ws; int ph_lo, ph_hi; };
__global__ void __launch_bounds__(NTHR, 2) dit_fwd(Args args) {
    extern __shared__ __attribute__((aligned(16))) unsigned char lds_raw[];
    LAS unsigned char* const ldsb = (LAS unsigned char*)lds_raw;
    const int WAVE = __builtin_amdgcn_readfirstlane((int)threadIdx.x >> 6);
    volatile LAS unsigned* xbw = (volatile LAS unsigned*)(ldsb + LDS_CTRL);
    if (threadIdx.x < 4) xbw[threadIdx.x] = 0u;
    __syncthreads();
    volatile LAS unsigned long long* tsl = (volatile LAS unsigned long long*)(ldsb + LDS_CTRL + 64);
    if (args.ph_hi - args.ph_lo > 1) (void)xcd_barrier_post((unsigned*)(args.ws + WS_CTL) + CW_BAR, xbw);
#ifndef SITE_MASK
#define SITE_MASK 0xFFFFFFFFu
#endif
#define SITE(n) (((SITE_MASK) >> (n)) & 1u)
#define IN(k) (args.ph_lo <= (k) && (k) < args.ph_hi)
#define STAMP(k) do { if (PROBE_MASK != 0u && blockIdx.x == 0 && opaque_tid(WAVE) == 0) tsl[(k)] = __builtin_amdgcn_s_memrealtime(); } while (0)
#define SEAM(k) do { if (IN(k) && IN((k) + 1)) { XcdBarrier _b; _b.bar = (unsigned*)(args.ws + WS_CTL) + CW_BAR; _b.x = xb_xcc_id(); _b.st = xbw; xcd_barrier(_b); } STAMP((k) + 1); } while (0)

#define WSBASE() size_t _wz = 0; asm volatile("" : "+s"(_wz)); unsigned char* ws = args.ws + _wz; float* MOD = (float*)(ws + WS_MOD); (void)MOD; \
    Frame F; F.lds = ldsb; F.ws = ws; F.ctl = (unsigned*)(ws + WS_CTL); F.in = args.in; F.out = args.out + _wz; F.wave0 = WAVE; F.tid = 0; F.lane = 0; F.wave = 0; \
    F.G = gridDim.x; { const int bx = blockIdx.x; F.vcu = (F.G % 8 == 0) ? (bx % 8) * (F.G / 8) + bx / 8 : bx; } const int c = (int)blockIdx.x; (void)c
#define P_COS ((const float*)(ws + WS_TAB))
#define P_SIN (P_COS + 1024)
#define P_LAMV (P_SIN + 1024)
#define P_XC ((float*)(ws + WS_XC))
#define P_H ((bf16_t*)(ws + WS_H))
#define P_U ((bf16_t*)(ws + WS_U))
#define P_Q ((bf16_t*)(ws + WS_Q))
#define P_KB ((bf16_t*)(ws + WS_K))
#define P_VT ((bf16_t*)(ws + WS_VT))
#define P_G ((unsigned char*)(ws + WS_G))
#define P_MA ((bf16_t*)(ws + WS_MA))
#define P_Y ((bf16_t*)(ws + WS_Y))
#define P_HID ((bf16_t*)(ws + WS_HID))
#define P_HIDM ((bf16_t*)(ws + WS_HIDM))
#define P_YM ((bf16_t*)(ws + WS_YM))

    if (PROBE_MASK != 0u && threadIdx.x == 0) { tsl[20] = 0; tsl[21] = 0; tsl[22] = 0; tsl[23] = 0; }
    STAMP(0);
    if (SITE(0) && IN(0)) { WSBASE(); phase_prologue(F); } SEAM(0);
    if (SITE(1) && IN(1)) { WSBASE(); phase_normmod<false>(F, F.in[0], F.in[2], F.in[6], MOD, 0, true, P_H); } SEAM(1);

    for (int l = 0; l < 2; ++l) {
        const int pb = 2 + 8 * l; const bool last = (l == 1);
        if (SITE(2) && IN(pb)) { WSBASE();
            ZSched S; S.init(F.G, c, last ? 1 : 0, P_H, ws + WS_WZ + (size_t)l * 9 * MiB, ws + WS_WV + (size_t)l * 2 * MiB);
            ZEpi E{P_U, P_Q, P_KB, P_G, P_VT, P_COS, P_SIN};
            pg8::gemm_phase(F.lds, WAVE, 1024, S, E);
        } SEAM(pb);
        if (SITE(3) && IN(pb + 1)) { WSBASE();
            phase_pool(F, P_U, P_MA, !last);
            const float lam = P_LAMV[2 * l], osc = P_LAMV[2 * l + 1]; const float* subg = F.in[15] + l * VD;
            bf16x8 qf[4];
            for (int i = 0;; ++i) { const int Lf = i * F.G + F.vcu; if (Lf >= NB * NH * 16) break; const int L = REV_ORDER ? NB * NH * 16 - 1 - Lf : Lf; const int bh = L >> 4, qt = L & 15, b = bh >> 3, h = bh & 7;
                const int Lfn = Lf + F.G; const bool hn = Lfn < NB * NH * 16; const int Ln = REV_ORDER ? NB * NH * 16 - 1 - Lfn : Lfn; const int nbh = Ln >> 4, nqt = Ln & 15, nb = nbh >> 3, nh = nbh & 7;
                att::attn_unit(F.lds, P_Q, P_KB, P_VT, P_MA, b, h, (size_t)b * LTOK + CTXL + qt * 128, 36, lam, osc, subg, qf, XUP ? i == 0 : true, XUP ? hn : false, nb, nh, (size_t)nb * LTOK + CTXL + nqt * 128, WAVE); }
            if (!last) for (int i = 0;; ++i) { const int L = i * F.G + F.vcu; if (L >= NB * NH * 2) break; const int bh = L >> 1, qt = L & 1, b = bh >> 3, h = bh & 7;
                const int Ln = L + F.G; const bool hn = Ln < NB * NH * 2; const int nbh = Ln >> 1, nqt = Ln & 1, nb = nbh >> 3, nh = nbh & 7;
                att::attn_unit(F.lds, P_Q, P_KB, P_VT, P_MA, b, h, (size_t)b * LTOK + qt * 128, 4, lam, osc, subg, qf, XUP ? i == 0 : true, XUP ? hn : false, nb, nh, (size_t)nb * LTOK + nqt * 128, WAVE); }
        } SEAM(pb + 1);
        if (SITE(4) && IN(pb + 2)) { WSBASE();
            MergeSched S; S.init(F.G, c, last ? 1 : 0, P_MA, ws + WS_WM + (size_t)l * 3 * MiB); MergeEpi E{P_Y, P_G}; pg8::gemm_phase(F.lds, WAVE, MAP, S, E);
        } SEAM(pb + 2);
        if (SITE(5) && IN(pb + 3)) { WSBASE();
            PlainSched S; S.init(F.G, c, last ? 1 : 0, 4, P_Y, ws + WS_WOUT + (size_t)l * 2 * MiB, 1024, REV_ORDER);
            OEpi E{P_Q, MOD + (size_t)l * 33 * MODW, 2 * D};
            pg8::gemm_phase(F.lds, WAVE, 1024, S, E);
        } SEAM(pb + 3);
        if (!last) {
            if (SITE(6) && IN(pb + 4)) { WSBASE(); phase_normmod<false>(F, F.in[0], F.in[2], F.in[7], MOD, 3 * D, true, P_H, P_Q, F.out, P_XC); } SEAM(pb + 4);
            if (SITE(7) && IN(pb + 5)) { WSBASE(); PlainSched S; S.init(F.G, c, 0, 22, P_H, ws + WS_WUP0, 1024); UpEpi E{P_HID, FFP}; pg8::gemm_phase(F.lds, WAVE, 1024, S, E); } SEAM(pb + 5);
            if (SITE(8) && IN(pb + 6)) { WSBASE(); PlainSched S; S.init(F.G, c, 0, 4, P_HID, ws + WS_WDN0, FFP, REV_ORDER); OEpi E{(bf16_t*)P_G, MOD, 5 * D}; pg8::gemm_phase(F.lds, WAVE, FFP, S, E); } SEAM(pb + 6);
            if (SITE(9) && IN(pb + 7)) { WSBASE(); phase_normmod<true>(F, F.out, P_XC, F.in[6] + D, MOD + (size_t)33 * MODW, 0, true, P_H, (const bf16_t*)P_G, F.out, P_XC); } SEAM(pb + 7);
        } else {
            if (SITE(10) && IN(pb + 4)) { WSBASE(); phase_router(F, (char*)F.out, F.in[7] + D, MOD + (size_t)33 * MODW, P_H, P_Q); } SEAM(pb + 4);
            if (SITE(12) && IN(pb + 5)) { WSBASE(); MoeInfo mi; mi.load(F.ctl); MoeSched S; S.init(F.G, c, 11, P_H, ws + WS_WUPE, 1024, 2816, mi); S.gather = 1; S.LIST = (const unsigned*)(ws + WS_LIST); UpEpi E{P_HIDM, FFE}; pg8::gemm_phase<true>(F.lds, WAVE, 1024, S, E); } SEAM(pb + 5);
            if (SITE(13) && IN(pb + 6)) { WSBASE(); MoeInfo mi; mi.load(F.ctl); MoeSched S; S.init(F.G, c, 4, P_HIDM, ws + WS_WDNE, FFE, 1024, mi); S.rev = REV_ORDER;
                MoeDownEpi E{P_YM, (const unsigned*)(ws + WS_LIST), (const float*)(ws + WS_WTS), mi}; pg8::gemm_phase(F.lds, WAVE, FFE, S, E); } SEAM(pb + 6);
            if (SITE(14) && IN(pb + 7)) { WSBASE(); phase_final(F, F.out, P_YM, MOD + (size_t)33 * MODW, F.in[26]); }
            if (PROBE_MASK != 0u && blockIdx.x == 0) { __syncthreads(); if (threadIdx.x == 0) { const unsigned long long tend = __builtin_amdgcn_s_memrealtime(); unsigned long long dly = 0;
                for (int k = 0; k < N_PHASES; ++k) if ((PROBE_MASK >> k) & 1u) dly += (k == N_PHASES - 1 ? tend : tsl[k + 1]) - tsl[k];
                if ((PROBE_MASK >> 20) & 1u) dly += tsl[20];
                if ((PROBE_MASK >> 21) & 1u) dly += tsl[21];
                if ((PROBE_MASK >> 22) & 1u) dly += tsl[22];
                if ((PROBE_MASK >> 23) & 1u) dly += tsl[23];
                while (__builtin_amdgcn_s_memrealtime() - tend < dly) __builtin_amdgcn_s_sleep(8); } }
        }
    }
#undef IN
#undef SEAM
}

extern "C" void kernel_launch(void* const* d_in, const int* in_sizes, int n_in, void* d_out, int out_size, void* d_ws, size_t ws_size, hipStream_t stream) {
    static int grid = 0;
    if (grid == 0) {
        if (n_in != 27 || ws_size < WS_END) { fprintf(stderr, "kernel_launch: unexpected n_in %d or ws %zu\n", n_in, ws_size); grid = -1; return; }
        int dev = 0, cus = 0;
        if (hipGetDevice(&dev) != hipSuccess || hipDeviceGetAttribute(&cus, hipDeviceAttributeMultiprocessorCount, dev) != hipSuccess) { grid = -1; return; }
        if (hipFuncSetAttribute((const void*)dit_fwd, hipFuncAttributeMaxDynamicSharedMemorySize, LDS_BYTES) != hipSuccess) { fprintf(stderr, "kernel_launch: hipFuncSetAttribute failed\n"); grid = -1; return; }
        (void)hipGetLastError();
        grid = cus;
    }
    if (grid < 0) return;
    (void)hipMemsetAsync((char*)d_ws + WS_CTL, 0, CTL_ZERO_BYTES, stream);
    Args a{};
    for (int i = 0; i < 27; ++i) a.in[i] = (const float*)d_in[i];
    a.out = (float*)d_out; a.ws = (unsigned char*)d_ws;
#if MK_ONE_LAUNCH
    a.ph_lo = 0; a.ph_hi = N_PHASES;
    hipLaunchKernelGGL(dit_fwd, dim3(grid), dim3(NTHR), LDS_BYTES, stream, a);
#else
    for (int p = 0; p < N_PHASES; ++p) { a.ph_lo = p; a.ph_hi = p + 1; hipLaunchKernelGGL(dit_fwd, dim3(grid), dim3(NTHR), LDS_BYTES, stream, a); }
#endif
}
```

```cpp
#include <hip/hip_runtime.h>
#include <cstdio>
#include <cstdint>

#define LAS __attribute__((address_space(3)))
#define GAS __attribute__((address_space(1)))
typedef unsigned short bf16_t;
typedef short bf16x8 __attribute__((ext_vector_type(8)));
typedef float f32x4 __attribute__((ext_vector_type(4)));
typedef float f32x16 __attribute__((ext_vector_type(16)));
typedef unsigned u32x4 __attribute__((ext_vector_type(4)));
typedef unsigned u32x2 __attribute__((ext_vector_type(2)));
typedef float f32x2_t __attribute__((ext_vector_type(2)));
typedef __bf16 bf16x2_t __attribute__((ext_vector_type(2)));

#ifndef PROBE_MASK
#define PROBE_MASK 0u
#endif
#ifndef PG8_ALIGN
#define PG8_ALIGN 1
#endif
#ifndef ATT_PRIO
#define ATT_PRIO 0
#ifndef REV_ORDER
#define REV_ORDER 1
#endif
#ifndef ROW_NT
#define ROW_NT 1
#endif
#endif
#ifndef XUP
#define XUP 0
#endif
#ifndef GEMM_STAGGER
#define GEMM_STAGGER 0
#endif
#ifndef MK_ONE_LAUNCH
#define MK_ONE_LAUNCH 1
#endif

constexpr int D = 1024, NB = 32, SEQ = 2048, CTXL = 256, LTOK = SEQ + CTXL, NTOK = NB * LTOK, NRT = NTOK / 256;
constexpr int NLAT = NB * SEQ;
constexpr int NH = 8, VD = 128;
constexpr int FF = 2752, FFP = 2816, NE = 8, FFE = 1408;
constexpr int MODW = 6 * D;
constexpr float EPS = 1e-6f;
constexpr float LOG2E = 1.4426950408889634f;
constexpr float QSCALE = 0.125f * LOG2E;
constexpr int NWAVES = 8, NTHR = 512;

constexpr size_t MiB = 1u << 20;
constexpr size_t WS_CTL = 0, CTL_ZERO_BYTES = 65536;
constexpr size_t WS_MOD = 65536;
constexpr size_t WS_TAB = 1703936;
constexpr size_t WS_XC = 2 * MiB;
constexpr size_t WS_W = 34 * MiB;
constexpr size_t WS_WZ = WS_W, WS_WV = WS_W + 18 * MiB, WS_WM = WS_W + 22 * MiB, WS_WOUT = WS_W + 28 * MiB, WS_WUP0 = WS_W + 32 * MiB, WS_WDN0 = WS_W + 43 * MiB;
constexpr size_t WS_H = 83 * MiB, WS_MA = 83 * MiB, WS_U = 299 * MiB, WS_Q = 371 * MiB, WS_K = 515 * MiB, WS_VT = 659 * MiB, WS_G = 803 * MiB, WS_END = 982 * MiB;
constexpr size_t WS_Y = WS_K, WS_HID = WS_U;
constexpr size_t WS_YM = 299 * MiB, WS_HIDM = 555 * MiB, WS_WUPE = 913 * MiB, WS_WDNE = 957 * MiB, WS_LIST = 979 * MiB, WS_WTS = 981 * MiB;
constexpr int MAP = 1536;
static_assert(WS_WDN0 + (size_t)D * FFP * 2 <= WS_H, "weights");
static_assert(WS_MA + (size_t)NTOK * MAP * 2 <= WS_U && WS_G + (size_t)NTOK * 2048 <= WS_END, "ma / g");
static_assert(WS_HID + (size_t)NTOK * FFP * 2 <= WS_END, "hid");
static_assert(WS_YM + (size_t)2 * NLAT * D * 2 <= WS_HIDM && WS_HIDM + (size_t)133120 * FFE * 2 <= WS_WUPE && WS_WTS + (size_t)NLAT * 8 <= WS_END, "moe");
constexpr int CW_BAR = 1024, CW_CNT = 8192;

constexpr int N_PHASES = 18;
constexpr int LDS_BYTES = 163840;
constexpr int LDS_CTRL = LDS_BYTES - 256;

__device__ __forceinline__ unsigned cvtpk(float lo, float hi) { f32x2_t v = {lo, hi}; bf16x2_t b = __builtin_convertvector(v, bf16x2_t); return __builtin_bit_cast(unsigned, b); }
__device__ __forceinline__ float bflo(unsigned w) { return __uint_as_float(w << 16); }
__device__ __forceinline__ float bfhi(unsigned w) { return __uint_as_float(w & 0xffff0000u); }
__device__ __forceinline__ u32x4 pack8(const f32x4 a, const f32x4 b) { u32x4 w; w.x = cvtpk(a[0], a[1]); w.y = cvtpk(a[2], a[3]); w.z = cvtpk(b[0], b[1]); w.w = cvtpk(b[2], b[3]); return w; }
__device__ __forceinline__ float shx(float v, int o, int lane) { return __int_as_float(__builtin_amdgcn_ds_bpermute((lane ^ o) << 2, __float_as_int(v))); }
__device__ __forceinline__ float wave_sum(float v, int lane) {
#pragma unroll
    for (int o = 1; o < 64; o <<= 1) v += shx(v, o, lane);
    return v;
}
__device__ __forceinline__ float pair_sum(float v) { auto rr = __builtin_amdgcn_permlane32_swap(__float_as_uint(v), __float_as_uint(v), false, false); return __uint_as_float(rr[0]) + __uint_as_float(rr[1]); }
__device__ __forceinline__ float pair_max(float v) { auto rr = __builtin_amdgcn_permlane32_swap(__float_as_uint(v), __float_as_uint(v), false, false); return fmaxf(__uint_as_float(rr[0]), __uint_as_float(rr[1])); }
__device__ __forceinline__ float fast_sigmoid(float x) { return __builtin_amdgcn_rcpf(1.f + __builtin_amdgcn_exp2f(-LOG2E * x)); }
#define LDS_WAIT() asm volatile("s_waitcnt lgkmcnt(0)" ::: "memory")
__device__ __forceinline__ int opaque_tid(int wave) { unsigned z = 0u; asm volatile("" : "+v"(z)); return (wave << 6) | (int)__builtin_amdgcn_mbcnt_hi(~0u, __builtin_amdgcn_mbcnt_lo(~0u, z)); }

#define XB_TMO      128
#define XB_XCNT(j)  (256  + 64 * (j))
#define XB_XSUB(j)  (1280 + 64 * (j))
#define XB_XGEN(j)  (2304 + 64 * (j))
#define XB_TOP      3328
#define XB_TOPGEN   3392
#define XCD_BAR_WORDS 3456
#define XB_SPIN_CAP (1u << 22)
__device__ __forceinline__ unsigned xb_ld(unsigned* p)              { return __hip_atomic_load(p, __ATOMIC_RELAXED, __HIP_MEMORY_SCOPE_AGENT); }
__device__ __forceinline__ unsigned xb_add(unsigned* p, unsigned v) { return __hip_atomic_fetch_add(p, v, __ATOMIC_RELAXED, __HIP_MEMORY_SCOPE_AGENT); }
__device__ __forceinline__ unsigned xb_xcc_id() { return (unsigned)__builtin_amdgcn_s_getreg((3 << 11) | 20) & 0xFu; }
#define XB_SPIN(cond, bar) do { unsigned _sp = 0; while (cond) { __builtin_amdgcn_s_sleep(1); \
    if ((++_sp & 255u) == 0u) { if (xb_ld(&(bar)[XB_TMO])) break; if (_sp > XB_SPIN_CAP) { atomicAdd(&(bar)[XB_TMO], 1u); break; } } } } while (0)
struct XcdBarrier { unsigned* bar; unsigned x; volatile LAS unsigned* st; };
__device__ __forceinline__ XcdBarrier xcd_barrier_post(unsigned* bar, volatile LAS unsigned* st) {
    XcdBarrier b; b.bar = bar; b.x = xb_xcc_id(); b.st = st;
    if (threadIdx.x == 0) (void)xb_add(&bar[XB_XCNT(b.x)], 1u);
    return b;
}
__device__ __forceinline__ void xcd_barrier_complete(unsigned* bar, unsigned x, unsigned& nloc, unsigned& nx) {
    const unsigned G = gridDim.x * gridDim.y * gridDim.z;
    unsigned sum, cnt, mine, sp = 0u;
    for (;;) {
        sum = 0u; cnt = 0u; mine = 0u;
#pragma unroll
        for (unsigned j = 0; j < 16; ++j) { const unsigned c = xb_ld(&bar[XB_XCNT(j)]); sum += c; cnt += (c > 0u) ? 1u : 0u; mine = (j == x) ? c : mine; }
        if (sum == G) break;
        __builtin_amdgcn_s_sleep(1);
        if ((++sp & 255u) == 0u) { if (xb_ld(&bar[XB_TMO])) break; if (sp > XB_SPIN_CAP) { atomicAdd(&bar[XB_TMO], 1u); break; } }
    }
    nloc = mine > 0u ? mine : 1u; nx = cnt > 0u ? cnt : 1u;
}
__device__ __forceinline__ void xcd_barrier(const XcdBarrier& b) {
    asm volatile("s_waitcnt vmcnt(0)" ::: "memory");
    __syncthreads();
    if (threadIdx.x == 0) {
        unsigned* bar = b.bar;
        __builtin_amdgcn_s_waitcnt(0);
        unsigned nloc = b.st[0], nx = b.st[1];
        if (nloc == 0u) { xcd_barrier_complete(bar, b.x, nloc, nx); b.st[0] = nloc; b.st[1] = nx; }
        const unsigned old = xb_add(&bar[XB_XSUB(b.x)], 1u);
        const unsigned gen = old / nloc;
        if (old + 1u == (gen + 1u) * nloc) {
            __builtin_amdgcn_fence(__ATOMIC_RELEASE, "agent");
            asm volatile("s_waitcnt vmcnt(0)" ::: "memory");
            const unsigned og = xb_add(&bar[XB_TOP], 1u);
            const unsigned tg = og / nx;
            if (og + 1u == (tg + 1u) * nx) xb_add(&bar[XB_TOPGEN], 1u);
            else XB_SPIN(xb_ld(&bar[XB_TOPGEN]) == tg, bar);
            __builtin_amdgcn_fence(__ATOMIC_ACQUIRE, "agent");
            xb_add(&bar[XB_XGEN(b.x)], 1u);
            asm volatile("s_waitcnt vmcnt(0)" ::: "memory");
        } else {
            XB_SPIN(xb_ld(&bar[XB_XGEN(b.x)]) == gen, bar);
            __builtin_amdgcn_fence(__ATOMIC_ACQUIRE, "agent");
            asm volatile("s_waitcnt vmcnt(0)" ::: "memory");
        }
    }
    __syncthreads();
}

namespace pg8 {
constexpr int BM = 256, BK = 64, HALF = 128, HTB = HALF * BK * 2, NXCD = 8, WGM = 8;
__host__ __device__ __forceinline__ int lds_byte(int r, int c) { const int st = (r >> 4) * 2 + (c >> 5), rr = r & 15, cc = c & 31, ob = rr * 64 + cc * 2; return st * 1024 + (ob ^ (((ob >> 9) & 1) << 5)); }
__host__ __device__ __forceinline__ void stage_rc(int b, int& R, int& C) { const int st = b / 1024, sb = b % 1024, swz = sb ^ (((sb >> 9) & 1) << 5); R = (st >> 1) * 16 + swz / 64; C = (st & 1) * 32 + (swz % 64) / 2; }
__host__ __device__ __forceinline__ int perm32(int rho) { const int n = rho >> 4, i = rho & 15; return 8 * (i >> 2) + 4 * n + (i & 3); }
struct Unit { int pm, pn, kind; };
struct GridMap {
    int nM, nN, nwg;
    __device__ __forceinline__ void init(int nM_, int nN_) { nM = nM_; nN = nN_; nwg = nM_ * nN_; }
    __device__ __forceinline__ void map(int L, int& pm, int& pn) const {
        int wgid = L; { const int q = nwg / NXCD, r = nwg % NXCD, xcd = wgid % NXCD, off = wgid / NXCD; wgid = (xcd < r ? xcd * (q + 1) : r * (q + 1) + (xcd - r) * q) + off; }
        const int nig = WGM * nN, gid = wgid / nig, fm = gid * WGM, gsz = (nM - fm) < WGM ? (nM - fm) : WGM;
        pm = fm + ((wgid % nig) % gsz); pn = (wgid % nig) / gsz;
    }
};
template <bool GATHER = false, class Epi, class Sched>
__device__ __forceinline__ void gemm_phase(LAS unsigned char* lds, const int wv, const int K, const Sched& S, const Epi& E) {
    const int tid = opaque_tid(wv), wid = __builtin_amdgcn_readfirstlane(tid >> 6), lane = tid & 63, wr = wid >> 2, wc = wid & 3, fr = lane & 15, fq = lane >> 4;
    int nt = K / BK;
    unsigned voffA[2], voffB[2]; int RA[2];
#pragma unroll
    for (int i = 0; i < 2; ++i) { int R, C; stage_rc(tid * 16 + i * 8192, R, C); const int Rb = (R & ~31) + perm32(R & 31); RA[i] = R;
        voffA[i] = GATHER ? (unsigned)C * 2u : (unsigned)(R * K + C) * 2u; voffB[i] = (unsigned)(Rb * K + C) * 2u; }
    unsigned gC[2][2] = {{0u, 0u}, {0u, 0u}}, gN[2][2] = {{0u, 0u}, {0u, 0u}};
    const size_t kstep = (size_t)(BK * 2);
    const size_t hstep = (size_t)HALF * K * 2;
    const unsigned ldsw = (unsigned)wid * 1024u;
    const int aoff = lds_byte(wr * 64 + fr, fq * 8), boff = lds_byte(wc * 32 + fr, fq * 8);
#define PG8_SA(b, h) (((b) * 2 + (h)) * HTB)
#define PG8_SB(b, h) ((4 + (b) * 2 + (h)) * HTB)
#define PG8_STAGE(bufoff, gbase, voff) do { _Pragma("unroll") for (int _i = 0; _i < 2; ++_i) \
        __builtin_amdgcn_global_load_lds((const unsigned*)((const char*)(gbase) + (voff)[_i]), (LAS unsigned*)(lds + (bufoff) + ldsw + _i * 8192), 16, 0, 0); } while (0)
#define PG8_STAGE2(bufoff, gbase, o0, o1) do { \
        __builtin_amdgcn_global_load_lds((const unsigned*)((const char*)(gbase) + (o0)), (LAS unsigned*)(lds + (bufoff) + ldsw), 16, 0, 0); \
        __builtin_amdgcn_global_load_lds((const unsigned*)((const char*)(gbase) + (o1)), (LAS unsigned*)(lds + (bufoff) + ldsw + 8192), 16, 0, 0); } while (0)
#define PG8_LDA(dst, b, h) do { _Pragma("unroll") for (int m = 0; m < 4; ++m) _Pragma("unroll") for (int k = 0; k < 2; ++k) dst[m][k] = *(const LAS bf16x8*)(lds + PG8_SA(b, h) + aoff + m * 2048 + k * 1024); } while (0)
#define PG8_LDB(dst, b, h) do { _Pragma("unroll") for (int n = 0; n < 2; ++n) _Pragma("unroll") for (int k = 0; k < 2; ++k) dst[n][k] = *(const LAS bf16x8*)(lds + PG8_SB(b, h) + boff + n * 2048 + k * 1024); } while (0)
#define PG8_MMA(ai, bj, At, Bt) do { __builtin_amdgcn_s_setprio(1); _Pragma("unroll") for (int m = 0; m < 4; ++m) _Pragma("unroll") for (int n = 0; n < 2; ++n) _Pragma("unroll") for (int k = 0; k < 2; ++k) \
        acc[ai][bj][m][n] = __builtin_amdgcn_mfma_f32_16x16x32_bf16(Bt[n][k], At[m][k], acc[ai][bj][m][n], 0, 0, 0); __builtin_amdgcn_s_setprio(0); } while (0)
#define PG8_WAIT_V(n) asm volatile("s_waitcnt vmcnt(" #n ")" ::: "memory")
#define PG8_WAIT_L(n) asm volatile("s_waitcnt lgkmcnt(" #n ")" ::: "memory")
#define PG8_BAR __builtin_amdgcn_s_barrier()
#define PG8_SCHED __builtin_amdgcn_sched_barrier(0)
#define PG8_ITER(t) do { \
            const bool last = (t == nt - 2); \
            const char* a1 = cA + (size_t)(t + 1) * kstep; \
            const char* a2 = (last ? nA : cA + (size_t)(t + 2) * kstep); const char* b2 = last ? nB : cB + (size_t)(t + 2) * kstep; \
            const char* a3 = a2 + kstep; const char* b3 = b2 + kstep; \
            unsigned s00 = 0u, s01 = 0u, s10 = 0u, s11 = 0u; \
            if constexpr (GATHER) { s00 = last ? gN[0][0] : gC[0][0]; s01 = last ? gN[0][1] : gC[0][1]; s10 = last ? gN[1][0] : gC[1][0]; s11 = last ? gN[1][1] : gC[1][1]; } \
            PG8_LDB(B0, 0, 0); PG8_LDB(B1, 0, 1); PG8_SCHED; PG8_LDA(At, 0, 0); \
            if constexpr (GATHER) PG8_STAGE2(PG8_SA(1, 1), a1, gC[1][0], gC[1][1]); else PG8_STAGE(PG8_SA(1, 1), a1 + hstep, voffA); \
            PG8_WAIT_V(8); \
            PG8_WAIT_L(0); PG8_BAR; PG8_MMA(0, 0, At, B0); PG8_MMA(0, 1, At, B1); PG8_BAR; PG8_SCHED; \
            PG8_LDA(At, 0, 1); PG8_STAGE(PG8_SB(0, 0), b2, voffB); PG8_STAGE(PG8_SB(0, 1), b2 + hstep, voffB); \
            if constexpr (GATHER) PG8_STAGE2(PG8_SA(0, 0), a2, s00, s01); else PG8_STAGE(PG8_SA(0, 0), a2, voffA); \
            PG8_WAIT_V(8); \
            PG8_WAIT_L(0); PG8_BAR; PG8_MMA(1, 0, At, B0); PG8_MMA(1, 1, At, B1); PG8_BAR; PG8_SCHED; \
            PG8_LDB(B0, 1, 0); PG8_LDB(B1, 1, 1); PG8_SCHED; PG8_LDA(At, 1, 0); \
            if constexpr (GATHER) PG8_STAGE2(PG8_SA(0, 1), a2, s10, s11); else PG8_STAGE(PG8_SA(0, 1), a2 + hstep, voffA); \
            PG8_WAIT_V(8); PG8_WAIT_L(0); PG8_BAR; PG8_MMA(0, 0, At, B0); PG8_MMA(0, 1, At, B1); PG8_BAR; PG8_SCHED; \
            PG8_LDA(At, 1, 1); PG8_STAGE(PG8_SB(1, 0), b3, voffB); PG8_STAGE(PG8_SB(1, 1), b3 + hstep, voffB); \
            if constexpr (GATHER) PG8_STAGE2(PG8_SA(1, 0), a3, s00, s01); else PG8_STAGE(PG8_SA(1, 0), a3, voffA); \
            PG8_WAIT_V(8); PG8_WAIT_L(0); PG8_BAR; PG8_MMA(1, 0, At, B0); PG8_MMA(1, 1, At, B1); PG8_BAR; PG8_SCHED; \
        } while (0)
    Unit cur, nxt; int ui = 0;
    if (!S.next(0, cur)) return;
#if GEMM_STAGGER
    if (blockIdx.x & 1) { const unsigned long long t0s = __builtin_amdgcn_s_memrealtime(); const unsigned long long dl = ((unsigned long long)K * GEMM_STAGGER) >> 4;
        while (__builtin_amdgcn_s_memrealtime() - t0s < dl) __builtin_amdgcn_s_sleep(16); }
#endif
    f32x4 acc[2][2][4][2];
#pragma unroll
    for (int a = 0; a < 2; ++a)
#pragma unroll
        for (int b = 0; b < 2; ++b)
#pragma unroll
            for (int m = 0; m < 4; ++m)
#pragma unroll
                for (int n = 0; n < 2; ++n) acc[a][b][m][n] = (f32x4){0.f, 0.f, 0.f, 0.f};
    bf16x8 At[4][2], B0[2][2], B1[2][2];
    const char* cA = S.abase(cur); const char* cB = S.bbase(cur);
    if constexpr (Sched::VAR_NT) nt = S.ktiles(cur);
    if constexpr (GATHER) {
#pragma unroll
        for (int h = 0; h < 2; ++h)
#pragma unroll
            for (int i = 0; i < 2; ++i) gC[h][i] = S.grow(cur, h * HALF + RA[i]) + voffA[i];
    }
    PG8_STAGE(PG8_SB(0, 0), cB, voffB); PG8_STAGE(PG8_SB(0, 1), cB + hstep, voffB);
    if constexpr (GATHER) { PG8_STAGE2(PG8_SA(0, 0), cA, gC[0][0], gC[0][1]); PG8_STAGE2(PG8_SA(0, 1), cA, gC[1][0], gC[1][1]); }
    else { PG8_STAGE(PG8_SA(0, 0), cA, voffA); PG8_STAGE(PG8_SA(0, 1), cA + hstep, voffA); }
    if (wr == 1) PG8_BAR;
    PG8_WAIT_V(2); PG8_BAR;
    PG8_STAGE(PG8_SB(1, 0), cB + kstep, voffB);
    if constexpr (GATHER) PG8_STAGE2(PG8_SA(1, 0), cA + kstep, gC[0][0], gC[0][1]); else PG8_STAGE(PG8_SA(1, 0), cA + kstep, voffA);
    PG8_STAGE(PG8_SB(1, 1), cB + hstep + kstep, voffB);
    PG8_WAIT_V(6); PG8_BAR;
    for (;;) {
        const bool has_next = S.next(ui + 1, nxt);
        const char* nA = has_next ? S.abase(nxt) : cA; const char* nB = has_next ? S.bbase(nxt) : cB;
        if constexpr (GATHER) {
#pragma unroll
            for (int h = 0; h < 2; ++h)
#pragma unroll
                for (int i = 0; i < 2; ++i) gN[h][i] = has_next ? S.grow(nxt, h * HALF + RA[i]) + voffA[i] : gC[h][i];
        }
        for (int t = 0; t < nt; t += 2) PG8_ITER(t);
        if (PG8_ALIGN) { if (wr == 0) PG8_BAR; }
#if PROBE_MASK
        const unsigned long long _te0 = __builtin_amdgcn_s_memrealtime();
#endif
        bool keep = false;
        if constexpr (Epi::CHAINED) { if (cur.kind == 0) { E.mid(acc, cur, wr, wc, fr, fq); keep = true; } else E(acc, cur, wr, wc, fr, fq); } else E(acc, cur, wr, wc, fr, fq);
#if PROBE_MASK
        if (blockIdx.x == 0 && tid == 0) { asm volatile("s_waitcnt vmcnt(0)" ::: "memory"); volatile LAS unsigned long long* pacc = (volatile LAS unsigned long long*)(lds + LDS_CTRL + 64) + 21; *pacc = *pacc + (__builtin_amdgcn_s_memrealtime() - _te0); }
#endif
        if (!has_next) break;
        if (!keep) {
#pragma unroll
        for (int a = 0; a < 2; ++a)
#pragma unroll
            for (int b = 0; b < 2; ++b)
#pragma unroll
                for (int m = 0; m < 4; ++m)
#pragma unroll
                    for (int n = 0; n < 2; ++n) acc[a][b][m][n] = (f32x4){0.f, 0.f, 0.f, 0.f};
        }
        cur = nxt; cA = nA; cB = nB; ++ui;
        if constexpr (Sched::VAR_NT) nt = S.ktiles(cur);
        if constexpr (GATHER) { gC[0][0] = gN[0][0]; gC[0][1] = gN[0][1]; gC[1][0] = gN[1][0]; gC[1][1] = gN[1][1]; }
        if (PG8_ALIGN) { if (wr == 1) PG8_BAR; }
    }
    PG8_WAIT_V(0);
    if (!PG8_ALIGN) { if (wr == 0) PG8_BAR; }
    PG8_BAR;
#undef PG8_SA
#undef PG8_SB
#undef PG8_STAGE
#undef PG8_STAGE2
#undef PG8_ITER
#undef PG8_LDA
#undef PG8_LDB
#undef PG8_MMA
#undef PG8_WAIT_V
#undef PG8_WAIT_L
#undef PG8_BAR
#undef PG8_SCHED
}
}
using pg8::Unit;
typedef const f32x4 (&AccRef)[2][2][4][2];

struct Frame {
    LAS unsigned char* lds;
    unsigned char* ws;
    unsigned* ctl;
    const float* const* in;
    float* out;
    int tid, lane, wave, vcu, G, wave0;
};

#if ROW_NT
#define RLD(p) __builtin_nontemporal_load(p)
#define RST(p, v) __builtin_nontemporal_store((v), (p))
#else
#define RLD(p) (*(p))
#define RST(p, v) (*(p) = (v))
#endif
#ifndef EPI_NT
#define EPI_NT 0u
#endif
template <unsigned BIT, class T> __device__ __forceinline__ void epi_st(T* p, const T v) { if constexpr ((EPI_NT & BIT) != 0u) __builtin_nontemporal_store(v, p); else *p = v; }
constexpr size_t TS1024 = (size_t)256 * 1024 * 2;

struct ZSched {
    static constexpr bool VAR_NT = false;
    int G, c, last, n0, n1; const char *H, *WZ, *WV; pg8::GridMap g0, g1, g2;
    __device__ __forceinline__ void init(int G_, int c_, int last_, const void* H_, const void* WZ_, const void* WV_) {
        G = G_; c = c_; last = last_; H = (const char*)H_; WZ = (const char*)WZ_; WV = (const char*)WV_;
        if (last) { g0.init(256, 18); g1.init(32, 4); } else { g0.init(NRT, 18); g1.init(0, 4); }
        g2.init(4, NRT); n0 = g0.nwg; n1 = g1.nwg;
    }
    __device__ __forceinline__ bool next(int i, Unit& u) const {
        int L = i * G + c, a, b;
        if (L < n0) { g0.map(L, a, b); u.kind = 0; u.pm = last ? (a >> 3) * 9 + 1 + (a & 7) : a; u.pn = b; return true; }
        L -= n0;
        if (L < n1) { g1.map(L, a, b); u.kind = 0; u.pm = a * 9; u.pn = 6 + b; return true; }
        L -= n1;
        if (L < g2.nwg) { g2.map(L, a, b); u.kind = 1; u.pm = a; u.pn = b; return true; }
        return false;
    }
    __device__ __forceinline__ const char* abase(const Unit& u) const { return (u.kind ? WV : H) + (size_t)u.pm * TS1024; }
    __device__ __forceinline__ const char* bbase(const Unit& u) const { return (u.kind ? H : WZ) + (size_t)u.pn * TS1024; }
};
struct ZEpi {
    static constexpr bool CHAINED = false;
    bf16_t *U, *Q, *KB; unsigned char* G; bf16_t* VT; const float *COS, *SIN;
    __device__ __forceinline__ void operator()(AccRef acc, const Unit& u, int wr, int wc, int fr, int fq) const {
        if (u.kind == 1) {
            const int b = u.pn / 9, jt = u.pn - b * 9;
            bf16_t* base = VT + ((size_t)b * 1024 + u.pm * 256 + wr * 64 + fr) * LTOK + jt * 256 + wc * 32 + 8 * fq;
#pragma unroll
            for (int ai = 0; ai < 2; ++ai)
#pragma unroll
                for (int m = 0; m < 4; ++m) { bf16_t* rowp = base + (size_t)(ai * 128 + m * 16) * LTOK;
#pragma unroll
                    for (int bj = 0; bj < 2; ++bj) epi_st<1u>((u32x4*)(rowp + bj * 128), pack8(acc[ai][bj][m][0], acc[ai][bj][m][1])); }
            return;
        }
        const int pn = u.pn; const size_t row0 = (size_t)u.pm * 256 + wr * 64 + fr; const int cin = wc * 32 + 8 * fq;
        if (pn < 2) {
#pragma unroll
            for (int ai = 0; ai < 2; ++ai)
#pragma unroll
                for (int m = 0; m < 4; ++m) { bf16_t* rowp = U + (row0 + ai * 128 + m * 16) * 512 + pn * 256 + cin;
#pragma unroll
                    for (int bj = 0; bj < 2; ++bj) epi_st<2u>((u32x4*)(rowp + bj * 128), pack8(acc[ai][bj][m][0], acc[ai][bj][m][1])); }
        } else if (pn < 10) {
            const bool isq = pn < 6; bf16_t* dst = isq ? Q : KB; const int ct = isq ? pn - 2 : pn - 6; const float sc = isq ? QSCALE : 1.f;
            const int jt = u.pm % 9; const bool lat = jt != 0; const int axis = wc & 1;
#pragma unroll
            for (int ai = 0; ai < 2; ++ai) {
                f32x4 c4[4], s4[4];
#pragma unroll
                for (int m = 0; m < 4; ++m) { const int pos = axis ? (16 * m + fr) : (((jt - 1) * 4 + 2 * ai + wr) & 63);
                    c4[m] = *(const f32x4*)(COS + pos * 16 + 4 * fq); s4[m] = *(const f32x4*)(SIN + pos * 16 + 4 * fq);
                    if (!lat) { c4[m] = (f32x4){1.f, 1.f, 1.f, 1.f}; s4[m] = (f32x4){0.f, 0.f, 0.f, 0.f}; } }
                asm volatile("" ::: "memory");
#pragma unroll
                for (int m = 0; m < 4; ++m) {
                    bf16_t* rowp = dst + (row0 + ai * 128 + m * 16) * 1024 + ct * 256 + cin;
#pragma unroll
                    for (int bj = 0; bj < 2; ++bj) { const f32x4 a = acc[ai][bj][m][0], b = acc[ai][bj][m][1];
                        const f32x4 ra = (a * c4[m] - b * s4[m]) * sc, rb = (a * s4[m] + b * c4[m]) * sc;
                        epi_st<4u>((u32x4*)(rowp + bj * 128), pack8(ra, rb)); }
                }
                asm volatile("" ::: "memory");
            }
        } else {
            const int ct = pn - 10;
#pragma unroll
            for (int ai = 0; ai < 2; ++ai)
#pragma unroll
                for (int m = 0; m < 4; ++m) { unsigned char* rowp = G + (row0 + ai * 128 + m * 16) * 2048 + ct * 256 + cin;
#pragma unroll
                    for (int bj = 0; bj < 2; ++bj) { const f32x4 a = acc[ai][bj][m][0], b = acc[ai][bj][m][1]; u32x2 o; o.x = 0u; o.y = 0u;
#pragma unroll
                        for (int j = 0; j < 4; ++j) { o.x = __builtin_amdgcn_cvt_pk_u8_f32(__builtin_rintf(fast_sigmoid(a[j]) * 255.f), j, o.x); o.y = __builtin_amdgcn_cvt_pk_u8_f32(__builtin_rintf(fast_sigmoid(b[j]) * 255.f), j, o.y); }
                        epi_st<8u>((u32x2*)(rowp + bj * 128), o); } }
        }
    }
};

struct PlainSched {
    static constexpr bool VAR_NT = false;
    int G, c, latonly, rev; const char *A, *B; size_t ats, bts; pg8::GridMap g;
    __device__ __forceinline__ void init(int G_, int c_, int latonly_, int nN, const void* A_, const void* B_, int K, int rev_ = 0) {
        G = G_; c = c_; latonly = latonly_; rev = rev_; A = (const char*)A_; B = (const char*)B_; ats = bts = (size_t)256 * K * 2; g.init(latonly_ ? 256 : NRT, nN);
    }
    __device__ __forceinline__ bool next(int i, Unit& u) const {
        int L = i * G + c; if (L >= g.nwg) return false; if (rev) L = g.nwg - 1 - L; int a, b; g.map(L, a, b);
        u.kind = 0; u.pm = latonly ? (a >> 3) * 9 + 1 + (a & 7) : a; u.pn = b; return true;
    }
    __device__ __forceinline__ const char* abase(const Unit& u) const { return A + (size_t)u.pm * ats; }
    __device__ __forceinline__ const char* bbase(const Unit& u) const { return B + (size_t)u.pn * bts; }
};
struct MergeSched {
    static constexpr bool VAR_NT = true;
    int G, c, latonly; const char *A, *B; pg8::GridMap g;
    __device__ __forceinline__ void init(int G_, int c_, int latonly_, const void* A_, const void* B_) { G = G_; c = c_; latonly = latonly_; A = (const char*)A_; B = (const char*)B_; g.init(latonly_ ? 256 : NRT, 4); }
    __device__ __forceinline__ bool next(int i, Unit& u) const {
        const int L = (i >> 1) * G + c; if (L >= g.nwg) return false; int a, b; g.map(L, a, b);
        u.kind = i & 1; u.pm = latonly ? (a >> 3) * 9 + 1 + (a & 7) : a; u.pn = b; return true;
    }
    __device__ __forceinline__ int ktiles(const Unit& u) const { return u.kind ? 16 : 8; }
    __device__ __forceinline__ const char* abase(const Unit& u) const { return A + (size_t)u.pm * ((size_t)256 * MAP * 2) + (u.kind ? 1024 : 0); }
    __device__ __forceinline__ const char* bbase(const Unit& u) const { return B + (size_t)u.pn * ((size_t)256 * MAP * 2) + (u.kind ? 1024 : 0); }
};
__device__ __forceinline__ void unpack8(const u32x4 w, f32x4& a, f32x4& b) { a = (f32x4){bflo(w.x), bfhi(w.x), bflo(w.y), bfhi(w.y)}; b = (f32x4){bflo(w.z), bfhi(w.z), bflo(w.w), bfhi(w.w)}; }
__device__ __forceinline__ f32x4 ub4(unsigned w) { return (f32x4){(float)(w & 255u), (float)((w >> 8) & 255u), (float)((w >> 16) & 255u), (float)(w >> 24)}; }
struct MergeEpi {
    static constexpr bool CHAINED = true;
    bf16_t* O; const unsigned char* Gt;
    __device__ __forceinline__ void mid(f32x4 (&acc)[2][2][4][2], const Unit& u, int wr, int wc, int fr, int fq) const {
        const unsigned loff = (unsigned)((wr * 64 + fr) * 2048 + wc * 32 + 8 * fq);
#pragma unroll
        for (int ai = 0; ai < 2; ++ai) {
            u32x2 wp[4][2], wa[4][2];
#pragma unroll
            for (int m = 0; m < 4; ++m) { const unsigned char* gp = Gt + (size_t)(u.pm * 256 + ai * 128 + m * 16) * 2048 + u.pn * 256;
#pragma unroll
                for (int bj = 0; bj < 2; ++bj) { wp[m][bj] = *(const u32x2*)(gp + loff + bj * 128); wa[m][bj] = *(const u32x2*)(gp + loff + 1024 + bj * 128); } }
#pragma unroll
            for (int m = 0; m < 4; ++m)
#pragma unroll
                for (int bj = 0; bj < 2; ++bj) { const f32x4 p0 = ub4(wp[m][bj].x), p1 = ub4(wp[m][bj].y), a0 = ub4(wa[m][bj].x), a1 = ub4(wa[m][bj].y);
#pragma unroll
                    for (int j = 0; j < 4; ++j) { acc[ai][bj][m][0][j] *= p0[j] * __builtin_amdgcn_rcpf(fmaxf(a0[j], 1e-9f)); acc[ai][bj][m][1][j] *= p1[j] * __builtin_amdgcn_rcpf(fmaxf(a1[j], 1e-9f)); } }
        }
    }
    __device__ __forceinline__ void operator()(AccRef acc, const Unit& u, int wr, int wc, int fr, int fq) const {
        const unsigned cpart = (unsigned)(wc * 32 + 8 * fq), rpart = (unsigned)((wr * 64 + fr) * 2048);
        const unsigned loffg = rpart + cpart, loffy = rpart + 2u * cpart;
        u32x2 wa[2][4][2];
#pragma unroll
        for (int ai = 0; ai < 2; ++ai)
#pragma unroll
            for (int m = 0; m < 4; ++m) { const unsigned char* gp = Gt + (size_t)(u.pm * 256 + ai * 128 + m * 16) * 2048 + 1024 + u.pn * 256;
#pragma unroll
                for (int bj = 0; bj < 2; ++bj) wa[ai][m][bj] = *(const u32x2*)(gp + loffg + bj * 128); }
        asm volatile("" ::: "memory");
#pragma unroll
        for (int ai = 0; ai < 2; ++ai)
#pragma unroll
            for (int m = 0; m < 4; ++m) { char* op = (char*)(O + (size_t)(u.pm * 256 + ai * 128 + m * 16) * 1024 + u.pn * 256);
#pragma unroll
                for (int bj = 0; bj < 2; ++bj) { f32x4 a0 = ub4(wa[ai][m][bj].x), a1 = ub4(wa[ai][m][bj].y);
#pragma unroll
                    for (int j = 0; j < 4; ++j) { a0[j] = fmaxf(a0[j], 1e-9f) * (1.f / 255.f); a1[j] = fmaxf(a1[j], 1e-9f) * (1.f / 255.f); }
                    epi_st<16u>((u32x4*)(op + loffy + bj * 256), pack8(a0 * acc[ai][bj][m][0], a1 * acc[ai][bj][m][1])); } }
    }
};
struct ResEpi {
    static constexpr bool CHAINED = false;
    const float *latsrc, *ctxsrc; float *latdst, *ctxdst; const float* mod; int goff;
    __device__ __forceinline__ void operator()(AccRef acc, const Unit& u, int wr, int wc, int fr, int fq) const {
        const int b = u.pm / 9, jt = u.pm - b * 9;
        const size_t rb = jt ? ((size_t)b * SEQ + (jt - 1) * 256) : (size_t)b * CTXL;
        const float* src = (jt ? latsrc : ctxsrc) + (rb + wr * 64 + fr) * D; float* dst = (jt ? latdst : ctxdst) + (rb + wr * 64 + fr) * D;
        const float* gate = mod + (size_t)(jt ? b : 32) * MODW + goff;
        const int col0 = u.pn * 256 + wc * 32 + 8 * fq;
        f32x4 gv[2][2];
#pragma unroll
        for (int bj = 0; bj < 2; ++bj)
#pragma unroll
            for (int n = 0; n < 2; ++n) gv[bj][n] = *(const f32x4*)(gate + col0 + bj * 128 + 4 * n);
#pragma unroll
        for (int ai = 0; ai < 2; ++ai) {
            f32x4 x[4][2][2];
#pragma unroll
            for (int m = 0; m < 4; ++m)
#pragma unroll
                for (int bj = 0; bj < 2; ++bj)
#pragma unroll
                    for (int n = 0; n < 2; ++n) x[m][bj][n] = *(const f32x4*)(src + (size_t)(ai * 128 + m * 16) * D + col0 + bj * 128 + 4 * n);
            asm volatile("" ::: "memory");
#pragma unroll
            for (int m = 0; m < 4; ++m)
#pragma unroll
                for (int bj = 0; bj < 2; ++bj)
#pragma unroll
                    for (int n = 0; n < 2; ++n) epi_st<32u>((f32x4*)(dst + (size_t)(ai * 128 + m * 16) * D + col0 + bj * 128 + 4 * n), x[m][bj][n] + gv[bj][n] * acc[ai][bj][m][n]);
            asm volatile("" ::: "memory");
        }
    }
};
struct OEpi {
    static constexpr bool CHAINED = false;
    bf16_t* O; const float* mod; int goff;
    __device__ __forceinline__ void operator()(AccRef acc, const Unit& u, int wr, int wc, int fr, int fq) const {
        const int b = u.pm / 9, jt = u.pm - b * 9;
        const float* gate = mod + (size_t)(jt ? b : 32) * MODW + goff;
        const int col0 = u.pn * 256 + wc * 32 + 8 * fq;
        f32x4 gv[2][2];
#pragma unroll
        for (int bj = 0; bj < 2; ++bj)
#pragma unroll
            for (int n = 0; n < 2; ++n) gv[bj][n] = *(const f32x4*)(gate + col0 + bj * 128 + 4 * n);
        asm volatile("" ::: "memory");
        bf16_t* base = O + ((size_t)u.pm * 256 + wr * 64 + fr) * D + col0;
#pragma unroll
        for (int ai = 0; ai < 2; ++ai)
#pragma unroll
            for (int m = 0; m < 4; ++m)
#pragma unroll
                for (int bj = 0; bj < 2; ++bj) epi_st<32u>((u32x4*)(base + (size_t)(ai * 128 + m * 16) * D + bj * 128), pack8(gv[bj][0] * acc[ai][bj][m][0], gv[bj][1] * acc[ai][bj][m][1]));
    }
};
struct UpEpi {
    static constexpr bool CHAINED = false;
    bf16_t* O; int ld;
    __device__ __forceinline__ void operator()(AccRef acc, const Unit& u, int wr, int wc, int fr, int fq) const {
        const size_t row0 = (size_t)u.pm * 256 + wr * 64 + fr; const int col0 = u.pn * 128 + wc * 32 + 8 * fq;
#pragma unroll
        for (int ai = 0; ai < 2; ++ai)
#pragma unroll
            for (int m = 0; m < 4; ++m) { f32x4 v[2];
#pragma unroll
                for (int n = 0; n < 2; ++n) { const f32x4 g = acc[ai][0][m][n], w = acc[ai][1][m][n];
#pragma unroll
                    for (int j = 0; j < 4; ++j) v[n][j] = g[j] * fast_sigmoid(g[j]) * w[j]; }
                epi_st<64u>((u32x4*)(O + (row0 + ai * 128 + m * 16) * ld + col0), pack8(v[0], v[1])); }
    }
};
struct MoeInfo {
    int cnt[NE], tb[NE + 1];
    __device__ __forceinline__ void load(const unsigned* cw) {
        int t = 0;
#pragma unroll
        for (int e = 0; e < NE; ++e) { const int c = __builtin_amdgcn_readfirstlane((int)__hip_atomic_load(cw + CW_CNT + 64 * e, __ATOMIC_RELAXED, __HIP_MEMORY_SCOPE_AGENT)); cnt[e] = c; tb[e] = t; t += (c + 255) >> 8; }
        tb[NE] = t;
    }
    __device__ __forceinline__ void lookup(int rt, int& e, int& t0, int& ce) const { e = 0; t0 = 0; ce = cnt[0];
#pragma unroll
        for (int k = 1; k < NE; ++k) { const bool ge = rt >= tb[k]; e = ge ? k : e; t0 = ge ? tb[k] : t0; ce = ge ? cnt[k] : ce; } }
};
struct MoeSched {
    static constexpr bool VAR_NT = false;
    int G, c, nN, gather, rev; const char *A, *B; const unsigned* LIST; size_t ats, bts, bes; MoeInfo mi; pg8::GridMap g;
    __device__ __forceinline__ void init(int G_, int c_, int nN_, const void* A_, const void* B_, int K, int Nrows, const MoeInfo& mi_) {
        G = G_; c = c_; nN = nN_; gather = 0; rev = 0; LIST = nullptr; A = (const char*)A_; B = (const char*)B_; ats = bts = (size_t)256 * K * 2; bes = (size_t)Nrows * K * 2; mi = mi_; g.init(mi_.tb[NE], nN_);
    }
    __device__ __forceinline__ bool next(int i, Unit& u) const {
        int L = i * G + c; if (L >= g.nwg) return false; if (rev) L = g.nwg - 1 - L; int a, b; g.map(L, a, b); u.pm = a; u.pn = b; int t0, ce; mi.lookup(a, u.kind, t0, ce); return true;
    }
    __device__ __forceinline__ const char* abase(const Unit& u) const { return gather ? A : A + (size_t)u.pm * ats; }
    __device__ __forceinline__ const char* bbase(const Unit& u) const { return B + (size_t)u.kind * bes + (size_t)u.pn * bts; }
    __device__ __forceinline__ unsigned grow(const Unit& u, int row) const { int e, t0, ce; mi.lookup(u.pm, e, t0, ce); const int slot = (u.pm - t0) * 256 + row;
        unsigned tok = 0u; if (slot < ce) tok = LIST[(size_t)e * NLAT + slot] >> 1;
        return ((tok >> 11) * (unsigned)LTOK + (unsigned)CTXL + (tok & 2047u)) * (unsigned)(D * 2); }
};
struct MoeDownEpi {
    static constexpr bool CHAINED = false;
    bf16_t* YM; const unsigned* LIST; const float* WTS; MoeInfo mi;
    __device__ __forceinline__ void operator()(AccRef acc, const Unit& u, int wr, int wc, int fr, int fq) const {
        int e, t0, ce; mi.lookup(u.pm, e, t0, ce); const int slot0 = (u.pm - t0) * 256 + wr * 64 + fr;
        const int col0 = u.pn * 256 + wc * 32 + 8 * fq;
        unsigned ent[2][4]; float wt[2][4];
#pragma unroll
        for (int ai = 0; ai < 2; ++ai)
#pragma unroll
            for (int m = 0; m < 4; ++m) { const int slot = slot0 + ai * 128 + m * 16; ent[ai][m] = slot < ce ? LIST[(size_t)e * NLAT + slot] : 0xffffffffu; }
#pragma unroll
        for (int ai = 0; ai < 2; ++ai)
#pragma unroll
            for (int m = 0; m < 4; ++m) wt[ai][m] = ent[ai][m] != 0xffffffffu ? WTS[ent[ai][m]] : 0.f;
        asm volatile("" ::: "memory");
#pragma unroll
        for (int ai = 0; ai < 2; ++ai)
#pragma unroll
            for (int m = 0; m < 4; ++m) {
                if (ent[ai][m] != 0xffffffffu) { const unsigned en = ent[ai][m]; const float w8 = wt[ai][m];
                    bf16_t* rowp = YM + ((size_t)(en & 1u) * NLAT + (en >> 1)) * D + col0;
#pragma unroll
                    for (int bj = 0; bj < 2; ++bj) epi_st<128u>((u32x4*)(rowp + bj * 128), pack8(acc[ai][bj][m][0] * w8, acc[ai][bj][m][1] * w8)); } }
    }
};

namespace att {
constexpr int BUFB = 32768, EXCH = 65536;
constexpr float THR = 6.f;
#define ATT_SBAR() __builtin_amdgcn_sched_barrier(0)
#define ATT_MFMA(a, b, c) __builtin_amdgcn_mfma_f32_32x32x16_bf16(a, b, c, 0, 0, 0)
#define ATT_SYNC() asm volatile("s_waitcnt vmcnt(0) lgkmcnt(0)\n\ts_barrier" ::: "memory")
__device__ __forceinline__ void attn_unit(LAS unsigned char* lds, const bf16_t* Q, const bf16_t* K, const bf16_t* VT, bf16_t* AY, int b, int h, size_t qrow0, int nkt, float lam, float osc, const float* subg,
                                          bf16x8 (&qf)[4], bool first, bool has_next, int nb, int nh, size_t nqrow0, int wv) {
    const int tid = opaque_tid(wv), lane = tid & 63, ql = lane & 31, hh = lane >> 5; const int w = __builtin_amdgcn_readfirstlane(tid >> 6); const int map = w >> 2, qb = w & 3;
    const size_t qrow = qrow0 + 32 * qb + ql;
    if (ATT_PRIO && w >= 4) __builtin_amdgcn_s_setprio(1);
#if PROBE_MASK
    unsigned long long att_wait = 0, att_b = 0, att_a = 0;
#endif
    if (first) {
#pragma unroll
        for (int ks = 0; ks < 4; ++ks) qf[ks] = *(const bf16x8*)(Q + qrow * 1024 + (h * 2 + map) * 64 + 16 * ks + 8 * hh);
    }
    const int prow = lane >> 3, pc = lane & 7;
    const int krow = 8 * w + prow, kc = pc ^ ((krow >> 1) & 7);
    const bf16_t* ksrc0 = K + ((size_t)b * LTOK + krow) * 1024 + (h * 2) * 64 + kc * 8;
    const bf16_t* ksrc1 = ksrc0 + 64;
    const int e0 = 16 * w + prow, e1 = e0 + 8;
    const bf16_t* vsrc0 = VT + ((size_t)b * 1024 + h * 128 + e0) * LTOK + (pc ^ ((e0 >> 1) & 7)) * 8;
    const bf16_t* vsrc1 = VT + ((size_t)b * 1024 + h * 128 + e1) * LTOK + (pc ^ ((e1 >> 1) & 7)) * 8;
#define ATT_DMA_K(t, BO) do { \
        __builtin_amdgcn_global_load_lds((const unsigned*)(ksrc0 + (size_t)(t) * 64 * 1024), (LAS unsigned*)(lds + (BO) + w * 1024), 16, 0, 0); \
        __builtin_amdgcn_global_load_lds((const unsigned*)(ksrc1 + (size_t)(t) * 64 * 1024), (LAS unsigned*)(lds + (BO) + 8192 + w * 1024), 16, 0, 0); } while (0)
#define ATT_DMA_V(t, BO) do { \
        __builtin_amdgcn_global_load_lds((const unsigned*)(vsrc0 + (size_t)(t) * 64), (LAS unsigned*)(lds + (BO) + 16384 + w * 2048), 16, 0, 0); \
        __builtin_amdgcn_global_load_lds((const unsigned*)(vsrc1 + (size_t)(t) * 64), (LAS unsigned*)(lds + (BO) + 16384 + w * 2048 + 1024), 16, 0, 0); } while (0)
    const int rp = (ql & ~12) | ((ql & 4) << 1) | ((ql & 8) >> 1);
    const int xk = (rp >> 1) & 7, xv = (ql >> 1) & 7;
    const LAS unsigned char* kbase = lds + map * 8192 + rp * 128;
    const LAS unsigned char* vbase = lds + 16384 + ql * 128;
    const unsigned kaddr0 = (unsigned)(uintptr_t)kbase, vaddr0 = (unsigned)(uintptr_t)vbase;
    int kof[4], vof[4];
#pragma unroll
    for (int i = 0; i < 4; ++i) { kof[i] = ((2 * i + hh) ^ xk) << 4; vof[i] = ((2 * i + hh) ^ xv) << 4; }
#define ATT_KRD(i, RB) (*(const LAS bf16x8*)(kbase + (RB) + ((i) >> 2) * 4096 + kof[(i) & 3]))
#define ATT_VRD(g, RB) (*(const LAS bf16x8*)(vbase + (RB) + ((g) >> 2) * 4096 + vof[(g) & 3]))
    const f32x16 Z16 = (f32x16){0.f, 0.f, 0.f, 0.f, 0.f, 0.f, 0.f, 0.f, 0.f, 0.f, 0.f, 0.f, 0.f, 0.f, 0.f, 0.f};
    f32x16 O[4];
#pragma unroll
    for (int i = 0; i < 4; ++i) O[i] = Z16;
    f32x16 negm = Z16, S0, S1;
    float lrun = 0.f, ral = 1.f; bool resc = false;
    bf16x8 kf[8]; u32x4 pA[4], pB[4];
#define ATT_QK() do { \
        S0 = ATT_MFMA(kf[0], qf[0], negm); S1 = ATT_MFMA(kf[4], qf[0], negm); \
        S0 = ATT_MFMA(kf[1], qf[1], S0);   S1 = ATT_MFMA(kf[5], qf[1], S1); \
        S0 = ATT_MFMA(kf[2], qf[2], S0);   S1 = ATT_MFMA(kf[6], qf[2], S1); \
        S0 = ATT_MFMA(kf[3], qf[3], S0);   S1 = ATT_MFMA(kf[7], qf[3], S1); } while (0)
#define ATT_ROWMAX(mx) do { float _a = fmaxf(S0[0], S1[0]), _b = fmaxf(S0[1], S1[1]); \
        _Pragma("unroll") for (int r = 2; r < 16; r += 2) { _a = fmaxf(_a, fmaxf(S0[r], S1[r])); _b = fmaxf(_b, fmaxf(S0[r + 1], S1[r + 1])); } \
        mx = pair_max(fmaxf(_a, _b)); } while (0)
#define ATT_IMAX3(a, b, c) max(max((a), (b)), (c))
#define ATT_SI(i) __float_as_int(ATT_SV(i))
#define ATT_ROWMAXI(mx) do { int _a = ATT_IMAX3(ATT_SI(0), ATT_SI(1), ATT_SI(2)), _b = ATT_IMAX3(ATT_SI(3), ATT_SI(4), ATT_SI(5)); \
        _a = ATT_IMAX3(_a, ATT_SI(6), ATT_SI(7)); _b = ATT_IMAX3(_b, ATT_SI(8), ATT_SI(9)); _a = ATT_IMAX3(_a, ATT_SI(10), ATT_SI(11)); _b = ATT_IMAX3(_b, ATT_SI(12), ATT_SI(13)); \
        _a = ATT_IMAX3(_a, ATT_SI(14), ATT_SI(15)); _b = ATT_IMAX3(_b, ATT_SI(16), ATT_SI(17)); _a = ATT_IMAX3(_a, ATT_SI(18), ATT_SI(19)); _b = ATT_IMAX3(_b, ATT_SI(20), ATT_SI(21)); \
        _a = ATT_IMAX3(_a, ATT_SI(22), ATT_SI(23)); _b = ATT_IMAX3(_b, ATT_SI(24), ATT_SI(25)); _a = ATT_IMAX3(_a, ATT_SI(26), ATT_SI(27)); _b = ATT_IMAX3(_b, ATT_SI(28), ATT_SI(29)); \
        _a = ATT_IMAX3(_a, ATT_SI(30), ATT_SI(31)); _a = max(_a, _b); \
        auto _rr = __builtin_amdgcn_permlane32_swap((unsigned)_a, (unsigned)_a, false, false); mx = __int_as_float(max((int)_rr[0], (int)_rr[1])); } while (0)
#define ATT_DECIDE() do { float mx; ATT_ROWMAXI(mx); \
        if (__any(mx > THR)) { const float dl = fmaxf(mx, 0.f); \
            _Pragma("unroll") for (int r = 0; r < 16; ++r) { S0[r] -= dl; S1[r] -= dl; negm[r] -= dl; } \
            ral = __builtin_amdgcn_exp2f(-dl); lrun *= ral; resc = true; } } while (0)
#define ATT_SV(i) ((i) < 16 ? S0[(i) & 15] : S1[(i) & 15])
#define ATT_EXP2(g, PN) do { const float _e0 = __builtin_amdgcn_exp2f(ATT_SV(2 * (g))), _e1 = __builtin_amdgcn_exp2f(ATT_SV(2 * (g) + 1)); ls += _e0; ls += _e1; unsigned _w = cvtpk(_e0, _e1); asm volatile("" : "+v"(_w), "+v"(ls)); PN[(g) >> 2][(g) & 3] = _w; } while (0)
#define ATT_DSRD(dst, addr, off) asm volatile("ds_read_b128 %0, %1 offset:%2" : "=v"(dst) : "v"(addr), "i"(off))
#define ATT_NW(g, DOK) ((DOK) ? ((g) <= 8 ? 2 : (g) == 9 ? 3 : (g) == 10 ? 4 : (g) <= 13 ? 5 : (g) == 14 ? 4 : 3) : ((g) <= 13 ? 2 : (g) == 14 ? 1 : 0))
#define ATT_GAPB(g, VC, VL, PP, PN, DOK) do { \
        asm volatile("s_waitcnt lgkmcnt(%1)" : "+v"(VC) : "i"(ATT_NW(g, DOK))); \
        O[(g) >> 2] = ATT_MFMA(VC, __builtin_bit_cast(bf16x8, PP[(g) & 3]), O[(g) >> 2]); \
        if ((g) + 3 < 16) ATT_DSRD(VL, va[((g) + 3) & 3], (((g) + 3) >> 2) * 4096); \
        if ((DOK) && (g) >= 8) ATT_DSRD(kf[(g) - 8], ka[((g) - 8) & 3], (((g) - 8) >> 2) * 4096); \
        ATT_EXP2(g, PN); ATT_SBAR(); } while (0)
#define ATT_PHASEB(RBK, RB, PP, PN, DOK) do { float ls = 0.f; unsigned va[4], ka[4]; \
        _Pragma("unroll") for (int _c = 0; _c < 4; ++_c) { va[_c] = vaddr0 + (unsigned)(RB) + (unsigned)vof[_c]; ka[_c] = kaddr0 + (unsigned)(RBK) + (unsigned)kof[_c]; } \
        bf16x8 v0, v1, v2, v3; ATT_DSRD(v0, va[0], 0); ATT_DSRD(v1, va[1], 0); ATT_DSRD(v2, va[2], 0); ATT_SBAR(); \
        ATT_GAPB(0, v0, v3, PP, PN, DOK); ATT_GAPB(1, v1, v0, PP, PN, DOK); ATT_GAPB(2, v2, v1, PP, PN, DOK); ATT_GAPB(3, v3, v2, PP, PN, DOK); \
        ATT_GAPB(4, v0, v3, PP, PN, DOK); ATT_GAPB(5, v1, v0, PP, PN, DOK); ATT_GAPB(6, v2, v1, PP, PN, DOK); ATT_GAPB(7, v3, v2, PP, PN, DOK); \
        ATT_GAPB(8, v0, v3, PP, PN, DOK); ATT_GAPB(9, v1, v0, PP, PN, DOK); ATT_GAPB(10, v2, v1, PP, PN, DOK); ATT_GAPB(11, v3, v2, PP, PN, DOK); \
        ATT_GAPB(12, v0, v3, PP, PN, DOK); ATT_GAPB(13, v1, v0, PP, PN, DOK); ATT_GAPB(14, v2, v1, PP, PN, DOK); ATT_GAPB(15, v3, v2, PP, PN, DOK); \
        if (DOK) { asm volatile("s_waitcnt lgkmcnt(0)" : "+v"(kf[0]), "+v"(kf[1]), "+v"(kf[2]), "+v"(kf[3]), "+v"(kf[4]), "+v"(kf[5]), "+v"(kf[6]), "+v"(kf[7])); ATT_SBAR(); } \
        lrun += ls; } while (0)
#define ATT_RESC() do { if (resc) { _Pragma("unroll") for (int i = 0; i < 4; ++i) _Pragma("unroll") for (int r = 0; r < 16; ++r) O[i][r] *= ral; resc = false; } } while (0)
#define ATT_BUF(j) (((j) & 3) * BUFB)
#if PROBE_MASK
#define ATT_TB0() const unsigned long long _tb0 = __builtin_amdgcn_s_memrealtime(); asm volatile("s_waitcnt lgkmcnt(0)" ::: "memory")
#define ATT_TB1() const unsigned long long _tb1 = __builtin_amdgcn_s_memrealtime(); att_b += _tb1 - _tb0
#define ATT_TB2() asm volatile("" : "+v"(S0), "+v"(S1)); att_a += __builtin_amdgcn_s_memrealtime() - _tb1
#else
#define ATT_TB0() do {} while (0)
#define ATT_TB1() do {} while (0)
#define ATT_TB2() do {} while (0)
#endif
#if PROBE_MASK
#define ATT_SYNCN(N) do { const unsigned long long _t0 = __builtin_amdgcn_s_memrealtime(); asm volatile("s_waitcnt vmcnt(" #N ") lgkmcnt(0)\n\ts_barrier" ::: "memory"); att_wait += __builtin_amdgcn_s_memrealtime() - _t0; } while (0)
#else
#define ATT_SYNCN(N) asm volatile("s_waitcnt vmcnt(" #N ") lgkmcnt(0)\n\ts_barrier" ::: "memory")
#endif
#define ATT_STEP(t, PP, PN) do { \
        ATT_TB0(); { const int rbk = ATT_BUF((t) + 1), rbv = ATT_BUF((t) - 1); ATT_PHASEB(rbk, rbv, PP, PN, true); } ATT_RESC(); ATT_TB1(); ATT_QK(); ATT_DECIDE(); ATT_TB2(); } while (0)

    if (first) { ATT_DMA_K(0, 0); ATT_DMA_K(1, BUFB); ATT_DMA_V(0, 0); ATT_DMA_V(1, BUFB); }
    ATT_DMA_K(2, 2 * BUFB); ATT_DMA_K(3, 3 * BUFB);
    ATT_SYNCN(4);
#pragma unroll
    for (int i = 0; i < 8; ++i) kf[i] = ATT_KRD(i, 0);
    ATT_QK();
    { float mx; ATT_ROWMAX(mx);
#pragma unroll
      for (int r = 0; r < 16; ++r) { S0[r] -= mx; S1[r] -= mx; negm[r] = -mx; } }
    { float ls = 0.f;
#pragma unroll
      for (int i = 0; i < 8; ++i) kf[i] = ATT_KRD(i, BUFB);
#define ATT_E0(g) ATT_EXP2(g, pA)
      ATT_E0(0); ATT_E0(1); ATT_E0(2); ATT_E0(3); ATT_E0(4); ATT_E0(5); ATT_E0(6); ATT_E0(7); ATT_E0(8); ATT_E0(9); ATT_E0(10); ATT_E0(11); ATT_E0(12); ATT_E0(13); ATT_E0(14); ATT_E0(15);
#undef ATT_E0
      lrun += ls; }
    ATT_QK(); ATT_DECIDE();
    for (int t = 1; t < nkt - 1; t += 2) {
        ATT_SYNCN(0);
        if (t + 3 < nkt) ATT_DMA_K(t + 3, ATT_BUF(t + 3));
        ATT_DMA_V(t + 1, ATT_BUF(t + 1));
        if (t + 4 < nkt) ATT_DMA_K(t + 4, ATT_BUF(t));
        ATT_DMA_V(t + 2, ATT_BUF(t + 2));
        ATT_STEP(t, pA, pB);
        ATT_STEP(t + 1, pB, pA);
    }
    ATT_SYNCN(0);
    if (has_next) {
        const size_t nqrow = nqrow0 + 32 * qb + ql;
#pragma unroll
        for (int ks = 0; ks < 4; ++ks) qf[ks] = *(const bf16x8*)(Q + nqrow * 1024 + (nh * 2 + map) * 64 + 16 * ks + 8 * hh);
        const bf16_t* nk0 = K + ((size_t)nb * LTOK + krow) * 1024 + (nh * 2) * 64 + kc * 8;
        const bf16_t* nv0 = VT + ((size_t)nb * 1024 + nh * 128 + e0) * LTOK + (pc ^ ((e0 >> 1) & 7)) * 8;
        const bf16_t* nv1 = VT + ((size_t)nb * 1024 + nh * 128 + e1) * LTOK + (pc ^ ((e1 >> 1) & 7)) * 8;
#pragma unroll
        for (int j = 0; j < 2; ++j) {
            __builtin_amdgcn_global_load_lds((const unsigned*)(nk0 + (size_t)j * 64 * 1024), (LAS unsigned*)(lds + j * BUFB + w * 1024), 16, 0, 0);
            __builtin_amdgcn_global_load_lds((const unsigned*)(nk0 + 64 + (size_t)j * 64 * 1024), (LAS unsigned*)(lds + j * BUFB + 8192 + w * 1024), 16, 0, 0);
            __builtin_amdgcn_global_load_lds((const unsigned*)(nv0 + (size_t)j * 64), (LAS unsigned*)(lds + j * BUFB + 16384 + w * 2048), 16, 0, 0);
            __builtin_amdgcn_global_load_lds((const unsigned*)(nv1 + (size_t)j * 64), (LAS unsigned*)(lds + j * BUFB + 16384 + w * 2048 + 1024), 16, 0, 0); }
    }
    { const int rbv = ATT_BUF(nkt - 2); ATT_PHASEB(0, rbv, pA, pB, false); } ATT_RESC();
    { const int rbv = ATT_BUF(nkt - 1); bf16x8 v0 = ATT_VRD(0, rbv), v1 = ATT_VRD(1, rbv), v2;
#define ATT_GF(g, VC, VL) do { O[(g) >> 2] = ATT_MFMA(VC, __builtin_bit_cast(bf16x8, pB[(g) & 3]), O[(g) >> 2]); if ((g) + 2 < 16) VL = ATT_VRD((g) + 2, rbv); } while (0)
      ATT_GF(0, v0, v2); ATT_GF(1, v1, v0); ATT_GF(2, v2, v1); ATT_GF(3, v0, v2); ATT_GF(4, v1, v0); ATT_GF(5, v2, v1); ATT_GF(6, v0, v2); ATT_GF(7, v1, v0);
      ATT_GF(8, v2, v1); ATT_GF(9, v0, v2); ATT_GF(10, v1, v0); ATT_GF(11, v2, v1); ATT_GF(12, v0, v2); ATT_GF(13, v1, v0); ATT_GF(14, v2, v1); ATT_GF(15, v0, v2);
#undef ATT_GF
    }
    asm volatile("s_waitcnt lgkmcnt(0)\n\ts_barrier" ::: "memory");
    const float inv = 1.f / pair_sum(lrun);
    f32x4 sgv[4][4];
    if (map == 0) {
#pragma unroll
        for (int i = 0; i < 4; ++i)
#pragma unroll
            for (int g = 0; g < 4; ++g) sgv[i][g] = *(const f32x4*)(subg + 32 * i + 8 * g + 4 * hh);
    }
    LAS float* ex = (LAS float*)(lds + EXCH) + (size_t)qb * 4096 + lane;
    if (map == 1) {
#pragma unroll
        for (int i = 0; i < 4; ++i)
#pragma unroll
            for (int r = 0; r < 16; ++r) ex[(i * 16 + r) * 64] = O[i][r] * inv;
    }
    asm volatile("s_waitcnt lgkmcnt(0)\n\ts_barrier" ::: "memory");
    if (map == 0) {
        float ss = 0.f;
#pragma unroll
        for (int i = 0; i < 4; ++i)
#pragma unroll
            for (int r = 0; r < 16; ++r) { const float y = O[i][r] * inv - lam * ex[(i * 16 + r) * 64]; O[i][r] = y; ss += y * y; }
        ss = pair_sum(ss);
        const float rs = rsqrtf(ss * (1.f / VD) + EPS) * osc;
        bf16_t* orow = AY + qrow * MAP + 512 + h * 128;
#pragma unroll
        for (int i = 0; i < 4; ++i)
#pragma unroll
            for (int g = 0; g < 4; ++g) { const int e = 32 * i + 8 * g + 4 * hh; const f32x4 gv = sgv[i][g];
                u32x2 o; o.x = cvtpk(O[i][4 * g] * rs * gv[0], O[i][4 * g + 1] * rs * gv[1]); o.y = cvtpk(O[i][4 * g + 2] * rs * gv[2], O[i][4 * g + 3] * rs * gv[3]);
                *(u32x2*)(orow + e) = o; }
    }
    asm volatile("s_waitcnt lgkmcnt(0)\n\ts_barrier" ::: "memory");
    if (ATT_PRIO && w >= 4) __builtin_amdgcn_s_setprio(0);
#if PROBE_MASK
    if (blockIdx.x == 0 && tid == 0) { volatile LAS unsigned long long* acc = (volatile LAS unsigned long long*)(lds + LDS_CTRL + 64) + 20; acc[0] = acc[0] + att_wait; acc[2] = acc[2] + att_b; acc[3] = acc[3] + att_a; }
#endif
#undef ATT_DMA_K
#undef ATT_DMA_V
#undef ATT_KRD
#undef ATT_VRD
#undef ATT_QK
#undef ATT_ROWMAX
#undef ATT_DECIDE
#undef ATT_IMAX3
#undef ATT_SI
#undef ATT_ROWMAXI
#undef ATT_SV
#undef ATT_EXP2
#undef ATT_GAPB
#undef ATT_DSRD
#undef ATT_NW
#undef ATT_PHASEB
#undef ATT_RESC
#undef ATT_STEP
#undef ATT_BUF
#undef ATT_TB0
#undef ATT_TB1
#undef ATT_TB2
#undef ATT_SYNCN
}
#undef ATT_SBAR
#undef ATT_MFMA
#undef ATT_SYNC
}

__device__ __forceinline__ void tr_item(const float* W, int ldw, int k0, int n0, bf16_t* WT, int ldt, int drow0, int dcol0, bool rope, LAS float* scr, int lane) {
    { f32x4 v[8];
#pragma unroll
      for (int j = 0; j < 8; ++j) v[j] = RLD((const f32x4*)(W + (size_t)(k0 + 8 * j + (lane >> 3)) * ldw + n0 + 4 * (lane & 7)));
#pragma unroll
      for (int j = 0; j < 8; ++j) { LAS float* d = scr + (8 * j + (lane >> 3)) * 33 + 4 * (lane & 7); d[0] = v[j][0]; d[1] = v[j][1]; d[2] = v[j][2]; d[3] = v[j][3]; } }
    LDS_WAIT(); asm volatile("" ::: "memory");
    const int c = lane & 7;
#pragma unroll
    for (int j = 0; j < 4; ++j) { const int n = (lane >> 3) + 8 * j; const LAS float* s = scr + (8 * c) * 33 + n;
        u32x4 o; o.x = cvtpk(s[0 * 33], s[1 * 33]); o.y = cvtpk(s[2 * 33], s[3 * 33]); o.z = cvtpk(s[4 * 33], s[5 * 33]); o.w = cvtpk(s[6 * 33], s[7 * 33]);
        const int dn = rope ? (8 * ((n >> 2) & 3) + 4 * (n >> 4) + (n & 3)) : n;
        *(u32x4*)(WT + (size_t)(drow0 + n0 + dn) * ldt + dcol0 + k0 + 8 * c) = o; }
    LDS_WAIT(); asm volatile("" ::: "memory");
}

__device__ __forceinline__ void phase_prologue(Frame F) {
    F.tid = opaque_tid(F.wave0); F.lane = F.tid & 63; F.wave = __builtin_amdgcn_readfirstlane(F.tid >> 6);
    const float* c = F.in[1]; const float* cctx = F.in[3]; const float* wmod = F.in[4]; const float* bmod = F.in[5];
    float* MOD = (float*)(F.ws + WS_MOD);
    for (int cb = blockIdx.x; cb < 192; cb += F.G) {
        LAS float* S = (LAS float*)F.lds;
        for (int idx = F.tid; idx < 1024 * 36; idx += NTHR) { const int k = idx / 36, bb = idx - k * 36; float v = 0.f;
            if (bb < 32) v = c[bb * 1024 + k]; else if (bb == 32) v = cctx[k];
            S[idx] = v / (1.f + expf(-v)); }
        __syncthreads();
        const int l = cb / 96, n = (cb % 96) * 64 + F.lane;
        float acc[36];
#pragma unroll
        for (int i = 0; i < 36; ++i) acc[i] = 0.f;
        const float* wp = wmod + ((size_t)l * 1024 + F.wave * 128) * MODW + n;
#pragma unroll 8
        for (int kk = 0; kk < 128; ++kk) { const float wv = wp[(size_t)kk * MODW]; const LAS f32x4* sp = (const LAS f32x4*)(S + (F.wave * 128 + kk) * 36);
#pragma unroll
            for (int q = 0; q < 9; ++q) { const f32x4 s4 = sp[q];
#pragma unroll
                for (int i = 0; i < 4; ++i) acc[4 * q + i] += s4[i] * wv; } }
        __syncthreads();
        LAS float* red = (LAS float*)F.lds;
#pragma unroll
        for (int bb = 0; bb < 33; ++bb) red[(F.wave * 33 + bb) * 64 + F.lane] = acc[bb];
        __syncthreads();
        for (int bb = F.wave; bb < 33; bb += 8) { float s = bmod[l * MODW + n];
#pragma unroll
            for (int w2 = 0; w2 < 8; ++w2) s += red[(w2 * 33 + bb) * 64 + F.lane];
            MOD[((size_t)l * 33 + bb) * MODW + n] = s; }
        __syncthreads();
    }
    __syncthreads();
    LAS float* scr = (LAS float*)(F.lds + F.wave * 8448);
    const int gw = F.vcu * NWAVES + F.wave, NGW = F.G * NWAVES;
    bf16_t* WZ = (bf16_t*)(F.ws + WS_WZ); bf16_t* WV = (bf16_t*)(F.ws + WS_WV); bf16_t* WM = (bf16_t*)(F.ws + WS_WM); bf16_t* WOUT = (bf16_t*)(F.ws + WS_WOUT);
    bf16_t* WUP0 = (bf16_t*)(F.ws + WS_WUP0); bf16_t* WDN0 = (bf16_t*)(F.ws + WS_WDN0);
    constexpr int I_IN = 16 * 176, I_SQ = 16 * 32, I_UP = 16 * 86, I_DN = 43 * 32;
    constexpr int NITEMS = 2 * I_IN + 4 * I_SQ + 2 * I_UP + I_DN;
    for (int it = gw; it < NITEMS; it += NGW) {
        int r = it;
        if (r < 2 * I_IN) { const int l = r / I_IN; r -= l * I_IN; const int kb = r / 176, nb = r % 176, n0 = nb * 32;
            const float* W = F.in[8] + (size_t)l * 1024 * 5632;
            if (n0 < 2560) tr_item(W, 5632, kb * 64, n0, WZ + (size_t)l * 4608 * 1024, 1024, 0, 0, n0 >= 512, scr, F.lane);
            else if (n0 < 3584) tr_item(W, 5632, kb * 64, n0, WV + (size_t)l * 1024 * 1024, 1024, -2560, 0, false, scr, F.lane);
            else tr_item(W, 5632, kb * 64, n0, WZ + (size_t)l * 4608 * 1024, 1024, -1024, 0, false, scr, F.lane);
            continue; }
        r -= 2 * I_IN;
        if (r < 4 * I_SQ) { const int q = r / I_SQ; r -= q * I_SQ; const int l = q & 1; const int kb = r / 32, nb = r % 32;
            const float* W = (q < 2 ? F.in[17] : F.in[18]) + (size_t)l * 1024 * 1024;
            if (q < 2) tr_item(W, 1024, kb * 64, nb * 32, WM + (size_t)l * 1024 * MAP, MAP, 0, 512, false, scr, F.lane);
            else tr_item(W, 1024, kb * 64, nb * 32, WOUT + (size_t)l * 1024 * 1024, 1024, 0, 0, false, scr, F.lane);
            continue; }
        r -= 4 * I_SQ;
        if (r < 2 * I_UP) { const int q = r / I_UP; r -= q * I_UP; const int kb = r / 86, nb = r % 86, n0 = nb * 32;
            const float* W = q ? F.in[20] : F.in[19];
            tr_item(W, FF, kb * 64, n0, WUP0, 1024, (n0 >> 7) * 256 + q * 128 - (n0 & ~127), 0, false, scr, F.lane); continue; }
        r -= 2 * I_UP;
        { const int kb = r / 32, nb = r % 32; tr_item(F.in[21], 1024, kb * 64, nb * 32, WDN0, FFP, 0, 0, false, scr, F.lane); }
    }
    { const int gt = F.vcu * NTHR + F.tid, NT = F.G * NTHR;
      for (int i = gt; i < 128 * 128; i += NT) { const int rr = i >> 7, cc = i & 127; const int row = 21 * 256 + (rr < 64 ? 64 + rr : 192 + (rr - 64)); *(u32x4*)(WUP0 + (size_t)row * 1024 + cc * 8) = (u32x4){0u, 0u, 0u, 0u}; }
      for (int i = gt; i < 1024 * 8; i += NT) { const int row = i >> 3, cc = i & 7; *(u32x4*)(WDN0 + (size_t)row * FFP + FF + cc * 8) = (u32x4){0u, 0u, 0u, 0u}; } }
    { bf16_t* WEFF = (bf16_t*)(F.ws + WS_WM);
      for (int it = gw; it < 1024; it += NGW) { const int l = it >> 9, g = (it >> 7) & 3, nbk = (it >> 3) & 15, cbk = it & 7; const int n = nbk * 64 + F.lane, c0 = cbk * 16;
          const float* pw = F.in[9] + ((size_t)(l * 4 + g) * 128 + c0) * 128; const float* ps = F.in[10] + l * 512 + g * 128; const float* wpp = F.in[16] + ((size_t)l * 512 + g * 128) * 1024 + n;
#pragma unroll
          for (int q = 0; q < 8; ++q) { const int idx = q * 256 + 4 * F.lane; const f32x4 v = *(const f32x4*)(pw + idx), sc = *(const f32x4*)(ps + (idx & 127)); *(LAS f32x4*)(scr + idx) = v * sc; }
          LDS_WAIT(); asm volatile("" ::: "memory");
          float a[16];
#pragma unroll
          for (int i = 0; i < 16; ++i) a[i] = 0.f;
#pragma unroll 4
          for (int d = 0; d < 128; ++d) { const float wv = wpp[(size_t)d * 1024];
#pragma unroll
              for (int i = 0; i < 16; ++i) a[i] += scr[i * 128 + d] * wv; }
          u32x4 o0, o1; o0.x = cvtpk(a[0], a[1]); o0.y = cvtpk(a[2], a[3]); o0.z = cvtpk(a[4], a[5]); o0.w = cvtpk(a[6], a[7]);
          o1.x = cvtpk(a[8], a[9]); o1.y = cvtpk(a[10], a[11]); o1.z = cvtpk(a[12], a[13]); o1.w = cvtpk(a[14], a[15]);
          bf16_t* dst = WEFF + ((size_t)l * 1024 + n) * MAP + g * 128 + c0; *(u32x4*)dst = o0; *(u32x4*)(dst + 8) = o1;
          LDS_WAIT(); asm volatile("" ::: "memory"); } }
    if (blockIdx.x == 0) {
        float* COS = (float*)(F.ws + WS_TAB); float* SIN = COS + 1024; float* LAMV = SIN + 1024;
        for (int idx = F.tid; idx < 1024; idx += NTHR) { const int pos = idx >> 4, i = idx & 15; const float inv = powf(10000.f, -(float)i * (2.0f / 32.0f)); const float ang = (float)pos * inv;
            COS[idx] = cosf(ang); SIN[idx] = sinf(ang); }
        if (F.wave == 1) {
            for (int l = 0; l < 2; ++l) { const float d1 = wave_sum(F.in[11][l * 64 + F.lane] * F.in[12][l * 64 + F.lane], F.lane), d2 = wave_sum(F.in[13][l * 64 + F.lane] * F.in[14][l * 64 + F.lane], F.lane);
                const float lam0 = 0.8f - 0.6f * expf(-0.3f * (float)l);
                if (F.lane == 0) { LAMV[2 * l] = expf(d1) - expf(d2) + lam0; LAMV[2 * l + 1] = 1.f - lam0; } }
        }
    }
}

constexpr size_t XPITCH = 4096;
#define XODD(i) ((size_t)((i) & 1) << 11)
template <bool SRC16>
__device__ __forceinline__ void phase_normmod(Frame F, const void* lat_, const void* ctx_, const float* g, const float* mod, int soff, bool do_ctx, bf16_t* H, const bf16_t* oadd = nullptr, void* latdst_ = nullptr, void* ctxdst_ = nullptr) {
    const char* lat = (const char*)lat_; const char* ctx = (const char*)ctx_; char* latdst = (char*)latdst_; char* ctxdst = (char*)ctxdst_;
    F.tid = opaque_tid(F.wave0); F.lane = F.tid & 63; F.wave = __builtin_amdgcn_readfirstlane(F.tid >> 6);
    const int gw = F.vcu * NWAVES + F.wave, NGW = F.G * NWAVES;
    const int per = (((NTOK + NGW - 1) / NGW) + 3) & ~3;
    const int r0 = gw * per, r1 = min(r0 + per, NTOK);
    int cur_bb = -1; f32x4 gs[4], sh[4];
#pragma unroll
    for (int q = 0; q < 4; ++q) { gs[q] = (f32x4){0.f, 0.f, 0.f, 0.f}; sh[q] = gs[q]; }
    for (int r = r0; r < r1; r += 4) {
        const int b = r / LTOK, j = r - b * LTOK; const bool isc = j < CTXL;
        if (isc && !do_ctx) continue;
        const int bb = isc ? 32 : b;
        if (bb != cur_bb) { cur_bb = bb; const float* mv = mod + (size_t)bb * MODW + soff;
#pragma unroll
            for (int q = 0; q < 4; ++q) { const int cidx = 4 * F.lane + 256 * q; const f32x4 gg = *(const f32x4*)(g + cidx), sc = *(const f32x4*)(mv + 1024 + cidx); gs[q] = gg * (sc + 1.f); sh[q] = *(const f32x4*)(mv + cidx); } }
        const char* src = isc ? ctx + ((size_t)b * CTXL + j) * XPITCH : lat + ((size_t)b * SEQ + (j - CTXL)) * XPITCH;
        f32x4 v[4][4]; float s[4];
        if (SRC16) {
            u32x2 xv[4][4];
#pragma unroll
            for (int i = 0; i < 4; ++i)
#pragma unroll
                for (int q = 0; q < 4; ++q) xv[i][q] = RLD((const u32x2*)(src + (size_t)i * XPITCH + XODD(i)) + F.lane + 64 * q);
#pragma unroll
            for (int i = 0; i < 4; ++i)
#pragma unroll
                for (int q = 0; q < 4; ++q) v[i][q] = (f32x4){bflo(xv[i][q].x), bfhi(xv[i][q].x), bflo(xv[i][q].y), bfhi(xv[i][q].y)};
        } else {
#pragma unroll
            for (int i = 0; i < 4; ++i)
#pragma unroll
                for (int q = 0; q < 4; ++q) v[i][q] = RLD((const f32x4*)(src + (size_t)i * XPITCH) + F.lane + 64 * q);
        }
        if (oadd) {
            u32x2 ov[4][4];
#pragma unroll
            for (int i = 0; i < 4; ++i)
#pragma unroll
                for (int q = 0; q < 4; ++q) ov[i][q] = RLD((const u32x2*)(oadd + (size_t)(r + i) * D) + F.lane + 64 * q);
            char* dst = isc ? ctxdst + ((size_t)b * CTXL + j) * XPITCH : latdst + ((size_t)b * SEQ + (j - CTXL)) * XPITCH;
#pragma unroll
            for (int i = 0; i < 4; ++i)
#pragma unroll
                for (int q = 0; q < 4; ++q) { v[i][q] += (f32x4){bflo(ov[i][q].x), bfhi(ov[i][q].x), bflo(ov[i][q].y), bfhi(ov[i][q].y)};
                    u32x2 xo; xo.x = cvtpk(v[i][q][0], v[i][q][1]); xo.y = cvtpk(v[i][q][2], v[i][q][3]); RST((u32x2*)(dst + (size_t)i * XPITCH + XODD(i)) + F.lane + 64 * q, xo); }
        }
#pragma unroll
        for (int i = 0; i < 4; ++i) { float a = 0.f;
#pragma unroll
            for (int q = 0; q < 4; ++q) a += (v[i][q][0] * v[i][q][0] + v[i][q][1] * v[i][q][1]) + (v[i][q][2] * v[i][q][2] + v[i][q][3] * v[i][q][3]);
            s[i] = a; }
#pragma unroll
        for (int o = 1; o < 64; o <<= 1)
#pragma unroll
            for (int i = 0; i < 4; ++i) s[i] += shx(s[i], o, F.lane);
#pragma unroll
        for (int i = 0; i < 4; ++i) { const float rstd = rsqrtf(s[i] * (1.f / D) + EPS); u32x2* o8 = (u32x2*)(H + (size_t)(r + i) * D) + F.lane;
#pragma unroll
            for (int q = 0; q < 4; ++q) { const f32x4 y = v[i][q] * rstd * gs[q] + sh[q]; u32x2 o; o.x = cvtpk(y[0], y[1]); o.y = cvtpk(y[2], y[3]); o8[64 * q] = o; } }
    }
}

__device__ __forceinline__ void phase_pool(Frame F, const bf16_t* U, bf16_t* M, bool do_ctx) {
    F.tid = opaque_tid(F.wave0); F.lane = F.tid & 63; F.wave = __builtin_amdgcn_readfirstlane(F.tid >> 6);
    const int gw = F.vcu * NWAVES + F.wave, NGW = F.G * NWAVES;
    const int per = (((NTOK + NGW - 1) / NGW) + 3) & ~3;
    const int r0 = gw * per, r1 = min(r0 + per, NTOK);
    const int half = 1 << (F.lane >> 4);
    for (int r = r0; r < r1; r += 4) {
        const int b = r / LTOK, j = r - b * LTOK; const bool isc = j < CTXL;
        if (isc && !do_ctx) continue;
        const int L = isc ? CTXL : SEQ, t = isc ? j : j - CTXL; const size_t base = (size_t)b * LTOK + (isc ? 0 : CTXL);
        u32x4 w[19];
#pragma unroll
        for (int k = 0; k < 19; ++k) { const int tt = min(max(t - 8 + k, 0), L - 1); w[k] = *(const u32x4*)(U + (base + tt) * 512 + 8 * F.lane); }
#pragma unroll
        for (int i = 0; i < 4; ++i) {
            const int ti = t + i, lo = max(ti - half, 0), hi = min(ti + half, L);
            float a[8];
#pragma unroll
            for (int q = 0; q < 8; ++q) a[q] = 0.f;
#pragma unroll
            for (int k = i; k < i + 16; ++k) { const int tt = t - 8 + k; const float mk = (tt >= lo && tt < hi) ? 1.f : 0.f;
                a[0] += mk * bflo(w[k].x); a[1] += mk * bfhi(w[k].x); a[2] += mk * bflo(w[k].y); a[3] += mk * bfhi(w[k].y); a[4] += mk * bflo(w[k].z); a[5] += mk * bfhi(w[k].z); a[6] += mk * bflo(w[k].w); a[7] += mk * bfhi(w[k].w); }
            const float ic = 1.f / (float)(hi - lo);
            const u32x4 ws = w[8 + i];
            u32x4 o; o.x = cvtpk(a[0] * ic - bflo(ws.x), a[1] * ic - bfhi(ws.x)); o.y = cvtpk(a[2] * ic - bflo(ws.y), a[3] * ic - bfhi(ws.y));
            o.z = cvtpk(a[4] * ic - bflo(ws.z), a[5] * ic - bfhi(ws.z)); o.w = cvtpk(a[6] * ic - bflo(ws.w), a[7] * ic - bfhi(ws.w));
            *(u32x4*)(M + (size_t)(r + i) * MAP + 8 * F.lane) = o;
        }
    }
}

__device__ __forceinline__ void phase_router(Frame F, char* x1, const float* g, const float* mod, bf16_t* H, const bf16_t* oadd) {
    F.tid = opaque_tid(F.wave0); F.lane = F.tid & 63; F.wave = __builtin_amdgcn_readfirstlane(F.tid >> 6);
    LAS float* WR = (LAS float*)F.lds;
    LAS float* LG = (LAS float*)(F.lds + 32768);
    LAS int* LCNT = (LAS int*)(F.lds + 32768 + 8192);
    unsigned* LIST = (unsigned*)(F.ws + WS_LIST); float* WTS = (float*)(F.ws + WS_WTS);
    for (int i = F.tid; i < 8192; i += NTHR) WR[i] = F.in[22][i];
    for (int ch = blockIdx.x; ch < NLAT / 256; ch += F.G) {
        if (F.tid < 16) LCNT[F.tid] = 0;
        __syncthreads();
        const int bch = (ch * 256) >> 11;
        f32x4 gs[4], sh[4];
        { const float* mv = mod + (size_t)bch * MODW + 3 * D;
#pragma unroll
          for (int q = 0; q < 4; ++q) { const int cidx = 4 * F.lane + 256 * q; const f32x4 gg = *(const f32x4*)(g + cidx), sc = *(const f32x4*)(mv + 1024 + cidx); gs[q] = gg * (sc + 1.f); sh[q] = *(const f32x4*)(mv + cidx); } }
        u32x2 vn[2][4], on[2][4];
#define RT_LOAD(rb_) do { const int _t0 = ch * 256 + F.wave * 32 + (rb_); const bf16_t* _or = oadd + ((size_t)bch * LTOK + CTXL + (_t0 & 2047)) * D; \
            _Pragma("unroll") for (int i = 0; i < 2; ++i) _Pragma("unroll") for (int q = 0; q < 4; ++q) { vn[i][q] = RLD((const u32x2*)(x1 + (size_t)(_t0 + i) * XPITCH + XODD(i)) + F.lane + 64 * q); on[i][q] = RLD((const u32x2*)(_or + (size_t)i * D) + F.lane + 64 * q); } } while (0)
        RT_LOAD(0);
        for (int rb = 0; rb < 32; rb += 2) {
            const int rr0 = F.wave * 32 + rb, tok0 = ch * 256 + rr0;
            f32x4 v[2][4]; float s[2];
#pragma unroll
            for (int i = 0; i < 2; ++i)
#pragma unroll
                for (int q = 0; q < 4; ++q) v[i][q] = (f32x4){bflo(vn[i][q].x) + bflo(on[i][q].x), bfhi(vn[i][q].x) + bfhi(on[i][q].x), bflo(vn[i][q].y) + bflo(on[i][q].y), bfhi(vn[i][q].y) + bfhi(on[i][q].y)};
            if (rb + 2 < 32) RT_LOAD(rb + 2);
#pragma unroll
            for (int i = 0; i < 2; ++i)
#pragma unroll
                for (int q = 0; q < 4; ++q) { u32x2 xo; xo.x = cvtpk(v[i][q][0], v[i][q][1]); xo.y = cvtpk(v[i][q][2], v[i][q][3]); RST((u32x2*)(x1 + (size_t)(tok0 + i) * XPITCH + XODD(i)) + F.lane + 64 * q, xo); }
#pragma unroll
            for (int i = 0; i < 2; ++i) { float a = 0.f;
#pragma unroll
                for (int q = 0; q < 4; ++q) a += (v[i][q][0] * v[i][q][0] + v[i][q][1] * v[i][q][1]) + (v[i][q][2] * v[i][q][2] + v[i][q][3] * v[i][q][3]);
                s[i] = a; }
#pragma unroll
            for (int o = 1; o < 64; o <<= 1)
#pragma unroll
                for (int i = 0; i < 2; ++i) s[i] += shx(s[i], o, F.lane);
#pragma unroll
            for (int i = 0; i < 2; ++i) {
                const int tok = tok0 + i; const float rstd = rsqrtf(s[i] * (1.f / D) + EPS);
                u32x2* o8 = (u32x2*)(H + ((size_t)bch * LTOK + CTXL + (tok & 2047)) * D) + F.lane;
                float lg[8];
#pragma unroll
                for (int e = 0; e < 8; ++e) lg[e] = 0.f;
#pragma unroll
                for (int q = 0; q < 4; ++q) { const int cidx = 4 * F.lane + 256 * q;
                    const f32x4 y = v[i][q] * rstd * gs[q] + sh[q];
                    u32x2 o; o.x = cvtpk(y[0], y[1]); o.y = cvtpk(y[2], y[3]); o8[64 * q] = o;
#pragma unroll
                    for (int k = 0; k < 4; ++k) { const LAS f32x4* wr = (const LAS f32x4*)(WR + (cidx + k) * 8); const f32x4 w0 = wr[0], w1 = wr[1];
                        lg[0] += y[k] * w0[0]; lg[1] += y[k] * w0[1]; lg[2] += y[k] * w0[2]; lg[3] += y[k] * w0[3]; lg[4] += y[k] * w1[0]; lg[5] += y[k] * w1[1]; lg[6] += y[k] * w1[2]; lg[7] += y[k] * w1[3]; } }
                const bool b0 = F.lane & 1, b1 = F.lane & 2, b2 = F.lane & 4;
                float a4[4], a2[2], a1;
#pragma unroll
                for (int j = 0; j < 4; ++j) { const float keep = b0 ? lg[4 + j] : lg[j], send = b0 ? lg[j] : lg[4 + j]; a4[j] = keep + shx(send, 1, F.lane); }
#pragma unroll
                for (int j = 0; j < 2; ++j) { const float keep = b1 ? a4[2 + j] : a4[j], send = b1 ? a4[j] : a4[2 + j]; a2[j] = keep + shx(send, 2, F.lane); }
                { const float keep = b2 ? a2[1] : a2[0], send = b2 ? a2[0] : a2[1]; a1 = keep + shx(send, 4, F.lane); }
                a1 += shx(a1, 8, F.lane); a1 += shx(a1, 16, F.lane); a1 += shx(a1, 32, F.lane);
                if (F.lane < 8) LG[(rr0 + i) * 8 + ((F.lane & 1) * 4 + (F.lane & 2) + ((F.lane >> 2) & 1))] = a1;
            }
        }
#undef RT_LOAD
        __syncthreads();
        int e1 = 0, e2 = 0, i1 = 0, i2 = 0; float w1 = 0.f, w2 = 0.f;
        if (F.tid < 256) {
            const f32x4 l0 = *(const LAS f32x4*)(LG + F.tid * 8), l1 = *(const LAS f32x4*)(LG + F.tid * 8 + 4);
            const float lg[8] = {l0[0], l0[1], l0[2], l0[3], l1[0], l1[1], l1[2], l1[3]};
            float v1 = lg[0];
#pragma unroll
            for (int e = 1; e < 8; ++e) if (lg[e] > v1) { v1 = lg[e]; e1 = e; }
            float v2 = -3.0e38f;
#pragma unroll
            for (int e = 0; e < 8; ++e) if (e != e1 && lg[e] > v2) { v2 = lg[e]; e2 = e; }
            const float p2 = expf(v2 - v1); w1 = 1.f / (1.f + p2); w2 = p2 * w1;
            i1 = atomicAdd((int*)&LCNT[e1], 1); i2 = atomicAdd((int*)&LCNT[e2], 1); }
        __syncthreads();
        if (F.tid < 8) LCNT[8 + F.tid] = (int)__hip_atomic_fetch_add(F.ctl + CW_CNT + 64 * F.tid, (unsigned)LCNT[F.tid], __ATOMIC_RELAXED, __HIP_MEMORY_SCOPE_AGENT);
        __syncthreads();
        if (F.tid < 256) { const unsigned tok = (unsigned)(ch * 256 + F.tid);
            LIST[(size_t)e1 * NLAT + LCNT[8 + e1] + i1] = tok * 2u; LIST[(size_t)e2 * NLAT + LCNT[8 + e2] + i2] = tok * 2u + 1u;
            WTS[tok * 2u] = w1; WTS[tok * 2u + 1u] = w2; }
        __syncthreads();
    }
    __syncthreads();
    LAS float* scr = (LAS float*)(F.lds + F.wave * 8448);
    const int gw = F.vcu * NWAVES + F.wave, NGW = F.G * NWAVES;
    bf16_t* WUPE = (bf16_t*)(F.ws + WS_WUPE); bf16_t* WDNE = (bf16_t*)(F.ws + WS_WDNE);
    constexpr int I_E = 16 * 44, I_D = 22 * 32;
    for (int it = gw; it < NE * (2 * I_E + I_D); it += NGW) {
        const int e = it / (2 * I_E + I_D); int r = it - e * (2 * I_E + I_D);
        if (r < 2 * I_E) { const int q = r / I_E; r -= q * I_E; const int kb = r / 44, nb = r % 44, n0 = nb * 32;
            const float* W = (q ? F.in[24] : F.in[23]) + (size_t)e * 1024 * FFE;
            tr_item(W, FFE, kb * 64, n0, WUPE + (size_t)e * 2816 * 1024, 1024, (n0 >> 7) * 256 + q * 128 - (n0 & ~127), 0, false, scr, F.lane); }
        else { r -= 2 * I_E; const int kb = r / 32, nb = r % 32;
            tr_item(F.in[25] + (size_t)e * FFE * 1024, 1024, kb * 64, nb * 32, WDNE + (size_t)e * 1024 * FFE, FFE, 0, 0, false, scr, F.lane); }
    }
}

__device__ __forceinline__ void phase_final(Frame F, float* x, const bf16_t* YM, const float* mod, const float* fg) {
    F.tid = opaque_tid(F.wave0); F.lane = F.tid & 63; F.wave = __builtin_amdgcn_readfirstlane(F.tid >> 6);
    const int gw = F.vcu * NWAVES + F.wave, NGW = F.G * NWAVES;
    const int per = (((NLAT + NGW - 1) / NGW) + 1) & ~1;
    const int t0 = gw * per, t1 = min(t0 + per, NLAT);
    f32x4 fgv[4];
#pragma unroll
    for (int q = 0; q < 4; ++q) fgv[q] = *(const f32x4*)(fg + 4 * F.lane + 256 * q);
    for (int tok = t0; tok < t1; tok += 2) {
        const int b = tok >> 11; const float* gate = mod + (size_t)b * MODW + 5 * D;
        f32x4 xv[2][4]; u32x2 xb[2][4], ya[2][4], yc[2][4];
#pragma unroll
        for (int i = 0; i < 2; ++i)
#pragma unroll
            for (int q = 0; q < 4; ++q) { xb[i][q] = RLD((const u32x2*)((const char*)x + (size_t)(tok + i) * XPITCH + XODD(i)) + F.lane + 64 * q);
                ya[i][q] = RLD((const u32x2*)(YM + (size_t)(tok + i) * D) + F.lane + 64 * q); yc[i][q] = RLD((const u32x2*)(YM + ((size_t)NLAT + tok + i) * D) + F.lane + 64 * q); }
        float s[2];
#pragma unroll
        for (int i = 0; i < 2; ++i) { float a = 0.f;
#pragma unroll
            for (int q = 0; q < 4; ++q) { const f32x4 gg = *(const f32x4*)(gate + 4 * F.lane + 256 * q);
                const f32x4 yy = (f32x4){bflo(ya[i][q].x) + bflo(yc[i][q].x), bfhi(ya[i][q].x) + bfhi(yc[i][q].x), bflo(ya[i][q].y) + bflo(yc[i][q].y), bfhi(ya[i][q].y) + bfhi(yc[i][q].y)};
                xv[i][q] = (f32x4){bflo(xb[i][q].x), bfhi(xb[i][q].x), bflo(xb[i][q].y), bfhi(xb[i][q].y)} + gg * yy; a += (xv[i][q][0] * xv[i][q][0] + xv[i][q][1] * xv[i][q][1]) + (xv[i][q][2] * xv[i][q][2] + xv[i][q][3] * xv[i][q][3]); }
            s[i] = a; }
#pragma unroll
        for (int o = 1; o < 64; o <<= 1)
#pragma unroll
            for (int i = 0; i < 2; ++i) s[i] += shx(s[i], o, F.lane);
#pragma unroll
        for (int i = 0; i < 2; ++i) { const float rstd = rsqrtf(s[i] * (1.f / D) + EPS);
#pragma unroll
            for (int q = 0; q < 4; ++q) RST((f32x4*)(x + (size_t)(tok + i) * D) + F.lane + 64 * q, xv[i][q] * rstd * fgv[q]); }
    }
}

struct Args { const float* in[27]; float* out; unsigned char* ws; int ph_lo, ph_hi; };
__global__ void __launch_bounds__(NTHR, 2) dit_fwd(Args args) {
    extern __shared__ __attribute__((aligned(16))) unsigned char lds_raw[];
    LAS unsigned char* const ldsb = (LAS unsigned char*)lds_raw;
    const int WAVE = __builtin_amdgcn_readfirstlane((int)threadIdx.x >> 6);
    volatile LAS unsigned* xbw = (volatile LAS unsigned*)(ldsb + LDS_CTRL);
    if (threadIdx.x < 4) xbw[threadIdx.x] = 0u;
    __syncthreads();
    volatile LAS unsigned long long* tsl = (volatile LAS unsigned long long*)(ldsb + LDS_CTRL + 64);
    if (args.ph_hi - args.ph_lo > 1) (void)xcd_barrier_post((unsigned*)(args.ws + WS_CTL) + CW_BAR, xbw);
#ifndef SITE_MASK
#define SITE_MASK 0xFFFFFFFFu
#endif
#define SITE(n) (((SITE_MASK) >> (n)) & 1u)
#define IN(k) (args.ph_lo <= (k) && (k) < args.ph_hi)
#define STAMP(k) do { if (PROBE_MASK != 0u && blockIdx.x == 0 && opaque_tid(WAVE) == 0) tsl[(k)] = __builtin_amdgcn_s_memrealtime(); } while (0)
#define SEAM(k) do { if (IN(k) && IN((k) + 1)) { XcdBarrier _b; _b.bar = (unsigned*)(args.ws + WS_CTL) + CW_BAR; _b.x = xb_xcc_id(); _b.st = xbw; xcd_barrier(_b); } STAMP((k) + 1); } while (0)

#define WSBASE() size_t _wz = 0; asm volatile("" : "+s"(_wz)); unsigned char* ws = args.ws + _wz; float* MOD = (float*)(ws + WS_MOD); (void)MOD; \
    Frame F; F.lds = ldsb; F.ws = ws; F.ctl = (unsigned*)(ws + WS_CTL); F.in = args.in; F.out = args.out + _wz; F.wave0 = WAVE; F.tid = 0; F.lane = 0; F.wave = 0; \
    F.G = gridDim.x; { const int bx = blockIdx.x; F.vcu = (F.G % 8 == 0) ? (bx % 8) * (F.G / 8) + bx / 8 : bx; } const int c = (int)blockIdx.x; (void)c
#define P_COS ((const float*)(ws + WS_TAB))
#define P_SIN (P_COS + 1024)
#define P_LAMV (P_SIN + 1024)
#define P_XC ((float*)(ws + WS_XC))
#define P_H ((bf16_t*)(ws + WS_H))
#define P_U ((bf16_t*)(ws + WS_U))
#define P_Q ((bf16_t*)(ws + WS_Q))
#define P_KB ((bf16_t*)(ws + WS_K))
#define P_VT ((bf16_t*)(ws + WS_VT))
#define P_G ((unsigned char*)(ws + WS_G))
#define P_MA ((bf16_t*)(ws + WS_MA))
#define P_Y ((bf16_t*)(ws + WS_Y))
#define P_HID ((bf16_t*)(ws + WS_HID))
#define P_HIDM ((bf16_t*)(ws + WS_HIDM))
#define P_YM ((bf16_t*)(ws + WS_YM))

    if (PROBE_MASK != 0u && threadIdx.x == 0) { tsl[20] = 0; tsl[21] = 0; tsl[22] = 0; tsl[23] = 0; }
    STAMP(0);
    if (SITE(0) && IN(0)) { WSBASE(); phase_prologue(F); } SEAM(0);
    if (SITE(1) && IN(1)) { WSBASE(); phase_normmod<false>(F, F.in[0], F.in[2], F.in[6], MOD, 0, true, P_H); } SEAM(1);

    for (int l = 0; l < 2; ++l) {
        const int pb = 2 + 8 * l; const bool last = (l == 1);
        if (SITE(2) && IN(pb)) { WSBASE();
            ZSched S; S.init(F.G, c, last ? 1 : 0, P_H, ws + WS_WZ + (size_t)l * 9 * MiB, ws + WS_WV + (size_t)l * 2 * MiB);
            ZEpi E{P_U, P_Q, P_KB, P_G, P_VT, P_COS, P_SIN};
            pg8::gemm_phase(F.lds, WAVE, 1024, S, E);
        } SEAM(pb);
        if (SITE(3) && IN(pb + 1)) { WSBASE();
            phase_pool(F, P_U, P_MA, !last);
            const float lam = P_LAMV[2 * l], osc = P_LAMV[2 * l + 1]; const float* subg = F.in[15] + l * VD;
            bf16x8 qf[4];
            for (int i = 0;; ++i) { const int Lf = i * F.G + F.vcu; if (Lf >= NB * NH * 16) break; const int L = REV_ORDER ? NB * NH * 16 - 1 - Lf : Lf; const int bh = L >> 4, qt = L & 15, b = bh >> 3, h = bh & 7;
                const int Lfn = Lf + F.G; const bool hn = Lfn < NB * NH * 16; const int Ln = REV_ORDER ? NB * NH * 16 - 1 - Lfn : Lfn; const int nbh = Ln >> 4, nqt = Ln & 15, nb = nbh >> 3, nh = nbh & 7;
                att::attn_unit(F.lds, P_Q, P_KB, P_VT, P_MA, b, h, (size_t)b * LTOK + CTXL + qt * 128, 36, lam, osc, subg, qf, XUP ? i == 0 : true, XUP ? hn : false, nb, nh, (size_t)nb * LTOK + CTXL + nqt * 128, WAVE); }
            if (!last) for (int i = 0;; ++i) { const int L = i * F.G + F.vcu; if (L >= NB * NH * 2) break; const int bh = L >> 1, qt = L & 1, b = bh >> 3, h = bh & 7;
                const int Ln = L + F.G; const bool hn = Ln < NB * NH * 2; const int nbh = Ln >> 1, nqt = Ln & 1, nb = nbh >> 3, nh = nbh & 7;
                att::attn_unit(F.lds, P_Q, P_KB, P_VT, P_MA, b, h, (size_t)b * LTOK + qt * 128, 4, lam, osc, subg, qf, XUP ? i == 0 : true, XUP ? hn : false, nb, nh, (size_t)nb * LTOK + nqt * 128, WAVE); }
        } SEAM(pb + 1);
        if (SITE(4) && IN(pb + 2)) { WSBASE();
            MergeSched S; S.init(F.G, c, last ? 1 : 0, P_MA, ws + WS_WM + (size_t)l * 3 * MiB); MergeEpi E{P_Y, P_G}; pg8::gemm_phase(F.lds, WAVE, MAP, S, E);
        } SEAM(pb + 2);
        if (SITE(5) && IN(pb + 3)) { WSBASE();
            PlainSched S; S.init(F.G, c, last ? 1 : 0, 4, P_Y, ws + WS_WOUT + (size_t)l * 2 * MiB, 1024, REV_ORDER);
            OEpi E{P_Q, MOD + (size_t)l * 33 * MODW, 2 * D};
            pg8::gemm_phase(F.lds, WAVE, 1024, S, E);
        } SEAM(pb + 3);
        if (!last) {
            if (SITE(6) && IN(pb + 4)) { WSBASE(); phase_normmod<false>(F, F.in[0], F.in[2], F.in[7], MOD, 3 * D, true, P_H, P_Q, F.out, P_XC); } SEAM(pb + 4);
            if (SITE(7) && IN(pb + 5)) { WSBASE(); PlainSched S; S.init(F.G, c, 0, 22, P_H, ws + WS_WUP0, 1024); UpEpi E{P_HID, FFP}; pg8::gemm_phase(F.lds, WAVE, 1024, S, E); } SEAM(pb + 5);
            if (SITE(8) && IN(pb + 6)) { WSBASE(); PlainSched S; S.init(F.G, c, 0, 4, P_HID, ws + WS_WDN0, FFP, REV_ORDER); OEpi E{(bf16_t*)P_G, MOD, 5 * D}; pg8::gemm_phase(F.lds, WAVE, FFP, S, E); } SEAM(pb + 6);
            if (SITE(9) && IN(pb + 7)) { WSBASE(); phase_normmod<true>(F, F.out, P_XC, F.in[6] + D, MOD + (size_t)33 * MODW, 0, true, P_H, (const bf16_t*)P_G, F.out, P_XC); } SEAM(pb + 7);
        } else {
            if (SITE(10) && IN(pb + 4)) { WSBASE(); phase_router(F, (char*)F.out, F.in[7] + D, MOD + (size_t)33 * MODW, P_H, P_Q); } SEAM(pb + 4);
            if (SITE(12) && IN(pb + 5)) { WSBASE(); MoeInfo mi; mi.load(F.ctl); MoeSched S; S.init(F.G, c, 11, P_H, ws + WS_WUPE, 1024, 2816, mi); S.gather = 1; S.LIST = (const unsigned*)(ws + WS_LIST); UpEpi E{P_HIDM, FFE}; pg8::gemm_phase<true>(F.lds, WAVE, 1024, S, E); } SEAM(pb + 5);
            if (SITE(13) && IN(pb + 6)) { WSBASE(); MoeInfo mi; mi.load(F.ctl); MoeSched S; S.init(F.G, c, 4, P_HIDM, ws + WS_WDNE, FFE, 1024, mi); S.rev = REV_ORDER;
                MoeDownEpi E{P_YM, (const unsigned*)(ws + WS_LIST), (const float*)(ws + WS_WTS), mi}; pg8::gemm_phase(F.lds, WAVE, FFE, S, E); } SEAM(pb + 6);
            if (SITE(14) && IN(pb + 7)) { WSBASE(); phase_final(F, F.out, P_YM, MOD + (size_t)33 * MODW, F.in[26]); }
            if (PROBE_MASK != 0u && blockIdx.x == 0) { __syncthreads(); if (threadIdx.x == 0) { const unsigned long long tend = __builtin_amdgcn_s_memrealtime(); unsigned long long dly = 0;
                for (int k = 0; k < N_PHASES; ++k) if ((PROBE_MASK >> k) & 1u) dly += (k == N_PHASES - 1 ? tend : tsl[k + 1]) - tsl[k];
                if ((PROBE_MASK >> 20) & 1u) dly += tsl[20];
                if ((PROBE_MASK >> 21) & 1u) dly += tsl[21];
                if ((PROBE_MASK >> 22) & 1u) dly += tsl[22];
                if ((PROBE_MASK >> 23) & 1u) dly += tsl[23];
                while (__builtin_amdgcn_s_memrealtime() - tend < dly) __builtin_amdgcn_s_sleep(8); } }
        }
    }
#undef IN
#undef SEAM
}

extern "C" void kernel_launch(void* const* d_in, const int* in_sizes, int n_in, void* d_out, int out_size, void* d_ws, size_t ws_size, hipStream_t stream) {
    static int grid = 0;
    if (grid == 0) {
        if (n_in != 27 || ws_size < WS_END) { fprintf(stderr, "kernel_launch: unexpected n_in %d or ws %zu\n", n_in, ws_size); grid = -1; return; }
        int dev = 0, cus = 0;
        if (hipGetDevice(&dev) != hipSuccess || hipDeviceGetAttribute(&cus, hipDeviceAttributeMultiprocessorCount, dev) != hipSuccess) { grid = -1; return; }
        if (hipFuncSetAttribute((const void*)dit_fwd, hipFuncAttributeMaxDynamicSharedMemorySize, LDS_BYTES) != hipSuccess) { fprintf(stderr, "kernel_launch: hipFuncSetAttribute failed\n"); grid = -1; return; }
        (void)hipGetLastError();
        grid = cus;
    }
    if (grid < 0) return;
    (void)hipMemsetAsync((char*)d_ws + WS_CTL, 0, CTL_ZERO_BYTES, stream);
    Args a{};
    for (int i = 0; i < 27; ++i) a.in[i] = (const float*)d_in[i];
    a.out = (float*)d_out; a.ws = (unsigned char*)d_ws;
#if MK_ONE_LAUNCH
    a.ph_lo = 0; a.ph_hi = N_PHASES;
    hipLaunchKernelGGL(dit_fwd, dim3(grid), dim3(NTHR), LDS_BYTES, stream, a);
#else
    for (int p = 0; p < N_PHASES; ++p) { a.ph_lo = p; a.ph_hi = p + 1; hipLaunchKernelGGL(dit_fwd, dim3(grid), dim3(NTHR), LDS_BYTES, stream, a); }
#endif
}
```

```cpp
#include <hip/hip_runtime.h>
#include <cstdio>
#include <cstdint>

#define LAS __attribute__((address_space(3)))
#define GAS __attribute__((address_space(1)))
typedef unsigned short bf16_t;
typedef short bf16x8 __attribute__((ext_vector_type(8)));
typedef float f32x4 __attribute__((ext_vector_type(4)));
typedef float f32x16 __attribute__((ext_vector_type(16)));
typedef unsigned u32x4 __attribute__((ext_vector_type(4)));
typedef unsigned u32x2 __attribute__((ext_vector_type(2)));
typedef float f32x2_t __attribute__((ext_vector_type(2)));
typedef __bf16 bf16x2_t __attribute__((ext_vector_type(2)));

#ifndef PROBE_MASK
#define PROBE_MASK 0u
#endif
#ifndef PG8_ALIGN
#define PG8_ALIGN 1
#endif
#ifndef ATT_PRIO
#define ATT_PRIO 0
#ifndef REV_ORDER
#define REV_ORDER 1
#endif
#ifndef ROW_NT
#define ROW_NT 1
#endif
#endif
#ifndef XUP
#define XUP 0
#endif
#ifndef GEMM_STAGGER
#define GEMM_STAGGER 0
#endif
#ifndef MK_ONE_LAUNCH
#define MK_ONE_LAUNCH 1
#endif

constexpr int D = 1024, NB = 32, SEQ = 2048, CTXL = 256, LTOK = SEQ + CTXL, NTOK = NB * LTOK, NRT = NTOK / 256;
constexpr int NLAT = NB * SEQ;
constexpr int NH = 8, VD = 128;
constexpr int FF = 2752, FFP = 2816, NE = 8, FFE = 1408;
constexpr int MODW = 6 * D;
constexpr float EPS = 1e-6f;
constexpr float LOG2E = 1.4426950408889634f;
constexpr float QSCALE = 0.125f * LOG2E;
constexpr int NWAVES = 8, NTHR = 512;

constexpr size_t MiB = 1u << 20;
constexpr size_t WS_CTL = 0, CTL_ZERO_BYTES = 65536;
constexpr size_t WS_MOD = 65536;
constexpr size_t WS_TAB = 1703936;
constexpr size_t WS_XC = 2 * MiB;
constexpr size_t WS_W = 34 * MiB;
constexpr size_t WS_WZ = WS_W, WS_WV = WS_W + 18 * MiB, WS_WM = WS_W + 22 * MiB, WS_WOUT = WS_W + 28 * MiB, WS_WUP0 = WS_W + 32 * MiB, WS_WDN0 = WS_W + 43 * MiB;
constexpr size_t WS_H = 83 * MiB, WS_MA = 83 * MiB, WS_U = 299 * MiB, WS_Q = 371 * MiB, WS_K = 515 * MiB, WS_VT = 659 * MiB, WS_G = 803 * MiB, WS_END = 982 * MiB;
constexpr size_t WS_Y = WS_K, WS_HID = WS_U;
constexpr size_t WS_YM = 299 * MiB, WS_HIDM = 555 * MiB, WS_WUPE = 913 * MiB, WS_WDNE = 957 * MiB, WS_LIST = 979 * MiB, WS_WTS = 981 * MiB;
constexpr int MAP = 1536;
static_assert(WS_WDN0 + (size_t)D * FFP * 2 <= WS_H, "weights");
static_assert(WS_MA + (size_t)NTOK * MAP * 2 <= WS_U && WS_G + (size_t)NTOK * 2048 <= WS_END, "ma / g");
static_assert(WS_HID + (size_t)NTOK * FFP * 2 <= WS_END, "hid");
static_assert(WS_YM + (size_t)2 * NLAT * D * 2 <= WS_HIDM && WS_HIDM + (size_t)133120 * FFE * 2 <= WS_WUPE && WS_WTS + (size_t)NLAT * 8 <= WS_END, "moe");
constexpr int CW_BAR = 1024, CW_CNT = 8192;

constexpr int N_PHASES = 18;
constexpr int LDS_BYTES = 163840;
constexpr int LDS_CTRL = LDS_BYTES - 256;

__device__ __forceinline__ unsigned cvtpk(float lo, float hi) { f32x2_t v = {lo, hi}; bf16x2_t b = __builtin_convertvector(v, bf16x2_t); return __builtin_bit_cast(unsigned, b); }
__device__ __forceinline__ float bflo(unsigned w) { return __uint_as_float(w << 16); }
__device__ __forceinline__ float bfhi(unsigned w) { return __uint_as_float(w & 0xffff0000u); }
__device__ __forceinline__ u32x4 pack8(const f32x4 a, const f32x4 b) { u32x4 w; w.x = cvtpk(a[0], a[1]); w.y = cvtpk(a[2], a[3]); w.z = cvtpk(b[0], b[1]); w.w = cvtpk(b[2], b[3]); return w; }
__device__ __forceinline__ float shx(float v, int o, int lane) { return __int_as_float(__builtin_amdgcn_ds_bpermute((lane ^ o) << 2, __float_as_int(v))); }
__device__ __forceinline__ float wave_sum(float v, int lane) {
#pragma unroll
    for (int o = 1; o < 64; o <<= 1) v += shx(v, o, lane);
    return v;
}
__device__ __forceinline__ float pair_sum(float v) { auto rr = __builtin_amdgcn_permlane32_swap(__float_as_uint(v), __float_as_uint(v), false, false); return __uint_as_float(rr[0]) + __uint_as_float(rr[1]); }
__device__ __forceinline__ float pair_max(float v) { auto rr = __builtin_amdgcn_permlane32_swap(__float_as_uint(v), __float_as_uint(v), false, false); return fmaxf(__uint_as_float(rr[0]), __uint_as_float(rr[1])); }
__device__ __forceinline__ float fast_sigmoid(float x) { return __builtin_amdgcn_rcpf(1.f + __builtin_amdgcn_exp2f(-LOG2E * x)); }
#define LDS_WAIT() asm volatile("s_waitcnt lgkmcnt(0)" ::: "memory")
__device__ __forceinline__ int opaque_tid(int wave) { unsigned z = 0u; asm volatile("" : "+v"(z)); return (wave << 6) | (int)__builtin_amdgcn_mbcnt_hi(~0u, __builtin_amdgcn_mbcnt_lo(~0u, z)); }

#define XB_TMO      128
#define XB_XCNT(j)  (256  + 64 * (j))
#define XB_XSUB(j)  (1280 + 64 * (j))
#define XB_XGEN(j)  (2304 + 64 * (j))
#define XB_TOP      3328
#define XB_TOPGEN   3392
#define XCD_BAR_WORDS 3456
#define XB_SPIN_CAP (1u << 22)
__device__ __forceinline__ unsigned xb_ld(unsigned* p)              { return __hip_atomic_load(p, __ATOMIC_RELAXED, __HIP_MEMORY_SCOPE_AGENT); }
__device__ __forceinline__ unsigned xb_add(unsigned* p, unsigned v) { return __hip_atomic_fetch_add(p, v, __ATOMIC_RELAXED, __HIP_MEMORY_SCOPE_AGENT); }
__device__ __forceinline__ unsigned xb_xcc_id() { return (unsigned)__builtin_amdgcn_s_getreg((3 << 11) | 20) & 0xFu; }
#define XB_SPIN(cond, bar) do { unsigned _sp = 0; while (cond) { __builtin_amdgcn_s_sleep(1); \
    if ((++_sp & 255u) == 0u) { if (xb_ld(&(bar)[XB_TMO])) break; if (_sp > XB_SPIN_CAP) { atomicAdd(&(bar)[XB_TMO], 1u); break; } } } } while (0)
struct XcdBarrier { unsigned* bar; unsigned x; volatile LAS unsigned* st; };
__device__ __forceinline__ XcdBarrier xcd_barrier_post(unsigned* bar, volatile LAS unsigned* st) {
    XcdBarrier b; b.bar = bar; b.x = xb_xcc_id(); b.st = st;
    if (threadIdx.x == 0) (void)xb_add(&bar[XB_XCNT(b.x)], 1u);
    return b;
}
__device__ __forceinline__ void xcd_barrier_complete(unsigned* bar, unsigned x, unsigned& nloc, unsigned& nx) {
    const unsigned G = gridDim.x * gridDim.y * gridDim.z;
    unsigned sum, cnt, mine, sp = 0u;
    for (;;) {
        sum = 0u; cnt = 0u; mine = 0u;
#pragma unroll
        for (unsigned j = 0; j < 16; ++j) { const unsigned c = xb_ld(&bar[XB_XCNT(j)]); sum += c; cnt += (c > 0u) ? 1u : 0u; mine = (j == x) ? c : mine; }
        if (sum == G) break;
        __builtin_amdgcn_s_sleep(1);
        if ((++sp & 255u) == 0u) { if (xb_ld(&bar[XB_TMO])) break; if (sp > XB_SPIN_CAP) { atomicAdd(&bar[XB_TMO], 1u); break; } }
    }
    nloc = mine > 0u ? mine : 1u; nx = cnt > 0u ? cnt : 1u;
}
__device__ __forceinline__ void xcd_barrier(const XcdBarrier& b) {
    asm volatile("s_waitcnt vmcnt(0)" ::: "memory");
    __syncthreads();
    if (threadIdx.x == 0) {
        unsigned* bar = b.bar;
        __builtin_amdgcn_s_waitcnt(0);
        unsigned nloc = b.st[0], nx = b.st[1];
        if (nloc == 0u) { xcd_barrier_complete(bar, b.x, nloc, nx); b.st[0] = nloc; b.st[1] = nx; }
        const unsigned old = xb_add(&bar[XB_XSUB(b.x)], 1u);
        const unsigned gen = old / nloc;
        if (old + 1u == (gen + 1u) * nloc) {
            __builtin_amdgcn_fence(__ATOMIC_RELEASE, "agent");
            asm volatile("s_waitcnt vmcnt(0)" ::: "memory");
            const unsigned og = xb_add(&bar[XB_TOP], 1u);
            const unsigned tg = og / nx;
            if (og + 1u == (tg + 1u) * nx) xb_add(&bar[XB_TOPGEN], 1u);
            else XB_SPIN(xb_ld(&bar[XB_TOPGEN]) == tg, bar);
            __builtin_amdgcn_fence(__ATOMIC_ACQUIRE, "agent");
            xb_add(&bar[XB_XGEN(b.x)], 1u);
            asm volatile("s_waitcnt vmcnt(0)" ::: "memory");
        } else {
            XB_SPIN(xb_ld(&bar[XB_XGEN(b.x)]) == gen, bar);
            __builtin_amdgcn_fence(__ATOMIC_ACQUIRE, "agent");
            asm volatile("s_waitcnt vmcnt(0)" ::: "memory");
        }
    }
    __syncthreads();
}

namespace pg8 {
constexpr int BM = 256, BK = 64, HALF = 128, HTB = HALF * BK * 2, NXCD = 8, WGM = 8;
__host__ __device__ __forceinline__ int lds_byte(int r, int c) { const int st = (r >> 4) * 2 + (c >> 5), rr = r & 15, cc = c & 31, ob = rr * 64 + cc * 2; return st * 1024 + (ob ^ (((ob >> 9) & 1) << 5)); }
__host__ __device__ __forceinline__ void stage_rc(int b, int& R, int& C) { const int st = b / 1024, sb = b % 1024, swz = sb ^ (((sb >> 9) & 1) << 5); R = (st >> 1) * 16 + swz / 64; C = (st & 1) * 32 + (swz % 64) / 2; }
__host__ __device__ __forceinline__ int perm32(int rho) { const int n = rho >> 4, i = rho & 15; return 8 * (i >> 2) + 4 * n + (i & 3); }
struct Unit { int pm, pn, kind; };
struct GridMap {
    int nM, nN, nwg;
    __device__ __forceinline__ void init(int nM_, int nN_) { nM = nM_; nN = nN_; nwg = nM_ * nN_; }
    __device__ __forceinline__ void map(int L, int& pm, int& pn) const {
        int wgid = L; { const int q = nwg / NXCD, r = nwg % NXCD, xcd = wgid % NXCD, off = wgid / NXCD; wgid = (xcd < r ? xcd * (q + 1) : r * (q + 1) + (xcd - r) * q) + off; }
        const int nig = WGM * nN, gid = wgid / nig, fm = gid * WGM, gsz = (nM - fm) < WGM ? (nM - fm) : WGM;
        pm = fm + ((wgid % nig) % gsz); pn = (wgid % nig) / gsz;
    }
};
template <bool GATHER = false, class Epi, class Sched>
__device__ __forceinline__ void gemm_phase(LAS unsigned char* lds, const int wv, const int K, const Sched& S, const Epi& E) {
    const int tid = opaque_tid(wv), wid = __builtin_amdgcn_readfirstlane(tid >> 6), lane = tid & 63, wr = wid >> 2, wc = wid & 3, fr = lane & 15, fq = lane >> 4;
    int nt = K / BK;
    unsigned voffA[2], voffB[2]; int RA[2];
#pragma unroll
    for (int i = 0; i < 2; ++i) { int R, C; stage_rc(tid * 16 + i * 8192, R, C); const int Rb = (R & ~31) + perm32(R & 31); RA[i] = R;
        voffA[i] = GATHER ? (unsigned)C * 2u : (unsigned)(R * K + C) * 2u; voffB[i] = (unsigned)(Rb * K + C) * 2u; }
    unsigned gC[2][2] = {{0u, 0u}, {0u, 0u}}, gN[2][2] = {{0u, 0u}, {0u, 0u}};
    const size_t kstep = (size_t)(BK * 2);
    const size_t hstep = (size_t)HALF * K * 2;
    const unsigned ldsw = (unsigned)wid * 1024u;
    const int aoff = lds_byte(wr * 64 + fr, fq * 8), boff = lds_byte(wc * 32 + fr, fq * 8);
#define PG8_SA(b, h) (((b) * 2 + (h)) * HTB)
#define PG8_SB(b, h) ((4 + (b) * 2 + (h)) * HTB)
#define PG8_STAGE(bufoff, gbase, voff) do { _Pragma("unroll") for (int _i = 0; _i < 2; ++_i) \
        __builtin_amdgcn_global_load_lds((const unsigned*)((const char*)(gbase) + (voff)[_i]), (LAS unsigned*)(lds + (bufoff) + ldsw + _i * 8192), 16, 0, 0); } while (0)
#define PG8_STAGE2(bufoff, gbase, o0, o1) do { \
        __builtin_amdgcn_global_load_lds((const unsigned*)((const char*)(gbase) + (o0)), (LAS unsigned*)(lds + (bufoff) + ldsw), 16, 0, 0); \
        __builtin_amdgcn_global_load_lds((const unsigned*)((const char*)(gbase) + (o1)), (LAS unsigned*)(lds + (bufoff) + ldsw + 8192), 16, 0, 0); } while (0)
#define PG8_LDA(dst, b, h) do { _Pragma("unroll") for (int m = 0; m < 4; ++m) _Pragma("unroll") for (int k = 0; k < 2; ++k) dst[m][k] = *(const LAS bf16x8*)(lds + PG8_SA(b, h) + aoff + m * 2048 + k * 1024); } while (0)
#define PG8_LDB(dst, b, h) do { _Pragma("unroll") for (int n = 0; n < 2; ++n) _Pragma("unroll") for (int k = 0; k < 2; ++k) dst[n][k] = *(const LAS bf16x8*)(lds + PG8_SB(b, h) + boff + n * 2048 + k * 1024); } while (0)
#define PG8_MMA(ai, bj, At, Bt) do { __builtin_amdgcn_s_setprio(1); _Pragma("unroll") for (int m = 0; m < 4; ++m) _Pragma("unroll") for (int n = 0; n < 2; ++n) _Pragma("unroll") for (int k = 0; k < 2; ++k) \
        acc[ai][bj][m][n] = __builtin_amdgcn_mfma_f32_16x16x32_bf16(Bt[n][k], At[m][k], acc[ai][bj][m][n], 0, 0, 0); __builtin_amdgcn_s_setprio(0); } while (0)
#define PG8_WAIT_V(n) asm volatile("s_waitcnt vmcnt(" #n ")" ::: "memory")
#define PG8_WAIT_L(n) asm volatile("s_waitcnt lgkmcnt(" #n ")" ::: "memory")
#define PG8_BAR __builtin_amdgcn_s_barrier()
#define PG8_SCHED __builtin_amdgcn_sched_barrier(0)
#define PG8_ITER(t) do { \
            const bool last = (t == nt - 2); \
            const char* a1 = cA + (size_t)(t + 1) * kstep; \
            const char* a2 = (last ? nA : cA + (size_t)(t + 2) * kstep); const char* b2 = last ? nB : cB + (size_t)(t + 2) * kstep; \
            const char* a3 = a2 + kstep; const char* b3 = b2 + kstep; \
            unsigned s00 = 0u, s01 = 0u, s10 = 0u, s11 = 0u; \
            if constexpr (GATHER) { s00 = last ? gN[0][0] : gC[0][0]; s01 = last ? gN[0][1] : gC[0][1]; s10 = last ? gN[1][0] : gC[1][0]; s11 = last ? gN[1][1] : gC[1][1]; } \
            PG8_LDB(B0, 0, 0); PG8_LDB(B1, 0, 1); PG8_SCHED; PG8_LDA(At, 0, 0); \
            if constexpr (GATHER) PG8_STAGE2(PG8_SA(1, 1), a1, gC[1][0], gC[1][1]); else PG8_STAGE(PG8_SA(1, 1), a1 + hstep, voffA); \
            PG8_WAIT_V(8); \
            PG8_WAIT_L(0); PG8_BAR; PG8_MMA(0, 0, At, B0); PG8_MMA(0, 1, At, B1); PG8_BAR; PG8_SCHED; \
            PG8_LDA(At, 0, 1); PG8_STAGE(PG8_SB(0, 0), b2, voffB); PG8_STAGE(PG8_SB(0, 1), b2 + hstep, voffB); \
            if constexpr (GATHER) PG8_STAGE2(PG8_SA(0, 0), a2, s00, s01); else PG8_STAGE(PG8_SA(0, 0), a2, voffA); \
            PG8_WAIT_V(8); \
            PG8_WAIT_L(0); PG8_BAR; PG8_MMA(1, 0, At, B0); PG8_MMA(1, 1, At, B1); PG8_BAR; PG8_SCHED; \
            PG8_LDB(B0, 1, 0); PG8_LDB(B1, 1, 1); PG8_SCHED; PG8_LDA(At, 1, 0); \
            if constexpr (GATHER) PG8_STAGE2(PG8_SA(0, 1), a2, s10, s11); else PG8_STAGE(PG8_SA(0, 1), a2 + hstep, voffA); \
            PG8_WAIT_V(8); PG8_WAIT_L(0); PG8_BAR; PG8_MMA(0, 0, At, B0); PG8_MMA(0, 1, At, B1); PG8_BAR; PG8_SCHED; \
            PG8_LDA(At, 1, 1); PG8_STAGE(PG8_SB(1, 0), b3, voffB); PG8_STAGE(PG8_SB(1, 1), b3 + hstep, voffB); \
            if constexpr (GATHER) PG8_STAGE2(PG8_SA(1, 0), a3, s00, s01); else PG8_STAGE(PG8_SA(1, 0), a3, voffA); \
            PG8_WAIT_V(8); PG8_WAIT_L(0); PG8_BAR; PG8_MMA(1, 0, At, B0); PG8_MMA(1, 1, At, B1); PG8_BAR; PG8_SCHED; \
        } while (0)
    Unit cur, nxt; int ui = 0;
    if (!S.next(0, cur)) return;
#if GEMM_STAGGER
    if (blockIdx.x & 1) { const unsigned long long t0s = __builtin_amdgcn_s_memrealtime(); const unsigned long long dl = ((unsigned long long)K * GEMM_STAGGER) >> 4;
        while (__builtin_amdgcn_s_memrealtime() - t0s < dl) __builtin_amdgcn_s_sleep(16); }
#endif
    f32x4 acc[2][2][4][2];
#pragma unroll
    for (int a = 0; a < 2; ++a)
#pragma unroll
        for (int b = 0; b < 2; ++b)
#pragma unroll
            for (int m = 0; m < 4; ++m)
#pragma unroll
                for (int n = 0; n < 2; ++n) acc[a][b][m][n] = (f32x4){0.f, 0.f, 0.f, 0.f};
    bf16x8 At[4][2], B0[2][2], B1[2][2];
    const char* cA = S.abase(cur); const char* cB = S.bbase(cur);
    if constexpr (Sched::VAR_NT) nt = S.ktiles(cur);
    if constexpr (GATHER) {
#pragma unroll
        for (int h = 0; h < 2; ++h)
#pragma unroll
            for (int i = 0; i < 2; ++i) gC[h][i] = S.grow(cur, h * HALF + RA[i]) + voffA[i];
    }
    PG8_STAGE(PG8_SB(0, 0), cB, voffB); PG8_STAGE(PG8_SB(0, 1), cB + hstep, voffB);
    if constexpr (GATHER) { PG8_STAGE2(PG8_SA(0, 0), cA, gC[0][0], gC[0][1]); PG8_STAGE2(PG8_SA(0, 1), cA, gC[1][0], gC[1][1]); }
    else { PG8_STAGE(PG8_SA(0, 0), cA, voffA); PG8_STAGE(PG8_SA(0, 1), cA + hstep, voffA); }
    if (wr == 1) PG8_BAR;
    PG8_WAIT_V(2); PG8_BAR;
    PG8_STAGE(PG8_SB(1, 0), cB + kstep, voffB);
    if constexpr (GATHER) PG8_STAGE2(PG8_SA(1, 0), cA + kstep, gC[0][0], gC[0][1]); else PG8_STAGE(PG8_SA(1, 0), cA + kstep, voffA);
    PG8_STAGE(PG8_SB(1, 1), cB + hstep + kstep, voffB);
    PG8_WAIT_V(6); PG8_BAR;
    for (;;) {
        const bool has_next = S.next(ui + 1, nxt);
        const char* nA = has_next ? S.abase(nxt) : cA; const char* nB = has_next ? S.bbase(nxt) : cB;
        if constexpr (GATHER) {
#pragma unroll
            for (int h = 0; h < 2; ++h)
#pragma unroll
                for (int i = 0; i < 2; ++i) gN[h][i] = has_next ? S.grow(nxt, h * HALF + RA[i]) + voffA[i] : gC[h][i];
        }
        for (int t = 0; t < nt; t += 2) PG8_ITER(t);
        if (PG8_ALIGN) { if (wr == 0) PG8_BAR; }
#if PROBE_MASK
        const unsigned long long _te0 = __builtin_amdgcn_s_memrealtime();
#endif
        bool keep = false;
        if constexpr (Epi::CHAINED) { if (cur.kind == 0) { E.mid(acc, cur, wr, wc, fr, fq); keep = true; } else E(acc, cur, wr, wc, fr, fq); } else E(acc, cur, wr, wc, fr, fq);
#if PROBE_MASK
        if (blockIdx.x == 0 && tid == 0) { asm volatile("s_waitcnt vmcnt(0)" ::: "memory"); volatile LAS unsigned long long* pacc = (volatile LAS unsigned long long*)(lds + LDS_CTRL + 64) + 21; *pacc = *pacc + (__builtin_amdgcn_s_memrealtime() - _te0); }
#endif
        if (!has_next) break;
        if (!keep) {
#pragma unroll
        for (int a = 0; a < 2; ++a)
#pragma unroll
            for (int b = 0; b < 2; ++b)
#pragma unroll
                for (int m = 0; m < 4; ++m)
#pragma unroll
                    for (int n = 0; n < 2; ++n) acc[a][b][m][n] = (f32x4){0.f, 0.f, 0.f, 0.f};
        }
        cur = nxt; cA = nA; cB = nB; ++ui;
        if constexpr (Sched::VAR_NT) nt = S.ktiles(cur);
        if constexpr (GATHER) { gC[0][0] = gN[0][0]; gC[0][1] = gN[0][1]; gC[1][0] = gN[1][0]; gC[1][1] = gN[1][1]; }
        if (PG8_ALIGN) { if (wr == 1) PG8_BAR; }
    }
    PG8_WAIT_V(0);
    if (!PG8_ALIGN) { if (wr == 0) PG8_BAR; }
    PG8_BAR;
#undef PG8_SA
#undef PG8_SB
#undef PG8_STAGE
#undef PG8_STAGE2
#undef PG8_ITER
#undef PG8_LDA
#undef PG8_LDB
#undef PG8_MMA
#undef PG8_WAIT_V
#undef PG8_WAIT_L
#undef PG8_BAR
#undef PG8_SCHED
}
}
using pg8::Unit;
typedef const f32x4 (&AccRef)[2][2][4][2];

struct Frame {
    LAS unsigned char* lds;
    unsigned char* ws;
    unsigned* ctl;
    const float* const* in;
    float* out;
    int tid, lane, wave, vcu, G, wave0;
};

#if ROW_NT
#define RLD(p) __builtin_nontemporal_load(p)
#define RST(p, v) __builtin_nontemporal_store((v), (p))
#else
#define RLD(p) (*(p))
#define RST(p, v) (*(p) = (v))
#endif
#ifndef EPI_NT
#define EPI_NT 0u
#endif
template <unsigned BIT, class T> __device__ __forceinline__ void epi_st(T* p, const T v) { if constexpr ((EPI_NT & BIT) != 0u) __builtin_nontemporal_store(v, p); else *p = v; }
constexpr size_t TS1024 = (size_t)256 * 1024 * 2;

struct ZSched {
    static constexpr bool VAR_NT = false;
    int G, c, last, n0, n1; const char *H, *WZ, *WV; pg8::GridMap g0, g1, g2;
    __device__ __forceinline__ void init(int G_, int c_, int last_, const void* H_, const void* WZ_, const void* WV_) {
        G = G_; c = c_; last = last_; H = (const char*)H_; WZ = (const char*)WZ_; WV = (const char*)WV_;
        if (last) { g0.init(256, 18); g1.init(32, 4); } else { g0.init(NRT, 18); g1.init(0, 4); }
        g2.init(4, NRT); n0 = g0.nwg; n1 = g1.nwg;
    }
    __device__ __forceinline__ bool next(int i, Unit& u) const {
        int L = i * G + c, a, b;
        if (L < n0) { g0.map(L, a, b); u.kind = 0; u.pm = last ? (a >> 3) * 9 + 1 + (a & 7) : a; u.pn = b; return true; }
        L -= n0;
        if (L < n1) { g1.map(L, a, b); u.kind = 0; u.pm = a * 9; u.pn = 6 + b; return true; }
        L -= n1;
        if (L < g2.nwg) { g2.map(L, a, b); u.kind = 1; u.pm = a; u.pn = b; return true; }
        return false;
    }
    __device__ __forceinline__ const char* abase(const Unit& u) const { return (u.kind ? WV : H) + (size_t)u.pm * TS1024; }
    __device__ __forceinline__ const char* bbase(const Unit& u) const { return (u.kind ? H : WZ) + (size_t)u.pn * TS1024; }
};
struct ZEpi {
    static constexpr bool CHAINED = false;
    bf16_t *U, *Q, *KB; unsigned char* G; bf16_t* VT; const float *COS, *SIN;
    __device__ __forceinline__ void operator()(AccRef acc, const Unit& u, int wr, int wc, int fr, int fq) const {
        if (u.kind == 1) {
            const int b = u.pn / 9, jt = u.pn - b * 9;
            bf16_t* base = VT + ((size_t)b * 1024 + u.pm * 256 + wr * 64 + fr) * LTOK + jt * 256 + wc * 32 + 8 * fq;
#pragma unroll
            for (int ai = 0; ai < 2; ++ai)
#pragma unroll
                for (int m = 0; m < 4; ++m) { bf16_t* rowp = base + (size_t)(ai * 128 + m * 16) * LTOK;
#pragma unroll
                    for (int bj = 0; bj < 2; ++bj) epi_st<1u>((u32x4*)(rowp + bj * 128), pack8(acc[ai][bj][m][0], acc[ai][bj][m][1])); }
            return;
        }
        const int pn = u.pn; const size_t row0 = (size_t)u.pm * 256 + wr * 64 + fr; const int cin = wc * 32 + 8 * fq;
        if (pn < 2) {
#pragma unroll
            for (int ai = 0; ai < 2; ++ai)
#pragma unroll
                for (int m = 0; m < 4; ++m) { bf16_t* rowp = U + (row0 + ai * 128 + m * 16) * 512 + pn * 256 + cin;
#pragma unroll
                    for (int bj = 0; bj < 2; ++bj) epi_st<2u>((u32x4*)(rowp + bj * 128), pack8(acc[ai][bj][m][0], acc[ai][bj][m][1])); }
        } else if (pn < 10) {
            const bool isq = pn < 6; bf16_t* dst = isq ? Q : KB; const int ct = isq ? pn - 2 : pn - 6; const float sc = isq ? QSCALE : 1.f;
            const int jt = u.pm % 9; const bool lat = jt != 0; const int axis = wc & 1;
#pragma unroll
            for (int ai = 0; ai < 2; ++ai) {
                f32x4 c4[4], s4[4];
#pragma unroll
                for (int m = 0; m < 4; ++m) { const int pos = axis ? (16 * m + fr) : (((jt - 1) * 4 + 2 * ai + wr) & 63);
                    c4[m] = *(const f32x4*)(COS + pos * 16 + 4 * fq); s4[m] = *(const f32x4*)(SIN + pos * 16 + 4 * fq);
                    if (!lat) { c4[m] = (f32x4){1.f, 1.f, 1.f, 1.f}; s4[m] = (f32x4){0.f, 0.f, 0.f, 0.f}; } }
                asm volatile("" ::: "memory");
#pragma unroll
                for (int m = 0; m < 4; ++m) {
                    bf16_t* rowp = dst + (row0 + ai * 128 + m * 16) * 1024 + ct * 256 + cin;
#pragma unroll
                    for (int bj = 0; bj < 2; ++bj) { const f32x4 a = acc[ai][bj][m][0], b = acc[ai][bj][m][1];
                        const f32x4 ra = (a * c4[m] - b * s4[m]) * sc, rb = (a * s4[m] + b * c4[m]) * sc;
                        epi_st<4u>((u32x4*)(rowp + bj * 128), pack8(ra, rb)); }
                }
                asm volatile("" ::: "memory");
            }
        } else {
            const int ct = pn - 10;
#pragma unroll
            for (int ai = 0; ai < 2; ++ai)
#pragma unroll
                for (int m = 0; m < 4; ++m) { unsigned char* rowp = G + (row0 + ai * 128 + m * 16) * 2048 + ct * 256 + cin;
#pragma unroll
                    for (int bj = 0; bj < 2; ++bj) { const f32x4 a = acc[ai][bj][m][0], b = acc[ai][bj][m][1]; u32x2 o; o.x = 0u; o.y = 0u;
#pragma unroll
                        for (int j = 0; j < 4; ++j) { o.x = __builtin_amdgcn_cvt_pk_u8_f32(__builtin_rintf(fast_sigmoid(a[j]) * 255.f), j, o.x); o.y = __builtin_amdgcn_cvt_pk_u8_f32(__builtin_rintf(fast_sigmoid(b[j]) * 255.f), j, o.y); }
                        epi_st<8u>((u32x2*)(rowp + bj * 128), o); } }
        }
    }
};

struct PlainSched {
    static constexpr bool VAR_NT = false;
    int G, c, latonly, rev; const char *A, *B; size_t ats, bts; pg8::GridMap g;
    __device__ __forceinline__ void init(int G_, int c_, int latonly_, int nN, const void* A_, const void* B_, int K, int rev_ = 0) {
        G = G_; c = c_; latonly = latonly_; rev = rev_; A = (const char*)A_; B = (const char*)B_; ats = bts = (size_t)256 * K * 2; g.init(latonly_ ? 256 : NRT, nN);
    }
    __device__ __forceinline__ bool next(int i, Unit& u) const {
        int L = i * G + c; if (L >= g.nwg) return false; if (rev) L = g.nwg - 1 - L; int a, b; g.map(L, a, b);
        u.kind = 0; u.pm = latonly ? (a >> 3) * 9 + 1 + (a & 7) : a; u.pn = b; return true;
    }
    __device__ __forceinline__ const char* abase(const Unit& u) const { return A + (size_t)u.pm * ats; }
    __device__ __forceinline__ const char* bbase(const Unit& u) const { return B + (size_t)u.pn * bts; }
};
struct MergeSched {
    static constexpr bool VAR_NT = true;
    int G, c, latonly; const char *A, *B; pg8::GridMap g;
    __device__ __forceinline__ void init(int G_, int c_, int latonly_, const void* A_, const void* B_) { G = G_; c = c_; latonly = latonly_; A = (const char*)A_; B = (const char*)B_; g.init(latonly_ ? 256 : NRT, 4); }
    __device__ __forceinline__ bool next(int i, Unit& u) const {
        const int L = (i >> 1) * G + c; if (L >= g.nwg) return false; int a, b; g.map(L, a, b);
        u.kind = i & 1; u.pm = latonly ? (a >> 3) * 9 + 1 + (a & 7) : a; u.pn = b; return true;
    }
    __device__ __forceinline__ int ktiles(const Unit& u) const { return u.kind ? 16 : 8; }
    __device__ __forceinline__ const char* abase(const Unit& u) const { return A + (size_t)u.pm * ((size_t)256 * MAP * 2) + (u.kind ? 1024 : 0); }
    __device__ __forceinline__ const char* bbase(const Unit& u) const { return B + (size_t)u.pn * ((size_t)256 * MAP * 2) + (u.kind ? 1024 : 0); }
};
__device__ __forceinline__ void unpack8(const u32x4 w, f32x4& a, f32x4& b) { a = (f32x4){bflo(w.x), bfhi(w.x), bflo(w.y), bfhi(w.y)}; b = (f32x4){bflo(w.z), bfhi(w.z), bflo(w.w), bfhi(w.w)}; }
__device__ __forceinline__ f32x4 ub4(unsigned w) { return (f32x4){(float)(w & 255u), (float)((w >> 8) & 255u), (float)((w >> 16) & 255u), (float)(w >> 24)}; }
struct MergeEpi {
    static constexpr bool CHAINED = true;
    bf16_t* O; const unsigned char* Gt;
    __device__ __forceinline__ void mid(f32x4 (&acc)[2][2][4][2], const Unit& u, int wr, int wc, int fr, int fq) const {
        const unsigned loff = (unsigned)((wr * 64 + fr) * 2048 + wc * 32 + 8 * fq);
#pragma unroll
        for (int ai = 0; ai < 2; ++ai) {
            u32x2 wp[4][2], wa[4][2];
#pragma unroll
            for (int m = 0; m < 4; ++m) { const unsigned char* gp = Gt + (size_t)(u.pm * 256 + ai * 128 + m * 16) * 2048 + u.pn * 256;
#pragma unroll
                for (int bj = 0; bj < 2; ++bj) { wp[m][bj] = *(const u32x2*)(gp + loff + bj * 128); wa[m][bj] = *(const u32x2*)(gp + loff + 1024 + bj * 128); } }
#pragma unroll
            for (int m = 0; m < 4; ++m)
#pragma unroll
                for (int bj = 0; bj < 2; ++bj) { const f32x4 p0 = ub4(wp[m][bj].x), p1 = ub4(wp[m][bj].y), a0 = ub4(wa[m][bj].x), a1 = ub4(wa[m][bj].y);
#pragma unroll
                    for (int j = 0; j < 4; ++j) { acc[ai][bj][m][0][j] *= p0[j] * __builtin_amdgcn_rcpf(fmaxf(a0[j], 1e-9f)); acc[ai][bj][m][1][j] *= p1[j] * __builtin_amdgcn_rcpf(fmaxf(a1[j], 1e-9f)); } }
        }
    }
    __device__ __forceinline__ void operator()(AccRef acc, const Unit& u, int wr, int wc, int fr, int fq) const {
        const unsigned cpart = (unsigned)(wc * 32 + 8 * fq), rpart = (unsigned)((wr * 64 + fr) * 2048);
        const unsigned loffg = rpart + cpart, loffy = rpart + 2u * cpart;
        u32x2 wa[2][4][2];
#pragma unroll
        for (int ai = 0; ai < 2; ++ai)
#pragma unroll
            for (int m = 0; m < 4; ++m) { const unsigned char* gp = Gt + (size_t)(u.pm * 256 + ai * 128 + m * 16) * 2048 + 1024 + u.pn * 256;
#pragma unroll
                for (int bj = 0; bj < 2; ++bj) wa[ai][m][bj] = *(const u32x2*)(gp + loffg + bj * 128); }
        asm volatile("" ::: "memory");
#pragma unroll
        for (int ai = 0; ai < 2; ++ai)
#pragma unroll
            for (int m = 0; m < 4; ++m) { char* op = (char*)(O + (size_t)(u.pm * 256 + ai * 128 + m * 16) * 1024 + u.pn * 256);
#pragma unroll
                for (int bj = 0; bj < 2; ++bj) { f32x4 a0 = ub4(wa[ai][m][bj].x), a1 = ub4(wa[ai][m][bj].y);
#pragma unroll
                    for (int j = 0; j < 4; ++j) { a0[j] = fmaxf(a0[j], 1e-9f) * (1.f / 255.f); a1[j] = fmaxf(a1[j], 1e-9f) * (1.f / 255.f); }
                    epi_st<16u>((u32x4*)(op + loffy + bj * 256), pack8(a0 * acc[ai][bj][m][0], a1 * acc[ai][bj][m][1])); } }
    }
};
struct ResEpi {
    static constexpr bool CHAINED = false;
    const float *latsrc, *ctxsrc; float *latdst, *ctxdst; const float* mod; int goff;
    __device__ __forceinline__ void operator()(AccRef acc, const Unit& u, int wr, int wc, int fr, int fq) const {
        const int b = u.pm / 9, jt = u.pm - b * 9;
        const size_t rb = jt ? ((size_t)b * SEQ + (jt - 1) * 256) : (size_t)b * CTXL;
        const float* src = (jt ? latsrc : ctxsrc) + (rb + wr * 64 + fr) * D; float* dst = (jt ? latdst : ctxdst) + (rb + wr * 64 + fr) * D;
        const float* gate = mod + (size_t)(jt ? b : 32) * MODW + goff;
        const int col0 = u.pn * 256 + wc * 32 + 8 * fq;
        f32x4 gv[2][2];
#pragma unroll
        for (int bj = 0; bj < 2; ++bj)
#pragma unroll
            for (int n = 0; n < 2; ++n) gv[bj][n] = *(const f32x4*)(gate + col0 + bj * 128 + 4 * n);
#pragma unroll
        for (int ai = 0; ai < 2; ++ai) {
            f32x4 x[4][2][2];
#pragma unroll
            for (int m = 0; m < 4; ++m)
#pragma unroll
                for (int bj = 0; bj < 2; ++bj)
#pragma unroll
                    for (int n = 0; n < 2; ++n) x[m][bj][n] = *(const f32x4*)(src + (size_t)(ai * 128 + m * 16) * D + col0 + bj * 128 + 4 * n);
            asm volatile("" ::: "memory");
#pragma unroll
            for (int m = 0; m < 4; ++m)
#pragma unroll
                for (int bj = 0; bj < 2; ++bj)
#pragma unroll
                    for (int n = 0; n < 2; ++n) epi_st<32u>((f32x4*)(dst + (size_t)(ai * 128 + m * 16) * D + col0 + bj * 128 + 4 * n), x[m][bj][n] + gv[bj][n] * acc[ai][bj][m][n]);
            asm volatile("" ::: "memory");
        }
    }
};
struct OEpi {
    static constexpr bool CHAINED = false;
    bf16_t* O; const float* mod; int goff;
    __device__ __forceinline__ void operator()(AccRef acc, const Unit& u, int wr, int wc, int fr, int fq) const {
        const int b = u.pm / 9, jt = u.pm - b * 9;
        const float* gate = mod + (size_t)(jt ? b : 32) * MODW + goff;
        const int col0 = u.pn * 256 + wc * 32 + 8 * fq;
        f32x4 gv[2][2];
#pragma unroll
        for (int bj = 0; bj < 2; ++bj)
#pragma unroll
            for (int n = 0; n < 2; ++n) gv[bj][n] = *(const f32x4*)(gate + col0 + bj * 128 + 4 * n);
        asm volatile("" ::: "memory");
        bf16_t* base = O + ((size_t)u.pm * 256 + wr * 64 + fr) * D + col0;
#pragma unroll
        for (int ai = 0; ai < 2; ++ai)
#pragma unroll
            for (int m = 0; m < 4; ++m)
#pragma unroll
                for (int bj = 0; bj < 2; ++bj) epi_st<32u>((u32x4*)(base + (size_t)(ai * 128 + m * 16) * D + bj * 128), pack8(gv[bj][0] * acc[ai][bj][m][0], gv[bj][1] * acc[ai][bj][m][1]));
    }
};
struct UpEpi {
    static constexpr bool CHAINED = false;
    bf16_t* O; int ld;
    __device__ __forceinline__ void operator()(AccRef acc, const Unit& u, int wr, int wc, int fr, int fq) const {
        const size_t row0 = (size_t)u.pm * 256 + wr * 64 + fr; const int col0 = u.pn * 128 + wc * 32 + 8 * fq;
#pragma unroll
        for (int ai = 0; ai < 2; ++ai)
#pragma unroll
            for (int m = 0; m < 4; ++m) { f32x4 v[2];
#pragma unroll
                for (int n = 0; n < 2; ++n) { const f32x4 g = acc[ai][0][m][n], w = acc[ai][1][m][n];
#pragma unroll
                    for (int j = 0; j < 4; ++j) v[n][j] = g[j] * fast_sigmoid(g[j]) * w[j]; }
                epi_st<64u>((u32x4*)(O + (row0 + ai * 128 + m * 16) * ld + col0), pack8(v[0], v[1])); }
    }
};
struct MoeInfo {
    int cnt[NE], tb[NE + 1];
    __device__ __forceinline__ void load(const unsigned* cw) {
        int t = 0;
#pragma unroll
        for (int e = 0; e < NE; ++e) { const int c = __builtin_amdgcn_readfirstlane((int)__hip_atomic_load(cw + CW_CNT + 64 * e, __ATOMIC_RELAXED, __HIP_MEMORY_SCOPE_AGENT)); cnt[e] = c; tb[e] = t; t += (c + 255) >> 8; }
        tb[NE] = t;
    }
    __device__ __forceinline__ void lookup(int rt, int& e, int& t0, int& ce) const { e = 0; t0 = 0; ce = cnt[0];
#pragma unroll
        for (int k = 1; k < NE; ++k) { const bool ge = rt >= tb[k]; e = ge ? k : e; t0 = ge ? tb[k] : t0; ce = ge ? cnt[k] : ce; } }
};
struct MoeSched {
    static constexpr bool VAR_NT = false;
    int G, c, nN, gather, rev; const char *A, *B; const unsigned* LIST; size_t ats, bts, bes; MoeInfo mi; pg8::GridMap g;
    __device__ __forceinline__ void init(int G_, int c_, int nN_, const void* A_, const void* B_, int K, int Nrows, const MoeInfo& mi_) {
        G = G_; c = c_; nN = nN_; gather = 0; rev = 0; LIST = nullptr; A = (const char*)A_; B = (const char*)B_; ats = bts = (size_t)256 * K * 2; bes = (size_t)Nrows * K * 2; mi = mi_; g.init(mi_.tb[NE], nN_);
    }
    __device__ __forceinline__ bool next(int i, Unit& u) const {
        int L = i * G + c; if (L >= g.nwg) return false; if (rev) L = g.nwg - 1 - L; int a, b; g.map(L, a, b); u.pm = a; u.pn = b; int t0, ce; mi.lookup(a, u.kind, t0, ce); return true;
    }
    __device__ __forceinline__ const char* abase(const Unit& u) const { return gather ? A : A + (size_t)u.pm * ats; }
    __device__ __forceinline__ const char* bbase(const Unit& u) const { return B + (size_t)u.kind * bes + (size_t)u.pn * bts; }
    __device__ __forceinline__ unsigned grow(const Unit& u, int row) const { int e, t0, ce; mi.lookup(u.pm, e, t0, ce); const int slot = (u.pm - t0) * 256 + row;
        unsigned tok = 0u; if (slot < ce) tok = LIST[(size_t)e * NLAT + slot] >> 1;
        return ((tok >> 11) * (unsigned)LTOK + (unsigned)CTXL + (tok & 2047u)) * (unsigned)(D * 2); }
};
struct MoeDownEpi {
    static constexpr bool CHAINED = false;
    bf16_t* YM; const unsigned* LIST; const float* WTS; MoeInfo mi;
    __device__ __forceinline__ void operator()(AccRef acc, const Unit& u, int wr, int wc, int fr, int fq) const {
        int e, t0, ce; mi.lookup(u.pm, e, t0, ce); const int slot0 = (u.pm - t0) * 256 + wr * 64 + fr;
        const int col0 = u.pn * 256 + wc * 32 + 8 * fq;
        unsigned ent[2][4]; float wt[2][4];
#pragma unroll
        for (int ai = 0; ai < 2; ++ai)
#pragma unroll
            for (int m = 0; m < 4; ++m) { const int slot = slot0 + ai * 128 + m * 16; ent[ai][m] = slot < ce ? LIST[(size_t)e * NLAT + slot] : 0xffffffffu; }
#pragma unroll
        for (int ai = 0; ai < 2; ++ai)
#pragma unroll
            for (int m = 0; m < 4; ++m) wt[ai][m] = ent[ai][m] != 0xffffffffu ? WTS[ent[ai][m]] : 0.f;
        asm volatile("" ::: "memory");
#pragma unroll
        for (int ai = 0; ai < 2; ++ai)
#pragma unroll
            for (int m = 0; m < 4; ++m) {
                if (ent[ai][m] != 0xffffffffu) { const unsigned en = ent[ai][m]; const float w8 = wt[ai][m];
                    bf16_t* rowp = YM + ((size_t)(en & 1u) * NLAT + (en >> 1)) * D + col0;
#pragma unroll
                    for (int bj = 0; bj < 2; ++bj) epi_st<128u>((u32x4*)(rowp + bj * 128), pack8(acc[ai][bj][m][0] * w8, acc[ai][bj][m][1] * w8)); } }
    }
};

namespace att {
constexpr int BUFB = 32768, EXCH = 65536;
constexpr float THR = 6.f;
#define ATT_SBAR() __builtin_amdgcn_sched_barrier(0)
#define ATT_MFMA(a, b, c) __builtin_amdgcn_mfma_f32_32x32x16_bf16(a, b, c, 0, 0, 0)
#define ATT_SYNC() asm volatile("s_waitcnt vmcnt(0) lgkmcnt(0)\n\ts_barrier" ::: "memory")
__device__ __forceinline__ void attn_unit(LAS unsigned char* lds, const bf16_t* Q, const bf16_t* K, const bf16_t* VT, bf16_t* AY, int b, int h, size_t qrow0, int nkt, float lam, float osc, const float* subg,
                                          bf16x8 (&qf)[4], bool first, bool has_next, int nb, int nh, size_t nqrow0, int wv) {
    const int tid = opaque_tid(wv), lane = tid & 63, ql = lane & 31, hh = lane >> 5; const int w = __builtin_amdgcn_readfirstlane(tid >> 6); const int map = w >> 2, qb = w & 3;
    const size_t qrow = qrow0 + 32 * qb + ql;
    if (ATT_PRIO && w >= 4) __builtin_amdgcn_s_setprio(1);
#if PROBE_MASK
    unsigned long long att_wait = 0, att_b = 0, att_a = 0;
#endif
    if (first) {
#pragma unroll
        for (int ks = 0; ks < 4; ++ks) qf[ks] = *(const bf16x8*)(Q + qrow * 1024 + (h * 2 + map) * 64 + 16 * ks + 8 * hh);
    }
    const int prow = lane >> 3, pc = lane & 7;
    const int krow = 8 * w + prow, kc = pc ^ ((krow >> 1) & 7);
    const bf16_t* ksrc0 = K + ((size_t)b * LTOK + krow) * 1024 + (h * 2) * 64 + kc * 8;
    const bf16_t* ksrc1 = ksrc0 + 64;
    const int e0 = 16 * w + prow, e1 = e0 + 8;
    const bf16_t* vsrc0 = VT + ((size_t)b * 1024 + h * 128 + e0) * LTOK + (pc ^ ((e0 >> 1) & 7)) * 8;
    const bf16_t* vsrc1 = VT + ((size_t)b * 1024 + h * 128 + e1) * LTOK + (pc ^ ((e1 >> 1) & 7)) * 8;
#define ATT_DMA_K(t, BO) do { \
        __builtin_amdgcn_global_load_lds((const unsigned*)(ksrc0 + (size_t)(t) * 64 * 1024), (LAS unsigned*)(lds + (BO) + w * 1024), 16, 0, 0); \
        __builtin_amdgcn_global_load_lds((const unsigned*)(ksrc1 + (size_t)(t) * 64 * 1024), (LAS unsigned*)(lds + (BO) + 8192 + w * 1024), 16, 0, 0); } while (0)
#define ATT_DMA_V(t, BO) do { \
        __builtin_amdgcn_global_load_lds((const unsigned*)(vsrc0 + (size_t)(t) * 64), (LAS unsigned*)(lds + (BO) + 16384 + w * 2048), 16, 0, 0); \
        __builtin_amdgcn_global_load_lds((const unsigned*)(vsrc1 + (size_t)(t) * 64), (LAS unsigned*)(lds + (BO) + 16384 + w * 2048 + 1024), 16, 0, 0); } while (0)
    const int rp = (ql & ~12) | ((ql & 4) << 1) | ((ql & 8) >> 1);
    const int xk = (rp >> 1) & 7, xv = (ql >> 1) & 7;
    const LAS unsigned char* kbase = lds + map * 8192 + rp * 128;
    const LAS unsigned char* vbase = lds + 16384 + ql * 128;
    const unsigned kaddr0 = (unsigned)(uintptr_t)kbase, vaddr0 = (unsigned)(uintptr_t)vbase;
    int kof[4], vof[4];
#pragma unroll
    for (int i = 0; i < 4; ++i) { kof[i] = ((2 * i + hh) ^ xk) << 4; vof[i] = ((2 * i + hh) ^ xv) << 4; }
#define ATT_KRD(i, RB) (*(const LAS bf16x8*)(kbase + (RB) + ((i) >> 2) * 4096 + kof[(i) & 3]))
#define ATT_VRD(g, RB) (*(const LAS bf16x8*)(vbase + (RB) + ((g) >> 2) * 4096 + vof[(g) & 3]))
    const f32x16 Z16 = (f32x16){0.f, 0.f, 0.f, 0.f, 0.f, 0.f, 0.f, 0.f, 0.f, 0.f, 0.f, 0.f, 0.f, 0.f, 0.f, 0.f};
    f32x16 O[4];
#pragma unroll
    for (int i = 0; i < 4; ++i) O[i] = Z16;
    f32x16 negm = Z16, S0, S1;
    float lrun = 0.f, ral = 1.f; bool resc = false;
    bf16x8 kf[8]; u32x4 pA[4], pB[4];
#define ATT_QK() do { \
        S0 = ATT_MFMA(kf[0], qf[0], negm); S1 = ATT_MFMA(kf[4], qf[0], negm); \
        S0 = ATT_MFMA(kf[1], qf[1], S0);   S1 = ATT_MFMA(kf[5], qf[1], S1); \
        S0 = ATT_MFMA(kf[2], qf[2], S0);   S1 = ATT_MFMA(kf[6], qf[2], S1); \
        S0 = ATT_MFMA(kf[3], qf[3], S0);   S1 = ATT_MFMA(kf[7], qf[3], S1); } while (0)
#define ATT_ROWMAX(mx) do { float _a = fmaxf(S0[0], S1[0]), _b = fmaxf(S0[1], S1[1]); \
        _Pragma("unroll") for (int r = 2; r < 16; r += 2) { _a = fmaxf(_a, fmaxf(S0[r], S1[r])); _b = fmaxf(_b, fmaxf(S0[r + 1], S1[r + 1])); } \
        mx = pair_max(fmaxf(_a, _b)); } while (0)
#define ATT_IMAX3(a, b, c) max(max((a), (b)), (c))
#define ATT_SI(i) __float_as_int(ATT_SV(i))
#define ATT_ROWMAXI(mx) do { int _a = ATT_IMAX3(ATT_SI(0), ATT_SI(1), ATT_SI(2)), _b = ATT_IMAX3(ATT_SI(3), ATT_SI(4), ATT_SI(5)); \
        _a = ATT_IMAX3(_a, ATT_SI(6), ATT_SI(7)); _b = ATT_IMAX3(_b, ATT_SI(8), ATT_SI(9)); _a = ATT_IMAX3(_a, ATT_SI(10), ATT_SI(11)); _b = ATT_IMAX3(_b, ATT_SI(12), ATT_SI(13)); \
        _a = ATT_IMAX3(_a, ATT_SI(14), ATT_SI(15)); _b = ATT_IMAX3(_b, ATT_SI(16), ATT_SI(17)); _a = ATT_IMAX3(_a, ATT_SI(18), ATT_SI(19)); _b = ATT_IMAX3(_b, ATT_SI(20), ATT_SI(21)); \
        _a = ATT_IMAX3(_a, ATT_SI(22), ATT_SI(23)); _b = ATT_IMAX3(_b, ATT_SI(24), ATT_SI(25)); _a = ATT_IMAX3(_a, ATT_SI(26), ATT_SI(27)); _b = ATT_IMAX3(_b, ATT_SI(28), ATT_SI(29)); \
        _a = ATT_IMAX3(_a, ATT_SI(30), ATT_SI(31)); _a = max(_a, _b); \
        auto _rr = __builtin_amdgcn_permlane32_swap((unsigned)_a, (unsigned)_a, false, false); mx = __int_as_float(max((int)_rr[0], (int)_rr[1])); } while (0)
#define ATT_DECIDE() do { float mx; ATT_ROWMAXI(mx); \
        if (__any(mx > THR)) { const float dl = fmaxf(mx, 0.f); \
            _Pragma("unroll") for (int r = 0; r < 16; ++r) { S0[r] -= dl; S1[r] -= dl; negm[r] -= dl; } \
            ral = __builtin_amdgcn_exp2f(-dl); lrun *= ral; resc = true; } } while (0)
#define ATT_SV(i) ((i) < 16 ? S0[(i) & 15] : S1[(i) & 15])
#define ATT_EXP2(g, PN) do { const float _e0 = __builtin_amdgcn_exp2f(ATT_SV(2 * (g))), _e1 = __builtin_amdgcn_exp2f(ATT_SV(2 * (g) + 1)); ls += _e0; ls += _e1; unsigned _w = cvtpk(_e0, _e1); asm volatile("" : "+v"(_w), "+v"(ls)); PN[(g) >> 2][(g) & 3] = _w; } while (0)
#define ATT_DSRD(dst, addr, off) asm volatile("ds_read_b128 %0, %1 offset:%2" : "=v"(dst) : "v"(addr), "i"(off))
#define ATT_NW(g, DOK) ((DOK) ? ((g) <= 8 ? 2 : (g) == 9 ? 3 : (g) == 10 ? 4 : (g) <= 13 ? 5 : (g) == 14 ? 4 : 3) : ((g) <= 13 ? 2 : (g) == 14 ? 1 : 0))
#define ATT_GAPB(g, VC, VL, PP, PN, DOK) do { \
        asm volatile("s_waitcnt lgkmcnt(%1)" : "+v"(VC) : "i"(ATT_NW(g, DOK))); \
        O[(g) >> 2] = ATT_MFMA(VC, __builtin_bit_cast(bf16x8, PP[(g) & 3]), O[(g) >> 2]); \
        if ((g) + 3 < 16) ATT_DSRD(VL, va[((g) + 3) & 3], (((g) + 3) >> 2) * 4096); \
        if ((DOK) && (g) >= 8) ATT_DSRD(kf[(g) - 8], ka[((g) - 8) & 3], (((g) - 8) >> 2) * 4096); \
        ATT_EXP2(g, PN); ATT_SBAR(); } while (0)
#define ATT_PHASEB(RBK, RB, PP, PN, DOK) do { float ls = 0.f; unsigned va[4], ka[4]; \
        _Pragma("unroll") for (int _c = 0; _c < 4; ++_c) { va[_c] = vaddr0 + (unsigned)(RB) + (unsigned)vof[_c]; ka[_c] = kaddr0 + (unsigned)(RBK) + (unsigned)kof[_c]; } \
        bf16x8 v0, v1, v2, v3; ATT_DSRD(v0, va[0], 0); ATT_DSRD(v1, va[1], 0); ATT_DSRD(v2, va[2], 0); ATT_SBAR(); \
        ATT_GAPB(0, v0, v3, PP, PN, DOK); ATT_GAPB(1, v1, v0, PP, PN, DOK); ATT_GAPB(2, v2, v1, PP, PN, DOK); ATT_GAPB(3, v3, v2, PP, PN, DOK); \
        ATT_GAPB(4, v0, v3, PP, PN, DOK); ATT_GAPB(5, v1, v0, PP, PN, DOK); ATT_GAPB(6, v2, v1, PP, PN, DOK); ATT_GAPB(7, v3, v2, PP, PN, DOK); \
        ATT_GAPB(8, v0, v3, PP, PN, DOK); ATT_GAPB(9, v1, v0, PP, PN, DOK); ATT_GAPB(10, v2, v1, PP, PN, DOK); ATT_GAPB(11, v3, v2, PP, PN, DOK); \
        ATT_GAPB(12, v0, v3, PP, PN, DOK); ATT_GAPB(13, v1, v0, PP, PN, DOK); ATT_GAPB(14, v2, v1, PP, PN, DOK); ATT_GAPB(15, v3, v2, PP, PN, DOK); \
        if (DOK) { asm volatile("s_waitcnt lgkmcnt(0)" : "+v"(kf[0]), "+v"(kf[1]), "+v"(kf[2]), "+v"(kf[3]), "+v"(kf[4]), "+v"(kf[5]), "+v"(kf[6]), "+v"(kf[7])); ATT_SBAR(); } \
        lrun += ls; } while (0)
#define ATT_RESC() do { if (resc) { _Pragma("unroll") for (int i = 0; i < 4; ++i) _Pragma("unroll") for (int r = 0; r < 16; ++r) O[i][r] *= ral; resc = false; } } while (0)
#define ATT_BUF(j) (((j) & 3) * BUFB)
#if PROBE_MASK
#define ATT_TB0() const unsigned long long _tb0 = __builtin_amdgcn_s_memrealtime(); asm volatile("s_waitcnt lgkmcnt(0)" ::: "memory")
#define ATT_TB1() const unsigned long long _tb1 = __builtin_amdgcn_s_memrealtime(); att_b += _tb1 - _tb0
#define ATT_TB2() asm volatile("" : "+v"(S0), "+v"(S1)); att_a += __builtin_amdgcn_s_memrealtime() - _tb1
#else
#define ATT_TB0() do {} while (0)
#define ATT_TB1() do {} while (0)
#define ATT_TB2() do {} while (0)
#endif
#if PROBE_MASK
#define ATT_SYNCN(N) do { const unsigned long long _t0 = __builtin_amdgcn_s_memrealtime(); asm volatile("s_waitcnt vmcnt(" #N ") lgkmcnt(0)\n\ts_barrier" ::: "memory"); att_wait += __builtin_amdgcn_s_memrealtime() - _t0; } while (0)
#else
#define ATT_SYNCN(N) asm volatile("s_waitcnt vmcnt(" #N ") lgkmcnt(0)\n\ts_barrier" ::: "memory")
#endif
#define ATT_STEP(t, PP, PN) do { \
        ATT_TB0(); { const int rbk = ATT_BUF((t) + 1), rbv = ATT_BUF((t) - 1); ATT_PHASEB(rbk, rbv, PP, PN, true); } ATT_RESC(); ATT_TB1(); ATT_QK(); ATT_DECIDE(); ATT_TB2(); } while (0)

    if (first) { ATT_DMA_K(0, 0); ATT_DMA_K(1, BUFB); ATT_DMA_V(0, 0); ATT_DMA_V(1, BUFB); }
    ATT_DMA_K(2, 2 * BUFB); ATT_DMA_K(3, 3 * BUFB);
    ATT_SYNCN(4);
#pragma unroll
    for (int i = 0; i < 8; ++i) kf[i] = ATT_KRD(i, 0);
    ATT_QK();
    { float mx; ATT_ROWMAX(mx);
#pragma unroll
      for (int r = 0; r < 16; ++r) { S0[r] -= mx; S1[r] -= mx; negm[r] = -mx; } }
    { float ls = 0.f;
#pragma unroll
      for (int i = 0; i < 8; ++i) kf[i] = ATT_KRD(i, BUFB);
#define ATT_E0(g) ATT_EXP2(g, pA)
      ATT_E0(0); ATT_E0(1); ATT_E0(2); ATT_E0(3); ATT_E0(4); ATT_E0(5); ATT_E0(6); ATT_E0(7); ATT_E0(8); ATT_E0(9); ATT_E0(10); ATT_E0(11); ATT_E0(12); ATT_E0(13); ATT_E0(14); ATT_E0(15);
#undef ATT_E0
      lrun += ls; }
    ATT_QK(); ATT_DECIDE();
    for (int t = 1; t < nkt - 1; t += 2) {
        ATT_SYNCN(0);
        if (t + 3 < nkt) ATT_DMA_K(t + 3, ATT_BUF(t + 3));
        ATT_DMA_V(t + 1, ATT_BUF(t + 1));
        if (t + 4 < nkt) ATT_DMA_K(t + 4, ATT_BUF(t));
        ATT_DMA_V(t + 2, ATT_BUF(t + 2));
        ATT_STEP(t, pA, pB);
        ATT_STEP(t + 1, pB, pA);
    }
    ATT_SYNCN(0);
    if (has_next) {
        const size_t nqrow = nqrow0 + 32 * qb + ql;
#pragma unroll
        for (int ks = 0; ks < 4; ++ks) qf[ks] = *(const bf16x8*)(Q + nqrow * 1024 + (nh * 2 + map) * 64 + 16 * ks + 8 * hh);
        const bf16_t* nk0 = K + ((size_t)nb * LTOK + krow) * 1024 + (nh * 2) * 64 + kc * 8;
        const bf16_t* nv0 = VT + ((size_t)nb * 1024 + nh * 128 + e0) * LTOK + (pc ^ ((e0 >> 1) & 7)) * 8;
        const bf16_t* nv1 = VT + ((size_t)nb * 1024 + nh * 128 + e1) * LTOK + (pc ^ ((e1 >> 1) & 7)) * 8;
#pragma unroll
        for (int j = 0; j < 2; ++j) {
            __builtin_amdgcn_global_load_lds((const unsigned*)(nk0 + (size_t)j * 64 * 1024), (LAS unsigned*)(lds + j * BUFB + w * 1024), 16, 0, 0);
            __builtin_amdgcn_global_load_lds((const unsigned*)(nk0 + 64 + (size_t)j * 64 * 1024), (LAS unsigned*)(lds + j * BUFB + 8192 + w * 1024), 16, 0, 0);
            __builtin_amdgcn_global_load_lds((const unsigned*)(nv0 + (size_t)j * 64), (LAS unsigned*)(lds + j * BUFB + 16384 + w * 2048), 16, 0, 0);
            __builtin_amdgcn_global_load_lds((const unsigned*)(nv1 + (size_t)j * 64), (LAS unsigned*)(lds + j * BUFB + 16384 + w * 2048 + 1024), 16, 0, 0); }
    }
    { const int rbv = ATT_BUF(nkt - 2); ATT_PHASEB(0, rbv, pA, pB, false); } ATT_RESC();
    { const int rbv = ATT_BUF(nkt - 1); bf16x8 v0 = ATT_VRD(0, rbv), v1 = ATT_VRD(1, rbv), v2;
#define ATT_GF(g, VC, VL) do { O[(g) >> 2] = ATT_MFMA(VC, __builtin_bit_cast(bf16x8, pB[(g) & 3]), O[(g) >> 2]); if ((g) + 2 < 16) VL = ATT_VRD((g) + 2, rbv); } while (0)
      ATT_GF(0, v0, v2); ATT_GF(1, v1, v0); ATT_GF(2, v2, v1); ATT_GF(3, v0, v2); ATT_GF(4, v1, v0); ATT_GF(5, v2, v1); ATT_GF(6, v0, v2); ATT_GF(7, v1, v0);
      ATT_GF(8, v2, v1); ATT_GF(9, v0, v2); ATT_GF(10, v1, v0); ATT_GF(11, v2, v1); ATT_GF(12, v0, v2); ATT_GF(13, v1, v0); ATT_GF(14, v2, v1); ATT_GF(15, v0, v2);
#undef ATT_GF
    }
    asm volatile("s_waitcnt lgkmcnt(0)\n\ts_barrier" ::: "memory");
    const float inv = 1.f / pair_sum(lrun);
    f32x4 sgv[4][4];
    if (map == 0) {
#pragma unroll
        for (int i = 0; i < 4; ++i)
#pragma unroll
            for (int g = 0; g < 4; ++g) sgv[i][g] = *(const f32x4*)(subg + 32 * i + 8 * g + 4 * hh);
    }
    LAS float* ex = (LAS float*)(lds + EXCH) + (size_t)qb * 4096 + lane;
    if (map == 1) {
#pragma unroll
        for (int i = 0; i < 4; ++i)
#pragma unroll
            for (int r = 0; r < 16; ++r) ex[(i * 16 + r) * 64] = O[i][r] * inv;
    }
    asm volatile("s_waitcnt lgkmcnt(0)\n\ts_barrier" ::: "memory");
    if (map == 0) {
        float ss = 0.f;
#pragma unroll
        for (int i = 0; i < 4; ++i)
#pragma unroll
            for (int r = 0; r < 16; ++r) { const float y = O[i][r] * inv - lam * ex[(i * 16 + r) * 64]; O[i][r] = y; ss += y * y; }
        ss = pair_sum(ss);
        const float rs = rsqrtf(ss * (1.f / VD) + EPS) * osc;
        bf16_t* orow = AY + qrow * MAP + 512 + h * 128;
#pragma unroll
        for (int i = 0; i < 4; ++i)
#pragma unroll
            for (int g = 0; g < 4; ++g) { const int e = 32 * i + 8 * g + 4 * hh; const f32x4 gv = sgv[i][g];
                u32x2 o; o.x = cvtpk(O[i][4 * g] * rs * gv[0], O[i][4 * g + 1] * rs * gv[1]); o.y = cvtpk(O[i][4 * g + 2] * rs * gv[2], O[i][4 * g + 3] * rs * gv[3]);
                *(u32x2*)(orow + e) = o; }
    }
    asm volatile("s_waitcnt lgkmcnt(0)\n\ts_barrier" ::: "memory");
    if (ATT_PRIO && w >= 4) __builtin_amdgcn_s_setprio(0);
#if PROBE_MASK
    if (blockIdx.x == 0 && tid == 0) { volatile LAS unsigned long long* acc = (volatile LAS unsigned long long*)(lds + LDS_CTRL + 64) + 20; acc[0] = acc[0] + att_wait; acc[2] = acc[2] + att_b; acc[3] = acc[3] + att_a; }
#endif
#undef ATT_DMA_K
#undef ATT_DMA_V
#undef ATT_KRD
#undef ATT_VRD
#undef ATT_QK
#undef ATT_ROWMAX
#undef ATT_DECIDE
#undef ATT_IMAX3
#undef ATT_SI
#undef ATT_ROWMAXI
#undef ATT_SV
#undef ATT_EXP2
#undef ATT_GAPB
#undef ATT_DSRD
#undef ATT_NW
#undef ATT_PHASEB
#undef ATT_RESC
#undef ATT_STEP
#undef ATT_BUF
#undef ATT_TB0
#undef ATT_TB1
#undef ATT_TB2
#undef ATT_SYNCN
}
#undef ATT_SBAR
#undef ATT_MFMA
#undef ATT_SYNC
}

__device__ __forceinline__ void tr_item(const float* W, int ldw, int k0, int n0, bf16_t* WT, int ldt, int drow0, int dcol0, bool rope, LAS float* scr, int lane) {
    { f32x4 v[8];
#pragma unroll
      for (int j = 0; j < 8; ++j) v[j] = RLD((const f32x4*)(W + (size_t)(k0 + 8 * j + (lane >> 3)) * ldw + n0 + 4 * (lane & 7)));
#pragma unroll
      for (int j = 0; j < 8; ++j) { LAS float* d = scr + (8 * j + (lane >> 3)) * 33 + 4 * (lane & 7); d[0] = v[j][0]; d[1] = v[j][1]; d[2] = v[j][2]; d[3] = v[j][3]; } }
    LDS_WAIT(); asm volatile("" ::: "memory");
    const int c = lane & 7;
#pragma unroll
    for (int j = 0; j < 4; ++j) { const int n = (lane >> 3) + 8 * j; const LAS float* s = scr + (8 * c) * 33 + n;
        u32x4 o; o.x = cvtpk(s[0 * 33], s[1 * 33]); o.y = cvtpk(s[2 * 33], s[3 * 33]); o.z = cvtpk(s[4 * 33], s[5 * 33]); o.w = cvtpk(s[6 * 33], s[7 * 33]);
        const int dn = rope ? (8 * ((n >> 2) & 3) + 4 * (n >> 4) + (n & 3)) : n;
        *(u32x4*)(WT + (size_t)(drow0 + n0 + dn) * ldt + dcol0 + k0 + 8 * c) = o; }
    LDS_WAIT(); asm volatile("" ::: "memory");
}

__device__ __forceinline__ void phase_prologue(Frame F) {
    F.tid = opaque_tid(F.wave0); F.lane = F.tid & 63; F.wave = __builtin_amdgcn_readfirstlane(F.tid >> 6);
    const float* c = F.in[1]; const float* cctx = F.in[3]; const float* wmod = F.in[4]; const float* bmod = F.in[5];
    float* MOD = (float*)(F.ws + WS_MOD);
    for (int cb = blockIdx.x; cb < 192; cb += F.G) {
        LAS float* S = (LAS float*)F.lds;
        for (int idx = F.tid; idx < 1024 * 36; idx += NTHR) { const int k = idx / 36, bb = idx - k * 36; float v = 0.f;
            if (bb < 32) v = c[bb * 1024 + k]; else if (bb == 32) v = cctx[k];
            S[idx] = v / (1.f + expf(-v)); }
        __syncthreads();
        const int l = cb / 96, n = (cb % 96) * 64 + F.lane;
        float acc[36];
#pragma unroll
        for (int i = 0; i < 36; ++i) acc[i] = 0.f;
        const float* wp = wmod + ((size_t)l * 1024 + F.wave * 128) * MODW + n;
#pragma unroll 8
        for (int kk = 0; kk < 128; ++kk) { const float wv = wp[(size_t)kk * MODW]; const LAS f32x4* sp = (const LAS f32x4*)(S + (F.wave * 128 + kk) * 36);
#pragma unroll
            for (int q = 0; q < 9; ++q) { const f32x4 s4 = sp[q];
#pragma unroll
                for (int i = 0; i < 4; ++i) acc[4 * q + i] += s4[i] * wv; } }
        __syncthreads();
        LAS float* red = (LAS float*)F.lds;
#pragma unroll
        for (int bb = 0; bb < 33; ++bb) red[(F.wave * 33 + bb) * 64 + F.lane] = acc[bb];
        __syncthreads();
        for (int bb = F.wave; bb < 33; bb += 8) { float s = bmod[l * MODW + n];
#pragma unroll
            for (int w2 = 0; w2 < 8; ++w2) s += red[(w2 * 33 + bb) * 64 + F.lane];
            MOD[((size_t)l * 33 + bb) * MODW + n] = s; }
        __syncthreads();
    }
    __syncthreads();
    LAS float* scr = (LAS float*)(F.lds + F.wave * 8448);
    const int gw = F.vcu * NWAVES + F.wave, NGW = F.G * NWAVES;
    bf16_t* WZ = (bf16_t*)(F.ws + WS_WZ); bf16_t* WV = (bf16_t*)(F.ws + WS_WV); bf16_t* WM = (bf16_t*)(F.ws + WS_WM); bf16_t* WOUT = (bf16_t*)(F.ws + WS_WOUT);
    bf16_t* WUP0 = (bf16_t*)(F.ws + WS_WUP0); bf16_t* WDN0 = (bf16_t*)(F.ws + WS_WDN0);
    constexpr int I_IN = 16 * 176, I_SQ = 16 * 32, I_UP = 16 * 86, I_DN = 43 * 32;
    constexpr int NITEMS = 2 * I_IN + 4 * I_SQ + 2 * I_UP + I_DN;
    for (int it = gw; it < NITEMS; it += NGW) {
        int r = it;
        if (r < 2 * I_IN) { const int l = r / I_IN; r -= l * I_IN; const int kb = r / 176, nb = r % 176, n0 = nb * 32;
            const float* W = F.in[8] + (size_t)l * 1024 * 5632;
            if (n0 < 2560) tr_item(W, 5632, kb * 64, n0, WZ + (size_t)l * 4608 * 1024, 1024, 0, 0, n0 >= 512, scr, F.lane);
            else if (n0 < 3584) tr_item(W, 5632, kb * 64, n0, WV + (size_t)l * 1024 * 1024, 1024, -2560, 0, false, scr, F.lane);
            else tr_item(W, 5632, kb * 64, n0, WZ + (size_t)l * 4608 * 1024, 1024, -1024, 0, false, scr, F.lane);
            continue; }
        r -= 2 * I_IN;
        if (r < 4 * I_SQ) { const int q = r / I_SQ; r -= q * I_SQ; const int l = q & 1; const int kb = r / 32, nb = r % 32;
            const float* W = (q < 2 ? F.in[17] : F.in[18]) + (size_t)l * 1024 * 1024;
            if (q < 2) tr_item(W, 1024, kb * 64, nb * 32, WM + (size_t)l * 1024 * MAP, MAP, 0, 512, false, scr, F.lane);
            else tr_item(W, 1024, kb * 64, nb * 32, WOUT + (size_t)l * 1024 * 1024, 1024, 0, 0, false, scr, F.lane);
            continue; }
        r -= 4 * I_SQ;
        if (r < 2 * I_UP) { const int q = r / I_UP; r -= q * I_UP; const int kb = r / 86, nb = r % 86, n0 = nb * 32;
            const float* W = q ? F.in[20] : F.in[19];
            tr_item(W, FF, kb * 64, n0, WUP0, 1024, (n0 >> 7) * 256 + q * 128 - (n0 & ~127), 0, false, scr, F.lane); continue; }
        r -= 2 * I_UP;
        { const int kb = r / 32, nb = r % 32; tr_item(F.in[21], 1024, kb * 64, nb * 32, WDN0, FFP, 0, 0, false, scr, F.lane); }
    }
    { const int gt = F.vcu * NTHR + F.tid, NT = F.G * NTHR;
      for (int i = gt; i < 128 * 128; i += NT) { const int rr = i >> 7, cc = i & 127; const int row = 21 * 256 + (rr < 64 ? 64 + rr : 192 + (rr - 64)); *(u32x4*)(WUP0 + (size_t)row * 1024 + cc * 8) = (u32x4){0u, 0u, 0u, 0u}; }
      for (int i = gt; i < 1024 * 8; i += NT) { const int row = i >> 3, cc = i & 7; *(u32x4*)(WDN0 + (size_t)row * FFP + FF + cc * 8) = (u32x4){0u, 0u, 0u, 0u}; } }
    { bf16_t* WEFF = (bf16_t*)(F.ws + WS_WM);
      for (int it = gw; it < 1024; it += NGW) { const int l = it >> 9, g = (it >> 7) & 3, nbk = (it >> 3) & 15, cbk = it & 7; const int n = nbk * 64 + F.lane, c0 = cbk * 16;
          const float* pw = F.in[9] + ((size_t)(l * 4 + g) * 128 + c0) * 128; const float* ps = F.in[10] + l * 512 + g * 128; const float* wpp = F.in[16] + ((size_t)l * 512 + g * 128) * 1024 + n;
#pragma unroll
          for (int q = 0; q < 8; ++q) { const int idx = q * 256 + 4 * F.lane; const f32x4 v = *(const f32x4*)(pw + idx), sc = *(const f32x4*)(ps + (idx & 127)); *(LAS f32x4*)(scr + idx) = v * sc; }
          LDS_WAIT(); asm volatile("" ::: "memory");
          float a[16];
#pragma unroll
          for (int i = 0; i < 16; ++i) a[i] = 0.f;
#pragma unroll 4
          for (int d = 0; d < 128; ++d) { const float wv = wpp[(size_t)d * 1024];
#pragma unroll
              for (int i = 0; i < 16; ++i) a[i] += scr[i * 128 + d] * wv; }
          u32x4 o0, o1; o0.x = cvtpk(a[0], a[1]); o0.y = cvtpk(a[2], a[3]); o0.z = cvtpk(a[4], a[5]); o0.w = cvtpk(a[6], a[7]);
          o1.x = cvtpk(a[8], a[9]); o1.y = cvtpk(a[10], a[11]); o1.z = cvtpk(a[12], a[13]); o1.w = cvtpk(a[14], a[15]);
          bf16_t* dst = WEFF + ((size_t)l * 1024 + n) * MAP + g * 128 + c0; *(u32x4*)dst = o0; *(u32x4*)(dst + 8) = o1;
          LDS_WAIT(); asm volatile("" ::: "memory"); } }
    if (blockIdx.x == 0) {
        float* COS = (float*)(F.ws + WS_TAB); float* SIN = COS + 1024; float* LAMV = SIN + 1024;
        for (int idx = F.tid; idx < 1024; idx += NTHR) { const int pos = idx >> 4, i = idx & 15; const float inv = powf(10000.f, -(float)i * (2.0f / 32.0f)); const float ang = (float)pos * inv;
            COS[idx] = cosf(ang); SIN[idx] = sinf(ang); }
        if (F.wave == 1) {
            for (int l = 0; l < 2; ++l) { const float d1 = wave_sum(F.in[11][l * 64 + F.lane] * F.in[12][l * 64 + F.lane], F.lane), d2 = wave_sum(F.in[13][l * 64 + F.lane] * F.in[14][l * 64 + F.lane], F.lane);
                const float lam0 = 0.8f - 0.6f * expf(-0.3f * (float)l);
                if (F.lane == 0) { LAMV[2 * l] = expf(d1) - expf(d2) + lam0; LAMV[2 * l + 1] = 1.f - lam0; } }
        }
    }
}

constexpr size_t XPITCH = 4096;
template <bool SRC16>
__device__ __forceinline__ void phase_normmod(Frame F, const void* lat_, const void* ctx_, const float* g, const float* mod, int soff, bool do_ctx, bf16_t* H, const bf16_t* oadd = nullptr, void* latdst_ = nullptr, void* ctxdst_ = nullptr) {
    const char* lat = (const char*)lat_; const char* ctx = (const char*)ctx_; char* latdst = (char*)latdst_; char* ctxdst = (char*)ctxdst_;
    F.tid = opaque_tid(F.wave0); F.lane = F.tid & 63; F.wave = __builtin_amdgcn_readfirstlane(F.tid >> 6);
    const int gw = F.vcu * NWAVES + F.wave, NGW = F.G * NWAVES;
    const int per = (((NTOK + NGW - 1) / NGW) + 3) & ~3;
    const int r0 = gw * per, r1 = min(r0 + per, NTOK);
    int cur_bb = -1; f32x4 gs[4], sh[4];
#pragma unroll
    for (int q = 0; q < 4; ++q) { gs[q] = (f32x4){0.f, 0.f, 0.f, 0.f}; sh[q] = gs[q]; }
    for (int r = r0; r < r1; r += 4) {
        const int b = r / LTOK, j = r - b * LTOK; const bool isc = j < CTXL;
        if (isc && !do_ctx) continue;
        const int bb = isc ? 32 : b;
        if (bb != cur_bb) { cur_bb = bb; const float* mv = mod + (size_t)bb * MODW + soff;
#pragma unroll
            for (int q = 0; q < 4; ++q) { const int cidx = 4 * F.lane + 256 * q; const f32x4 gg = *(const f32x4*)(g + cidx), sc = *(const f32x4*)(mv + 1024 + cidx); gs[q] = gg * (sc + 1.f); sh[q] = *(const f32x4*)(mv + cidx); } }
        const char* src = isc ? ctx + ((size_t)b * CTXL + j) * XPITCH : lat + ((size_t)b * SEQ + (j - CTXL)) * XPITCH;
        f32x4 v[4][4]; float s[4];
        if (SRC16) {
            u32x2 xv[4][4];
#pragma unroll
            for (int i = 0; i < 4; ++i)
#pragma unroll
                for (int q = 0; q < 4; ++q) xv[i][q] = RLD((const u32x2*)(src + (size_t)i * XPITCH) + F.lane + 64 * q);
#pragma unroll
            for (int i = 0; i < 4; ++i)
#pragma unroll
                for (int q = 0; q < 4; ++q) v[i][q] = (f32x4){bflo(xv[i][q].x), bfhi(xv[i][q].x), bflo(xv[i][q].y), bfhi(xv[i][q].y)};
        } else {
#pragma unroll
            for (int i = 0; i < 4; ++i)
#pragma unroll
                for (int q = 0; q < 4; ++q) v[i][q] = RLD((const f32x4*)(src + (size_t)i * XPITCH) + F.lane + 64 * q);
        }
        if (oadd) {
            u32x2 ov[4][4];
#pragma unroll
            for (int i = 0; i < 4; ++i)
#pragma unroll
                for (int q = 0; q < 4; ++q) ov[i][q] = RLD((const u32x2*)(oadd + (size_t)(r + i) * D) + F.lane + 64 * q);
            char* dst = isc ? ctxdst + ((size_t)b * CTXL + j) * XPITCH : latdst + ((size_t)b * SEQ + (j - CTXL)) * XPITCH;
#pragma unroll
            for (int i = 0; i < 4; ++i)
#pragma unroll
                for (int q = 0; q < 4; ++q) { v[i][q] += (f32x4){bflo(ov[i][q].x), bfhi(ov[i][q].x), bflo(ov[i][q].y), bfhi(ov[i][q].y)};
                    u32x2 xo; xo.x = cvtpk(v[i][q][0], v[i][q][1]); xo.y = cvtpk(v[i][q][2], v[i][q][3]); RST((u32x2*)(dst + (size_t)i * XPITCH) + F.lane + 64 * q, xo); }
        }
#pragma unroll
        for (int i = 0; i < 4; ++i) { float a = 0.f;
#pragma unroll
            for (int q = 0; q < 4; ++q) a += (v[i][q][0] * v[i][q][0] + v[i][q][1] * v[i][q][1]) + (v[i][q][2] * v[i][q][2] + v[i][q][3] * v[i][q][3]);
            s[i] = a; }
#pragma unroll
        for (int o = 1; o < 64; o <<= 1)
#pragma unroll
            for (int i = 0; i < 4; ++i) s[i] += shx(s[i], o, F.lane);
#pragma unroll
        for (int i = 0; i < 4; ++i) { const float rstd = rsqrtf(s[i] * (1.f / D) + EPS); u32x2* o8 = (u32x2*)(H + (size_t)(r + i) * D) + F.lane;
#pragma unroll
            for (int q = 0; q < 4; ++q) { const f32x4 y = v[i][q] * rstd * gs[q] + sh[q]; u32x2 o; o.x = cvtpk(y[0], y[1]); o.y = cvtpk(y[2], y[3]); o8[64 * q] = o; } }
    }
}

__device__ __forceinline__ void pool_unpack(const u32x4 w, float (&v)[8]) { v[0] = bflo(w.x); v[1] = bfhi(w.x); v[2] = bflo(w.y); v[3] = bfhi(w.y); v[4] = bflo(w.z); v[5] = bfhi(w.z); v[6] = bflo(w.w); v[7] = bfhi(w.w); }
__device__ __forceinline__ void phase_pool(Frame F, const bf16_t* U, bf16_t* M, bool do_ctx) {
    F.tid = opaque_tid(F.wave0); F.lane = F.tid & 63; F.wave = __builtin_amdgcn_readfirstlane(F.tid >> 6);
    const int gw = F.vcu * NWAVES + F.wave, NGW = F.G * NWAVES;
    const int per = (((NTOK + NGW - 1) / NGW) + 3) & ~3;
    const int r0 = gw * per, r1 = min(r0 + per, NTOK);
    const int half = 1 << (F.lane >> 4);
    float S[8];
#pragma unroll
    for (int q = 0; q < 8; ++q) S[q] = 0.f;
    bool need_init = true;
    for (int r = r0; r < r1; r += 4) {
        const int b = r / LTOK, j = r - b * LTOK; const bool isc = j < CTXL;
        if (isc && !do_ctx) { need_init = true; continue; }
        const int L = isc ? CTXL : SEQ, t = isc ? j : j - CTXL; const size_t base = (size_t)b * LTOK + (isc ? 0 : CTXL);
        const bf16_t* Ul = U + base * 512 + 8 * F.lane;
        u32x4 wc[4], wi[4], wo[4];
#pragma unroll
        for (int i = 0; i < 4; ++i) { wc[i] = *(const u32x4*)(Ul + (size_t)(t + i) * 512); wi[i] = *(const u32x4*)(Ul + (size_t)min(t + i + half, L - 1) * 512); wo[i] = *(const u32x4*)(Ul + (size_t)max(t + i - half, 0) * 512); }
        if (need_init || t == 0) {
            need_init = false;
            const int lo = max(t - half, 0), hi = min(t + half, L);
            u32x4 w[16];
#pragma unroll
            for (int k = 0; k < 16; ++k) { const int tt = min(max(t - 8 + k, 0), L - 1); w[k] = *(const u32x4*)(Ul + (size_t)tt * 512); }
#pragma unroll
            for (int q = 0; q < 8; ++q) S[q] = 0.f;
#pragma unroll
            for (int k = 0; k < 16; ++k) { const int tt = t - 8 + k; const float mk = (tt >= lo && tt < hi) ? 1.f : 0.f; float v[8]; pool_unpack(w[k], v);
#pragma unroll
                for (int q = 0; q < 8; ++q) S[q] += mk * v[q]; }
        }
#pragma unroll
        for (int i = 0; i < 4; ++i) {
            const int ti = t + i, lo = max(ti - half, 0), hi = min(ti + half, L);
            const float ic = 1.f / (float)(hi - lo);
            float c[8], vi[8], vo[8]; pool_unpack(wc[i], c); pool_unpack(wi[i], vi); pool_unpack(wo[i], vo);
            u32x4 o; o.x = cvtpk(S[0] * ic - c[0], S[1] * ic - c[1]); o.y = cvtpk(S[2] * ic - c[2], S[3] * ic - c[3]);
            o.z = cvtpk(S[4] * ic - c[4], S[5] * ic - c[5]); o.w = cvtpk(S[6] * ic - c[6], S[7] * ic - c[7]);
            *(u32x4*)(M + (size_t)(r + i) * MAP + 8 * F.lane) = o;
            const float mi = (ti + half < L) ? 1.f : 0.f, mo = (ti - half >= 0) ? 1.f : 0.f;
#pragma unroll
            for (int q = 0; q < 8; ++q) S[q] = (S[q] + mi * vi[q]) - mo * vo[q];
        }
    }
}

__device__ __forceinline__ void phase_router(Frame F, char* x1, const float* g, const float* mod, bf16_t* H, const bf16_t* oadd) {
    F.tid = opaque_tid(F.wave0); F.lane = F.tid & 63; F.wave = __builtin_amdgcn_readfirstlane(F.tid >> 6);
    LAS float* WR = (LAS float*)F.lds;
    LAS float* LG = (LAS float*)(F.lds + 32768);
    LAS int* LCNT = (LAS int*)(F.lds + 32768 + 8192);
    unsigned* LIST = (unsigned*)(F.ws + WS_LIST); float* WTS = (float*)(F.ws + WS_WTS);
    for (int i = F.tid; i < 8192; i += NTHR) WR[i] = F.in[22][i];
    for (int ch = blockIdx.x; ch < NLAT / 256; ch += F.G) {
        if (F.tid < 16) LCNT[F.tid] = 0;
        __syncthreads();
        const int bch = (ch * 256) >> 11;
        f32x4 gs[4], sh[4];
        { const float* mv = mod + (size_t)bch * MODW + 3 * D;
#pragma unroll
          for (int q = 0; q < 4; ++q) { const int cidx = 4 * F.lane + 256 * q; const f32x4 gg = *(const f32x4*)(g + cidx), sc = *(const f32x4*)(mv + 1024 + cidx); gs[q] = gg * (sc + 1.f); sh[q] = *(const f32x4*)(mv + cidx); } }
        u32x2 vn[2][4], on[2][4];
#define RT_LOAD(rb_) do { const int _t0 = ch * 256 + F.wave * 32 + (rb_); const bf16_t* _or = oadd + ((size_t)bch * LTOK + CTXL + (_t0 & 2047)) * D; \
            _Pragma("unroll") for (int i = 0; i < 2; ++i) _Pragma("unroll") for (int q = 0; q < 4; ++q) { vn[i][q] = RLD((const u32x2*)(x1 + (size_t)(_t0 + i) * XPITCH) + F.lane + 64 * q); on[i][q] = RLD((const u32x2*)(_or + (size_t)i * D) + F.lane + 64 * q); } } while (0)
        RT_LOAD(0);
        for (int rb = 0; rb < 32; rb += 2) {
            const int rr0 = F.wave * 32 + rb, tok0 = ch * 256 + rr0;
            f32x4 v[2][4]; float s[2];
#pragma unroll
            for (int i = 0; i < 2; ++i)
#pragma unroll
                for (int q = 0; q < 4; ++q) v[i][q] = (f32x4){bflo(vn[i][q].x) + bflo(on[i][q].x), bfhi(vn[i][q].x) + bfhi(on[i][q].x), bflo(vn[i][q].y) + bflo(on[i][q].y), bfhi(vn[i][q].y) + bfhi(on[i][q].y)};
            if (rb + 2 < 32) RT_LOAD(rb + 2);
#pragma unroll
            for (int i = 0; i < 2; ++i)
#pragma unroll
                for (int q = 0; q < 4; ++q) { u32x2 xo; xo.x = cvtpk(v[i][q][0], v[i][q][1]); xo.y = cvtpk(v[i][q][2], v[i][q][3]); RST((u32x2*)(x1 + (size_t)(tok0 + i) * XPITCH) + F.lane + 64 * q, xo); }
#pragma unroll
            for (int i = 0; i < 2; ++i) { float a = 0.f;
#pragma unroll
                for (int q = 0; q < 4; ++q) a += (v[i][q][0] * v[i][q][0] + v[i][q][1] * v[i][q][1]) + (v[i][q][2] * v[i][q][2] + v[i][q][3] * v[i][q][3]);
                s[i] = a; }
#pragma unroll
            for (int o = 1; o < 64; o <<= 1)
#pragma unroll
                for (int i = 0; i < 2; ++i) s[i] += shx(s[i], o, F.lane);
#pragma unroll
            for (int i = 0; i < 2; ++i) {
                const int tok = tok0 + i; const float rstd = rsqrtf(s[i] * (1.f / D) + EPS);
                u32x2* o8 = (u32x2*)(H + ((size_t)bch * LTOK + CTXL + (tok & 2047)) * D) + F.lane;
                float lg[8];
#pragma unroll
                for (int e = 0; e < 8; ++e) lg[e] = 0.f;
#pragma unroll
                for (int q = 0; q < 4; ++q) { const int cidx = 4 * F.lane + 256 * q;
                    const f32x4 y = v[i][q] * rstd * gs[q] + sh[q];
                    u32x2 o; o.x = cvtpk(y[0], y[1]); o.y = cvtpk(y[2], y[3]); o8[64 * q] = o;
#pragma unroll
                    for (int k = 0; k < 4; ++k) { const LAS f32x4* wr = (const LAS f32x4*)(WR + (cidx + k) * 8); const f32x4 w0 = wr[0], w1 = wr[1];
                        lg[0] += y[k] * w0[0]; lg[1] += y[k] * w0[1]; lg[2] += y[k] * w0[2]; lg[3] += y[k] * w0[3]; lg[4] += y[k] * w1[0]; lg[5] += y[k] * w1[1]; lg[6] += y[k] * w1[2]; lg[7] += y[k] * w1[3]; } }
                const bool b0 = F.lane & 1, b1 = F.lane & 2, b2 = F.lane & 4;
                float a4[4], a2[2], a1;
#pragma unroll
                for (int j = 0; j < 4; ++j) { const float keep = b0 ? lg[4 + j] : lg[j], send = b0 ? lg[j] : lg[4 + j]; a4[j] = keep + shx(send, 1, F.lane); }
#pragma unroll
                for (int j = 0; j < 2; ++j) { const float keep = b1 ? a4[2 + j] : a4[j], send = b1 ? a4[j] : a4[2 + j]; a2[j] = keep + shx(send, 2, F.lane); }
                { const float keep = b2 ? a2[1] : a2[0], send = b2 ? a2[0] : a2[1]; a1 = keep + shx(send, 4, F.lane); }
                a1 += shx(a1, 8, F.lane); a1 += shx(a1, 16, F.lane); a1 += shx(a1, 32, F.lane);
                if (F.lane < 8) LG[(rr0 + i) * 8 + ((F.lane & 1) * 4 + (F.lane & 2) + ((F.lane >> 2) & 1))] = a1;
            }
        }
#undef RT_LOAD
        __syncthreads();
        int e1 = 0, e2 = 0, i1 = 0, i2 = 0; float w1 = 0.f, w2 = 0.f;
        if (F.tid < 256) {
            const f32x4 l0 = *(const LAS f32x4*)(LG + F.tid * 8), l1 = *(const LAS f32x4*)(LG + F.tid * 8 + 4);
            const float lg[8] = {l0[0], l0[1], l0[2], l0[3], l1[0], l1[1], l1[2], l1[3]};
            float v1 = lg[0];
#pragma unroll
            for (int e = 1; e < 8; ++e) if (lg[e] > v1) { v1 = lg[e]; e1 = e; }
            float v2 = -3.0e38f;
#pragma unroll
            for (int e = 0; e < 8; ++e) if (e != e1 && lg[e] > v2) { v2 = lg[e]; e2 = e; }
            const float p2 = expf(v2 - v1); w1 = 1.f / (1.f + p2); w2 = p2 * w1;
            i1 = atomicAdd((int*)&LCNT[e1], 1); i2 = atomicAdd((int*)&LCNT[e2], 1); }
        __syncthreads();
        if (F.tid < 8) LCNT[8 + F.tid] = (int)__hip_atomic_fetch_add(F.ctl + CW_CNT + 64 * F.tid, (unsigned)LCNT[F.tid], __ATOMIC_RELAXED, __HIP_MEMORY_SCOPE_AGENT);
        __syncthreads();
        if (F.tid < 256) { const unsigned tok = (unsigned)(ch * 256 + F.tid);
            LIST[(size_t)e1 * NLAT + LCNT[8 + e1] + i1] = tok * 2u; LIST[(size_t)e2 * NLAT + LCNT[8 + e2] + i2] = tok * 2u + 1u;
            WTS[tok * 2u] = w1; WTS[tok * 2u + 1u] = w2; }
        __syncthreads();
    }
    __syncthreads();
    LAS float* scr = (LAS float*)(F.lds + F.wave * 8448);
    const int gw = F.vcu * NWAVES + F.wave, NGW = F.G * NWAVES;
    bf16_t* WUPE = (bf16_t*)(F.ws + WS_WUPE); bf16_t* WDNE = (bf16_t*)(F.ws + WS_WDNE);
    constexpr int I_E = 16 * 44, I_D = 22 * 32;
    for (int it = gw; it < NE * (2 * I_E + I_D); it += NGW) {
        const int e = it / (2 * I_E + I_D); int r = it - e * (2 * I_E + I_D);
        if (r < 2 * I_E) { const int q = r / I_E; r -= q * I_E; const int kb = r / 44, nb = r % 44, n0 = nb * 32;
            const float* W = (q ? F.in[24] : F.in[23]) + (size_t)e * 1024 * FFE;
            tr_item(W, FFE, kb * 64, n0, WUPE + (size_t)e * 2816 * 1024, 1024, (n0 >> 7) * 256 + q * 128 - (n0 & ~127), 0, false, scr, F.lane); }
        else { r -= 2 * I_E; const int kb = r / 32, nb = r % 32;
            tr_item(F.in[25] + (size_t)e * FFE * 1024, 1024, kb * 64, nb * 32, WDNE + (size_t)e * 1024 * FFE, FFE, 0, 0, false, scr, F.lane); }
    }
}

__device__ __forceinline__ void phase_final(Frame F, float* x, const bf16_t* YM, const float* mod, const float* fg) {
    F.tid = opaque_tid(F.wave0); F.lane = F.tid & 63; F.wave = __builtin_amdgcn_readfirstlane(F.tid >> 6);
    const int gw = F.vcu * NWAVES + F.wave, NGW = F.G * NWAVES;
    const int per = (((NLAT + NGW - 1) / NGW) + 1) & ~1;
    const int t0 = gw * per, t1 = min(t0 + per, NLAT);
    f32x4 fgv[4];
#pragma unroll
    for (int q = 0; q < 4; ++q) fgv[q] = *(const f32x4*)(fg + 4 * F.lane + 256 * q);
    for (int tok = t0; tok < t1; tok += 2) {
        const int b = tok >> 11; const float* gate = mod + (size_t)b * MODW + 5 * D;
        f32x4 xv[2][4]; u32x2 xb[2][4], ya[2][4], yc[2][4];
#pragma unroll
        for (int i = 0; i < 2; ++i)
#pragma unroll
            for (int q = 0; q < 4; ++q) { xb[i][q] = RLD((const u32x2*)((const char*)x + (size_t)(tok + i) * XPITCH) + F.lane + 64 * q);
                ya[i][q] = RLD((const u32x2*)(YM + (size_t)(tok + i) * D) + F.lane + 64 * q); yc[i][q] = RLD((const u32x2*)(YM + ((size_t)NLAT + tok + i) * D) + F.lane + 64 * q); }
        float s[2];
#pragma unroll
        for (int i = 0; i < 2; ++i) { float a = 0.f;
#pragma unroll
            for (int q = 0; q < 4; ++q) { const f32x4 gg = *(const f32x4*)(gate + 4 * F.lane + 256 * q);
                const f32x4 yy = (f32x4){bflo(ya[i][q].x) + bflo(yc[i][q].x), bfhi(ya[i][q].x) + bfhi(yc[i][q].x), bflo(ya[i][q].y) + bflo(yc[i][q].y), bfhi(ya[i][q].y) + bfhi(yc[i][q].y)};
                xv[i][q] = (f32x4){bflo(xb[i][q].x), bfhi(xb[i][q].x), bflo(xb[i][q].y), bfhi(xb[i][q].y)} + gg * yy; a += (xv[i][q][0] * xv[i][q][0] + xv[i][q][1] * xv[i][q][1]) + (xv[i][q][2] * xv[i][q][2] + xv[i][q][3] * xv[i][q][3]); }
            s[i] = a; }
#pragma unroll
        for (int o = 1; o < 64; o <<= 1)
#pragma unroll
            for (int i = 0; i < 2; ++i) s[i] += shx(s[i], o, F.lane);
#pragma unroll
        for (int i = 0; i < 2; ++i) { const float rstd = rsqrtf(s[i] * (1.f / D) + EPS);
#pragma unroll
            for (int q = 0; q < 4; ++q) RST((f32x4*)(x + (size_t)(tok + i) * D) + F.lane + 64 * q, xv[i][q] * rstd * fgv[q]); }
    }
}

struct Args { const float* in[27]; float* out; unsigned char* ws; int ph_lo, ph_hi; };
__global__ void __launch_bounds__(NTHR, 2) dit_fwd(Args args) {
    extern __shared__ __attribute__((aligned(16))) unsigned char lds_raw[];
    LAS unsigned char* const ldsb = (LAS unsigned char*)lds_raw;
    const int WAVE = __builtin_amdgcn_readfirstlane((int)threadIdx.x >> 6);
    volatile LAS unsigned* xbw = (volatile LAS unsigned*)(ldsb + LDS_CTRL);
    if (threadIdx.x < 4) xbw[threadIdx.x] = 0u;
    __syncthreads();
    volatile LAS unsigned long long* tsl = (volatile LAS unsigned long long*)(ldsb + LDS_CTRL + 64);
    if (args.ph_hi - args.ph_lo > 1) (void)xcd_barrier_post((unsigned*)(args.ws + WS_CTL) + CW_BAR, xbw);
#ifndef SITE_MASK
#define SITE_MASK 0xFFFFFFFFu
#endif
#define SITE(n) (((SITE_MASK) >> (n)) & 1u)
#define IN(k) (args.ph_lo <= (k) && (k) < args.ph_hi)
#define STAMP(k) do { if (PROBE_MASK != 0u && blockIdx.x == 0 && opaque_tid(WAVE) == 0) tsl[(k)] = __builtin_amdgcn_s_memrealtime(); } while (0)
#define SEAM(k) do { if (IN(k) && IN((k) + 1)) { XcdBarrier _b; _b.bar = (unsigned*)(args.ws + WS_CTL) + CW_BAR; _b.x = xb_xcc_id(); _b.st = xbw; xcd_barrier(_b); } STAMP((k) + 1); } while (0)

#define WSBASE() size_t _wz = 0; asm volatile("" : "+s"(_wz)); unsigned char* ws = args.ws + _wz; float* MOD = (float*)(ws + WS_MOD); (void)MOD; \
    Frame F; F.lds = ldsb; F.ws = ws; F.ctl = (unsigned*)(ws + WS_CTL); F.in = args.in; F.out = args.out + _wz; F.wave0 = WAVE; F.tid = 0; F.lane = 0; F.wave = 0; \
    F.G = gridDim.x; { const int bx = blockIdx.x; F.vcu = (F.G % 8 == 0) ? (bx % 8) * (F.G / 8) + bx / 8 : bx; } const int c = (int)blockIdx.x; (void)c
#define P_COS ((const float*)(ws + WS_TAB))
#define P_SIN (P_COS + 1024)
#define P_LAMV (P_SIN + 1024)
#define P_XC ((float*)(ws + WS_XC))
#define P_H ((bf16_t*)(ws + WS_H))
#define P_U ((bf16_t*)(ws + WS_U))
#define P_Q ((bf16_t*)(ws + WS_Q))
#define P_KB ((bf16_t*)(ws + WS_K))
#define P_VT ((bf16_t*)(ws + WS_VT))
#define P_G ((unsigned char*)(ws + WS_G))
#define P_MA ((bf16_t*)(ws + WS_MA))
#define P_Y ((bf16_t*)(ws + WS_Y))
#define P_HID ((bf16_t*)(ws + WS_HID))
#define P_HIDM ((bf16_t*)(ws + WS_HIDM))
#define P_YM ((bf16_t*)(ws + WS_YM))

    if (PROBE_MASK != 0u && threadIdx.x == 0) { tsl[20] = 0; tsl[21] = 0; tsl[22] = 0; tsl[23] = 0; }
    STAMP(0);
    if (SITE(0) && IN(0)) { WSBASE(); phase_prologue(F); } SEAM(0);
    if (SITE(1) && IN(1)) { WSBASE(); phase_normmod<false>(F, F.in[0], F.in[2], F.in[6], MOD, 0, true, P_H); } SEAM(1);

    for (int l = 0; l < 2; ++l) {
        const int pb = 2 + 8 * l; const bool last = (l == 1);
        if (SITE(2) && IN(pb)) { WSBASE();
            ZSched S; S.init(F.G, c, last ? 1 : 0, P_H, ws + WS_WZ + (size_t)l * 9 * MiB, ws + WS_WV + (size_t)l * 2 * MiB);
            ZEpi E{P_U, P_Q, P_KB, P_G, P_VT, P_COS, P_SIN};
            pg8::gemm_phase(F.lds, WAVE, 1024, S, E);
        } SEAM(pb);
        if (SITE(3) && IN(pb + 1)) { WSBASE();
            phase_pool(F, P_U, P_MA, !last);
            const float lam = P_LAMV[2 * l], osc = P_LAMV[2 * l + 1]; const float* subg = F.in[15] + l * VD;
            bf16x8 qf[4];
            for (int i = 0;; ++i) { const int Lf = i * F.G + F.vcu; if (Lf >= NB * NH * 16) break; const int L = REV_ORDER ? NB * NH * 16 - 1 - Lf : Lf; const int bh = L >> 4, qt = L & 15, b = bh >> 3, h = bh & 7;
                const int Lfn = Lf + F.G; const bool hn = Lfn < NB * NH * 16; const int Ln = REV_ORDER ? NB * NH * 16 - 1 - Lfn : Lfn; const int nbh = Ln >> 4, nqt = Ln & 15, nb = nbh >> 3, nh = nbh & 7;
                att::attn_unit(F.lds, P_Q, P_KB, P_VT, P_MA, b, h, (size_t)b * LTOK + CTXL + qt * 128, 36, lam, osc, subg, qf, XUP ? i == 0 : true, XUP ? hn : false, nb, nh, (size_t)nb * LTOK + CTXL + nqt * 128, WAVE); }
            if (!last) for (int i = 0;; ++i) { const int L = i * F.G + F.vcu; if (L >= NB * NH * 2) break; const int bh = L >> 1, qt = L & 1, b = bh >> 3, h = bh & 7;
                const int Ln = L + F.G; const bool hn = Ln < NB * NH * 2; const int nbh = Ln >> 1, nqt = Ln & 1, nb = nbh >> 3, nh = nbh & 7;
                att::attn_unit(F.lds, P_Q, P_KB, P_VT, P_MA, b, h, (size_t)b * LTOK + qt * 128, 4, lam, osc, subg, qf, XUP ? i == 0 : true, XUP ? hn : false, nb, nh, (size_t)nb * LTOK + nqt * 128, WAVE); }
        } SEAM(pb + 1);
        if (SITE(4) && IN(pb + 2)) { WSBASE();
            MergeSched S; S.init(F.G, c, last ? 1 : 0, P_MA, ws + WS_WM + (size_t)l * 3 * MiB); MergeEpi E{P_Y, P_G}; pg8::gemm_phase(F.lds, WAVE, MAP, S, E);
        } SEAM(pb + 2);
        if (SITE(5) && IN(pb + 3)) { WSBASE();
            PlainSched S; S.init(F.G, c, last ? 1 : 0, 4, P_Y, ws + WS_WOUT + (size_t)l * 2 * MiB, 1024, REV_ORDER);
            OEpi E{P_Q, MOD + (size_t)l * 33 * MODW, 2 * D};
            pg8::gemm_phase(F.lds, WAVE, 1024, S, E);
        } SEAM(pb + 3);
        if (!last) {
            if (SITE(6) && IN(pb + 4)) { WSBASE(); phase_normmod<false>(F, F.in[0], F.in[2], F.in[7], MOD, 3 * D, true, P_H, P_Q, F.out, P_XC); } SEAM(pb + 4);
            if (SITE(7) && IN(pb + 5)) { WSBASE(); PlainSched S; S.init(F.G, c, 0, 22, P_H, ws + WS_WUP0, 1024); UpEpi E{P_HID, FFP}; pg8::gemm_phase(F.lds, WAVE, 1024, S, E); } SEAM(pb + 5);
            if (SITE(8) && IN(pb + 6)) { WSBASE(); PlainSched S; S.init(F.G, c, 0, 4, P_HID, ws + WS_WDN0, FFP, REV_ORDER); OEpi E{(bf16_t*)P_G, MOD, 5 * D}; pg8::gemm_phase(F.lds, WAVE, FFP, S, E); } SEAM(pb + 6);
            if (SITE(9) && IN(pb + 7)) { WSBASE(); phase_normmod<true>(F, F.out, P_XC, F.in[6] + D, MOD + (size_t)33 * MODW, 0, true, P_H, (const bf16_t*)P_G, F.out, P_XC); } SEAM(pb + 7);
        } else {
            if (SITE(10) && IN(pb + 4)) { WSBASE(); phase_router(F, (char*)F.out, F.in[7] + D, MOD + (size_t)33 * MODW, P_H, P_Q); } SEAM(pb + 4);
            if (SITE(12) && IN(pb + 5)) { WSBASE(); MoeInfo mi; mi.load(F.ctl); MoeSched S; S.init(F.G, c, 11, P_H, ws + WS_WUPE, 1024, 2816, mi); S.gather = 1; S.LIST = (const unsigned*)(ws + WS_LIST); UpEpi E{P_HIDM, FFE}; pg8::gemm_phase<true>(F.lds, WAVE, 1024, S, E); } SEAM(pb + 5);
            if (SITE(13) && IN(pb + 6)) { WSBASE(); MoeInfo mi; mi.load(F.ctl); MoeSched S; S.init(F.G, c, 4, P_HIDM, ws + WS_WDNE, FFE, 1024, mi); S.rev = REV_ORDER;
                MoeDownEpi E{P_YM, (const unsigned*)(ws + WS_LIST), (const float*)(ws + WS_WTS), mi}; pg8::gemm_phase(F.lds, WAVE, FFE, S, E); } SEAM(pb + 6);
            if (SITE(14) && IN(pb + 7)) { WSBASE(); phase_final(F, F.out, P_YM, MOD + (size_t)33 * MODW, F.in[26]); }
            if (PROBE_MASK != 0u && blockIdx.x == 0) { __syncthreads(); if (threadIdx.x == 0) { const unsigned long long tend = __builtin_amdgcn_s_memrealtime(); unsigned long long dly = 0;
                for (int k = 0; k < N_PHASES; ++k) if ((PROBE_MASK >> k) & 1u) dly += (k == N_PHASES - 1 ? tend : tsl[k + 1]) - tsl[k];
                if ((PROBE_MASK >> 20) & 1u) dly += tsl[20];
                if ((PROBE_MASK >> 21) & 1u) dly += tsl[21];
                if ((PROBE_MASK >> 22) & 1u) dly += tsl[22];
                if ((PROBE_MASK >> 23) & 1u) dly += tsl[23];
                while (__builtin_amdgcn_s_memrealtime() - tend < dly) __builtin_amdgcn_s_sleep(8); } }
        }
    }
#undef IN
#undef SEAM
}

extern "C" void kernel_launch(void* const* d_in, const int* in_sizes, int n_in, void* d_out, int out_size, void* d_ws, size_t ws_size, hipStream_t stream) {
    static int grid = 0;
    if (grid == 0) {
        if (n_in != 27 || ws_size < WS_END) { fprintf(stderr, "kernel_launch: unexpected n_in %d or ws %zu\n", n_in, ws_size); grid = -1; return; }
        int dev = 0, cus = 0;
        if (hipGetDevice(&dev) != hipSuccess || hipDeviceGetAttribute(&cus, hipDeviceAttributeMultiprocessorCount, dev) != hipSuccess) { grid = -1; return; }
        if (hipFuncSetAttribute((const void*)dit_fwd, hipFuncAttributeMaxDynamicSharedMemorySize, LDS_BYTES) != hipSuccess) { fprintf(stderr, "kernel_launch: hipFuncSetAttribute failed\n"); grid = -1; return; }
        (void)hipGetLastError();
        grid = cus;
    }
    if (grid < 0) return;
    (void)hipMemsetAsync((char*)d_ws + WS_CTL, 0, CTL_ZERO_BYTES, stream);
    Args a{};
    for (int i = 0; i < 27; ++i) a.in[i] = (const float*)d_in[i];
    a.out = (float*)d_out; a.ws = (unsigned char*)d_ws;
#if MK_ONE_LAUNCH
    a.ph_lo = 0; a.ph_hi = N_PHASES;
    hipLaunchKernelGGL(dit_fwd, dim3(grid), dim3(NTHR), LDS_BYTES, stream, a);
#else
    for (int p = 0; p < N_PHASES; ++p) { a.ph_lo = p; a.ph_hi = p + 1; hipLaunchKernelGGL(dit_fwd, dim3(grid), dim3(NTHR), LDS_BYTES, stream, a); }
#endif
}
```

```cpp
#include <hip/hip_runtime.h>
#include <cstdio>
#include <cstdint>

#define LAS __attribute__((address_space(3)))
#define GAS __attribute__((address_space(1)))
typedef unsigned short bf16_t;
typedef short bf16x8 __attribute__((ext_vector_type(8)));
typedef float f32x4 __attribute__((ext_vector_type(4)));
typedef float f32x16 __attribute__((ext_vector_type(16)));
typedef unsigned u32x4 __attribute__((ext_vector_type(4)));
typedef unsigned u32x2 __attribute__((ext_vector_type(2)));
typedef float f32x2_t __attribute__((ext_vector_type(2)));
typedef __bf16 bf16x2_t __attribute__((ext_vector_type(2)));

#ifndef PROBE_MASK
#define PROBE_MASK 0u
#endif
#ifndef PG8_ALIGN
#define PG8_ALIGN 1
#endif
#ifndef ATT_PRIO
#define ATT_PRIO 0
#ifndef REV_ORDER
#define REV_ORDER 1
#endif
#ifndef ROW_NT
#define ROW_NT 1
#endif
#endif
#ifndef XUP
#define XUP 0
#endif
#ifndef GEMM_STAGGER
#define GEMM_STAGGER 0
#endif
#ifndef MK_ONE_LAUNCH
#define MK_ONE_LAUNCH 1
#endif

constexpr int D = 1024, NB = 32, SEQ = 2048, CTXL = 256, LTOK = SEQ + CTXL, NTOK = NB * LTOK, NRT = NTOK / 256;
constexpr int NLAT = NB * SEQ;
constexpr int NH = 8, VD = 128;
constexpr int FF = 2752, FFP = 2816, NE = 8, FFE = 1408;
constexpr int MODW = 6 * D;
constexpr float EPS = 1e-6f;
constexpr float LOG2E = 1.4426950408889634f;
constexpr float QSCALE = 0.125f * LOG2E;
constexpr int NWAVES = 8, NTHR = 512;

constexpr size_t MiB = 1u << 20;
constexpr size_t WS_CTL = 0, CTL_ZERO_BYTES = 65536;
constexpr size_t WS_MOD = 65536;
constexpr size_t WS_TAB = 1703936;
constexpr size_t WS_XC = 2 * MiB;
constexpr size_t WS_W = 34 * MiB;
constexpr size_t WS_WZ = WS_W, WS_WV = WS_W + 18 * MiB, WS_WM = WS_W + 22 * MiB, WS_WOUT = WS_W + 28 * MiB, WS_WUP0 = WS_W + 32 * MiB, WS_WDN0 = WS_W + 43 * MiB;
constexpr size_t WS_H = 83 * MiB, WS_MA = 83 * MiB, WS_U = 299 * MiB, WS_Q = 371 * MiB, WS_K = 515 * MiB, WS_VT = 659 * MiB, WS_G = 803 * MiB, WS_END = 982 * MiB;
constexpr size_t WS_Y = WS_K, WS_HID = WS_U;
constexpr size_t WS_YM = 299 * MiB, WS_HIDM = 555 * MiB, WS_WUPE = 913 * MiB, WS_WDNE = 957 * MiB, WS_LIST = 979 * MiB, WS_WTS = 981 * MiB;
constexpr int MAP = 1536;
static_assert(WS_WDN0 + (size_t)D * FFP * 2 <= WS_H, "weights");
static_assert(WS_MA + (size_t)NTOK * MAP * 2 <= WS_U && WS_G + (size_t)NTOK * 2048 <= WS_END, "ma / g");
static_assert(WS_HID + (size_t)NTOK * FFP * 2 <= WS_END, "hid");
static_assert(WS_YM + (size_t)2 * NLAT * D * 2 <= WS_HIDM && WS_HIDM + (size_t)133120 * FFE * 2 <= WS_WUPE && WS_WTS + (size_t)NLAT * 8 <= WS_END, "moe");
constexpr int CW_BAR = 1024, CW_CNT = 8192;

constexpr int N_PHASES = 18;
constexpr int LDS_BYTES = 163840;
constexpr int LDS_CTRL = LDS_BYTES - 256;

__device__ __forceinline__ unsigned cvtpk(float lo, float hi) { f32x2_t v = {lo, hi}; bf16x2_t b = __builtin_convertvector(v, bf16x2_t); return __builtin_bit_cast(unsigned, b); }
__device__ __forceinline__ float bflo(unsigned w) { return __uint_as_float(w << 16); }
__device__ __forceinline__ float bfhi(unsigned w) { return __uint_as_float(w & 0xffff0000u); }
__device__ __forceinline__ u32x4 pack8(const f32x4 a, const f32x4 b) { u32x4 w; w.x = cvtpk(a[0], a[1]); w.y = cvtpk(a[2], a[3]); w.z = cvtpk(b[0], b[1]); w.w = cvtpk(b[2], b[3]); return w; }
__device__ __forceinline__ float shx(float v, int o, int lane) { return __int_as_float(__builtin_amdgcn_ds_bpermute((lane ^ o) << 2, __float_as_int(v))); }
__device__ __forceinline__ float wave_sum(float v, int lane) {
#pragma unroll
    for (int o = 1; o < 64; o <<= 1) v += shx(v, o, lane);
    return v;
}
__device__ __forceinline__ float pair_sum(float v) { auto rr = __builtin_amdgcn_permlane32_swap(__float_as_uint(v), __float_as_uint(v), false, false); return __uint_as_float(rr[0]) + __uint_as_float(rr[1]); }
__device__ __forceinline__ float pair_max(float v) { auto rr = __builtin_amdgcn_permlane32_swap(__float_as_uint(v), __float_as_uint(v), false, false); return fmaxf(__uint_as_float(rr[0]), __uint_as_float(rr[1])); }
__device__ __forceinline__ float fast_sigmoid(float x) { return __builtin_amdgcn_rcpf(1.f + __builtin_amdgcn_exp2f(-LOG2E * x)); }
#define LDS_WAIT() asm volatile("s_waitcnt lgkmcnt(0)" ::: "memory")
__device__ __forceinline__ int opaque_tid(int wave) { unsigned z = 0u; asm volatile("" : "+v"(z)); return (wave << 6) | (int)__builtin_amdgcn_mbcnt_hi(~0u, __builtin_amdgcn_mbcnt_lo(~0u, z)); }

#define XB_TMO      128
#define XB_XCNT(j)  (256  + 64 * (j))
#define XB_XSUB(j)  (1280 + 64 * (j))
#define XB_XGEN(j)  (2304 + 64 * (j))
#define XB_TOP      3328
#define XB_TOPGEN   3392
#define XCD_BAR_WORDS 3456
#define XB_SPIN_CAP (1u << 22)
__device__ __forceinline__ unsigned xb_ld(unsigned* p)              { return __hip_atomic_load(p, __ATOMIC_RELAXED, __HIP_MEMORY_SCOPE_AGENT); }
__device__ __forceinline__ unsigned xb_add(unsigned* p, unsigned v) { return __hip_atomic_fetch_add(p, v, __ATOMIC_RELAXED, __HIP_MEMORY_SCOPE_AGENT); }
__device__ __forceinline__ unsigned xb_xcc_id() { return (unsigned)__builtin_amdgcn_s_getreg((3 << 11) | 20) & 0xFu; }
#define XB_SPIN(cond, bar) do { unsigned _sp = 0; while (cond) { __builtin_amdgcn_s_sleep(1); \
    if ((++_sp & 255u) == 0u) { if (xb_ld(&(bar)[XB_TMO])) break; if (_sp > XB_SPIN_CAP) { atomicAdd(&(bar)[XB_TMO], 1u); break; } } } } while (0)
struct XcdBarrier { unsigned* bar; unsigned x; volatile LAS unsigned* st; };
__device__ __forceinline__ XcdBarrier xcd_barrier_post(unsigned* bar, volatile LAS unsigned* st) {
    XcdBarrier b; b.bar = bar; b.x = xb_xcc_id(); b.st = st;
    if (threadIdx.x == 0) (void)xb_add(&bar[XB_XCNT(b.x)], 1u);
    return b;
}
__device__ __forceinline__ void xcd_barrier_complete(unsigned* bar, unsigned x, unsigned& nloc, unsigned& nx) {
    const unsigned G = gridDim.x * gridDim.y * gridDim.z;
    unsigned sum, cnt, mine, sp = 0u;
    for (;;) {
        sum = 0u; cnt = 0u; mine = 0u;
#pragma unroll
        for (unsigned j = 0; j < 16; ++j) { const unsigned c = xb_ld(&bar[XB_XCNT(j)]); sum += c; cnt += (c > 0u) ? 1u : 0u; mine = (j == x) ? c : mine; }
        if (sum == G) break;
        __builtin_amdgcn_s_sleep(1);
        if ((++sp & 255u) == 0u) { if (xb_ld(&bar[XB_TMO])) break; if (sp > XB_SPIN_CAP) { atomicAdd(&bar[XB_TMO], 1u); break; } }
    }
    nloc = mine > 0u ? mine : 1u; nx = cnt > 0u ? cnt : 1u;
}
__device__ __forceinline__ void xcd_barrier(const XcdBarrier& b) {
    asm volatile("s_waitcnt vmcnt(0)" ::: "memory");
    __syncthreads();
    if (threadIdx.x == 0) {
        unsigned* bar = b.bar;
        __builtin_amdgcn_s_waitcnt(0);
        unsigned nloc = b.st[0], nx = b.st[1];
        if (nloc == 0u) { xcd_barrier_complete(bar, b.x, nloc, nx); b.st[0] = nloc; b.st[1] = nx; }
        const unsigned old = xb_add(&bar[XB_XSUB(b.x)], 1u);
        const unsigned gen = old / nloc;
        if (old + 1u == (gen + 1u) * nloc) {
            __builtin_amdgcn_fence(__ATOMIC_RELEASE, "agent");
            asm volatile("s_waitcnt vmcnt(0)" ::: "memory");
            const unsigned og = xb_add(&bar[XB_TOP], 1u);
            const unsigned tg = og / nx;
            if (og + 1u == (tg + 1u) * nx) xb_add(&bar[XB_TOPGEN], 1u);
            else XB_SPIN(xb_ld(&bar[XB_TOPGEN]) == tg, bar);
            __builtin_amdgcn_fence(__ATOMIC_ACQUIRE, "agent");
            xb_add(&bar[XB_XGEN(b.x)], 1u);
            asm volatile("s_waitcnt vmcnt(0)" ::: "memory");
        } else {
            XB_SPIN(xb_ld(&bar[XB_XGEN(b.x)]) == gen, bar);
            __builtin_amdgcn_fence(__ATOMIC_ACQUIRE, "agent");
            asm volatile("s_waitcnt vmcnt(0)" ::: "memory");
        }
    }
    __syncthreads();
}

namespace pg8 {
constexpr int BM = 256, BK = 64, HALF = 128, HTB = HALF * BK * 2, NXCD = 8, WGM = 8;
__host__ __device__ __forceinline__ int lds_byte(int r, int c) { const int st = (r >> 4) * 2 + (c >> 5), rr = r & 15, cc = c & 31, ob = rr * 64 + cc * 2; return st * 1024 + (ob ^ (((ob >> 9) & 1) << 5)); }
__host__ __device__ __forceinline__ void stage_rc(int b, int& R, int& C) { const int st = b / 1024, sb = b % 1024, swz = sb ^ (((sb >> 9) & 1) << 5); R = (st >> 1) * 16 + swz / 64; C = (st & 1) * 32 + (swz % 64) / 2; }
__host__ __device__ __forceinline__ int perm32(int rho) { const int n = rho >> 4, i = rho & 15; return 8 * (i >> 2) + 4 * n + (i & 3); }
struct Unit { int pm, pn, kind; };
struct GridMap {
    int nM, nN, nwg;
    __device__ __forceinline__ void init(int nM_, int nN_) { nM = nM_; nN = nN_; nwg = nM_ * nN_; }
    __device__ __forceinline__ void map(int L, int& pm, int& pn) const {
        int wgid = L; { const int q = nwg / NXCD, r = nwg % NXCD, xcd = wgid % NXCD, off = wgid / NXCD; wgid = (xcd < r ? xcd * (q + 1) : r * (q + 1) + (xcd - r) * q) + off; }
        const int nig = WGM * nN, gid = wgid / nig, fm = gid * WGM, gsz = (nM - fm) < WGM ? (nM - fm) : WGM;
        pm = fm + ((wgid % nig) % gsz); pn = (wgid % nig) / gsz;
    }
};
template <bool GATHER = false, class Epi, class Sched>
__device__ __forceinline__ void gemm_phase(LAS unsigned char* lds, const int wv, const int K, const Sched& S, const Epi& E) {
    const int tid = opaque_tid(wv), wid = __builtin_amdgcn_readfirstlane(tid >> 6), lane = tid & 63, wr = wid >> 2, wc = wid & 3, fr = lane & 15, fq = lane >> 4;
    int nt = K / BK;
    unsigned voffA[2], voffB[2]; int RA[2];
#pragma unroll
    for (int i = 0; i < 2; ++i) { int R, C; stage_rc(tid * 16 + i * 8192, R, C); const int Rb = (R & ~31) + perm32(R & 31); RA[i] = R;
        voffA[i] = GATHER ? (unsigned)C * 2u : (unsigned)(R * K + C) * 2u; voffB[i] = (unsigned)(Rb * K + C) * 2u; }
    unsigned gC[2][2] = {{0u, 0u}, {0u, 0u}}, gN[2][2] = {{0u, 0u}, {0u, 0u}};
    const size_t kstep = (size_t)(BK * 2);
    const size_t hstep = (size_t)HALF * K * 2;
    const unsigned ldsw = (unsigned)wid * 1024u;
    const int aoff = lds_byte(wr * 64 + fr, fq * 8), boff = lds_byte(wc * 32 + fr, fq * 8);
#define PG8_SA(b, h) (((b) * 2 + (h)) * HTB)
#define PG8_SB(b, h) ((4 + (b) * 2 + (h)) * HTB)
#define PG8_STAGE(bufoff, gbase, voff) do { _Pragma("unroll") for (int _i = 0; _i < 2; ++_i) \
        __builtin_amdgcn_global_load_lds((const unsigned*)((const char*)(gbase) + (voff)[_i]), (LAS unsigned*)(lds + (bufoff) + ldsw + _i * 8192), 16, 0, 0); } while (0)
#define PG8_STAGE2(bufoff, gbase, o0, o1) do { \
        __builtin_amdgcn_global_load_lds((const unsigned*)((const char*)(gbase) + (o0)), (LAS unsigned*)(lds + (bufoff) + ldsw), 16, 0, 0); \
        __builtin_amdgcn_global_load_lds((const unsigned*)((const char*)(gbase) + (o1)), (LAS unsigned*)(lds + (bufoff) + ldsw + 8192), 16, 0, 0); } while (0)
#define PG8_LDA(dst, b, h) do { _Pragma("unroll") for (int m = 0; m < 4; ++m) _Pragma("unroll") for (int k = 0; k < 2; ++k) dst[m][k] = *(const LAS bf16x8*)(lds + PG8_SA(b, h) + aoff + m * 2048 + k * 1024); } while (0)
#define PG8_LDB(dst, b, h) do { _Pragma("unroll") for (int n = 0; n < 2; ++n) _Pragma("unroll") for (int k = 0; k < 2; ++k) dst[n][k] = *(const LAS bf16x8*)(lds + PG8_SB(b, h) + boff + n * 2048 + k * 1024); } while (0)
#define PG8_MMA(ai, bj, At, Bt) do { __builtin_amdgcn_s_setprio(1); _Pragma("unroll") for (int m = 0; m < 4; ++m) _Pragma("unroll") for (int n = 0; n < 2; ++n) _Pragma("unroll") for (int k = 0; k < 2; ++k) \
        acc[ai][bj][m][n] = __builtin_amdgcn_mfma_f32_16x16x32_bf16(Bt[n][k], At[m][k], acc[ai][bj][m][n], 0, 0, 0); __builtin_amdgcn_s_setprio(0); } while (0)
#define PG8_WAIT_V(n) asm volatile("s_waitcnt vmcnt(" #n ")" ::: "memory")
#define PG8_WAIT_L(n) asm volatile("s_waitcnt lgkmcnt(" #n ")" ::: "memory")
#define PG8_BAR __builtin_amdgcn_s_barrier()
#define PG8_SCHED __builtin_amdgcn_sched_barrier(0)
#define PG8_ITER(t) do { \
            const bool last = (t == nt - 2); \
            const char* a1 = cA + (size_t)(t + 1) * kstep; \
            const char* a2 = (last ? nA : cA + (size_t)(t + 2) * kstep); const char* b2 = last ? nB : cB + (size_t)(t + 2) * kstep; \
            const char* a3 = a2 + kstep; const char* b3 = b2 + kstep; \
            unsigned s00 = 0u, s01 = 0u, s10 = 0u, s11 = 0u; \
            if constexpr (GATHER) { s00 = last ? gN[0][0] : gC[0][0]; s01 = last ? gN[0][1] : gC[0][1]; s10 = last ? gN[1][0] : gC[1][0]; s11 = last ? gN[1][1] : gC[1][1]; } \
            PG8_LDB(B0, 0, 0); PG8_LDB(B1, 0, 1); PG8_SCHED; PG8_LDA(At, 0, 0); \
            if constexpr (GATHER) PG8_STAGE2(PG8_SA(1, 1), a1, gC[1][0], gC[1][1]); else PG8_STAGE(PG8_SA(1, 1), a1 + hstep, voffA); \
            PG8_WAIT_V(8); \
            PG8_WAIT_L(0); PG8_BAR; PG8_MMA(0, 0, At, B0); PG8_MMA(0, 1, At, B1); PG8_BAR; PG8_SCHED; \
            PG8_LDA(At, 0, 1); PG8_STAGE(PG8_SB(0, 0), b2, voffB); PG8_STAGE(PG8_SB(0, 1), b2 + hstep, voffB); \
            if constexpr (GATHER) PG8_STAGE2(PG8_SA(0, 0), a2, s00, s01); else PG8_STAGE(PG8_SA(0, 0), a2, voffA); \
            PG8_WAIT_V(8); \
            PG8_WAIT_L(0); PG8_BAR; PG8_MMA(1, 0, At, B0); PG8_MMA(1, 1, At, B1); PG8_BAR; PG8_SCHED; \
            PG8_LDB(B0, 1, 0); PG8_LDB(B1, 1, 1); PG8_SCHED; PG8_LDA(At, 1, 0); \
            if constexpr (GATHER) PG8_STAGE2(PG8_SA(0, 1), a2, s10, s11); else PG8_STAGE(PG8_SA(0, 1), a2 + hstep, voffA); \
            PG8_WAIT_V(8); PG8_WAIT_L(0); PG8_BAR; PG8_MMA(0, 0, At, B0); PG8_MMA(0, 1, At, B1); PG8_BAR; PG8_SCHED; \
            PG8_LDA(At, 1, 1); PG8_STAGE(PG8_SB(1, 0), b3, voffB); PG8_STAGE(PG8_SB(1, 1), b3 + hstep, voffB); \
            if constexpr (GATHER) PG8_STAGE2(PG8_SA(1, 0), a3, s00, s01); else PG8_STAGE(PG8_SA(1, 0), a3, voffA); \
            PG8_WAIT_V(8); PG8_WAIT_L(0); PG8_BAR; PG8_MMA(1, 0, At, B0); PG8_MMA(1, 1, At, B1); PG8_BAR; PG8_SCHED; \
        } while (0)
    Unit cur, nxt; int ui = 0;
    if (!S.next(0, cur)) return;
#if GEMM_STAGGER
    if (blockIdx.x & 1) { const unsigned long long t0s = __builtin_amdgcn_s_memrealtime(); const unsigned long long dl = ((unsigned long long)K * GEMM_STAGGER) >> 4;
        while (__builtin_amdgcn_s_memrealtime() - t0s < dl) __builtin_amdgcn_s_sleep(16); }
#endif
    f32x4 acc[2][2][4][2];
#pragma unroll
    for (int a = 0; a < 2; ++a)
#pragma unroll
        for (int b = 0; b < 2; ++b)
#pragma unroll
            for (int m = 0; m < 4; ++m)
#pragma unroll
                for (int n = 0; n < 2; ++n) acc[a][b][m][n] = (f32x4){0.f, 0.f, 0.f, 0.f};
    bf16x8 At[4][2], B0[2][2], B1[2][2];
    const char* cA = S.abase(cur); const char* cB = S.bbase(cur);
    if constexpr (Sched::VAR_NT) nt = S.ktiles(cur);
    if constexpr (GATHER) {
#pragma unroll
        for (int h = 0; h < 2; ++h)
#pragma unroll
            for (int i = 0; i < 2; ++i) gC[h][i] = S.grow(cur, h * HALF + RA[i]) + voffA[i];
    }
    PG8_STAGE(PG8_SB(0, 0), cB, voffB); PG8_STAGE(PG8_SB(0, 1), cB + hstep, voffB);
    if constexpr (GATHER) { PG8_STAGE2(PG8_SA(0, 0), cA, gC[0][0], gC[0][1]); PG8_STAGE2(PG8_SA(0, 1), cA, gC[1][0], gC[1][1]); }
    else { PG8_STAGE(PG8_SA(0, 0), cA, voffA); PG8_STAGE(PG8_SA(0, 1), cA + hstep, voffA); }
    if (wr == 1) PG8_BAR;
    PG8_WAIT_V(2); PG8_BAR;
    PG8_STAGE(PG8_SB(1, 0), cB + kstep, voffB);
    if constexpr (GATHER) PG8_STAGE2(PG8_SA(1, 0), cA + kstep, gC[0][0], gC[0][1]); else PG8_STAGE(PG8_SA(1, 0), cA + kstep, voffA);
    PG8_STAGE(PG8_SB(1, 1), cB + hstep + kstep, voffB);
    PG8_WAIT_V(6); PG8_BAR;
    for (;;) {
        const bool has_next = S.next(ui + 1, nxt);
        const char* nA = has_next ? S.abase(nxt) : cA; const char* nB = has_next ? S.bbase(nxt) : cB;
        if constexpr (GATHER) {
#pragma unroll
            for (int h = 0; h < 2; ++h)
#pragma unroll
                for (int i = 0; i < 2; ++i) gN[h][i] = has_next ? S.grow(nxt, h * HALF + RA[i]) + voffA[i] : gC[h][i];
        }
        for (int t = 0; t < nt; t += 2) PG8_ITER(t);
        if (PG8_ALIGN) { if (wr == 0) PG8_BAR; }
#if PROBE_MASK
        const unsigned long long _te0 = __builtin_amdgcn_s_memrealtime();
#endif
        bool keep = false;
        if constexpr (Epi::CHAINED) { if (cur.kind == 0) { E.mid(acc, cur, wr, wc, fr, fq); keep = true; } else E(acc, cur, wr, wc, fr, fq); } else E(acc, cur, wr, wc, fr, fq);
#if PROBE_MASK
        if (blockIdx.x == 0 && tid == 0) { asm volatile("s_waitcnt vmcnt(0)" ::: "memory"); volatile LAS unsigned long long* pacc = (volatile LAS unsigned long long*)(lds + LDS_CTRL + 64) + 21; *pacc = *pacc + (__builtin_amdgcn_s_memrealtime() - _te0); }
#endif
        if (!has_next) break;
        if (!keep) {
#pragma unroll
        for (int a = 0; a < 2; ++a)
#pragma unroll
            for (int b = 0; b < 2; ++b)
#pragma unroll
                for (int m = 0; m < 4; ++m)
#pragma unroll
                    for (int n = 0; n < 2; ++n) acc[a][b][m][n] = (f32x4){0.f, 0.f, 0.f, 0.f};
        }
        cur = nxt; cA = nA; cB = nB; ++ui;
        if constexpr (Sched::VAR_NT) nt = S.ktiles(cur);
        if constexpr (GATHER) { gC[0][0] = gN[0][0]; gC[0][1] = gN[0][1]; gC[1][0] = gN[1][0]; gC[1][1] = gN[1][1]; }
        if (PG8_ALIGN) { if (wr == 1) PG8_BAR; }
    }
    PG8_WAIT_V(0);
    if (!PG8_ALIGN) { if (wr == 0) PG8_BAR; }
    PG8_BAR;
#undef PG8_SA
#undef PG8_SB
#undef PG8_STAGE
#undef PG8_STAGE2
#undef PG8_ITER
#undef PG8_LDA
#undef PG8_LDB
#undef PG8_MMA
#undef PG8_WAIT_V
#undef PG8_WAIT_L
#undef PG8_BAR
#undef PG8_SCHED
}
}
using pg8::Unit;
typedef const f32x4 (&AccRef)[2][2][4][2];

struct Frame {
    LAS unsigned char* lds;
    unsigned char* ws;
    unsigned* ctl;
    const float* const* in;
    float* out;
    int tid, lane, wave, vcu, G, wave0;
};

#if ROW_NT
#define RLD(p) __builtin_nontemporal_load(p)
#define RST(p, v) __builtin_nontemporal_store((v), (p))
#else
#define RLD(p) (*(p))
#define RST(p, v) (*(p) = (v))
#endif
#ifndef EPI_NT
#define EPI_NT 0u
#endif
template <unsigned BIT, class T> __device__ __forceinline__ void epi_st(T* p, const T v) { if constexpr ((EPI_NT & BIT) != 0u) __builtin_nontemporal_store(v, p); else *p = v; }
constexpr size_t TS1024 = (size_t)256 * 1024 * 2;

struct ZSched {
    static constexpr bool VAR_NT = false;
    int G, c, last, n0, n1; const char *H, *WZ, *WV; pg8::GridMap g0, g1, g2;
    __device__ __forceinline__ void init(int G_, int c_, int last_, const void* H_, const void* WZ_, const void* WV_) {
        G = G_; c = c_; last = last_; H = (const char*)H_; WZ = (const char*)WZ_; WV = (const char*)WV_;
        if (last) { g0.init(256, 18); g1.init(32, 4); } else { g0.init(NRT, 18); g1.init(0, 4); }
        g2.init(4, NRT); n0 = g0.nwg; n1 = g1.nwg;
    }
    __device__ __forceinline__ bool next(int i, Unit& u) const {
        int L = i * G + c, a, b;
        if (L < n0) { g0.map(L, a, b); u.kind = 0; u.pm = last ? (a >> 3) * 9 + 1 + (a & 7) : a; u.pn = b; return true; }
        L -= n0;
        if (L < n1) { g1.map(L, a, b); u.kind = 0; u.pm = a * 9; u.pn = 6 + b; return true; }
        L -= n1;
        if (L < g2.nwg) { g2.map(L, a, b); u.kind = 1; u.pm = a; u.pn = b; return true; }
        return false;
    }
    __device__ __forceinline__ const char* abase(const Unit& u) const { return (u.kind ? WV : H) + (size_t)u.pm * TS1024; }
    __device__ __forceinline__ const char* bbase(const Unit& u) const { return (u.kind ? H : WZ) + (size_t)u.pn * TS1024; }
};
struct ZEpi {
    static constexpr bool CHAINED = false;
    bf16_t *U, *Q, *KB; unsigned char* G; bf16_t* VT; const float *COS, *SIN;
    __device__ __forceinline__ void operator()(AccRef acc, const Unit& u, int wr, int wc, int fr, int fq) const {
        if (u.kind == 1) {
            const int b = u.pn / 9, jt = u.pn - b * 9;
            bf16_t* base = VT + ((size_t)b * 1024 + u.pm * 256 + wr * 64 + fr) * LTOK + jt * 256 + wc * 32 + 8 * fq;
#pragma unroll
            for (int ai = 0; ai < 2; ++ai)
#pragma unroll
                for (int m = 0; m < 4; ++m) { bf16_t* rowp = base + (size_t)(ai * 128 + m * 16) * LTOK;
#pragma unroll
                    for (int bj = 0; bj < 2; ++bj) epi_st<1u>((u32x4*)(rowp + bj * 128), pack8(acc[ai][bj][m][0], acc[ai][bj][m][1])); }
            return;
        }
        const int pn = u.pn; const size_t row0 = (size_t)u.pm * 256 + wr * 64 + fr; const int cin = wc * 32 + 8 * fq;
        if (pn < 2) {
#pragma unroll
            for (int ai = 0; ai < 2; ++ai)
#pragma unroll
                for (int m = 0; m < 4; ++m) { bf16_t* rowp = U + (row0 + ai * 128 + m * 16) * 512 + pn * 256 + cin;
#pragma unroll
                    for (int bj = 0; bj < 2; ++bj) epi_st<2u>((u32x4*)(rowp + bj * 128), pack8(acc[ai][bj][m][0], acc[ai][bj][m][1])); }
        } else if (pn < 10) {
            const bool isq = pn < 6; bf16_t* dst = isq ? Q : KB; const int ct = isq ? pn - 2 : pn - 6; const float sc = isq ? QSCALE : 1.f;
            const int jt = u.pm % 9; const bool lat = jt != 0; const int axis = wc & 1;
#pragma unroll
            for (int ai = 0; ai < 2; ++ai) {
                f32x4 c4[4], s4[4];
#pragma unroll
                for (int m = 0; m < 4; ++m) { const int pos = axis ? (16 * m + fr) : (((jt - 1) * 4 + 2 * ai + wr) & 63);
                    c4[m] = *(const f32x4*)(COS + pos * 16 + 4 * fq); s4[m] = *(const f32x4*)(SIN + pos * 16 + 4 * fq);
                    if (!lat) { c4[m] = (f32x4){1.f, 1.f, 1.f, 1.f}; s4[m] = (f32x4){0.f, 0.f, 0.f, 0.f}; } }
                asm volatile("" ::: "memory");
#pragma unroll
                for (int m = 0; m < 4; ++m) {
                    bf16_t* rowp = dst + (row0 + ai * 128 + m * 16) * 1024 + ct * 256 + cin;
#pragma unroll
                    for (int bj = 0; bj < 2; ++bj) { const f32x4 a = acc[ai][bj][m][0], b = acc[ai][bj][m][1];
                        const f32x4 ra = (a * c4[m] - b * s4[m]) * sc, rb = (a * s4[m] + b * c4[m]) * sc;
                        epi_st<4u>((u32x4*)(rowp + bj * 128), pack8(ra, rb)); }
                }
                asm volatile("" ::: "memory");
            }
        } else {
            const int ct = pn - 10;
#pragma unroll
            for (int ai = 0; ai < 2; ++ai)
#pragma unroll
                for (int m = 0; m < 4; ++m) { unsigned char* rowp = G + (row0 + ai * 128 + m * 16) * 2048 + ct * 256 + cin;
#pragma unroll
                    for (int bj = 0; bj < 2; ++bj) { const f32x4 a = acc[ai][bj][m][0], b = acc[ai][bj][m][1]; u32x2 o; o.x = 0u; o.y = 0u;
#pragma unroll
                        for (int j = 0; j < 4; ++j) { o.x = __builtin_amdgcn_cvt_pk_u8_f32(__builtin_rintf(fast_sigmoid(a[j]) * 255.f), j, o.x); o.y = __builtin_amdgcn_cvt_pk_u8_f32(__builtin_rintf(fast_sigmoid(b[j]) * 255.f), j, o.y); }
                        epi_st<8u>((u32x2*)(rowp + bj * 128), o); } }
        }
    }
};

struct PlainSched {
    static constexpr bool VAR_NT = false;
    int G, c, latonly, rev; const char *A, *B; size_t ats, bts; pg8::GridMap g;
    __device__ __forceinline__ void init(int G_, int c_, int latonly_, int nN, const void* A_, const void* B_, int K, int rev_ = 0) {
        G = G_; c = c_; latonly = latonly_; rev = rev_; A = (const char*)A_; B = (const char*)B_; ats = bts = (size_t)256 * K * 2; g.init(latonly_ ? 256 : NRT, nN);
    }
    __device__ __forceinline__ bool next(int i, Unit& u) const {
        int L = i * G + c; if (L >= g.nwg) return false; if (rev) L = g.nwg - 1 - L; int a, b; g.map(L, a, b);
        u.kind = 0; u.pm = latonly ? (a >> 3) * 9 + 1 + (a & 7) : a; u.pn = b; return true;
    }
    __device__ __forceinline__ const char* abase(const Unit& u) const { return A + (size_t)u.pm * ats; }
    __device__ __forceinline__ const char* bbase(const Unit& u) const { return B + (size_t)u.pn * bts; }
};
struct MergeSched {
    static constexpr bool VAR_NT = true;
    int G, c, latonly; const char *A, *B; pg8::GridMap g;
    __device__ __forceinline__ void init(int G_, int c_, int latonly_, const void* A_, const void* B_) { G = G_; c = c_; latonly = latonly_; A = (const char*)A_; B = (const char*)B_; g.init(latonly_ ? 256 : NRT, 4); }
    __device__ __forceinline__ bool next(int i, Unit& u) const {
        const int L = (i >> 1) * G + c; if (L >= g.nwg) return false; int a, b; g.map(L, a, b);
        u.kind = i & 1; u.pm = latonly ? (a >> 3) * 9 + 1 + (a & 7) : a; u.pn = b; return true;
    }
    __device__ __forceinline__ int ktiles(const Unit& u) const { return u.kind ? 16 : 8; }
    __device__ __forceinline__ const char* abase(const Unit& u) const { return A + (size_t)u.pm * ((size_t)256 * MAP * 2) + (u.kind ? 1024 : 0); }
    __device__ __forceinline__ const char* bbase(const Unit& u) const { return B + (size_t)u.pn * ((size_t)256 * MAP * 2) + (u.kind ? 1024 : 0); }
};
__device__ __forceinline__ void unpack8(const u32x4 w, f32x4& a, f32x4& b) { a = (f32x4){bflo(w.x), bfhi(w.x), bflo(w.y), bfhi(w.y)}; b = (f32x4){bflo(w.z), bfhi(w.z), bflo(w.w), bfhi(w.w)}; }
__device__ __forceinline__ f32x4 ub4(unsigned w) { return (f32x4){(float)(w & 255u), (float)((w >> 8) & 255u), (float)((w >> 16) & 255u), (float)(w >> 24)}; }
struct MergeEpi {
    static constexpr bool CHAINED = true;
    bf16_t* O; const unsigned char* Gt;
    __device__ __forceinline__ void mid(f32x4 (&acc)[2][2][4][2], const Unit& u, int wr, int wc, int fr, int fq) const {
        const unsigned loff = (unsigned)((wr * 64 + fr) * 2048 + wc * 32 + 8 * fq);
#pragma unroll
        for (int ai = 0; ai < 2; ++ai) {
            u32x2 wp[4][2], wa[4][2];
#pragma unroll
            for (int m = 0; m < 4; ++m) { const unsigned char* gp = Gt + (size_t)(u.pm * 256 + ai * 128 + m * 16) * 2048 + u.pn * 256;
#pragma unroll
                for (int bj = 0; bj < 2; ++bj) { wp[m][bj] = *(const u32x2*)(gp + loff + bj * 128); wa[m][bj] = *(const u32x2*)(gp + loff + 1024 + bj * 128); } }
#pragma unroll
            for (int m = 0; m < 4; ++m)
#pragma unroll
                for (int bj = 0; bj < 2; ++bj) { const f32x4 p0 = ub4(wp[m][bj].x), p1 = ub4(wp[m][bj].y), a0 = ub4(wa[m][bj].x), a1 = ub4(wa[m][bj].y);
#pragma unroll
                    for (int j = 0; j < 4; ++j) { acc[ai][bj][m][0][j] *= p0[j] * __builtin_amdgcn_rcpf(fmaxf(a0[j], 1e-9f)); acc[ai][bj][m][1][j] *= p1[j] * __builtin_amdgcn_rcpf(fmaxf(a1[j], 1e-9f)); } }
        }
    }
    __device__ __forceinline__ void operator()(AccRef acc, const Unit& u, int wr, int wc, int fr, int fq) const {
        const unsigned cpart = (unsigned)(wc * 32 + 8 * fq), rpart = (unsigned)((wr * 64 + fr) * 2048);
        const unsigned loffg = rpart + cpart, loffy = rpart + 2u * cpart;
        u32x2 wa[2][4][2];
#pragma unroll
        for (int ai = 0; ai < 2; ++ai)
#pragma unroll
            for (int m = 0; m < 4; ++m) { const unsigned char* gp = Gt + (size_t)(u.pm * 256 + ai * 128 + m * 16) * 2048 + 1024 + u.pn * 256;
#pragma unroll
                for (int bj = 0; bj < 2; ++bj) wa[ai][m][bj] = *(const u32x2*)(gp + loffg + bj * 128); }
        asm volatile("" ::: "memory");
#pragma unroll
        for (int ai = 0; ai < 2; ++ai)
#pragma unroll
            for (int m = 0; m < 4; ++m) { char* op = (char*)(O + (size_t)(u.pm * 256 + ai * 128 + m * 16) * 1024 + u.pn * 256);
#pragma unroll
                for (int bj = 0; bj < 2; ++bj) { f32x4 a0 = ub4(wa[ai][m][bj].x), a1 = ub4(wa[ai][m][bj].y);
#pragma unroll
                    for (int j = 0; j < 4; ++j) { a0[j] = fmaxf(a0[j], 1e-9f) * (1.f / 255.f); a1[j] = fmaxf(a1[j], 1e-9f) * (1.f / 255.f); }
                    epi_st<16u>((u32x4*)(op + loffy + bj * 256), pack8(a0 * acc[ai][bj][m][0], a1 * acc[ai][bj][m][1])); } }
    }
};
struct ResEpi {
    static constexpr bool CHAINED = false;
    const float *latsrc, *ctxsrc; float *latdst, *ctxdst; const float* mod; int goff;
    __device__ __forceinline__ void operator()(AccRef acc, const Unit& u, int wr, int wc, int fr, int fq) const {
        const int b = u.pm / 9, jt = u.pm - b * 9;
        const size_t rb = jt ? ((size_t)b * SEQ + (jt - 1) * 256) : (size_t)b * CTXL;
        const float* src = (jt ? latsrc : ctxsrc) + (rb + wr * 64 + fr) * D; float* dst = (jt ? latdst : ctxdst) + (rb + wr * 64 + fr) * D;
        const float* gate = mod + (size_t)(jt ? b : 32) * MODW + goff;
        const int col0 = u.pn * 256 + wc * 32 + 8 * fq;
        f32x4 gv[2][2];
#pragma unroll
        for (int bj = 0; bj < 2; ++bj)
#pragma unroll
            for (int n = 0; n < 2; ++n) gv[bj][n] = *(const f32x4*)(gate + col0 + bj * 128 + 4 * n);
#pragma unroll
        for (int ai = 0; ai < 2; ++ai) {
            f32x4 x[4][2][2];
#pragma unroll
            for (int m = 0; m < 4; ++m)
#pragma unroll
                for (int bj = 0; bj < 2; ++bj)
#pragma unroll
                    for (int n = 0; n < 2; ++n) x[m][bj][n] = *(const f32x4*)(src + (size_t)(ai * 128 + m * 16) * D + col0 + bj * 128 + 4 * n);
            asm volatile("" ::: "memory");
#pragma unroll
            for (int m = 0; m < 4; ++m)
#pragma unroll
                for (int bj = 0; bj < 2; ++bj)
#pragma unroll
                    for (int n = 0; n < 2; ++n) epi_st<32u>((f32x4*)(dst + (size_t)(ai * 128 + m * 16) * D + col0 + bj * 128 + 4 * n), x[m][bj][n] + gv[bj][n] * acc[ai][bj][m][n]);
            asm volatile("" ::: "memory");
        }
    }
};
struct OEpi {
    static constexpr bool CHAINED = false;
    bf16_t* O; const float* mod; int goff;
    __device__ __forceinline__ void operator()(AccRef acc, const Unit& u, int wr, int wc, int fr, int fq) const {
        const int b = u.pm / 9, jt = u.pm - b * 9;
        const float* gate = mod + (size_t)(jt ? b : 32) * MODW + goff;
        const int col0 = u.pn * 256 + wc * 32 + 8 * fq;
        f32x4 gv[2][2];
#pragma unroll
        for (int bj = 0; bj < 2; ++bj)
#pragma unroll
            for (int n = 0; n < 2; ++n) gv[bj][n] = *(const f32x4*)(gate + col0 + bj * 128 + 4 * n);
        asm volatile("" ::: "memory");
        bf16_t* base = O + ((size_t)u.pm * 256 + wr * 64 + fr) * D + col0;
#pragma unroll
        for (int ai = 0; ai < 2; ++ai)
#pragma unroll
            for (int m = 0; m < 4; ++m)
#pragma unroll
                for (int bj = 0; bj < 2; ++bj) epi_st<32u>((u32x4*)(base + (size_t)(ai * 128 + m * 16) * D + bj * 128), pack8(gv[bj][0] * acc[ai][bj][m][0], gv[bj][1] * acc[ai][bj][m][1]));
    }
};
struct UpEpi {
    static constexpr bool CHAINED = false;
    bf16_t* O; int ld;
    __device__ __forceinline__ void operator()(AccRef acc, const Unit& u, int wr, int wc, int fr, int fq) const {
        const size_t row0 = (size_t)u.pm * 256 + wr * 64 + fr; const int col0 = u.pn * 128 + wc * 32 + 8 * fq;
#pragma unroll
        for (int ai = 0; ai < 2; ++ai)
#pragma unroll
            for (int m = 0; m < 4; ++m) { f32x4 v[2];
#pragma unroll
                for (int n = 0; n < 2; ++n) { const f32x4 g = acc[ai][0][m][n], w = acc[ai][1][m][n];
#pragma unroll
                    for (int j = 0; j < 4; ++j) v[n][j] = g[j] * fast_sigmoid(g[j]) * w[j]; }
                epi_st<64u>((u32x4*)(O + (row0 + ai * 128 + m * 16) * ld + col0), pack8(v[0], v[1])); }
    }
};
struct MoeInfo {
    int cnt[NE], tb[NE + 1];
    __device__ __forceinline__ void load(const unsigned* cw) {
        int t = 0;
#pragma unroll
        for (int e = 0; e < NE; ++e) { const int c = __builtin_amdgcn_readfirstlane((int)__hip_atomic_load(cw + CW_CNT + 64 * e, __ATOMIC_RELAXED, __HIP_MEMORY_SCOPE_AGENT)); cnt[e] = c; tb[e] = t; t += (c + 255) >> 8; }
        tb[NE] = t;
    }
    __device__ __forceinline__ void lookup(int rt, int& e, int& t0, int& ce) const { e = 0; t0 = 0; ce = cnt[0];
#pragma unroll
        for (int k = 1; k < NE; ++k) { const bool ge = rt >= tb[k]; e = ge ? k : e; t0 = ge ? tb[k] : t0; ce = ge ? cnt[k] : ce; } }
};
struct MoeSched {
    static constexpr bool VAR_NT = false;
    int G, c, nN, gather, rev; const char *A, *B; const unsigned* LIST; size_t ats, bts, bes; MoeInfo mi; pg8::GridMap g;
    __device__ __forceinline__ void init(int G_, int c_, int nN_, const void* A_, const void* B_, int K, int Nrows, const MoeInfo& mi_) {
        G = G_; c = c_; nN = nN_; gather = 0; rev = 0; LIST = nullptr; A = (const char*)A_; B = (const char*)B_; ats = bts = (size_t)256 * K * 2; bes = (size_t)Nrows * K * 2; mi = mi_; g.init(mi_.tb[NE], nN_);
    }
    __device__ __forceinline__ bool next(int i, Unit& u) const {
        int L = i * G + c; if (L >= g.nwg) return false; if (rev) L = g.nwg - 1 - L; int a, b; g.map(L, a, b); u.pm = a; u.pn = b; int t0, ce; mi.lookup(a, u.kind, t0, ce); return true;
    }
    __device__ __forceinline__ const char* abase(const Unit& u) const { return gather ? A : A + (size_t)u.pm * ats; }
    __device__ __forceinline__ const char* bbase(const Unit& u) const { return B + (size_t)u.kind * bes + (size_t)u.pn * bts; }
    __device__ __forceinline__ unsigned grow(const Unit& u, int row) const { int e, t0, ce; mi.lookup(u.pm, e, t0, ce); const int slot = (u.pm - t0) * 256 + row;
        unsigned tok = 0u; if (slot < ce) tok = LIST[(size_t)e * NLAT + slot] >> 1;
        return ((tok >> 11) * (unsigned)LTOK + (unsigned)CTXL + (tok & 2047u)) * (unsigned)(D * 2); }
};
struct MoeDownEpi {
    static constexpr bool CHAINED = false;
    bf16_t* YM; const unsigned* LIST; const float* WTS; MoeInfo mi;
    __device__ __forceinline__ void operator()(AccRef acc, const Unit& u, int wr, int wc, int fr, int fq) const {
        int e, t0, ce; mi.lookup(u.pm, e, t0, ce); const int slot0 = (u.pm - t0) * 256 + wr * 64 + fr;
        const int col0 = u.pn * 256 + wc * 32 + 8 * fq;
        unsigned ent[2][4]; float wt[2][4];
#pragma unroll
        for (int ai = 0; ai < 2; ++ai)
#pragma unroll
            for (int m = 0; m < 4; ++m) { const int slot = slot0 + ai * 128 + m * 16; ent[ai][m] = slot < ce ? LIST[(size_t)e * NLAT + slot] : 0xffffffffu; }
#pragma unroll
        for (int ai = 0; ai < 2; ++ai)
#pragma unroll
            for (int m = 0; m < 4; ++m) wt[ai][m] = ent[ai][m] != 0xffffffffu ? WTS[ent[ai][m]] : 0.f;
        asm volatile("" ::: "memory");
#pragma unroll
        for (int ai = 0; ai < 2; ++ai)
#pragma unroll
            for (int m = 0; m < 4; ++m) {
                if (ent[ai][m] != 0xffffffffu) { const unsigned en = ent[ai][m]; const float w8 = wt[ai][m];
                    bf16_t* rowp = YM + ((size_t)(en & 1u) * NLAT + (en >> 1)) * D + col0;
#pragma unroll
                    for (int bj = 0; bj < 2; ++bj) epi_st<128u>((u32x4*)(rowp + bj * 128), pack8(acc[ai][bj][m][0] * w8, acc[ai][bj][m][1] * w8)); } }
    }
};

namespace att {
constexpr int BUFB = 32768, EXCH = 65536;
constexpr float THR = 6.f;
#define ATT_SBAR() __builtin_amdgcn_sched_barrier(0)
#define ATT_MFMA(a, b, c) __builtin_amdgcn_mfma_f32_32x32x16_bf16(a, b, c, 0, 0, 0)
#define ATT_SYNC() asm volatile("s_waitcnt vmcnt(0) lgkmcnt(0)\n\ts_barrier" ::: "memory")
__device__ __forceinline__ void attn_unit(LAS unsigned char* lds, const bf16_t* Q, const bf16_t* K, const bf16_t* VT, bf16_t* AY, int b, int h, size_t qrow0, int nkt, float lam, float osc, const float* subg,
                                          bf16x8 (&qf)[4], bool first, bool has_next, int nb, int nh, size_t nqrow0, int wv) {
    const int tid = opaque_tid(wv), lane = tid & 63, ql = lane & 31, hh = lane >> 5; const int w = __builtin_amdgcn_readfirstlane(tid >> 6); const int map = w >> 2, qb = w & 3;
    const size_t qrow = qrow0 + 32 * qb + ql;
    if (ATT_PRIO && w >= 4) __builtin_amdgcn_s_setprio(1);
#if PROBE_MASK
    unsigned long long att_wait = 0, att_b = 0, att_a = 0;
#endif
    if (first) {
#pragma unroll
        for (int ks = 0; ks < 4; ++ks) qf[ks] = *(const bf16x8*)(Q + qrow * 1024 + (h * 2 + map) * 64 + 16 * ks + 8 * hh);
    }
    const int prow = lane >> 3, pc = lane & 7;
    const int krow = 8 * w + prow, kc = pc ^ ((krow >> 1) & 7);
    const bf16_t* ksrc0 = K + ((size_t)b * LTOK + krow) * 1024 + (h * 2) * 64 + kc * 8;
    const bf16_t* ksrc1 = ksrc0 + 64;
    const int e0 = 16 * w + prow, e1 = e0 + 8;
    const bf16_t* vsrc0 = VT + ((size_t)b * 1024 + h * 128 + e0) * LTOK + (pc ^ ((e0 >> 1) & 7)) * 8;
    const bf16_t* vsrc1 = VT + ((size_t)b * 1024 + h * 128 + e1) * LTOK + (pc ^ ((e1 >> 1) & 7)) * 8;
#define ATT_DMA_K(t, BO) do { \
        __builtin_amdgcn_global_load_lds((const unsigned*)(ksrc0 + (size_t)(t) * 64 * 1024), (LAS unsigned*)(lds + (BO) + w * 1024), 16, 0, 0); \
        __builtin_amdgcn_global_load_lds((const unsigned*)(ksrc1 + (size_t)(t) * 64 * 1024), (LAS unsigned*)(lds + (BO) + 8192 + w * 1024), 16, 0, 0); } while (0)
#define ATT_DMA_V(t, BO) do { \
        __builtin_amdgcn_global_load_lds((const unsigned*)(vsrc0 + (size_t)(t) * 64), (LAS unsigned*)(lds + (BO) + 16384 + w * 2048), 16, 0, 0); \
        __builtin_amdgcn_global_load_lds((const unsigned*)(vsrc1 + (size_t)(t) * 64), (LAS unsigned*)(lds + (BO) + 16384 + w * 2048 + 1024), 16, 0, 0); } while (0)
    const int rp = (ql & ~12) | ((ql & 4) << 1) | ((ql & 8) >> 1);
    const int xk = (rp >> 1) & 7, xv = (ql >> 1) & 7;
    const LAS unsigned char* kbase = lds + map * 8192 + rp * 128;
    const LAS unsigned char* vbase = lds + 16384 + ql * 128;
    const unsigned kaddr0 = (unsigned)(uintptr_t)kbase, vaddr0 = (unsigned)(uintptr_t)vbase;
    int kof[4], vof[4];
#pragma unroll
    for (int i = 0; i < 4; ++i) { kof[i] = ((2 * i + hh) ^ xk) << 4; vof[i] = ((2 * i + hh) ^ xv) << 4; }
#define ATT_KRD(i, RB) (*(const LAS bf16x8*)(kbase + (RB) + ((i) >> 2) * 4096 + kof[(i) & 3]))
#define ATT_VRD(g, RB) (*(const LAS bf16x8*)(vbase + (RB) + ((g) >> 2) * 4096 + vof[(g) & 3]))
    const f32x16 Z16 = (f32x16){0.f, 0.f, 0.f, 0.f, 0.f, 0.f, 0.f, 0.f, 0.f, 0.f, 0.f, 0.f, 0.f, 0.f, 0.f, 0.f};
    f32x16 O[4];
#pragma unroll
    for (int i = 0; i < 4; ++i) O[i] = Z16;
    f32x16 negm = Z16, S0, S1;
    float lrun = 0.f, ral = 1.f; bool resc = false;
    bf16x8 kf[8]; u32x4 pA[4], pB[4];
#define ATT_QK() do { \
        S0 = ATT_MFMA(kf[0], qf[0], negm); S1 = ATT_MFMA(kf[4], qf[0], negm); \
        S0 = ATT_MFMA(kf[1], qf[1], S0);   S1 = ATT_MFMA(kf[5], qf[1], S1); \
        S0 = ATT_MFMA(kf[2], qf[2], S0);   S1 = ATT_MFMA(kf[6], qf[2], S1); \
        S0 = ATT_MFMA(kf[3], qf[3], S0);   S1 = ATT_MFMA(kf[7], qf[3], S1); } while (0)
#define ATT_ROWMAX(mx) do { float _a = fmaxf(S0[0], S1[0]), _b = fmaxf(S0[1], S1[1]); \
        _Pragma("unroll") for (int r = 2; r < 16; r += 2) { _a = fmaxf(_a, fmaxf(S0[r], S1[r])); _b = fmaxf(_b, fmaxf(S0[r + 1], S1[r + 1])); } \
        mx = pair_max(fmaxf(_a, _b)); } while (0)
#define ATT_IMAX3(a, b, c) max(max((a), (b)), (c))
#define ATT_SI(i) __float_as_int(ATT_SV(i))
#define ATT_ROWMAXI(mx) do { int _a = ATT_IMAX3(ATT_SI(0), ATT_SI(1), ATT_SI(2)), _b = ATT_IMAX3(ATT_SI(3), ATT_SI(4), ATT_SI(5)); \
        _a = ATT_IMAX3(_a, ATT_SI(6), ATT_SI(7)); _b = ATT_IMAX3(_b, ATT_SI(8), ATT_SI(9)); _a = ATT_IMAX3(_a, ATT_SI(10), ATT_SI(11)); _b = ATT_IMAX3(_b, ATT_SI(12), ATT_SI(13)); \
        _a = ATT_IMAX3(_a, ATT_SI(14), ATT_SI(15)); _b = ATT_IMAX3(_b, ATT_SI(16), ATT_SI(17)); _a = ATT_IMAX3(_a, ATT_SI(18), ATT_SI(19)); _b = ATT_IMAX3(_b, ATT_SI(20), ATT_SI(21)); \
        _a = ATT_IMAX3(_a, ATT_SI(22), ATT_SI(23)); _b = ATT_IMAX3(_b, ATT_SI(24), ATT_SI(25)); _a = ATT_IMAX3(_a, ATT_SI(26), ATT_SI(27)); _b = ATT_IMAX3(_b, ATT_SI(28), ATT_SI(29)); \
        _a = ATT_IMAX3(_a, ATT_SI(30), ATT_SI(31)); _a = max(_a, _b); \
        auto _rr = __builtin_amdgcn_permlane32_swap((unsigned)_a, (unsigned)_a, false, false); mx = __int_as_float(max((int)_rr[0], (int)_rr[1])); } while (0)
#define ATT_DECIDE() do { float mx; ATT_ROWMAXI(mx); \
        if (__any(mx > THR)) { const float dl = fmaxf(mx, 0.f); \
            _Pragma("unroll") for (int r = 0; r < 16; ++r) { S0[r] -= dl; S1[r] -= dl; negm[r] -= dl; } \
            ral = __builtin_amdgcn_exp2f(-dl); lrun *= ral; resc = true; } } while (0)
#define ATT_SV(i) ((i) < 16 ? S0[(i) & 15] : S1[(i) & 15])
#define ATT_EXP2(g, PN) do { const float _e0 = __builtin_amdgcn_exp2f(ATT_SV(2 * (g))), _e1 = __builtin_amdgcn_exp2f(ATT_SV(2 * (g) + 1)); ls += _e0; ls += _e1; unsigned _w = cvtpk(_e0, _e1); asm volatile("" : "+v"(_w), "+v"(ls)); PN[(g) >> 2][(g) & 3] = _w; } while (0)
#define ATT_DSRD(dst, addr, off) asm volatile("ds_read_b128 %0, %1 offset:%2" : "=v"(dst) : "v"(addr), "i"(off))
#define ATT_NW(g, DOK) ((DOK) ? ((g) <= 8 ? 2 : (g) == 9 ? 3 : (g) == 10 ? 4 : (g) <= 13 ? 5 : (g) == 14 ? 4 : 3) : ((g) <= 13 ? 2 : (g) == 14 ? 1 : 0))
#define ATT_GAPB(g, VC, VL, PP, PN, DOK) do { \
        asm volatile("s_waitcnt lgkmcnt(%1)" : "+v"(VC) : "i"(ATT_NW(g, DOK))); \
        O[(g) >> 2] = ATT_MFMA(VC, __builtin_bit_cast(bf16x8, PP[(g) & 3]), O[(g) >> 2]); \
        if ((g) + 3 < 16) ATT_DSRD(VL, va[((g) + 3) & 3], (((g) + 3) >> 2) * 4096); \
        if ((DOK) && (g) >= 8) ATT_DSRD(kf[(g) - 8], ka[((g) - 8) & 3], (((g) - 8) >> 2) * 4096); \
        ATT_EXP2(g, PN); ATT_SBAR(); } while (0)
#define ATT_PHASEB(RBK, RB, PP, PN, DOK) do { float ls = 0.f; unsigned va[4], ka[4]; \
        _Pragma("unroll") for (int _c = 0; _c < 4; ++_c) { va[_c] = vaddr0 + (unsigned)(RB) + (unsigned)vof[_c]; ka[_c] = kaddr0 + (unsigned)(RBK) + (unsigned)kof[_c]; } \
        bf16x8 v0, v1, v2, v3; ATT_DSRD(v0, va[0], 0); ATT_DSRD(v1, va[1], 0); ATT_DSRD(v2, va[2], 0); ATT_SBAR(); \
        ATT_GAPB(0, v0, v3, PP, PN, DOK); ATT_GAPB(1, v1, v0, PP, PN, DOK); ATT_GAPB(2, v2, v1, PP, PN, DOK); ATT_GAPB(3, v3, v2, PP, PN, DOK); \
        ATT_GAPB(4, v0, v3, PP, PN, DOK); ATT_GAPB(5, v1, v0, PP, PN, DOK); ATT_GAPB(6, v2, v1, PP, PN, DOK); ATT_GAPB(7, v3, v2, PP, PN, DOK); \
        ATT_GAPB(8, v0, v3, PP, PN, DOK); ATT_GAPB(9, v1, v0, PP, PN, DOK); ATT_GAPB(10, v2, v1, PP, PN, DOK); ATT_GAPB(11, v3, v2, PP, PN, DOK); \
        ATT_GAPB(12, v0, v3, PP, PN, DOK); ATT_GAPB(13, v1, v0, PP, PN, DOK); ATT_GAPB(14, v2, v1, PP, PN, DOK); ATT_GAPB(15, v3, v2, PP, PN, DOK); \
        if (DOK) { asm volatile("s_waitcnt lgkmcnt(0)" : "+v"(kf[0]), "+v"(kf[1]), "+v"(kf[2]), "+v"(kf[3]), "+v"(kf[4]), "+v"(kf[5]), "+v"(kf[6]), "+v"(kf[7])); ATT_SBAR(); } \
        lrun += ls; } while (0)
#define ATT_RESC() do { if (resc) { _Pragma("unroll") for (int i = 0; i < 4; ++i) _Pragma("unroll") for (int r = 0; r < 16; ++r) O[i][r] *= ral; resc = false; } } while (0)
#define ATT_BUF(j) (((j) & 3) * BUFB)
#if PROBE_MASK
#define ATT_TB0() const unsigned long long _tb0 = __builtin_amdgcn_s_memrealtime(); asm volatile("s_waitcnt lgkmcnt(0)" ::: "memory")
#define ATT_TB1() const unsigned long long _tb1 = __builtin_amdgcn_s_memrealtime(); att_b += _tb1 - _tb0
#define ATT_TB2() asm volatile("" : "+v"(S0), "+v"(S1)); att_a += __builtin_amdgcn_s_memrealtime() - _tb1
#else
#define ATT_TB0() do {} while (0)
#define ATT_TB1() do {} while (0)
#define ATT_TB2() do {} while (0)
#endif
#if PROBE_MASK
#define ATT_SYNCN(N) do { const unsigned long long _t0 = __builtin_amdgcn_s_memrealtime(); asm volatile("s_waitcnt vmcnt(" #N ") lgkmcnt(0)\n\ts_barrier" ::: "memory"); att_wait += __builtin_amdgcn_s_memrealtime() - _t0; } while (0)
#else
#define ATT_SYNCN(N) asm volatile("s_waitcnt vmcnt(" #N ") lgkmcnt(0)\n\ts_barrier" ::: "memory")
#endif
#define ATT_STEP(t, PP, PN) do { \
        ATT_TB0(); { const int rbk = ATT_BUF((t) + 1), rbv = ATT_BUF((t) - 1); ATT_PHASEB(rbk, rbv, PP, PN, true); } ATT_RESC(); ATT_TB1(); ATT_QK(); ATT_DECIDE(); ATT_TB2(); } while (0)

    if (first) { ATT_DMA_K(0, 0); ATT_DMA_K(1, BUFB); ATT_DMA_V(0, 0); ATT_DMA_V(1, BUFB); }
    ATT_DMA_K(2, 2 * BUFB); ATT_DMA_K(3, 3 * BUFB);
    ATT_SYNCN(4);
#pragma unroll
    for (int i = 0; i < 8; ++i) kf[i] = ATT_KRD(i, 0);
    ATT_QK();
    { float mx; ATT_ROWMAX(mx);
#pragma unroll
      for (int r = 0; r < 16; ++r) { S0[r] -= mx; S1[r] -= mx; negm[r] = -mx; } }
    { float ls = 0.f;
#pragma unroll
      for (int i = 0; i < 8; ++i) kf[i] = ATT_KRD(i, BUFB);
#define ATT_E0(g) ATT_EXP2(g, pA)
      ATT_E0(0); ATT_E0(1); ATT_E0(2); ATT_E0(3); ATT_E0(4); ATT_E0(5); ATT_E0(6); ATT_E0(7); ATT_E0(8); ATT_E0(9); ATT_E0(10); ATT_E0(11); ATT_E0(12); ATT_E0(13); ATT_E0(14); ATT_E0(15);
#undef ATT_E0
      lrun += ls; }
    ATT_QK(); ATT_DECIDE();
    for (int t = 1; t < nkt - 1; t += 2) {
        ATT_SYNCN(0);
        if (t + 3 < nkt) ATT_DMA_K(t + 3, ATT_BUF(t + 3));
        ATT_DMA_V(t + 1, ATT_BUF(t + 1));
        if (t + 4 < nkt) ATT_DMA_K(t + 4, ATT_BUF(t));
        ATT_DMA_V(t + 2, ATT_BUF(t + 2));
        ATT_STEP(t, pA, pB);
        ATT_STEP(t + 1, pB, pA);
    }
    ATT_SYNCN(0);
    if (has_next) {
        const size_t nqrow = nqrow0 + 32 * qb + ql;
#pragma unroll
        for (int ks = 0; ks < 4; ++ks) qf[ks] = *(const bf16x8*)(Q + nqrow * 1024 + (nh * 2 + map) * 64 + 16 * ks + 8 * hh);
        const bf16_t* nk0 = K + ((size_t)nb * LTOK + krow) * 1024 + (nh * 2) * 64 + kc * 8;
        const bf16_t* nv0 = VT + ((size_t)nb * 1024 + nh * 128 + e0) * LTOK + (pc ^ ((e0 >> 1) & 7)) * 8;
        const bf16_t* nv1 = VT + ((size_t)nb * 1024 + nh * 128 + e1) * LTOK + (pc ^ ((e1 >> 1) & 7)) * 8;
#pragma unroll
        for (int j = 0; j < 2; ++j) {
            __builtin_amdgcn_global_load_lds((const unsigned*)(nk0 + (size_t)j * 64 * 1024), (LAS unsigned*)(lds + j * BUFB + w * 1024), 16, 0, 0);
            __builtin_amdgcn_global_load_lds((const unsigned*)(nk0 + 64 + (size_t)j * 64 * 1024), (LAS unsigned*)(lds + j * BUFB + 8192 + w * 1024), 16, 0, 0);
            __builtin_amdgcn_global_load_lds((const unsigned*)(nv0 + (size_t)j * 64), (LAS unsigned*)(lds + j * BUFB + 16384 + w * 2048), 16, 0, 0);
            __builtin_amdgcn_global_load_lds((const unsigned*)(nv1 + (size_t)j * 64), (LAS unsigned*)(lds + j * BUFB + 16384 + w * 2048 + 1024), 16, 0, 0); }
    }
    { const int rbv = ATT_BUF(nkt - 2); ATT_PHASEB(0, rbv, pA, pB, false); } ATT_RESC();
    { const int rbv = ATT_BUF(nkt - 1); bf16x8 v0 = ATT_VRD(0, rbv), v1 = ATT_VRD(1, rbv), v2;
#define ATT_GF(g, VC, VL) do { O[(g) >> 2] = ATT_MFMA(VC, __builtin_bit_cast(bf16x8, pB[(g) & 3]), O[(g) >> 2]); if ((g) + 2 < 16) VL = ATT_VRD((g) + 2, rbv); } while (0)
      ATT_GF(0, v0, v2); ATT_GF(1, v1, v0); ATT_GF(2, v2, v1); ATT_GF(3, v0, v2); ATT_GF(4, v1, v0); ATT_GF(5, v2, v1); ATT_GF(6, v0, v2); ATT_GF(7, v1, v0);
      ATT_GF(8, v2, v1); ATT_GF(9, v0, v2); ATT_GF(10, v1, v0); ATT_GF(11, v2, v1); ATT_GF(12, v0, v2); ATT_GF(13, v1, v0); ATT_GF(14, v2, v1); ATT_GF(15, v0, v2);
#undef ATT_GF
    }
    asm volatile("s_waitcnt lgkmcnt(0)\n\ts_barrier" ::: "memory");
    const float inv = 1.f / pair_sum(lrun);
    f32x4 sgv[4][4];
    if (map == 0) {
#pragma unroll
        for (int i = 0; i < 4; ++i)
#pragma unroll
            for (int g = 0; g < 4; ++g) sgv[i][g] = *(const f32x4*)(subg + 32 * i + 8 * g + 4 * hh);
    }
    LAS float* ex = (LAS float*)(lds + EXCH) + (size_t)qb * 4096 + lane;
    if (map == 1) {
#pragma unroll
        for (int i = 0; i < 4; ++i)
#pragma unroll
            for (int r = 0; r < 16; ++r) ex[(i * 16 + r) * 64] = O[i][r] * inv;
    }
    asm volatile("s_waitcnt lgkmcnt(0)\n\ts_barrier" ::: "memory");
    if (map == 0) {
        float ss = 0.f;
#pragma unroll
        for (int i = 0; i < 4; ++i)
#pragma unroll
            for (int r = 0; r < 16; ++r) { const float y = O[i][r] * inv - lam * ex[(i * 16 + r) * 64]; O[i][r] = y; ss += y * y; }
        ss = pair_sum(ss);
        const float rs = rsqrtf(ss * (1.f / VD) + EPS) * osc;
        bf16_t* orow = AY + qrow * MAP + 512 + h * 128;
#pragma unroll
        for (int i = 0; i < 4; ++i)
#pragma unroll
            for (int g = 0; g < 4; ++g) { const int e = 32 * i + 8 * g + 4 * hh; const f32x4 gv = sgv[i][g];
                u32x2 o; o.x = cvtpk(O[i][4 * g] * rs * gv[0], O[i][4 * g + 1] * rs * gv[1]); o.y = cvtpk(O[i][4 * g + 2] * rs * gv[2], O[i][4 * g + 3] * rs * gv[3]);
                *(u32x2*)(orow + e) = o; }
    }
    asm volatile("s_waitcnt lgkmcnt(0)\n\ts_barrier" ::: "memory");
    if (ATT_PRIO && w >= 4) __builtin_amdgcn_s_setprio(0);
#if PROBE_MASK
    if (blockIdx.x == 0 && tid == 0) { volatile LAS unsigned long long* acc = (volatile LAS unsigned long long*)(lds + LDS_CTRL + 64) + 20; acc[0] = acc[0] + att_wait; acc[2] = acc[2] + att_b; acc[3] = acc[3] + att_a; }
#endif
#undef ATT_DMA_K
#undef ATT_DMA_V
#undef ATT_KRD
#undef ATT_VRD
#undef ATT_QK
#undef ATT_ROWMAX
#undef ATT_DECIDE
#undef ATT_IMAX3
#undef ATT_SI
#undef ATT_ROWMAXI
#undef ATT_SV
#undef ATT_EXP2
#undef ATT_GAPB
#undef ATT_DSRD
#undef ATT_NW
#undef ATT_PHASEB
#undef ATT_RESC
#undef ATT_STEP
#undef ATT_BUF
#undef ATT_TB0
#undef ATT_TB1
#undef ATT_TB2
#undef ATT_SYNCN
}
#undef ATT_SBAR
#undef ATT_MFMA
#undef ATT_SYNC
}

__device__ __forceinline__ void tr_item(const float* W, int ldw, int k0, int n0, bf16_t* WT, int ldt, int drow0, int dcol0, bool rope, LAS float* scr, int lane) {
    { f32x4 v[8];
#pragma unroll
      for (int j = 0; j < 8; ++j) v[j] = RLD((const f32x4*)(W + (size_t)(k0 + 8 * j + (lane >> 3)) * ldw + n0 + 4 * (lane & 7)));
#pragma unroll
      for (int j = 0; j < 8; ++j) { LAS float* d = scr + (8 * j + (lane >> 3)) * 33 + 4 * (lane & 7); d[0] = v[j][0]; d[1] = v[j][1]; d[2] = v[j][2]; d[3] = v[j][3]; } }
    LDS_WAIT(); asm volatile("" ::: "memory");
    const int c = lane & 7;
#pragma unroll
    for (int j = 0; j < 4; ++j) { const int n = (lane >> 3) + 8 * j; const LAS float* s = scr + (8 * c) * 33 + n;
        u32x4 o; o.x = cvtpk(s[0 * 33], s[1 * 33]); o.y = cvtpk(s[2 * 33], s[3 * 33]); o.z = cvtpk(s[4 * 33], s[5 * 33]); o.w = cvtpk(s[6 * 33], s[7 * 33]);
        const int dn = rope ? (8 * ((n >> 2) & 3) + 4 * (n >> 4) + (n & 3)) : n;
        *(u32x4*)(WT + (size_t)(drow0 + n0 + dn) * ldt + dcol0 + k0 + 8 * c) = o; }
    LDS_WAIT(); asm volatile("" ::: "memory");
}

__device__ __forceinline__ void phase_prologue(Frame F) {
    F.tid = opaque_tid(F.wave0); F.lane = F.tid & 63; F.wave = __builtin_amdgcn_readfirstlane(F.tid >> 6);
    const float* c = F.in[1]; const float* cctx = F.in[3]; const float* wmod = F.in[4]; const float* bmod = F.in[5];
    float* MOD = (float*)(F.ws + WS_MOD);
    for (int cb = blockIdx.x; cb < 192; cb += F.G) {
        LAS float* S = (LAS float*)F.lds;
        for (int idx = F.tid; idx < 1024 * 36; idx += NTHR) { const int k = idx / 36, bb = idx - k * 36; float v = 0.f;
            if (bb < 32) v = c[bb * 1024 + k]; else if (bb == 32) v = cctx[k];
            S[idx] = v / (1.f + expf(-v)); }
        __syncthreads();
        const int l = cb / 96, n = (cb % 96) * 64 + F.lane;
        float acc[36];
#pragma unroll
        for (int i = 0; i < 36; ++i) acc[i] = 0.f;
        const float* wp = wmod + ((size_t)l * 1024 + F.wave * 128) * MODW + n;
#pragma unroll 8
        for (int kk = 0; kk < 128; ++kk) { const float wv = wp[(size_t)kk * MODW]; const LAS f32x4* sp = (const LAS f32x4*)(S + (F.wave * 128 + kk) * 36);
#pragma unroll
            for (int q = 0; q < 9; ++q) { const f32x4 s4 = sp[q];
#pragma unroll
                for (int i = 0; i < 4; ++i) acc[4 * q + i] += s4[i] * wv; } }
        __syncthreads();
        LAS float* red = (LAS float*)F.lds;
#pragma unroll
        for (int bb = 0; bb < 33; ++bb) red[(F.wave * 33 + bb) * 64 + F.lane] = acc[bb];
        __syncthreads();
        for (int bb = F.wave; bb < 33; bb += 8) { float s = bmod[l * MODW + n];
#pragma unroll
            for (int w2 = 0; w2 < 8; ++w2) s += red[(w2 * 33 + bb) * 64 + F.lane];
            MOD[((size_t)l * 33 + bb) * MODW + n] = s; }
        __syncthreads();
    }
    __syncthreads();
    LAS float* scr = (LAS float*)(F.lds + F.wave * 8448);
    const int gw = F.vcu * NWAVES + F.wave, NGW = F.G * NWAVES;
    bf16_t* WZ = (bf16_t*)(F.ws + WS_WZ); bf16_t* WV = (bf16_t*)(F.ws + WS_WV); bf16_t* WM = (bf16_t*)(F.ws + WS_WM); bf16_t* WOUT = (bf16_t*)(F.ws + WS_WOUT);
    bf16_t* WUP0 = (bf16_t*)(F.ws + WS_WUP0); bf16_t* WDN0 = (bf16_t*)(F.ws + WS_WDN0);
    constexpr int I_IN = 16 * 176, I_SQ = 16 * 32, I_UP = 16 * 86, I_DN = 43 * 32;
    constexpr int NITEMS = 2 * I_IN + 4 * I_SQ + 2 * I_UP + I_DN;
    for (int it = gw; it < NITEMS; it += NGW) {
        int r = it;
        if (r < 2 * I_IN) { const int l = r / I_IN; r -= l * I_IN; const int kb = r / 176, nb = r % 176, n0 = nb * 32;
            const float* W = F.in[8] + (size_t)l * 1024 * 5632;
            if (n0 < 2560) tr_item(W, 5632, kb * 64, n0, WZ + (size_t)l * 4608 * 1024, 1024, 0, 0, n0 >= 512, scr, F.lane);
            else if (n0 < 3584) tr_item(W, 5632, kb * 64, n0, WV + (size_t)l * 1024 * 1024, 1024, -2560, 0, false, scr, F.lane);
            else tr_item(W, 5632, kb * 64, n0, WZ + (size_t)l * 4608 * 1024, 1024, -1024, 0, false, scr, F.lane);
            continue; }
        r -= 2 * I_IN;
        if (r < 4 * I_SQ) { const int q = r / I_SQ; r -= q * I_SQ; const int l = q & 1; const int kb = r / 32, nb = r % 32;
            const float* W = (q < 2 ? F.in[17] : F.in[18]) + (size_t)l * 1024 * 1024;
            if (q < 2) tr_item(W, 1024, kb * 64, nb * 32, WM + (size_t)l * 1024 * MAP, MAP, 0, 512, false, scr, F.lane);
            else tr_item(W, 1024, kb * 64, nb * 32, WOUT + (size_t)l * 1024 * 1024, 1024, 0, 0, false, scr, F.lane);
            continue; }
        r -= 4 * I_SQ;
        if (r < 2 * I_UP) { const int q = r / I_UP; r -= q * I_UP; const int kb = r / 86, nb = r % 86, n0 = nb * 32;
            const float* W = q ? F.in[20] : F.in[19];
            tr_item(W, FF, kb * 64, n0, WUP0, 1024, (n0 >> 7) * 256 + q * 128 - (n0 & ~127), 0, false, scr, F.lane); continue; }
        r -= 2 * I_UP;
        { const int kb = r / 32, nb = r % 32; tr_item(F.in[21], 1024, kb * 64, nb * 32, WDN0, FFP, 0, 0, false, scr, F.lane); }
    }
    { const int gt = F.vcu * NTHR + F.tid, NT = F.G * NTHR;
      for (int i = gt; i < 128 * 128; i += NT) { const int rr = i >> 7, cc = i & 127; const int row = 21 * 256 + (rr < 64 ? 64 + rr : 192 + (rr - 64)); *(u32x4*)(WUP0 + (size_t)row * 1024 + cc * 8) = (u32x4){0u, 0u, 0u, 0u}; }
      for (int i = gt; i < 1024 * 8; i += NT) { const int row = i >> 3, cc = i & 7; *(u32x4*)(WDN0 + (size_t)row * FFP + FF + cc * 8) = (u32x4){0u, 0u, 0u, 0u}; } }
    { bf16_t* WEFF = (bf16_t*)(F.ws + WS_WM);
      for (int it = gw; it < 1024; it += NGW) { const int l = it >> 9, g = (it >> 7) & 3, nbk = (it >> 3) & 15, cbk = it & 7; const int n = nbk * 64 + F.lane, c0 = cbk * 16;
          const float* pw = F.in[9] + ((size_t)(l * 4 + g) * 128 + c0) * 128; const float* ps = F.in[10] + l * 512 + g * 128; const float* wpp = F.in[16] + ((size_t)l * 512 + g * 128) * 1024 + n;
#pragma unroll
          for (int q = 0; q < 8; ++q) { const int idx = q * 256 + 4 * F.lane; const f32x4 v = *(const f32x4*)(pw + idx), sc = *(const f32x4*)(ps + (idx & 127)); *(LAS f32x4*)(scr + idx) = v * sc; }
          LDS_WAIT(); asm volatile("" ::: "memory");
          float a[16];
#pragma unroll
          for (int i = 0; i < 16; ++i) a[i] = 0.f;
#pragma unroll 4
          for (int d = 0; d < 128; ++d) { const float wv = wpp[(size_t)d * 1024];
#pragma unroll
              for (int i = 0; i < 16; ++i) a[i] += scr[i * 128 + d] * wv; }
          u32x4 o0, o1; o0.x = cvtpk(a[0], a[1]); o0.y = cvtpk(a[2], a[3]); o0.z = cvtpk(a[4], a[5]); o0.w = cvtpk(a[6], a[7]);
          o1.x = cvtpk(a[8], a[9]); o1.y = cvtpk(a[10], a[11]); o1.z = cvtpk(a[12], a[13]); o1.w = cvtpk(a[14], a[15]);
          bf16_t* dst = WEFF + ((size_t)l * 1024 + n) * MAP + g * 128 + c0; *(u32x4*)dst = o0; *(u32x4*)(dst + 8) = o1;
          LDS_WAIT(); asm volatile("" ::: "memory"); } }
    if (blockIdx.x == 0) {
        float* COS = (float*)(F.ws + WS_TAB); float* SIN = COS + 1024; float* LAMV = SIN + 1024;
        for (int idx = F.tid; idx < 1024; idx += NTHR) { const int pos = idx >> 4, i = idx & 15; const float inv = powf(10000.f, -(float)i * (2.0f / 32.0f)); const float ang = (float)pos * inv;
            COS[idx] = cosf(ang); SIN[idx] = sinf(ang); }
        if (F.wave == 1) {
            for (int l = 0; l < 2; ++l) { const float d1 = wave_sum(F.in[11][l * 64 + F.lane] * F.in[12][l * 64 + F.lane], F.lane), d2 = wave_sum(F.in[13][l * 64 + F.lane] * F.in[14][l * 64 + F.lane], F.lane);
                const float lam0 = 0.8f - 0.6f * expf(-0.3f * (float)l);
                if (F.lane == 0) { LAMV[2 * l] = expf(d1) - expf(d2) + lam0; LAMV[2 * l + 1] = 1.f - lam0; } }
        }
    }
}

constexpr size_t XPITCH = 4096;
template <bool SRC16>
__device__ __forceinline__ void phase_normmod(Frame F, const void* lat_, const void* ctx_, const float* g, const float* mod, int soff, bool do_ctx, bf16_t* H, const bf16_t* oadd = nullptr, void* latdst_ = nullptr, void* ctxdst_ = nullptr) {
    const char* lat = (const char*)lat_; const char* ctx = (const char*)ctx_; char* latdst = (char*)latdst_; char* ctxdst = (char*)ctxdst_;
    F.tid = opaque_tid(F.wave0); F.lane = F.tid & 63; F.wave = __builtin_amdgcn_readfirstlane(F.tid >> 6);
    const int gw = F.vcu * NWAVES + F.wave, NGW = F.G * NWAVES;
    const int per = (((NTOK + NGW - 1) / NGW) + 3) & ~3;
    const int r0 = gw * per, r1 = min(r0 + per, NTOK);
    int cur_bb = -1; f32x4 gs[4], sh[4];
#pragma unroll
    for (int q = 0; q < 4; ++q) { gs[q] = (f32x4){0.f, 0.f, 0.f, 0.f}; sh[q] = gs[q]; }
    for (int r = r0; r < r1; r += 4) {
        const int b = r / LTOK, j = r - b * LTOK; const bool isc = j < CTXL;
        if (isc && !do_ctx) continue;
        const int bb = isc ? 32 : b;
        if (bb != cur_bb) { cur_bb = bb; const float* mv = mod + (size_t)bb * MODW + soff;
#pragma unroll
            for (int q = 0; q < 4; ++q) { const int cidx = 4 * F.lane + 256 * q; const f32x4 gg = *(const f32x4*)(g + cidx), sc = *(const f32x4*)(mv + 1024 + cidx); gs[q] = gg * (sc + 1.f); sh[q] = *(const f32x4*)(mv + cidx); } }
        const char* src = isc ? ctx + ((size_t)b * CTXL + j) * XPITCH : lat + ((size_t)b * SEQ + (j - CTXL)) * XPITCH;
        f32x4 v[4][4]; float s[4];
        if (SRC16) {
            u32x2 xv[4][4];
#pragma unroll
            for (int i = 0; i < 4; ++i)
#pragma unroll
                for (int q = 0; q < 4; ++q) xv[i][q] = RLD((const u32x2*)(src + (size_t)i * XPITCH) + F.lane + 64 * q);
#pragma unroll
            for (int i = 0; i < 4; ++i)
#pragma unroll
                for (int q = 0; q < 4; ++q) v[i][q] = (f32x4){bflo(xv[i][q].x), bfhi(xv[i][q].x), bflo(xv[i][q].y), bfhi(xv[i][q].y)};
        } else {
#pragma unroll
            for (int i = 0; i < 4; ++i)
#pragma unroll
                for (int q = 0; q < 4; ++q) v[i][q] = RLD((const f32x4*)(src + (size_t)i * XPITCH) + F.lane + 64 * q);
        }
        if (oadd) {
            u32x2 ov[4][4];
#pragma unroll
            for (int i = 0; i < 4; ++i)
#pragma unroll
                for (int q = 0; q < 4; ++q) ov[i][q] = RLD((const u32x2*)(oadd + (size_t)(r + i) * D) + F.lane + 64 * q);
            char* dst = isc ? ctxdst + ((size_t)b * CTXL + j) * XPITCH : latdst + ((size_t)b * SEQ + (j - CTXL)) * XPITCH;
#pragma unroll
            for (int i = 0; i < 4; ++i)
#pragma unroll
                for (int q = 0; q < 4; ++q) { v[i][q] += (f32x4){bflo(ov[i][q].x), bfhi(ov[i][q].x), bflo(ov[i][q].y), bfhi(ov[i][q].y)};
                    u32x2 xo; xo.x = cvtpk(v[i][q][0], v[i][q][1]); xo.y = cvtpk(v[i][q][2], v[i][q][3]); RST((u32x2*)(dst + (size_t)i * XPITCH) + F.lane + 64 * q, xo); }
        }
#pragma unroll
        for (int i = 0; i < 4; ++i) { float a = 0.f;
#pragma unroll
            for (int q = 0; q < 4; ++q) a += (v[i][q][0] * v[i][q][0] + v[i][q][1] * v[i][q][1]) + (v[i][q][2] * v[i][q][2] + v[i][q][3] * v[i][q][3]);
            s[i] = a; }
#pragma unroll
        for (int o = 1; o < 64; o <<= 1)
#pragma unroll
            for (int i = 0; i < 4; ++i) s[i] += shx(s[i], o, F.lane);
#pragma unroll
        for (int i = 0; i < 4; ++i) { const float rstd = rsqrtf(s[i] * (1.f / D) + EPS); u32x2* o8 = (u32x2*)(H + (size_t)(r + i) * D) + F.lane;
#pragma unroll
            for (int q = 0; q < 4; ++q) { const f32x4 y = v[i][q] * rstd * gs[q] + sh[q]; u32x2 o; o.x = cvtpk(y[0], y[1]); o.y = cvtpk(y[2], y[3]); o8[64 * q] = o; } }
    }
}

__device__ __forceinline__ void pool_unpack(const u32x4 w, float (&v)[8]) { v[0] = bflo(w.x); v[1] = bfhi(w.x); v[2] = bflo(w.y); v[3] = bfhi(w.y); v[4] = bflo(w.z); v[5] = bfhi(w.z); v[6] = bflo(w.w); v[7] = bfhi(w.w); }
__device__ __forceinline__ void phase_pool(Frame F, const bf16_t* U, bf16_t* M, bool do_ctx) {
    F.tid = opaque_tid(F.wave0); F.lane = F.tid & 63; F.wave = __builtin_amdgcn_readfirstlane(F.tid >> 6);
    const int gw = F.vcu * NWAVES + F.wave, NGW = F.G * NWAVES;
    const int per = (((NTOK + NGW - 1) / NGW) + 3) & ~3;
    const int r0 = gw * per, r1 = min(r0 + per, NTOK);
    const int half = 1 << (F.lane >> 4);
    float S[8];
#pragma unroll
    for (int q = 0; q < 8; ++q) S[q] = 0.f;
    bool need_init = true;
    for (int r = r0; r < r1; r += 4) {
        const int b = r / LTOK, j = r - b * LTOK; const bool isc = j < CTXL;
        if (isc && !do_ctx) { need_init = true; continue; }
        const int L = isc ? CTXL : SEQ, t = isc ? j : j - CTXL; const size_t base = (size_t)b * LTOK + (isc ? 0 : CTXL);
        const bf16_t* Ul = U + base * 512 + 8 * F.lane;
        u32x4 wc[4], wi[4], wo[4];
#pragma unroll
        for (int i = 0; i < 4; ++i) { wc[i] = *(const u32x4*)(Ul + (size_t)(t + i) * 512); wi[i] = *(const u32x4*)(Ul + (size_t)min(t + i + half, L - 1) * 512); wo[i] = *(const u32x4*)(Ul + (size_t)max(t + i - half, 0) * 512); }
        if (need_init || t == 0) {
            need_init = false;
            const int lo = max(t - half, 0), hi = min(t + half, L);
            u32x4 w[16];
#pragma unroll
            for (int k = 0; k < 16; ++k) { const int tt = min(max(t - 8 + k, 0), L - 1); w[k] = *(const u32x4*)(Ul + (size_t)tt * 512); }
#pragma unroll
            for (int q = 0; q < 8; ++q) S[q] = 0.f;
#pragma unroll
            for (int k = 0; k < 16; ++k) { const int tt = t - 8 + k; const float mk = (tt >= lo && tt < hi) ? 1.f : 0.f; float v[8]; pool_unpack(w[k], v);
#pragma unroll
                for (int q = 0; q < 8; ++q) S[q] += mk * v[q]; }
        }
#pragma unroll
        for (int i = 0; i < 4; ++i) {
            const int ti = t + i, lo = max(ti - half, 0), hi = min(ti + half, L);
            const float ic = 1.f / (float)(hi - lo);
            float c[8], vi[8], vo[8]; pool_unpack(wc[i], c); pool_unpack(wi[i], vi); pool_unpack(wo[i], vo);
            u32x4 o; o.x = cvtpk(S[0] * ic - c[0], S[1] * ic - c[1]); o.y = cvtpk(S[2] * ic - c[2], S[3] * ic - c[3]);
            o.z = cvtpk(S[4] * ic - c[4], S[5] * ic - c[5]); o.w = cvtpk(S[6] * ic - c[6], S[7] * ic - c[7]);
            *(u32x4*)(M + (size_t)(r + i) * MAP + 8 * F.lane) = o;
            const float mi = (ti + half < L) ? 1.f : 0.f, mo = (ti - half >= 0) ? 1.f : 0.f;
#pragma unroll
            for (int q = 0; q < 8; ++q) S[q] = (S[q] + mi * vi[q]) - mo * vo[q];
        }
    }
}

__device__ __forceinline__ void phase_router(Frame F, char* x1, const float* g, const float* mod, bf16_t* H, const bf16_t* oadd) {
    F.tid = opaque_tid(F.wave0); F.lane = F.tid & 63; F.wave = __builtin_amdgcn_readfirstlane(F.tid >> 6);
    LAS float* WR = (LAS float*)F.lds;
    LAS float* LG = (LAS float*)(F.lds + 32768);
    LAS int* LCNT = (LAS int*)(F.lds + 32768 + 8192);
    unsigned* LIST = (unsigned*)(F.ws + WS_LIST); float* WTS = (float*)(F.ws + WS_WTS);
    for (int i = F.tid; i < 8192; i += NTHR) WR[i] = F.in[22][i];
    for (int ch = blockIdx.x; ch < NLAT / 256; ch += F.G) {
        if (F.tid < 16) LCNT[F.tid] = 0;
        __syncthreads();
        const int bch = (ch * 256) >> 11;
        f32x4 gs[4], sh[4];
        { const float* mv = mod + (size_t)bch * MODW + 3 * D;
#pragma unroll
          for (int q = 0; q < 4; ++q) { const int cidx = 4 * F.lane + 256 * q; const f32x4 gg = *(const f32x4*)(g + cidx), sc = *(const f32x4*)(mv + 1024 + cidx); gs[q] = gg * (sc + 1.f); sh[q] = *(const f32x4*)(mv + cidx); } }
        u32x2 vn[2][4], on[2][4];
#define RT_LOAD(rb_) do { const int _t0 = ch * 256 + F.wave * 32 + (rb_); const bf16_t* _or = oadd + ((size_t)bch * LTOK + CTXL + (_t0 & 2047)) * D; \
            _Pragma("unroll") for (int i = 0; i < 2; ++i) _Pragma("unroll") for (int q = 0; q < 4; ++q) { vn[i][q] = RLD((const u32x2*)(x1 + (size_t)(_t0 + i) * XPITCH) + F.lane + 64 * q); on[i][q] = RLD((const u32x2*)(_or + (size_t)i * D) + F.lane + 64 * q); } } while (0)
        RT_LOAD(0);
        for (int rb = 0; rb < 32; rb += 2) {
            const int rr0 = F.wave * 32 + rb, tok0 = ch * 256 + rr0;
            f32x4 v[2][4]; float s[2];
#pragma unroll
            for (int i = 0; i < 2; ++i)
#pragma unroll
                for (int q = 0; q < 4; ++q) v[i][q] = (f32x4){bflo(vn[i][q].x) + bflo(on[i][q].x), bfhi(vn[i][q].x) + bfhi(on[i][q].x), bflo(vn[i][q].y) + bflo(on[i][q].y), bfhi(vn[i][q].y) + bfhi(on[i][q].y)};
            if (rb + 2 < 32) RT_LOAD(rb + 2);
#pragma unroll
            for (int i = 0; i < 2; ++i)
#pragma unroll
                for (int q = 0; q < 4; ++q) { u32x2 xo; xo.x = cvtpk(v[i][q][0], v[i][q][1]); xo.y = cvtpk(v[i][q][2], v[i][q][3]); RST((u32x2*)(x1 + (size_t)(tok0 + i) * XPITCH) + F.lane + 64 * q, xo); }
#pragma unroll
            for (int i = 0; i < 2; ++i) { float a = 0.f;
#pragma unroll
                for (int q = 0; q < 4; ++q) a += (v[i][q][0] * v[i][q][0] + v[i][q][1] * v[i][q][1]) + (v[i][q][2] * v[i][q][2] + v[i][q][3] * v[i][q][3]);
                s[i] = a; }
#pragma unroll
            for (int o = 1; o < 64; o <<= 1)
#pragma unroll
                for (int i = 0; i < 2; ++i) s[i] += shx(s[i], o, F.lane);
#pragma unroll
            for (int i = 0; i < 2; ++i) {
                const int tok = tok0 + i; const float rstd = rsqrtf(s[i] * (1.f / D) + EPS);
                u32x2* o8 = (u32x2*)(H + ((size_t)bch * LTOK + CTXL + (tok & 2047)) * D) + F.lane;
                float lg[8];
#pragma unroll
                for (int e = 0; e < 8; ++e) lg[e] = 0.f;
#pragma unroll
                for (int q = 0; q < 4; ++q) { const int cidx = 4 * F.lane + 256 * q;
                    const f32x4 y = v[i][q] * rstd * gs[q] + sh[q];
                    u32x2 o; o.x = cvtpk(y[0], y[1]); o.y = cvtpk(y[2], y[3]); o8[64 * q] = o;
#pragma unroll
                    for (int k = 0; k < 4; ++k) { const LAS f32x4* wr = (const LAS f32x4*)(WR + (cidx + k) * 8); const f32x4 w0 = wr[0], w1 = wr[1];
                        lg[0] += y[k] * w0[0]; lg[1] += y[k] * w0[1]; lg[2] += y[k] * w0[2]; lg[3] += y[k] * w0[3]; lg[4] += y[k] * w1[0]; lg[5] += y[k] * w1[1]; lg[6] += y[k] * w1[2]; lg[7] += y[k] * w1[3]; } }
                const bool b0 = F.lane & 1, b1 = F.lane & 2, b2 = F.lane & 4;
                float a4[4], a2[2], a1;
#pragma unroll
                for (int j = 0; j < 4; ++j) { const float keep = b0 ? lg[4 + j] : lg[j], send = b0 ? lg[j] : lg[4 + j]; a4[j] = keep + shx(send, 1, F.lane); }
#pragma unroll
                for (int j = 0; j < 2; ++j) { const float keep = b1 ? a4[2 + j] : a4[j], send = b1 ? a4[j] : a4[2 + j]; a2[j] = keep + shx(send, 2, F.lane); }
                { const float keep = b2 ? a2[1] : a2[0], send = b2 ? a2[0] : a2[1]; a1 = keep + shx(send, 4, F.lane); }
                a1 += shx(a1, 8, F.lane); a1 += shx(a1, 16, F.lane); a1 += shx(a1, 32, F.lane);
                if (F.lane < 8) LG[(rr0 + i) * 8 + ((F.lane & 1) * 4 + (F.lane & 2) + ((F.lane >> 2) & 1))] = a1;
            }
        }
#undef RT_LOAD
        __syncthreads();
        int e1 = 0, e2 = 0, i1 = 0, i2 = 0; float w1 = 0.f, w2 = 0.f;
        if (F.tid < 256) {
            const f32x4 l0 = *(const LAS f32x4*)(LG + F.tid * 8), l1 = *(const LAS f32x4*)(LG + F.tid * 8 + 4);
            const float lg[8] = {l0[0], l0[1], l0[2], l0[3], l1[0], l1[1], l1[2], l1[3]};
            float v1 = lg[0];
#pragma unroll
            for (int e = 1; e < 8; ++e) if (lg[e] > v1) { v1 = lg[e]; e1 = e; }
            float v2 = -3.0e38f;
#pragma unroll
            for (int e = 0; e < 8; ++e) if (e != e1 && lg[e] > v2) { v2 = lg[e]; e2 = e; }
            const float p2 = expf(v2 - v1); w1 = 1.f / (1.f + p2); w2 = p2 * w1;
            i1 = atomicAdd((int*)&LCNT[e1], 1); i2 = atomicAdd((int*)&LCNT[e2], 1); }
        __syncthreads();
        if (F.tid < 8) LCNT[8 + F.tid] = (int)__hip_atomic_fetch_add(F.ctl + CW_CNT + 64 * F.tid, (unsigned)LCNT[F.tid], __ATOMIC_RELAXED, __HIP_MEMORY_SCOPE_AGENT);
        __syncthreads();
        if (F.tid < 256) { const unsigned tok = (unsigned)(ch * 256 + F.tid);
            LIST[(size_t)e1 * NLAT + LCNT[8 + e1] + i1] = tok * 2u; LIST[(size_t)e2 * NLAT + LCNT[8 + e2] + i2] = tok * 2u + 1u;
            WTS[tok * 2u] = w1; WTS[tok * 2u + 1u] = w2; }
        __syncthreads();
    }
    __syncthreads();
    LAS float* scr = (LAS float*)(F.lds + F.wave * 8448);
    const int gw = F.vcu * NWAVES + F.wave, NGW = F.G * NWAVES;
    bf16_t* WUPE = (bf16_t*)(F.ws + WS_WUPE); bf16_t* WDNE = (bf16_t*)(F.ws + WS_WDNE);
    constexpr int I_E = 16 * 44, I_D = 22 * 32;
    for (int it = gw; it < NE * (2 * I_E + I_D); it += NGW) {
        const int e = it / (2 * I_E + I_D); int r = it - e * (2 * I_E + I_D);
        if (r < 2 * I_E) { const int q = r / I_E; r -= q * I_E; const int kb = r / 44, nb = r % 44, n0 = nb * 32;
            const float* W = (q ? F.in[24] : F.in[23]) + (size_t)e * 1024 * FFE;
            tr_item(W, FFE, kb * 64, n0, WUPE + (size_t)e * 2816 * 1024, 1024, (n0 >> 7) * 256 + q * 128 - (n0 & ~127), 0, false, scr, F.lane); }
        else { r -= 2 * I_E; const int kb = r / 32, nb = r % 32;
            tr_item(F.in[25] + (size_t)e * FFE * 1024, 1024, kb * 64, nb * 32, WDNE + (size_t)e * 1024 * FFE, FFE, 0, 0, false, scr, F.lane); }
    }
}

__device__ __forceinline__ void phase_final(Frame F, float* x, const bf16_t* YM, const float* mod, const float* fg) {
    F.tid = opaque_tid(F.wave0); F.lane = F.tid & 63; F.wave = __builtin_amdgcn_readfirstlane(F.tid >> 6);
    const int gw = F.vcu * NWAVES + F.wave, NGW = F.G * NWAVES;
    const int per = (((NLAT + NGW - 1) / NGW) + 1) & ~1;
    const int t0 = gw * per, t1 = min(t0 + per, NLAT);
    if (t0 >= t1) return;
    f32x4 fgv[4], gg[4]; int cur_b = -1;
#pragma unroll
    for (int q = 0; q < 4; ++q) { fgv[q] = *(const f32x4*)(fg + 4 * F.lane + 256 * q); gg[q] = (f32x4){0.f, 0.f, 0.f, 0.f}; }
    u32x2 xb[2][4], ya[2][4], yc[2][4];
#define FIN_LOAD(tk) do { _Pragma("unroll") for (int i = 0; i < 2; ++i) _Pragma("unroll") for (int q = 0; q < 4; ++q) { \
            xb[i][q] = RLD((const u32x2*)((const char*)x + (size_t)((tk) + i) * XPITCH) + F.lane + 64 * q); \
            ya[i][q] = RLD((const u32x2*)(YM + (size_t)((tk) + i) * D) + F.lane + 64 * q); yc[i][q] = RLD((const u32x2*)(YM + ((size_t)NLAT + (tk) + i) * D) + F.lane + 64 * q); } } while (0)
    FIN_LOAD(t0);
    for (int tok = t0; tok < t1; tok += 2) {
        const int b = tok >> 11;
        if (b != cur_b) { cur_b = b; const float* gate = mod + (size_t)b * MODW + 5 * D;
#pragma unroll
            for (int q = 0; q < 4; ++q) gg[q] = *(const f32x4*)(gate + 4 * F.lane + 256 * q); }
        f32x4 xv[2][4]; float s[2];
#pragma unroll
        for (int i = 0; i < 2; ++i) { float a = 0.f;
#pragma unroll
            for (int q = 0; q < 4; ++q) {
                const f32x4 yy = (f32x4){bflo(ya[i][q].x) + bflo(yc[i][q].x), bfhi(ya[i][q].x) + bfhi(yc[i][q].x), bflo(ya[i][q].y) + bflo(yc[i][q].y), bfhi(ya[i][q].y) + bfhi(yc[i][q].y)};
                xv[i][q] = (f32x4){bflo(xb[i][q].x), bfhi(xb[i][q].x), bflo(xb[i][q].y), bfhi(xb[i][q].y)} + gg[q] * yy; a += (xv[i][q][0] * xv[i][q][0] + xv[i][q][1] * xv[i][q][1]) + (xv[i][q][2] * xv[i][q][2] + xv[i][q][3] * xv[i][q][3]); }
            s[i] = a; }
        if (tok + 2 < t1) FIN_LOAD(tok + 2);
#pragma unroll
        for (int o = 1; o < 64; o <<= 1)
#pragma unroll
            for (int i = 0; i < 2; ++i) s[i] += shx(s[i], o, F.lane);
#pragma unroll
        for (int i = 0; i < 2; ++i) { const float rstd = rsqrtf(s[i] * (1.f / D) + EPS);
#pragma unroll
            for (int q = 0; q < 4; ++q) RST((f32x4*)(x + (size_t)(tok + i) * D) + F.lane + 64 * q, xv[i][q] * rstd * fgv[q]); }
    }
#undef FIN_LOAD
}

struct Args { const float* in[27]; float* out; unsigned char* ws; int ph_lo, ph_hi; };
__global__ void __launch_bounds__(NTHR, 2) dit_fwd(Args args) {
    extern __shared__ __attribute__((aligned(16))) unsigned char lds_raw[];
    LAS unsigned char* const ldsb = (LAS unsigned char*)lds_raw;
    const int WAVE = __builtin_amdgcn_readfirstlane((int)threadIdx.x >> 6);
    volatile LAS unsigned* xbw = (volatile LAS unsigned*)(ldsb + LDS_CTRL);
    if (threadIdx.x < 4) xbw[threadIdx.x] = 0u;
    __syncthreads();
    volatile LAS unsigned long long* tsl = (volatile LAS unsigned long long*)(ldsb + LDS_CTRL + 64);
    if (args.ph_hi - args.ph_lo > 1) (void)xcd_barrier_post((unsigned*)(args.ws + WS_CTL) + CW_BAR, xbw);
#ifndef SITE_MASK
#define SITE_MASK 0xFFFFFFFFu
#endif
#define SITE(n) (((SITE_MASK) >> (n)) & 1u)
#define IN(k) (args.ph_lo <= (k) && (k) < args.ph_hi)
#define STAMP(k) do { if (PROBE_MASK != 0u && blockIdx.x == 0 && opaque_tid(WAVE) == 0) tsl[(k)] = __builtin_amdgcn_s_memrealtime(); } while (0)
#define SEAM(k) do { if (IN(k) && IN((k) + 1)) { XcdBarrier _b; _b.bar = (unsigned*)(args.ws + WS_CTL) + CW_BAR; _b.x = xb_xcc_id(); _b.st = xbw; xcd_barrier(_b); } STAMP((k) + 1); } while (0)

#define WSBASE() size_t _wz = 0; asm volatile("" : "+s"(_wz)); unsigned char* ws = args.ws + _wz; float* MOD = (float*)(ws + WS_MOD); (void)MOD; \
    Frame F; F.lds = ldsb; F.ws = ws; F.ctl = (unsigned*)(ws + WS_CTL); F.in = args.in; F.out = args.out + _wz; F.wave0 = WAVE; F.tid = 0; F.lane = 0; F.wave = 0; \
    F.G = gridDim.x; { const int bx = blockIdx.x; F.vcu = (F.G % 8 == 0) ? (bx % 8) * (F.G / 8) + bx / 8 : bx; } const int c = (int)blockIdx.x; (void)c
#define P_COS ((const float*)(ws + WS_TAB))
#define P_SIN (P_COS + 1024)
#define P_LAMV (P_SIN + 1024)
#define P_XC ((float*)(ws + WS_XC))
#define P_H ((bf16_t*)(ws + WS_H))
#define P_U ((bf16_t*)(ws + WS_U))
#define P_Q ((bf16_t*)(ws + WS_Q))
#define P_KB ((bf16_t*)(ws + WS_K))
#define P_VT ((bf16_t*)(ws + WS_VT))
#define P_G ((unsigned char*)(ws + WS_G))
#define P_MA ((bf16_t*)(ws + WS_MA))
#define P_Y ((bf16_t*)(ws + WS_Y))
#define P_HID ((bf16_t*)(ws + WS_HID))
#define P_HIDM ((bf16_t*)(ws + WS_HIDM))
#define P_YM ((bf16_t*)(ws + WS_YM))

    if (PROBE_MASK != 0u && threadIdx.x == 0) { tsl[20] = 0; tsl[21] = 0; tsl[22] = 0; tsl[23] = 0; }
    STAMP(0);
    if (SITE(0) && IN(0)) { WSBASE(); phase_prologue(F); } SEAM(0);
    if (SITE(1) && IN(1)) { WSBASE(); phase_normmod<false>(F, F.in[0], F.in[2], F.in[6], MOD, 0, true, P_H); } SEAM(1);

    for (int l = 0; l < 2; ++l) {
        const int pb = 2 + 8 * l; const bool last = (l == 1);
        if (SITE(2) && IN(pb)) { WSBASE();
            ZSched S; S.init(F.G, c, last ? 1 : 0, P_H, ws + WS_WZ + (size_t)l * 9 * MiB, ws + WS_WV + (size_t)l * 2 * MiB);
            ZEpi E{P_U, P_Q, P_KB, P_G, P_VT, P_COS, P_SIN};
            pg8::gemm_phase(F.lds, WAVE, 1024, S, E);
        } SEAM(pb);
        if (SITE(3) && IN(pb + 1)) { WSBASE();
            phase_pool(F, P_U, P_MA, !last);
            const float lam = P_LAMV[2 * l], osc = P_LAMV[2 * l + 1]; const float* subg = F.in[15] + l * VD;
            bf16x8 qf[4];
            for (int i = 0;; ++i) { const int Lf = i * F.G + F.vcu; if (Lf >= NB * NH * 16) break; const int L = REV_ORDER ? NB * NH * 16 - 1 - Lf : Lf; const int bh = L >> 4, qt = L & 15, b = bh >> 3, h = bh & 7;
                const int Lfn = Lf + F.G; const bool hn = Lfn < NB * NH * 16; const int Ln = REV_ORDER ? NB * NH * 16 - 1 - Lfn : Lfn; const int nbh = Ln >> 4, nqt = Ln & 15, nb = nbh >> 3, nh = nbh & 7;
                att::attn_unit(F.lds, P_Q, P_KB, P_VT, P_MA, b, h, (size_t)b * LTOK + CTXL + qt * 128, 36, lam, osc, subg, qf, XUP ? i == 0 : true, XUP ? hn : false, nb, nh, (size_t)nb * LTOK + CTXL + nqt * 128, WAVE); }
            if (!last) for (int i = 0;; ++i) { const int L = i * F.G + F.vcu; if (L >= NB * NH * 2) break; const int bh = L >> 1, qt = L & 1, b = bh >> 3, h = bh & 7;
                const int Ln = L + F.G; const bool hn = Ln < NB * NH * 2; const int nbh = Ln >> 1, nqt = Ln & 1, nb = nbh >> 3, nh = nbh & 7;
                att::attn_unit(F.lds, P_Q, P_KB, P_VT, P_MA, b, h, (size_t)b * LTOK + qt * 128, 4, lam, osc, subg, qf, XUP ? i == 0 : true, XUP ? hn : false, nb, nh, (size_t)nb * LTOK + nqt * 128, WAVE); }
        } SEAM(pb + 1);
        if (SITE(4) && IN(pb + 2)) { WSBASE();
            MergeSched S; S.init(F.G, c, last ? 1 : 0, P_MA, ws + WS_WM + (size_t)l * 3 * MiB); MergeEpi E{P_Y, P_G}; pg8::gemm_phase(F.lds, WAVE, MAP, S, E);
        } SEAM(pb + 2);
        if (SITE(5) && IN(pb + 3)) { WSBASE();
            PlainSched S; S.init(F.G, c, last ? 1 : 0, 4, P_Y, ws + WS_WOUT + (size_t)l * 2 * MiB, 1024, REV_ORDER);
            OEpi E{P_Q, MOD + (size_t)l * 33 * MODW, 2 * D};
            pg8::gemm_phase(F.lds, WAVE, 1024, S, E);
        } SEAM(pb + 3);
        if (!last) {
            if (SITE(6) && IN(pb + 4)) { WSBASE(); phase_normmod<false>(F, F.in[0], F.in[2], F.in[7], MOD, 3 * D, true, P_H, P_Q, F.out, P_XC); } SEAM(pb + 4);
            if (SITE(7) && IN(pb + 5)) { WSBASE(); PlainSched S; S.init(F.G, c, 0, 22, P_H, ws + WS_WUP0, 1024); UpEpi E{P_HID, FFP}; pg8::gemm_phase(F.lds, WAVE, 1024, S, E); } SEAM(pb + 5);
            if (SITE(8) && IN(pb + 6)) { WSBASE(); PlainSched S; S.init(F.G, c, 0, 4, P_HID, ws + WS_WDN0, FFP, REV_ORDER); OEpi E{(bf16_t*)P_G, MOD, 5 * D}; pg8::gemm_phase(F.lds, WAVE, FFP, S, E); } SEAM(pb + 6);
            if (SITE(9) && IN(pb + 7)) { WSBASE(); phase_normmod<true>(F, F.out, P_XC, F.in[6] + D, MOD + (size_t)33 * MODW, 0, true, P_H, (const bf16_t*)P_G, F.out, P_XC); } SEAM(pb + 7);
        } else {
            if (SITE(10) && IN(pb + 4)) { WSBASE(); phase_router(F, (char*)F.out, F.in[7] + D, MOD + (size_t)33 * MODW, P_H, P_Q); } SEAM(pb + 4);
            if (SITE(12) && IN(pb + 5)) { WSBASE(); MoeInfo mi; mi.load(F.ctl); MoeSched S; S.init(F.G, c, 11, P_H, ws + WS_WUPE, 1024, 2816, mi); S.gather = 1; S.LIST = (const unsigned*)(ws + WS_LIST); UpEpi E{P_HIDM, FFE}; pg8::gemm_phase<true>(F.lds, WAVE, 1024, S, E); } SEAM(pb + 5);
            if (SITE(13) && IN(pb + 6)) { WSBASE(); MoeInfo mi; mi.load(F.ctl); MoeSched S; S.init(F.G, c, 4, P_HIDM, ws + WS_WDNE, FFE, 1024, mi); S.rev = REV_ORDER;
                MoeDownEpi E{P_YM, (const unsigned*)(ws + WS_LIST), (const float*)(ws + WS_WTS), mi}; pg8::gemm_phase(F.lds, WAVE, FFE, S, E); } SEAM(pb + 6);
            if (SITE(14) && IN(pb + 7)) { WSBASE(); phase_final(F, F.out, P_YM, MOD + (size_t)33 * MODW, F.in[26]); }
            if (PROBE_MASK != 0u && blockIdx.x == 0) { __syncthreads(); if (threadIdx.x == 0) { const unsigned long long tend = __builtin_amdgcn_s_memrealtime(); unsigned long long dly = 0;
                for (int k = 0; k < N_PHASES; ++k) if ((PROBE_MASK >> k) & 1u) dly += (k == N_PHASES - 1 ? tend : tsl[k + 1]) - tsl[k];
                if ((PROBE_MASK >> 20) & 1u) dly += tsl[20];
                if ((PROBE_MASK >> 21) & 1u) dly += tsl[21];
                if ((PROBE_MASK >> 22) & 1u) dly += tsl[22];
                if ((PROBE_MASK >> 23) & 1u) dly += tsl[23];
                while (__builtin_amdgcn_s_memrealtime() - tend < dly) __builtin_amdgcn_s_sleep(8); } }
        }
    }
#undef IN
#undef SEAM
}

extern "C" void kernel_launch(void* const* d_in, const int* in_sizes, int n_in, void* d_out, int out_size, void* d_ws, size_t ws_size, hipStream_t stream) {
    static int grid = 0;
    if (grid == 0) {
        if (n_in != 27 || ws_size < WS_END) { fprintf(stderr, "kernel_launch: unexpected n_in %d or ws %zu\n", n_in, ws_size); grid = -1; return; }
        int dev = 0, cus = 0;
        if (hipGetDevice(&dev) != hipSuccess || hipDeviceGetAttribute(&cus, hipDeviceAttributeMultiprocessorCount, dev) != hipSuccess) { grid = -1; return; }
        if (hipFuncSetAttribute((const void*)dit_fwd, hipFuncAttributeMaxDynamicSharedMemorySize, LDS_BYTES) != hipSuccess) { fprintf(stderr, "kernel_launch: hipFuncSetAttribute failed\n"); grid = -1; return; }
        (void)hipGetLastError();
        grid = cus;
    }
    if (grid < 0) return;
    (void)hipMemsetAsync((char*)d_ws + WS_CTL, 0, CTL_ZERO_BYTES, stream);
    Args a{};
    for (int i = 0; i < 27; ++i) a.in[i] = (const float*)d_in[i];
    a.out = (float*)d_out; a.ws = (unsigned char*)d_ws;
#if MK_ONE_LAUNCH
    a.ph_lo = 0; a.ph_hi = N_PHASES;
    hipLaunchKernelGGL(dit_fwd, dim3(grid), dim3(NTHR), LDS_BYTES, stream, a);
#else
    for (int p = 0; p < N_PHASES; ++p) { a.ph_lo = p; a.ph_hi = p + 1; hipLaunchKernelGGL(dit_fwd, dim3(grid), dim3(NTHR), LDS_BYTES, stream, a); }
#endif
}
```

```cpp
#include <hip/hip_runtime.h>
#include <cstdio>
#include <cstdint>

#define LAS __attribute__((address_space(3)))
#define GAS __attribute__((address_space(1)))
typedef unsigned short bf16_t;
typedef short bf16x8 __attribute__((ext_vector_type(8)));
typedef float f32x4 __attribute__((ext_vector_type(4)));
typedef float f32x16 __attribute__((ext_vector_type(16)));
typedef unsigned u32x4 __attribute__((ext_vector_type(4)));
typedef unsigned u32x2 __attribute__((ext_vector_type(2)));
typedef float f32x2_t __attribute__((ext_vector_type(2)));
typedef __bf16 bf16x2_t __attribute__((ext_vector_type(2)));

#ifndef PROBE_MASK
#define PROBE_MASK 0u
#endif
#ifndef PG8_ALIGN
#define PG8_ALIGN 1
#endif
#ifndef ATT_PRIO
#define ATT_PRIO 0
#ifndef REV_ORDER
#define REV_ORDER 1
#endif
#ifndef ROW_NT
#define ROW_NT 1
#endif
#endif
#ifndef XUP
#define XUP 0
#endif
#ifndef GEMM_STAGGER
#define GEMM_STAGGER 0
#endif
#ifndef MK_ONE_LAUNCH
#define MK_ONE_LAUNCH 1
#endif

constexpr int D = 1024, NB = 32, SEQ = 2048, CTXL = 256, LTOK = SEQ + CTXL, NTOK = NB * LTOK, NRT = NTOK / 256;
constexpr int NLAT = NB * SEQ;
constexpr int NH = 8, VD = 128;
constexpr int FF = 2752, FFP = 2816, NE = 8, FFE = 1408;
constexpr int MODW = 6 * D;
constexpr float EPS = 1e-6f;
constexpr float LOG2E = 1.4426950408889634f;
constexpr float QSCALE = 0.125f * LOG2E;
constexpr int NWAVES = 8, NTHR = 512;

constexpr size_t MiB = 1u << 20;
constexpr size_t WS_CTL = 0, CTL_ZERO_BYTES = 65536;
constexpr size_t WS_MOD = 65536;
constexpr size_t WS_TAB = 1703936;
constexpr size_t WS_XC = 2 * MiB;
constexpr size_t WS_W = 34 * MiB;
constexpr size_t WS_WZ = WS_W, WS_WV = WS_W + 18 * MiB, WS_WM = WS_W + 22 * MiB, WS_WOUT = WS_W + 28 * MiB, WS_WUP0 = WS_W + 32 * MiB, WS_WDN0 = WS_W + 43 * MiB;
constexpr size_t WS_H = 83 * MiB, WS_MA = 83 * MiB, WS_U = 299 * MiB, WS_Q = 371 * MiB, WS_K = 515 * MiB, WS_VT = 659 * MiB, WS_G = 803 * MiB, WS_END = 982 * MiB;
constexpr size_t WS_Y = WS_K, WS_HID = WS_U;
constexpr size_t WS_YM = 299 * MiB, WS_HIDM = 555 * MiB, WS_WUPE = 913 * MiB, WS_WDNE = 957 * MiB, WS_LIST = 979 * MiB, WS_WTS = 981 * MiB;
constexpr int MAP = 1536;
static_assert(WS_WDN0 + (size_t)D * FFP * 2 <= WS_H, "weights");
static_assert(WS_MA + (size_t)NTOK * MAP * 2 <= WS_U && WS_G + (size_t)NTOK * 2048 <= WS_END, "ma / g");
static_assert(WS_HID + (size_t)NTOK * FFP * 2 <= WS_END, "hid");
static_assert(WS_YM + (size_t)2 * NLAT * D * 2 <= WS_HIDM && WS_HIDM + (size_t)133120 * FFE * 2 <= WS_WUPE && WS_WTS + (size_t)NLAT * 8 <= WS_END, "moe");
constexpr int CW_BAR = 1024, CW_CNT = 8192;

constexpr int N_PHASES = 18;
constexpr int LDS_BYTES = 163840;
constexpr int LDS_CTRL = LDS_BYTES - 256;

__device__ __forceinline__ unsigned cvtpk(float lo, float hi) { f32x2_t v = {lo, hi}; bf16x2_t b = __builtin_convertvector(v, bf16x2_t); return __builtin_bit_cast(unsigned, b); }
__device__ __forceinline__ float bflo(unsigned w) { return __uint_as_float(w << 16); }
__device__ __forceinline__ float bfhi(unsigned w) { return __uint_as_float(w & 0xffff0000u); }
__device__ __forceinline__ u32x4 pack8(const f32x4 a, const f32x4 b) { u32x4 w; w.x = cvtpk(a[0], a[1]); w.y = cvtpk(a[2], a[3]); w.z = cvtpk(b[0], b[1]); w.w = cvtpk(b[2], b[3]); return w; }
__device__ __forceinline__ float shx(float v, int o, int lane) { return __int_as_float(__builtin_amdgcn_ds_bpermute((lane ^ o) << 2, __float_as_int(v))); }
__device__ __forceinline__ float wave_sum(float v, int lane) {
#pragma unroll
    for (int o = 1; o < 64; o <<= 1) v += shx(v, o, lane);
    return v;
}
__device__ __forceinline__ float pair_sum(float v) { auto rr = __builtin_amdgcn_permlane32_swap(__float_as_uint(v), __float_as_uint(v), false, false); return __uint_as_float(rr[0]) + __uint_as_float(rr[1]); }
__device__ __forceinline__ float pair_max(float v) { auto rr = __builtin_amdgcn_permlane32_swap(__float_as_uint(v), __float_as_uint(v), false, false); return fmaxf(__uint_as_float(rr[0]), __uint_as_float(rr[1])); }
__device__ __forceinline__ float fast_sigmoid(float x) { return __builtin_amdgcn_rcpf(1.f + __builtin_amdgcn_exp2f(-LOG2E * x)); }
#define LDS_WAIT() asm volatile("s_waitcnt lgkmcnt(0)" ::: "memory")
__device__ __forceinline__ int opaque_tid(int wave) { unsigned z = 0u; asm volatile("" : "+v"(z)); return (wave << 6) | (int)__builtin_amdgcn_mbcnt_hi(~0u, __builtin_amdgcn_mbcnt_lo(~0u, z)); }

#define XB_TMO      128
#define XB_XCNT(j)  (256  + 64 * (j))
#define XB_XSUB(j)  (1280 + 64 * (j))
#define XB_XGEN(j)  (2304 + 64 * (j))
#define XB_TOP      3328
#define XB_TOPGEN   3392
#define XCD_BAR_WORDS 3456
#define XB_SPIN_CAP (1u << 22)
__device__ __forceinline__ unsigned xb_ld(unsigned* p)              { return __hip_atomic_load(p, __ATOMIC_RELAXED, __HIP_MEMORY_SCOPE_AGENT); }
__device__ __forceinline__ unsigned xb_add(unsigned* p, unsigned v) { return __hip_atomic_fetch_add(p, v, __ATOMIC_RELAXED, __HIP_MEMORY_SCOPE_AGENT); }
__device__ __forceinline__ unsigned xb_xcc_id() { return (unsigned)__builtin_amdgcn_s_getreg((3 << 11) | 20) & 0xFu; }
#define XB_SPIN(cond, bar) do { unsigned _sp = 0; while (cond) { __builtin_amdgcn_s_sleep(1); \
    if ((++_sp & 255u) == 0u) { if (xb_ld(&(bar)[XB_TMO])) break; if (_sp > XB_SPIN_CAP) { atomicAdd(&(bar)[XB_TMO], 1u); break; } } } } while (0)
struct XcdBarrier { unsigned* bar; unsigned x; volatile LAS unsigned* st; };
__device__ __forceinline__ XcdBarrier xcd_barrier_post(unsigned* bar, volatile LAS unsigned* st) {
    XcdBarrier b; b.bar = bar; b.x = xb_xcc_id(); b.st = st;
    if (threadIdx.x == 0) (void)xb_add(&bar[XB_XCNT(b.x)], 1u);
    return b;
}
__device__ __forceinline__ void xcd_barrier_complete(unsigned* bar, unsigned x, unsigned& nloc, unsigned& nx) {
    const unsigned G = gridDim.x * gridDim.y * gridDim.z;
    unsigned sum, cnt, mine, sp = 0u;
    for (;;) {
        sum = 0u; cnt = 0u; mine = 0u;
#pragma unroll
        for (unsigned j = 0; j < 16; ++j) { const unsigned c = xb_ld(&bar[XB_XCNT(j)]); sum += c; cnt += (c > 0u) ? 1u : 0u; mine = (j == x) ? c : mine; }
        if (sum == G) break;
        __builtin_amdgcn_s_sleep(1);
        if ((++sp & 255u) == 0u) { if (xb_ld(&bar[XB_TMO])) break; if (sp > XB_SPIN_CAP) { atomicAdd(&bar[XB_TMO], 1u); break; } }
    }
    nloc = mine > 0u ? mine : 1u; nx = cnt > 0u ? cnt : 1u;
}
__device__ __forceinline__ void xcd_barrier(const XcdBarrier& b) {
    asm volatile("s_waitcnt vmcnt(0)" ::: "memory");
    __syncthreads();
    if (threadIdx.x == 0) {
        unsigned* bar = b.bar;
        __builtin_amdgcn_s_waitcnt(0);
        unsigned nloc = b.st[0], nx = b.st[1];
        if (nloc == 0u) { xcd_barrier_complete(bar, b.x, nloc, nx); b.st[0] = nloc; b.st[1] = nx; }
        const unsigned old = xb_add(&bar[XB_XSUB(b.x)], 1u);
        const unsigned gen = old / nloc;
        if (old + 1u == (gen + 1u) * nloc) {
            __builtin_amdgcn_fence(__ATOMIC_RELEASE, "agent");
            asm volatile("s_waitcnt vmcnt(0)" ::: "memory");
            const unsigned og = xb_add(&bar[XB_TOP], 1u);
            const unsigned tg = og / nx;
            if (og + 1u == (tg + 1u) * nx) xb_add(&bar[XB_TOPGEN], 1u);
            else XB_SPIN(xb_ld(&bar[XB_TOPGEN]) == tg, bar);
            __builtin_amdgcn_fence(__ATOMIC_ACQUIRE, "agent");
            xb_add(&bar[XB_XGEN(b.x)], 1u);
            asm volatile("s_waitcnt vmcnt(0)" ::: "memory");
        } else {
            XB_SPIN(xb_ld(&bar[XB_XGEN(b.x)]) == gen, bar);
            __builtin_amdgcn_fence(__ATOMIC_ACQUIRE, "agent");
            asm volatile("s_waitcnt vmcnt(0)" ::: "memory");
        }
    }
    __syncthreads();
}

namespace pg8 {
constexpr int BM = 256, BK = 64, HALF = 128, HTB = HALF * BK * 2, NXCD = 8, WGM = 8;
__host__ __device__ __forceinline__ int lds_byte(int r, int c) { const int st = (r >> 4) * 2 + (c >> 5), rr = r & 15, cc = c & 31, ob = rr * 64 + cc * 2; return st * 1024 + (ob ^ (((ob >> 9) & 1) << 5)); }
__host__ __device__ __forceinline__ void stage_rc(int b, int& R, int& C) { const int st = b / 1024, sb = b % 1024, swz = sb ^ (((sb >> 9) & 1) << 5); R = (st >> 1) * 16 + swz / 64; C = (st & 1) * 32 + (swz % 64) / 2; }
__host__ __device__ __forceinline__ int perm32(int rho) { const int n = rho >> 4, i = rho & 15; return 8 * (i >> 2) + 4 * n + (i & 3); }
struct Unit { int pm, pn, kind; };
struct GridMap {
    int nM, nN, nwg;
    __device__ __forceinline__ void init(int nM_, int nN_) { nM = nM_; nN = nN_; nwg = nM_ * nN_; }
    __device__ __forceinline__ void map(int L, int& pm, int& pn) const {
        int wgid = L; { const int q = nwg / NXCD, r = nwg % NXCD, xcd = wgid % NXCD, off = wgid / NXCD; wgid = (xcd < r ? xcd * (q + 1) : r * (q + 1) + (xcd - r) * q) + off; }
        const int nig = WGM * nN, gid = wgid / nig, fm = gid * WGM, gsz = (nM - fm) < WGM ? (nM - fm) : WGM;
        pm = fm + ((wgid % nig) % gsz); pn = (wgid % nig) / gsz;
    }
};
template <bool GATHER = false, class Epi, class Sched>
__device__ __forceinline__ void gemm_phase(LAS unsigned char* lds, const int wv, const int K, const Sched& S, const Epi& E) {
    const int tid = opaque_tid(wv), wid = __builtin_amdgcn_readfirstlane(tid >> 6), lane = tid & 63, wr = wid >> 2, wc = wid & 3, fr = lane & 15, fq = lane >> 4;
    int nt = K / BK;
    unsigned voffA[2], voffB[2]; int RA[2];
#pragma unroll
    for (int i = 0; i < 2; ++i) { int R, C; stage_rc(tid * 16 + i * 8192, R, C); const int Rb = (R & ~31) + perm32(R & 31); RA[i] = R;
        voffA[i] = GATHER ? (unsigned)C * 2u : (unsigned)(R * K + C) * 2u; voffB[i] = (unsigned)(Rb * K + C) * 2u; }
    unsigned gC[2][2] = {{0u, 0u}, {0u, 0u}}, gN[2][2] = {{0u, 0u}, {0u, 0u}};
    const size_t kstep = (size_t)(BK * 2);
    const size_t hstep = (size_t)HALF * K * 2;
    const unsigned ldsw = (unsigned)wid * 1024u;
    const int aoff = lds_byte(wr * 64 + fr, fq * 8), boff = lds_byte(wc * 32 + fr, fq * 8);
#define PG8_SA(b, h) (((b) * 2 + (h)) * HTB)
#define PG8_SB(b, h) ((4 + (b) * 2 + (h)) * HTB)
#define PG8_STAGE(bufoff, gbase, voff) do { _Pragma("unroll") for (int _i = 0; _i < 2; ++_i) \
        __builtin_amdgcn_global_load_lds((const unsigned*)((const char*)(gbase) + (voff)[_i]), (LAS unsigned*)(lds + (bufoff) + ldsw + _i * 8192), 16, 0, 0); } while (0)
#define PG8_STAGE2(bufoff, gbase, o0, o1) do { \
        __builtin_amdgcn_global_load_lds((const unsigned*)((const char*)(gbase) + (o0)), (LAS unsigned*)(lds + (bufoff) + ldsw), 16, 0, 0); \
        __builtin_amdgcn_global_load_lds((const unsigned*)((const char*)(gbase) + (o1)), (LAS unsigned*)(lds + (bufoff) + ldsw + 8192), 16, 0, 0); } while (0)
#define PG8_LDA(dst, b, h) do { _Pragma("unroll") for (int m = 0; m < 4; ++m) _Pragma("unroll") for (int k = 0; k < 2; ++k) dst[m][k] = *(const LAS bf16x8*)(lds + PG8_SA(b, h) + aoff + m * 2048 + k * 1024); } while (0)
#define PG8_LDB(dst, b, h) do { _Pragma("unroll") for (int n = 0; n < 2; ++n) _Pragma("unroll") for (int k = 0; k < 2; ++k) dst[n][k] = *(const LAS bf16x8*)(lds + PG8_SB(b, h) + boff + n * 2048 + k * 1024); } while (0)
#define PG8_MMA(ai, bj, At, Bt) do { __builtin_amdgcn_s_setprio(1); _Pragma("unroll") for (int m = 0; m < 4; ++m) _Pragma("unroll") for (int n = 0; n < 2; ++n) _Pragma("unroll") for (int k = 0; k < 2; ++k) \
        acc[ai][bj][m][n] = __builtin_amdgcn_mfma_f32_16x16x32_bf16(Bt[n][k], At[m][k], acc[ai][bj][m][n], 0, 0, 0); __builtin_amdgcn_s_setprio(0); } while (0)
#define PG8_WAIT_V(n) asm volatile("s_waitcnt vmcnt(" #n ")" ::: "memory")
#define PG8_WAIT_L(n) asm volatile("s_waitcnt lgkmcnt(" #n ")" ::: "memory")
#define PG8_BAR __builtin_amdgcn_s_barrier()
#define PG8_SCHED __builtin_amdgcn_sched_barrier(0)
#define PG8_ITER(t) do { \
            const bool last = (t == nt - 2); \
            const char* a1 = cA + (size_t)(t + 1) * kstep; \
            const char* a2 = (last ? nA : cA + (size_t)(t + 2) * kstep); const char* b2 = last ? nB : cB + (size_t)(t + 2) * kstep; \
            const char* a3 = a2 + kstep; const char* b3 = b2 + kstep; \
            unsigned s00 = 0u, s01 = 0u, s10 = 0u, s11 = 0u; \
            if constexpr (GATHER) { s00 = last ? gN[0][0] : gC[0][0]; s01 = last ? gN[0][1] : gC[0][1]; s10 = last ? gN[1][0] : gC[1][0]; s11 = last ? gN[1][1] : gC[1][1]; } \
            PG8_LDB(B0, 0, 0); PG8_LDB(B1, 0, 1); PG8_SCHED; PG8_LDA(At, 0, 0); \
            if constexpr (GATHER) PG8_STAGE2(PG8_SA(1, 1), a1, gC[1][0], gC[1][1]); else PG8_STAGE(PG8_SA(1, 1), a1 + hstep, voffA); \
            PG8_WAIT_V(8); \
            PG8_WAIT_L(0); PG8_BAR; PG8_MMA(0, 0, At, B0); PG8_MMA(0, 1, At, B1); PG8_BAR; PG8_SCHED; \
            PG8_LDA(At, 0, 1); PG8_STAGE(PG8_SB(0, 0), b2, voffB); PG8_STAGE(PG8_SB(0, 1), b2 + hstep, voffB); \
            if constexpr (GATHER) PG8_STAGE2(PG8_SA(0, 0), a2, s00, s01); else PG8_STAGE(PG8_SA(0, 0), a2, voffA); \
            PG8_WAIT_V(8); \
            PG8_WAIT_L(0); PG8_BAR; PG8_MMA(1, 0, At, B0); PG8_MMA(1, 1, At, B1); PG8_BAR; PG8_SCHED; \
            PG8_LDB(B0, 1, 0); PG8_LDB(B1, 1, 1); PG8_SCHED; PG8_LDA(At, 1, 0); \
            if constexpr (GATHER) PG8_STAGE2(PG8_SA(0, 1), a2, s10, s11); else PG8_STAGE(PG8_SA(0, 1), a2 + hstep, voffA); \
            PG8_WAIT_V(8); PG8_WAIT_L(0); PG8_BAR; PG8_MMA(0, 0, At, B0); PG8_MMA(0, 1, At, B1); PG8_BAR; PG8_SCHED; \
            PG8_LDA(At, 1, 1); PG8_STAGE(PG8_SB(1, 0), b3, voffB); PG8_STAGE(PG8_SB(1, 1), b3 + hstep, voffB); \
            if constexpr (GATHER) PG8_STAGE2(PG8_SA(1, 0), a3, s00, s01); else PG8_STAGE(PG8_SA(1, 0), a3, voffA); \
            PG8_WAIT_V(8); PG8_WAIT_L(0); PG8_BAR; PG8_MMA(1, 0, At, B0); PG8_MMA(1, 1, At, B1); PG8_BAR; PG8_SCHED; \
        } while (0)
    Unit cur, nxt; int ui = 0;
    if (!S.next(0, cur)) return;
#if GEMM_STAGGER
    if (blockIdx.x & 1) { const unsigned long long t0s = __builtin_amdgcn_s_memrealtime(); const unsigned long long dl = ((unsigned long long)K * GEMM_STAGGER) >> 4;
        while (__builtin_amdgcn_s_memrealtime() - t0s < dl) __builtin_amdgcn_s_sleep(16); }
#endif
    f32x4 acc[2][2][4][2];
#pragma unroll
    for (int a = 0; a < 2; ++a)
#pragma unroll
        for (int b = 0; b < 2; ++b)
#pragma unroll
            for (int m = 0; m < 4; ++m)
#pragma unroll
                for (int n = 0; n < 2; ++n) acc[a][b][m][n] = (f32x4){0.f, 0.f, 0.f, 0.f};
    bf16x8 At[4][2], B0[2][2], B1[2][2];
    const char* cA = S.abase(cur); const char* cB = S.bbase(cur);
    if constexpr (Sched::VAR_NT) nt = S.ktiles(cur);
    if constexpr (GATHER) {
#pragma unroll
        for (int h = 0; h < 2; ++h)
#pragma unroll
            for (int i = 0; i < 2; ++i) gC[h][i] = S.grow(cur, h * HALF + RA[i]) + voffA[i];
    }
    PG8_STAGE(PG8_SB(0, 0), cB, voffB); PG8_STAGE(PG8_SB(0, 1), cB + hstep, voffB);
    if constexpr (GATHER) { PG8_STAGE2(PG8_SA(0, 0), cA, gC[0][0], gC[0][1]); PG8_STAGE2(PG8_SA(0, 1), cA, gC[1][0], gC[1][1]); }
    else { PG8_STAGE(PG8_SA(0, 0), cA, voffA); PG8_STAGE(PG8_SA(0, 1), cA + hstep, voffA); }
    if (wr == 1) PG8_BAR;
    PG8_WAIT_V(2); PG8_BAR;
    PG8_STAGE(PG8_SB(1, 0), cB + kstep, voffB);
    if constexpr (GATHER) PG8_STAGE2(PG8_SA(1, 0), cA + kstep, gC[0][0], gC[0][1]); else PG8_STAGE(PG8_SA(1, 0), cA + kstep, voffA);
    PG8_STAGE(PG8_SB(1, 1), cB + hstep + kstep, voffB);
    PG8_WAIT_V(6); PG8_BAR;
    for (;;) {
        const bool has_next = S.next(ui + 1, nxt);
        const char* nA = has_next ? S.abase(nxt) : cA; const char* nB = has_next ? S.bbase(nxt) : cB;
        if constexpr (GATHER) {
#pragma unroll
            for (int h = 0; h < 2; ++h)
#pragma unroll
                for (int i = 0; i < 2; ++i) gN[h][i] = has_next ? S.grow(nxt, h * HALF + RA[i]) + voffA[i] : gC[h][i];
        }
        for (int t = 0; t < nt; t += 2) PG8_ITER(t);
        if (PG8_ALIGN) { if (wr == 0) PG8_BAR; }
#if PROBE_MASK
        const unsigned long long _te0 = __builtin_amdgcn_s_memrealtime();
#endif
        bool keep = false;
        if constexpr (Epi::CHAINED) { if (cur.kind == 0) { E.mid(acc, cur, wr, wc, fr, fq); keep = true; } else E(acc, cur, wr, wc, fr, fq); } else E(acc, cur, wr, wc, fr, fq);
#if PROBE_MASK
        if (blockIdx.x == 0 && tid == 0) { asm volatile("s_waitcnt vmcnt(0)" ::: "memory"); volatile LAS unsigned long long* pacc = (volatile LAS unsigned long long*)(lds + LDS_CTRL + 64) + 21; *pacc = *pacc + (__builtin_amdgcn_s_memrealtime() - _te0); }
#endif
        if (!has_next) break;
        if (!keep) {
#pragma unroll
        for (int a = 0; a < 2; ++a)
#pragma unroll
            for (int b = 0; b < 2; ++b)
#pragma unroll
                for (int m = 0; m < 4; ++m)
#pragma unroll
                    for (int n = 0; n < 2; ++n) acc[a][b][m][n] = (f32x4){0.f, 0.f, 0.f, 0.f};
        }
        cur = nxt; cA = nA; cB = nB; ++ui;
        if constexpr (Sched::VAR_NT) nt = S.ktiles(cur);
        if constexpr (GATHER) { gC[0][0] = gN[0][0]; gC[0][1] = gN[0][1]; gC[1][0] = gN[1][0]; gC[1][1] = gN[1][1]; }
        if (PG8_ALIGN) { if (wr == 1) PG8_BAR; }
    }
    PG8_WAIT_V(0);
    if (!PG8_ALIGN) { if (wr == 0) PG8_BAR; }
    PG8_BAR;
#undef PG8_SA
#undef PG8_SB
#undef PG8_STAGE
#undef PG8_STAGE2
#undef PG8_ITER
#undef PG8_LDA
#undef PG8_LDB
#undef PG8_MMA
#undef PG8_WAIT_V
#undef PG8_WAIT_L
#undef PG8_BAR
#undef PG8_SCHED
}
}
using pg8::Unit;
typedef const f32x4 (&AccRef)[2][2][4][2];

struct Frame {
    LAS unsigned char* lds;
    unsigned char* ws;
    unsigned* ctl;
    const float* const* in;
    float* out;
    int tid, lane, wave, vcu, G, wave0;
};

#if ROW_NT
#define RLD(p) __builtin_nontemporal_load(p)
#define RST(p, v) __builtin_nontemporal_store((v), (p))
#else
#define RLD(p) (*(p))
#define RST(p, v) (*(p) = (v))
#endif
#ifndef EPI_NT
#define EPI_NT 0u
#endif
template <unsigned BIT, class T> __device__ __forceinline__ void epi_st(T* p, const T v) { if constexpr ((EPI_NT & BIT) != 0u) __builtin_nontemporal_store(v, p); else *p = v; }
constexpr size_t TS1024 = (size_t)256 * 1024 * 2;

struct ZSched {
    static constexpr bool VAR_NT = false;
    int G, c, last, n0, n1; const char *H, *WZ, *WV; pg8::GridMap g0, g1, g2;
    __device__ __forceinline__ void init(int G_, int c_, int last_, const void* H_, const void* WZ_, const void* WV_) {
        G = G_; c = c_; last = last_; H = (const char*)H_; WZ = (const char*)WZ_; WV = (const char*)WV_;
        if (last) { g0.init(256, 18); g1.init(32, 4); } else { g0.init(NRT, 18); g1.init(0, 4); }
        g2.init(4, NRT); n0 = g0.nwg; n1 = g1.nwg;
    }
    __device__ __forceinline__ bool next(int i, Unit& u) const {
        int L = i * G + c, a, b;
        if (L < n0) { g0.map(L, a, b); u.kind = 0; u.pm = last ? (a >> 3) * 9 + 1 + (a & 7) : a; u.pn = b; return true; }
        L -= n0;
        if (L < n1) { g1.map(L, a, b); u.kind = 0; u.pm = a * 9; u.pn = 6 + b; return true; }
        L -= n1;
        if (L < g2.nwg) { g2.map(L, a, b); u.kind = 1; u.pm = a; u.pn = b; return true; }
        return false;
    }
    __device__ __forceinline__ const char* abase(const Unit& u) const { return (u.kind ? WV : H) + (size_t)u.pm * TS1024; }
    __device__ __forceinline__ const char* bbase(const Unit& u) const { return (u.kind ? H : WZ) + (size_t)u.pn * TS1024; }
};
struct ZEpi {
    static constexpr bool CHAINED = false;
    bf16_t *U, *Q, *KB; unsigned char* G; bf16_t* VT; const float *COS, *SIN;
    __device__ __forceinline__ void operator()(AccRef acc, const Unit& u, int wr, int wc, int fr, int fq) const {
        if (u.kind == 1) {
            const int b = u.pn / 9, jt = u.pn - b * 9;
            bf16_t* base = VT + ((size_t)b * 1024 + u.pm * 256 + wr * 64 + fr) * LTOK + jt * 256 + wc * 32 + 8 * fq;
#pragma unroll
            for (int ai = 0; ai < 2; ++ai)
#pragma unroll
                for (int m = 0; m < 4; ++m) { bf16_t* rowp = base + (size_t)(ai * 128 + m * 16) * LTOK;
#pragma unroll
                    for (int bj = 0; bj < 2; ++bj) epi_st<1u>((u32x4*)(rowp + bj * 128), pack8(acc[ai][bj][m][0], acc[ai][bj][m][1])); }
            return;
        }
        const int pn = u.pn; const size_t row0 = (size_t)u.pm * 256 + wr * 64 + fr; const int cin = wc * 32 + 8 * fq;
        if (pn < 2) {
#pragma unroll
            for (int ai = 0; ai < 2; ++ai)
#pragma unroll
                for (int m = 0; m < 4; ++m) { bf16_t* rowp = U + (row0 + ai * 128 + m * 16) * 512 + pn * 256 + cin;
#pragma unroll
                    for (int bj = 0; bj < 2; ++bj) epi_st<2u>((u32x4*)(rowp + bj * 128), pack8(acc[ai][bj][m][0], acc[ai][bj][m][1])); }
        } else if (pn < 10) {
            const bool isq = pn < 6; bf16_t* dst = isq ? Q : KB; const int ct = isq ? pn - 2 : pn - 6; const float sc = isq ? QSCALE : 1.f;
            const int jt = u.pm % 9; const bool lat = jt != 0; const int axis = wc & 1;
#pragma unroll
            for (int ai = 0; ai < 2; ++ai) {
                f32x4 c4[4], s4[4];
#pragma unroll
                for (int m = 0; m < 4; ++m) { const int pos = axis ? (16 * m + fr) : (((jt - 1) * 4 + 2 * ai + wr) & 63);
                    c4[m] = *(const f32x4*)(COS + pos * 16 + 4 * fq); s4[m] = *(const f32x4*)(SIN + pos * 16 + 4 * fq);
                    if (!lat) { c4[m] = (f32x4){1.f, 1.f, 1.f, 1.f}; s4[m] = (f32x4){0.f, 0.f, 0.f, 0.f}; } }
                asm volatile("" ::: "memory");
#pragma unroll
                for (int m = 0; m < 4; ++m) {
                    bf16_t* rowp = dst + (row0 + ai * 128 + m * 16) * 1024 + ct * 256 + cin;
#pragma unroll
                    for (int bj = 0; bj < 2; ++bj) { const f32x4 a = acc[ai][bj][m][0], b = acc[ai][bj][m][1];
                        const f32x4 ra = (a * c4[m] - b * s4[m]) * sc, rb = (a * s4[m] + b * c4[m]) * sc;
                        epi_st<4u>((u32x4*)(rowp + bj * 128), pack8(ra, rb)); }
                }
                asm volatile("" ::: "memory");
            }
        } else {
            const int ct = pn - 10;
#pragma unroll
            for (int ai = 0; ai < 2; ++ai)
#pragma unroll
                for (int m = 0; m < 4; ++m) { unsigned char* rowp = G + (row0 + ai * 128 + m * 16) * 2048 + ct * 256 + cin;
#pragma unroll
                    for (int bj = 0; bj < 2; ++bj) { const f32x4 a = acc[ai][bj][m][0], b = acc[ai][bj][m][1]; u32x2 o; o.x = 0u; o.y = 0u;
#pragma unroll
                        for (int j = 0; j < 4; ++j) { o.x = __builtin_amdgcn_cvt_pk_u8_f32(__builtin_rintf(fast_sigmoid(a[j]) * 255.f), j, o.x); o.y = __builtin_amdgcn_cvt_pk_u8_f32(__builtin_rintf(fast_sigmoid(b[j]) * 255.f), j, o.y); }
                        epi_st<8u>((u32x2*)(rowp + bj * 128), o); } }
        }
    }
};

struct PlainSched {
    static constexpr bool VAR_NT = false;
    int G, c, latonly, rev; const char *A, *B; size_t ats, bts; pg8::GridMap g;
    __device__ __forceinline__ void init(int G_, int c_, int latonly_, int nN, const void* A_, const void* B_, int K, int rev_ = 0) {
        G = G_; c = c_; latonly = latonly_; rev = rev_; A = (const char*)A_; B = (const char*)B_; ats = bts = (size_t)256 * K * 2; g.init(latonly_ ? 256 : NRT, nN);
    }
    __device__ __forceinline__ bool next(int i, Unit& u) const {
        int L = i * G + c; if (L >= g.nwg) return false; if (rev) L = g.nwg - 1 - L; int a, b; g.map(L, a, b);
        u.kind = 0; u.pm = latonly ? (a >> 3) * 9 + 1 + (a & 7) : a; u.pn = b; return true;
    }
    __device__ __forceinline__ const char* abase(const Unit& u) const { return A + (size_t)u.pm * ats; }
    __device__ __forceinline__ const char* bbase(const Unit& u) const { return B + (size_t)u.pn * bts; }
};
struct MergeSched {
    static constexpr bool VAR_NT = true;
    int G, c, latonly; const char *A, *B; pg8::GridMap g;
    __device__ __forceinline__ void init(int G_, int c_, int latonly_, const void* A_, const void* B_) { G = G_; c = c_; latonly = latonly_; A = (const char*)A_; B = (const char*)B_; g.init(latonly_ ? 256 : NRT, 4); }
    __device__ __forceinline__ bool next(int i, Unit& u) const {
        const int L = (i >> 1) * G + c; if (L >= g.nwg) return false; int a, b; g.map(L, a, b);
        u.kind = i & 1; u.pm = latonly ? (a >> 3) * 9 + 1 + (a & 7) : a; u.pn = b; return true;
    }
    __device__ __forceinline__ int ktiles(const Unit& u) const { return u.kind ? 16 : 8; }
    __device__ __forceinline__ const char* abase(const Unit& u) const { return A + (size_t)u.pm * ((size_t)256 * MAP * 2) + (u.kind ? 1024 : 0); }
    __device__ __forceinline__ const char* bbase(const Unit& u) const { return B + (size_t)u.pn * ((size_t)256 * MAP * 2) + (u.kind ? 1024 : 0); }
};
__device__ __forceinline__ void unpack8(const u32x4 w, f32x4& a, f32x4& b) { a = (f32x4){bflo(w.x), bfhi(w.x), bflo(w.y), bfhi(w.y)}; b = (f32x4){bflo(w.z), bfhi(w.z), bflo(w.w), bfhi(w.w)}; }
__device__ __forceinline__ f32x4 ub4(unsigned w) { return (f32x4){(float)(w & 255u), (float)((w >> 8) & 255u), (float)((w >> 16) & 255u), (float)(w >> 24)}; }
struct MergeEpi {
    static constexpr bool CHAINED = true;
    bf16_t* O; const unsigned char* Gt;
    __device__ __forceinline__ void mid(f32x4 (&acc)[2][2][4][2], const Unit& u, int wr, int wc, int fr, int fq) const {
        const unsigned loff = (unsigned)((wr * 64 + fr) * 2048 + wc * 32 + 8 * fq);
#pragma unroll
        for (int ai = 0; ai < 2; ++ai) {
            u32x2 wp[4][2], wa[4][2];
#pragma unroll
            for (int m = 0; m < 4; ++m) { const unsigned char* gp = Gt + (size_t)(u.pm * 256 + ai * 128 + m * 16) * 2048 + u.pn * 256;
#pragma unroll
                for (int bj = 0; bj < 2; ++bj) { wp[m][bj] = *(const u32x2*)(gp + loff + bj * 128); wa[m][bj] = *(const u32x2*)(gp + loff + 1024 + bj * 128); } }
#pragma unroll
            for (int m = 0; m < 4; ++m)
#pragma unroll
                for (int bj = 0; bj < 2; ++bj) { const f32x4 p0 = ub4(wp[m][bj].x), p1 = ub4(wp[m][bj].y), a0 = ub4(wa[m][bj].x), a1 = ub4(wa[m][bj].y);
#pragma unroll
                    for (int j = 0; j < 4; ++j) { acc[ai][bj][m][0][j] *= p0[j] * __builtin_amdgcn_rcpf(fmaxf(a0[j], 1e-9f)); acc[ai][bj][m][1][j] *= p1[j] * __builtin_amdgcn_rcpf(fmaxf(a1[j], 1e-9f)); } }
        }
    }
    __device__ __forceinline__ void operator()(AccRef acc, const Unit& u, int wr, int wc, int fr, int fq) const {
        const unsigned cpart = (unsigned)(wc * 32 + 8 * fq), rpart = (unsigned)((wr * 64 + fr) * 2048);
        const unsigned loffg = rpart + cpart, loffy = rpart + 2u * cpart;
        u32x2 wa[2][4][2];
#pragma unroll
        for (int ai = 0; ai < 2; ++ai)
#pragma unroll
            for (int m = 0; m < 4; ++m) { const unsigned char* gp = Gt + (size_t)(u.pm * 256 + ai * 128 + m * 16) * 2048 + 1024 + u.pn * 256;
#pragma unroll
                for (int bj = 0; bj < 2; ++bj) wa[ai][m][bj] = *(const u32x2*)(gp + loffg + bj * 128); }
        asm volatile("" ::: "memory");
#pragma unroll
        for (int ai = 0; ai < 2; ++ai)
#pragma unroll
            for (int m = 0; m < 4; ++m) { char* op = (char*)(O + (size_t)(u.pm * 256 + ai * 128 + m * 16) * 1024 + u.pn * 256);
#pragma unroll
                for (int bj = 0; bj < 2; ++bj) { f32x4 a0 = ub4(wa[ai][m][bj].x), a1 = ub4(wa[ai][m][bj].y);
#pragma unroll
                    for (int j = 0; j < 4; ++j) { a0[j] = fmaxf(a0[j], 1e-9f) * (1.f / 255.f); a1[j] = fmaxf(a1[j], 1e-9f) * (1.f / 255.f); }
                    epi_st<16u>((u32x4*)(op + loffy + bj * 256), pack8(a0 * acc[ai][bj][m][0], a1 * acc[ai][bj][m][1])); } }
    }
};
struct ResEpi {
    static constexpr bool CHAINED = false;
    const float *latsrc, *ctxsrc; float *latdst, *ctxdst; const float* mod; int goff;
    __device__ __forceinline__ void operator()(AccRef acc, const Unit& u, int wr, int wc, int fr, int fq) const {
        const int b = u.pm / 9, jt = u.pm - b * 9;
        const size_t rb = jt ? ((size_t)b * SEQ + (jt - 1) * 256) : (size_t)b * CTXL;
        const float* src = (jt ? latsrc : ctxsrc) + (rb + wr * 64 + fr) * D; float* dst = (jt ? latdst : ctxdst) + (rb + wr * 64 + fr) * D;
        const float* gate = mod + (size_t)(jt ? b : 32) * MODW + goff;
        const int col0 = u.pn * 256 + wc * 32 + 8 * fq;
        f32x4 gv[2][2];
#pragma unroll
        for (int bj = 0; bj < 2; ++bj)
#pragma unroll
            for (int n = 0; n < 2; ++n) gv[bj][n] = *(const f32x4*)(gate + col0 + bj * 128 + 4 * n);
#pragma unroll
        for (int ai = 0; ai < 2; ++ai) {
            f32x4 x[4][2][2];
#pragma unroll
            for (int m = 0; m < 4; ++m)
#pragma unroll
                for (int bj = 0; bj < 2; ++bj)
#pragma unroll
                    for (int n = 0; n < 2; ++n) x[m][bj][n] = *(const f32x4*)(src + (size_t)(ai * 128 + m * 16) * D + col0 + bj * 128 + 4 * n);
            asm volatile("" ::: "memory");
#pragma unroll
            for (int m = 0; m < 4; ++m)
#pragma unroll
                for (int bj = 0; bj < 2; ++bj)
#pragma unroll
                    for (int n = 0; n < 2; ++n) epi_st<32u>((f32x4*)(dst + (size_t)(ai * 128 + m * 16) * D + col0 + bj * 128 + 4 * n), x[m][bj][n] + gv[bj][n] * acc[ai][bj][m][n]);
            asm volatile("" ::: "memory");
        }
    }
};
struct OEpi {
    static constexpr bool CHAINED = false;
    bf16_t* O; const float* mod; int goff;
    __device__ __forceinline__ void operator()(AccRef acc, const Unit& u, int wr, int wc, int fr, int fq) const {
        const int b = u.pm / 9, jt = u.pm - b * 9;
        const float* gate = mod + (size_t)(jt ? b : 32) * MODW + goff;
        const int col0 = u.pn * 256 + wc * 32 + 8 * fq;
        f32x4 gv[2][2];
#pragma unroll
        for (int bj = 0; bj < 2; ++bj)
#pragma unroll
            for (int n = 0; n < 2; ++n) gv[bj][n] = *(const f32x4*)(gate + col0 + bj * 128 + 4 * n);
        asm volatile("" ::: "memory");
        bf16_t* base = O + ((size_t)u.pm * 256 + wr * 64 + fr) * D + col0;
#pragma unroll
        for (int ai = 0; ai < 2; ++ai)
#pragma unroll
            for (int m = 0; m < 4; ++m)
#pragma unroll
                for (int bj = 0; bj < 2; ++bj) epi_st<32u>((u32x4*)(base + (size_t)(ai * 128 + m * 16) * D + bj * 128), pack8(gv[bj][0] * acc[ai][bj][m][0], gv[bj][1] * acc[ai][bj][m][1]));
    }
};
struct UpEpi {
    static constexpr bool CHAINED = false;
    bf16_t* O; int ld;
    __device__ __forceinline__ void operator()(AccRef acc, const Unit& u, int wr, int wc, int fr, int fq) const {
        const size_t row0 = (size_t)u.pm * 256 + wr * 64 + fr; const int col0 = u.pn * 128 + wc * 32 + 8 * fq;
#pragma unroll
        for (int ai = 0; ai < 2; ++ai)
#pragma unroll
            for (int m = 0; m < 4; ++m) { f32x4 v[2];
#pragma unroll
                for (int n = 0; n < 2; ++n) { const f32x4 g = acc[ai][0][m][n], w = acc[ai][1][m][n];
#pragma unroll
                    for (int j = 0; j < 4; ++j) v[n][j] = g[j] * fast_sigmoid(g[j]) * w[j]; }
                epi_st<64u>((u32x4*)(O + (row0 + ai * 128 + m * 16) * ld + col0), pack8(v[0], v[1])); }
    }
};
struct MoeInfo {
    int cnt[NE], tb[NE + 1];
    __device__ __forceinline__ void load(const unsigned* cw) {
        int t = 0;
#pragma unroll
        for (int e = 0; e < NE; ++e) { const int c = __builtin_amdgcn_readfirstlane((int)__hip_atomic_load(cw + CW_CNT + 64 * e, __ATOMIC_RELAXED, __HIP_MEMORY_SCOPE_AGENT)); cnt[e] = c; tb[e] = t; t += (c + 255) >> 8; }
        tb[NE] = t;
    }
    __device__ __forceinline__ void lookup(int rt, int& e, int& t0, int& ce) const { e = 0; t0 = 0; ce = cnt[0];
#pragma unroll
        for (int k = 1; k < NE; ++k) { const bool ge = rt >= tb[k]; e = ge ? k : e; t0 = ge ? tb[k] : t0; ce = ge ? cnt[k] : ce; } }
};
struct MoeSched {
    static constexpr bool VAR_NT = false;
    int G, c, nN, gather, rev; const char *A, *B; const unsigned* LIST; size_t ats, bts, bes; MoeInfo mi; pg8::GridMap g;
    __device__ __forceinline__ void init(int G_, int c_, int nN_, const void* A_, const void* B_, int K, int Nrows, const MoeInfo& mi_) {
        G = G_; c = c_; nN = nN_; gather = 0; rev = 0; LIST = nullptr; A = (const char*)A_; B = (const char*)B_; ats = bts = (size_t)256 * K * 2; bes = (size_t)Nrows * K * 2; mi = mi_; g.init(mi_.tb[NE], nN_);
    }
    __device__ __forceinline__ bool next(int i, Unit& u) const {
        int L = i * G + c; if (L >= g.nwg) return false; if (rev) L = g.nwg - 1 - L; int a, b; g.map(L, a, b); u.pm = a; u.pn = b; int t0, ce; mi.lookup(a, u.kind, t0, ce); return true;
    }
    __device__ __forceinline__ const char* abase(const Unit& u) const { return gather ? A : A + (size_t)u.pm * ats; }
    __device__ __forceinline__ const char* bbase(const Unit& u) const { return B + (size_t)u.kind * bes + (size_t)u.pn * bts; }
    __device__ __forceinline__ unsigned grow(const Unit& u, int row) const { int e, t0, ce; mi.lookup(u.pm, e, t0, ce); const int slot = (u.pm - t0) * 256 + row;
        unsigned tok = 0u; if (slot < ce) tok = LIST[(size_t)e * NLAT + slot] >> 1;
        return ((tok >> 11) * (unsigned)LTOK + (unsigned)CTXL + (tok & 2047u)) * (unsigned)(D * 2); }
};
struct MoeDownEpi {
    static constexpr bool CHAINED = false;
    bf16_t* YM; const unsigned* LIST; const float* WTS; MoeInfo mi;
    __device__ __forceinline__ void operator()(AccRef acc, const Unit& u, int wr, int wc, int fr, int fq) const {
        int e, t0, ce; mi.lookup(u.pm, e, t0, ce); const int slot0 = (u.pm - t0) * 256 + wr * 64 + fr;
        const int col0 = u.pn * 256 + wc * 32 + 8 * fq;
        unsigned ent[2][4]; float wt[2][4];
#pragma unroll
        for (int ai = 0; ai < 2; ++ai)
#pragma unroll
            for (int m = 0; m < 4; ++m) { const int slot = slot0 + ai * 128 + m * 16; ent[ai][m] = slot < ce ? LIST[(size_t)e * NLAT + slot] : 0xffffffffu; }
#pragma unroll
        for (int ai = 0; ai < 2; ++ai)
#pragma unroll
            for (int m = 0; m < 4; ++m) wt[ai][m] = ent[ai][m] != 0xffffffffu ? WTS[ent[ai][m]] : 0.f;
        asm volatile("" ::: "memory");
#pragma unroll
        for (int ai = 0; ai < 2; ++ai)
#pragma unroll
            for (int m = 0; m < 4; ++m) {
                if (ent[ai][m] != 0xffffffffu) { const unsigned en = ent[ai][m]; const float w8 = wt[ai][m];
                    bf16_t* rowp = YM + ((size_t)(en & 1u) * NLAT + (en >> 1)) * D + col0;
#pragma unroll
                    for (int bj = 0; bj < 2; ++bj) epi_st<128u>((u32x4*)(rowp + bj * 128), pack8(acc[ai][bj][m][0] * w8, acc[ai][bj][m][1] * w8)); } }
    }
};

namespace att {
constexpr int BUFB = 32768, EXCH = 65536;
constexpr float THR = 6.f;
#define ATT_SBAR() __builtin_amdgcn_sched_barrier(0)
#define ATT_MFMA(a, b, c) __builtin_amdgcn_mfma_f32_32x32x16_bf16(a, b, c, 0, 0, 0)
#define ATT_SYNC() asm volatile("s_waitcnt vmcnt(0) lgkmcnt(0)\n\ts_barrier" ::: "memory")
__device__ __forceinline__ void attn_unit(LAS unsigned char* lds, const bf16_t* Q, const bf16_t* K, const bf16_t* VT, bf16_t* AY, int b, int h, size_t qrow0, int nkt, float lam, float osc, const float* subg,
                                          bf16x8 (&qf)[4], bool first, bool has_next, int nb, int nh, size_t nqrow0, int wv) {
    const int tid = opaque_tid(wv), lane = tid & 63, ql = lane & 31, hh = lane >> 5; const int w = __builtin_amdgcn_readfirstlane(tid >> 6); const int map = w >> 2, qb = w & 3;
    const size_t qrow = qrow0 + 32 * qb + ql;
    if (ATT_PRIO && w >= 4) __builtin_amdgcn_s_setprio(1);
#if PROBE_MASK
    unsigned long long att_wait = 0, att_b = 0, att_a = 0;
#endif
    if (first) {
#pragma unroll
        for (int ks = 0; ks < 4; ++ks) qf[ks] = *(const bf16x8*)(Q + qrow * 1024 + (h * 2 + map) * 64 + 16 * ks + 8 * hh);
    }
    const int prow = lane >> 3, pc = lane & 7;
    const int krow = 8 * w + prow, kc = pc ^ ((krow >> 1) & 7);
    const bf16_t* ksrc0 = K + ((size_t)b * LTOK + krow) * 1024 + (h * 2) * 64 + kc * 8;
    const bf16_t* ksrc1 = ksrc0 + 64;
    const int e0 = 16 * w + prow, e1 = e0 + 8;
    const bf16_t* vsrc0 = VT + ((size_t)b * 1024 + h * 128 + e0) * LTOK + (pc ^ ((e0 >> 1) & 7)) * 8;
    const bf16_t* vsrc1 = VT + ((size_t)b * 1024 + h * 128 + e1) * LTOK + (pc ^ ((e1 >> 1) & 7)) * 8;
#define ATT_DMA_K(t, BO) do { \
        __builtin_amdgcn_global_load_lds((const unsigned*)(ksrc0 + (size_t)(t) * 64 * 1024), (LAS unsigned*)(lds + (BO) + w * 1024), 16, 0, 0); \
        __builtin_amdgcn_global_load_lds((const unsigned*)(ksrc1 + (size_t)(t) * 64 * 1024), (LAS unsigned*)(lds + (BO) + 8192 + w * 1024), 16, 0, 0); } while (0)
#define ATT_DMA_V(t, BO) do { \
        __builtin_amdgcn_global_load_lds((const unsigned*)(vsrc0 + (size_t)(t) * 64), (LAS unsigned*)(lds + (BO) + 16384 + w * 2048), 16, 0, 0); \
        __builtin_amdgcn_global_load_lds((const unsigned*)(vsrc1 + (size_t)(t) * 64), (LAS unsigned*)(lds + (BO) + 16384 + w * 2048 + 1024), 16, 0, 0); } while (0)
    const int rp = (ql & ~12) | ((ql & 4) << 1) | ((ql & 8) >> 1);
    const int xk = (rp >> 1) & 7, xv = (ql >> 1) & 7;
    const LAS unsigned char* kbase = lds + map * 8192 + rp * 128;
    const LAS unsigned char* vbase = lds + 16384 + ql * 128;
    const unsigned kaddr0 = (unsigned)(uintptr_t)kbase, vaddr0 = (unsigned)(uintptr_t)vbase;
    int kof[4], vof[4];
#pragma unroll
    for (int i = 0; i < 4; ++i) { kof[i] = ((2 * i + hh) ^ xk) << 4; vof[i] = ((2 * i + hh) ^ xv) << 4; }
#define ATT_KRD(i, RB) (*(const LAS bf16x8*)(kbase + (RB) + ((i) >> 2) * 4096 + kof[(i) & 3]))
#define ATT_VRD(g, RB) (*(const LAS bf16x8*)(vbase + (RB) + ((g) >> 2) * 4096 + vof[(g) & 3]))
    const f32x16 Z16 = (f32x16){0.f, 0.f, 0.f, 0.f, 0.f, 0.f, 0.f, 0.f, 0.f, 0.f, 0.f, 0.f, 0.f, 0.f, 0.f, 0.f};
    f32x16 O[4];
#pragma unroll
    for (int i = 0; i < 4; ++i) O[i] = Z16;
    f32x16 negm = Z16, S0, S1;
    float lrun = 0.f, ral = 1.f; bool resc = false;
    bf16x8 kf[8]; u32x4 pA[4], pB[4];
#define ATT_QK() do { \
        S0 = ATT_MFMA(kf[0], qf[0], negm); S1 = ATT_MFMA(kf[4], qf[0], negm); \
        S0 = ATT_MFMA(kf[1], qf[1], S0);   S1 = ATT_MFMA(kf[5], qf[1], S1); \
        S0 = ATT_MFMA(kf[2], qf[2], S0);   S1 = ATT_MFMA(kf[6], qf[2], S1); \
        S0 = ATT_MFMA(kf[3], qf[3], S0);   S1 = ATT_MFMA(kf[7], qf[3], S1); } while (0)
#define ATT_ROWMAX(mx) do { float _a = fmaxf(S0[0], S1[0]), _b = fmaxf(S0[1], S1[1]); \
        _Pragma("unroll") for (int r = 2; r < 16; r += 2) { _a = fmaxf(_a, fmaxf(S0[r], S1[r])); _b = fmaxf(_b, fmaxf(S0[r + 1], S1[r + 1])); } \
        mx = pair_max(fmaxf(_a, _b)); } while (0)
#define ATT_IMAX3(a, b, c) max(max((a), (b)), (c))
#define ATT_SI(i) __float_as_int(ATT_SV(i))
#define ATT_ROWMAXI(mx) do { int _a = ATT_IMAX3(ATT_SI(0), ATT_SI(1), ATT_SI(2)), _b = ATT_IMAX3(ATT_SI(3), ATT_SI(4), ATT_SI(5)); \
        _a = ATT_IMAX3(_a, ATT_SI(6), ATT_SI(7)); _b = ATT_IMAX3(_b, ATT_SI(8), ATT_SI(9)); _a = ATT_IMAX3(_a, ATT_SI(10), ATT_SI(11)); _b = ATT_IMAX3(_b, ATT_SI(12), ATT_SI(13)); \
        _a = ATT_IMAX3(_a, ATT_SI(14), ATT_SI(15)); _b = ATT_IMAX3(_b, ATT_SI(16), ATT_SI(17)); _a = ATT_IMAX3(_a, ATT_SI(18), ATT_SI(19)); _b = ATT_IMAX3(_b, ATT_SI(20), ATT_SI(21)); \
        _a = ATT_IMAX3(_a, ATT_SI(22), ATT_SI(23)); _b = ATT_IMAX3(_b, ATT_SI(24), ATT_SI(25)); _a = ATT_IMAX3(_a, ATT_SI(26), ATT_SI(27)); _b = ATT_IMAX3(_b, ATT_SI(28), ATT_SI(29)); \
        _a = ATT_IMAX3(_a, ATT_SI(30), ATT_SI(31)); _a = max(_a, _b); \
        auto _rr = __builtin_amdgcn_permlane32_swap((unsigned)_a, (unsigned)_a, false, false); mx = __int_as_float(max((int)_rr[0], (int)_rr[1])); } while (0)
#define ATT_DECIDE() do { float mx; ATT_ROWMAXI(mx); \
        if (__any(mx > THR)) { const float dl = fmaxf(mx, 0.f); \
            _Pragma("unroll") for (int r = 0; r < 16; ++r) { S0[r] -= dl; S1[r] -= dl; negm[r] -= dl; } \
            ral = __builtin_amdgcn_exp2f(-dl); lrun *= ral; resc = true; } } while (0)
#define ATT_SV(i) ((i) < 16 ? S0[(i) & 15] : S1[(i) & 15])
#define ATT_EXP2(g, PN) do { const float _e0 = __builtin_amdgcn_exp2f(ATT_SV(2 * (g))), _e1 = __builtin_amdgcn_exp2f(ATT_SV(2 * (g) + 1)); ls += _e0; ls += _e1; unsigned _w = cvtpk(_e0, _e1); asm volatile("" : "+v"(_w), "+v"(ls)); PN[(g) >> 2][(g) & 3] = _w; } while (0)
#define ATT_DSRD(dst, addr, off) asm volatile("ds_read_b128 %0, %1 offset:%2" : "=v"(dst) : "v"(addr), "i"(off))
#define ATT_NW(g, DOK) ((DOK) ? ((g) <= 8 ? 2 : (g) == 9 ? 3 : (g) == 10 ? 4 : (g) <= 13 ? 5 : (g) == 14 ? 4 : 3) : ((g) <= 13 ? 2 : (g) == 14 ? 1 : 0))
#define ATT_GAPB(g, VC, VL, PP, PN, DOK) do { \
        asm volatile("s_waitcnt lgkmcnt(%1)" : "+v"(VC) : "i"(ATT_NW(g, DOK))); \
        O[(g) >> 2] = ATT_MFMA(VC, __builtin_bit_cast(bf16x8, PP[(g) & 3]), O[(g) >> 2]); \
        if ((g) + 3 < 16) ATT_DSRD(VL, va[((g) + 3) & 3], (((g) + 3) >> 2) * 4096); \
        if ((DOK) && (g) >= 8) ATT_DSRD(kf[(g) - 8], ka[((g) - 8) & 3], (((g) - 8) >> 2) * 4096); \
        ATT_EXP2(g, PN); ATT_SBAR(); } while (0)
#define ATT_PHASEB(RBK, RB, PP, PN, DOK) do { float ls = 0.f; unsigned va[4], ka[4]; \
        _Pragma("unroll") for (int _c = 0; _c < 4; ++_c) { va[_c] = vaddr0 + (unsigned)(RB) + (unsigned)vof[_c]; ka[_c] = kaddr0 + (unsigned)(RBK) + (unsigned)kof[_c]; } \
        bf16x8 v0, v1, v2, v3; ATT_DSRD(v0, va[0], 0); ATT_DSRD(v1, va[1], 0); ATT_DSRD(v2, va[2], 0); ATT_SBAR(); \
        ATT_GAPB(0, v0, v3, PP, PN, DOK); ATT_GAPB(1, v1, v0, PP, PN, DOK); ATT_GAPB(2, v2, v1, PP, PN, DOK); ATT_GAPB(3, v3, v2, PP, PN, DOK); \
        ATT_GAPB(4, v0, v3, PP, PN, DOK); ATT_GAPB(5, v1, v0, PP, PN, DOK); ATT_GAPB(6, v2, v1, PP, PN, DOK); ATT_GAPB(7, v3, v2, PP, PN, DOK); \
        ATT_GAPB(8, v0, v3, PP, PN, DOK); ATT_GAPB(9, v1, v0, PP, PN, DOK); ATT_GAPB(10, v2, v1, PP, PN, DOK); ATT_GAPB(11, v3, v2, PP, PN, DOK); \
        ATT_GAPB(12, v0, v3, PP, PN, DOK); ATT_GAPB(13, v1, v0, PP, PN, DOK); ATT_GAPB(14, v2, v1, PP, PN, DOK); ATT_GAPB(15, v3, v2, PP, PN, DOK); \
        if (DOK) { asm volatile("s_waitcnt lgkmcnt(0)" : "+v"(kf[0]), "+v"(kf[1]), "+v"(kf[2]), "+v"(kf[3]), "+v"(kf[4]), "+v"(kf[5]), "+v"(kf[6]), "+v"(kf[7])); ATT_SBAR(); } \
        lrun += ls; } while (0)
#define ATT_RESC() do { if (resc) { _Pragma("unroll") for (int i = 0; i < 4; ++i) _Pragma("unroll") for (int r = 0; r < 16; ++r) O[i][r] *= ral; resc = false; } } while (0)
#define ATT_BUF(j) (((j) & 3) * BUFB)
#if PROBE_MASK
#define ATT_TB0() const unsigned long long _tb0 = __builtin_amdgcn_s_memrealtime(); asm volatile("s_waitcnt lgkmcnt(0)" ::: "memory")
#define ATT_TB1() const unsigned long long _tb1 = __builtin_amdgcn_s_memrealtime(); att_b += _tb1 - _tb0
#define ATT_TB2() asm volatile("" : "+v"(S0), "+v"(S1)); att_a += __builtin_amdgcn_s_memrealtime() - _tb1
#else
#define ATT_TB0() do {} while (0)
#define ATT_TB1() do {} while (0)
#define ATT_TB2() do {} while (0)
#endif
#if PROBE_MASK
#define ATT_SYNCN(N) do { const unsigned long long _t0 = __builtin_amdgcn_s_memrealtime(); asm volatile("s_waitcnt vmcnt(" #N ") lgkmcnt(0)\n\ts_barrier" ::: "memory"); att_wait += __builtin_amdgcn_s_memrealtime() - _t0; } while (0)
#else
#define ATT_SYNCN(N) asm volatile("s_waitcnt vmcnt(" #N ") lgkmcnt(0)\n\ts_barrier" ::: "memory")
#endif
#define ATT_STEP(t, PP, PN) do { \
        ATT_TB0(); { const int rbk = ATT_BUF((t) + 1), rbv = ATT_BUF((t) - 1); ATT_PHASEB(rbk, rbv, PP, PN, true); } ATT_RESC(); ATT_TB1(); ATT_QK(); ATT_DECIDE(); ATT_TB2(); } while (0)

    if (first) { ATT_DMA_K(0, 0); ATT_DMA_K(1, BUFB); ATT_DMA_V(0, 0); ATT_DMA_V(1, BUFB); }
    ATT_DMA_K(2, 2 * BUFB); ATT_DMA_K(3, 3 * BUFB);
    ATT_SYNCN(4);
#pragma unroll
    for (int i = 0; i < 8; ++i) kf[i] = ATT_KRD(i, 0);
    ATT_QK();
    { float mx; ATT_ROWMAX(mx);
#pragma unroll
      for (int r = 0; r < 16; ++r) { S0[r] -= mx; S1[r] -= mx; negm[r] = -mx; } }
    { float ls = 0.f;
#pragma unroll
      for (int i = 0; i < 8; ++i) kf[i] = ATT_KRD(i, BUFB);
#define ATT_E0(g) ATT_EXP2(g, pA)
      ATT_E0(0); ATT_E0(1); ATT_E0(2); ATT_E0(3); ATT_E0(4); ATT_E0(5); ATT_E0(6); ATT_E0(7); ATT_E0(8); ATT_E0(9); ATT_E0(10); ATT_E0(11); ATT_E0(12); ATT_E0(13); ATT_E0(14); ATT_E0(15);
#undef ATT_E0
      lrun += ls; }
    ATT_QK(); ATT_DECIDE();
    for (int t = 1; t < nkt - 1; t += 2) {
        ATT_SYNCN(0);
        if (t + 3 < nkt) ATT_DMA_K(t + 3, ATT_BUF(t + 3));
        ATT_DMA_V(t + 1, ATT_BUF(t + 1));
        if (t + 4 < nkt) ATT_DMA_K(t + 4, ATT_BUF(t));
        ATT_DMA_V(t + 2, ATT_BUF(t + 2));
        ATT_STEP(t, pA, pB);
        ATT_STEP(t + 1, pB, pA);
    }
    ATT_SYNCN(0);
    if (has_next) {
        const size_t nqrow = nqrow0 + 32 * qb + ql;
#pragma unroll
        for (int ks = 0; ks < 4; ++ks) qf[ks] = *(const bf16x8*)(Q + nqrow * 1024 + (nh * 2 + map) * 64 + 16 * ks + 8 * hh);
        const bf16_t* nk0 = K + ((size_t)nb * LTOK + krow) * 1024 + (nh * 2) * 64 + kc * 8;
        const bf16_t* nv0 = VT + ((size_t)nb * 1024 + nh * 128 + e0) * LTOK + (pc ^ ((e0 >> 1) & 7)) * 8;
        const bf16_t* nv1 = VT + ((size_t)nb * 1024 + nh * 128 + e1) * LTOK + (pc ^ ((e1 >> 1) & 7)) * 8;
#pragma unroll
        for (int j = 0; j < 2; ++j) {
            __builtin_amdgcn_global_load_lds((const unsigned*)(nk0 + (size_t)j * 64 * 1024), (LAS unsigned*)(lds + j * BUFB + w * 1024), 16, 0, 0);
            __builtin_amdgcn_global_load_lds((const unsigned*)(nk0 + 64 + (size_t)j * 64 * 1024), (LAS unsigned*)(lds + j * BUFB + 8192 + w * 1024), 16, 0, 0);
            __builtin_amdgcn_global_load_lds((const unsigned*)(nv0 + (size_t)j * 64), (LAS unsigned*)(lds + j * BUFB + 16384 + w * 2048), 16, 0, 0);
            __builtin_amdgcn_global_load_lds((const unsigned*)(nv1 + (size_t)j * 64), (LAS unsigned*)(lds + j * BUFB + 16384 + w * 2048 + 1024), 16, 0, 0); }
    }
    { const int rbv = ATT_BUF(nkt - 2); ATT_PHASEB(0, rbv, pA, pB, false); } ATT_RESC();
    { const int rbv = ATT_BUF(nkt - 1); bf16x8 v0 = ATT_VRD(0, rbv), v1 = ATT_VRD(1, rbv), v2;
#define ATT_GF(g, VC, VL) do { O[(g) >> 2] = ATT_MFMA(VC, __builtin_bit_cast(bf16x8, pB[(g) & 3]), O[(g) >> 2]); if ((g) + 2 < 16) VL = ATT_VRD((g) + 2, rbv); } while (0)
      ATT_GF(0, v0, v2); ATT_GF(1, v1, v0); ATT_GF(2, v2, v1); ATT_GF(3, v0, v2); ATT_GF(4, v1, v0); ATT_GF(5, v2, v1); ATT_GF(6, v0, v2); ATT_GF(7, v1, v0);
      ATT_GF(8, v2, v1); ATT_GF(9, v0, v2); ATT_GF(10, v1, v0); ATT_GF(11, v2, v1); ATT_GF(12, v0, v2); ATT_GF(13, v1, v0); ATT_GF(14, v2, v1); ATT_GF(15, v0, v2);
#undef ATT_GF
    }
    asm volatile("s_waitcnt lgkmcnt(0)\n\ts_barrier" ::: "memory");
    const float inv = 1.f / pair_sum(lrun);
    f32x4 sgv[4][4];
    if (map == 0) {
#pragma unroll
        for (int i = 0; i < 4; ++i)
#pragma unroll
            for (int g = 0; g < 4; ++g) sgv[i][g] = *(const f32x4*)(subg + 32 * i + 8 * g + 4 * hh);
    }
    LAS float* ex = (LAS float*)(lds + EXCH) + (size_t)qb * 4096 + lane;
    if (map == 1) {
#pragma unroll
        for (int i = 0; i < 4; ++i)
#pragma unroll
            for (int r = 0; r < 16; ++r) ex[(i * 16 + r) * 64] = O[i][r] * inv;
    }
    asm volatile("s_waitcnt lgkmcnt(0)\n\ts_barrier" ::: "memory");
    if (map == 0) {
        float ss = 0.f;
#pragma unroll
        for (int i = 0; i < 4; ++i)
#pragma unroll
            for (int r = 0; r < 16; ++r) { const float y = O[i][r] * inv - lam * ex[(i * 16 + r) * 64]; O[i][r] = y; ss += y * y; }
        ss = pair_sum(ss);
        const float rs = rsqrtf(ss * (1.f / VD) + EPS) * osc;
        bf16_t* orow = AY + qrow * MAP + 512 + h * 128;
#pragma unroll
        for (int i = 0; i < 4; ++i)
#pragma unroll
            for (int g = 0; g < 4; ++g) { const int e = 32 * i + 8 * g + 4 * hh; const f32x4 gv = sgv[i][g];
                u32x2 o; o.x = cvtpk(O[i][4 * g] * rs * gv[0], O[i][4 * g + 1] * rs * gv[1]); o.y = cvtpk(O[i][4 * g + 2] * rs * gv[2], O[i][4 * g + 3] * rs * gv[3]);
                *(u32x2*)(orow + e) = o; }
    }
    asm volatile("s_waitcnt lgkmcnt(0)\n\ts_barrier" ::: "memory");
    if (ATT_PRIO && w >= 4) __builtin_amdgcn_s_setprio(0);
#if PROBE_MASK
    if (blockIdx.x == 0 && tid == 0) { volatile LAS unsigned long long* acc = (volatile LAS unsigned long long*)(lds + LDS_CTRL + 64) + 20; acc[0] = acc[0] + att_wait; acc[2] = acc[2] + att_b; acc[3] = acc[3] + att_a; }
#endif
#undef ATT_DMA_K
#undef ATT_DMA_V
#undef ATT_KRD
#undef ATT_VRD
#undef ATT_QK
#undef ATT_ROWMAX
#undef ATT_DECIDE
#undef ATT_IMAX3
#undef ATT_SI
#undef ATT_ROWMAXI
#undef ATT_SV
#undef ATT_EXP2
#undef ATT_GAPB
#undef ATT_DSRD
#undef ATT_NW
#undef ATT_PHASEB
#undef ATT_RESC
#undef ATT_STEP
#undef ATT_BUF
#undef ATT_TB0
#undef ATT_TB1
#undef ATT_TB2
#undef ATT_SYNCN
}
#undef ATT_SBAR
#undef ATT_MFMA
#undef ATT_SYNC
}

__device__ __forceinline__ void tr_item(const float* W, int ldw, int k0, int n0, bf16_t* WT, int ldt, int drow0, int dcol0, bool rope, LAS float* scr, int lane) {
    { f32x4 v[8];
#pragma unroll
      for (int j = 0; j < 8; ++j) v[j] = RLD((const f32x4*)(W + (size_t)(k0 + 8 * j + (lane >> 3)) * ldw + n0 + 4 * (lane & 7)));
#pragma unroll
      for (int j = 0; j < 8; ++j) { LAS float* d = scr + (8 * j + (lane >> 3)) * 33 + 4 * (lane & 7); d[0] = v[j][0]; d[1] = v[j][1]; d[2] = v[j][2]; d[3] = v[j][3]; } }
    LDS_WAIT(); asm volatile("" ::: "memory");
    const int c = lane & 7;
#pragma unroll
    for (int j = 0; j < 4; ++j) { const int n = (lane >> 3) + 8 * j; const LAS float* s = scr + (8 * c) * 33 + n;
        u32x4 o; o.x = cvtpk(s[0 * 33], s[1 * 33]); o.y = cvtpk(s[2 * 33], s[3 * 33]); o.z = cvtpk(s[4 * 33], s[5 * 33]); o.w = cvtpk(s[6 * 33], s[7 * 33]);
        const int dn = rope ? (8 * ((n >> 2) & 3) + 4 * (n >> 4) + (n & 3)) : n;
        *(u32x4*)(WT + (size_t)(drow0 + n0 + dn) * ldt + dcol0 + k0 + 8 * c) = o; }
    LDS_WAIT(); asm volatile("" ::: "memory");
}

__device__ __forceinline__ void phase_prologue(Frame F) {
    F.tid = opaque_tid(F.wave0); F.lane = F.tid & 63; F.wave = __builtin_amdgcn_readfirstlane(F.tid >> 6);
    const float* c = F.in[1]; const float* cctx = F.in[3]; const float* wmod = F.in[4]; const float* bmod = F.in[5];
    float* MOD = (float*)(F.ws + WS_MOD);
    for (int cb = blockIdx.x; cb < 192; cb += F.G) {
        LAS float* S = (LAS float*)F.lds;
        for (int idx = F.tid; idx < 1024 * 36; idx += NTHR) { const int k = idx / 36, bb = idx - k * 36; float v = 0.f;
            if (bb < 32) v = c[bb * 1024 + k]; else if (bb == 32) v = cctx[k];
            S[idx] = v / (1.f + expf(-v)); }
        __syncthreads();
        const int l = cb / 96, n = (cb % 96) * 64 + F.lane;
        float acc[36];
#pragma unroll
        for (int i = 0; i < 36; ++i) acc[i] = 0.f;
        const float* wp = wmod + ((size_t)l * 1024 + F.wave * 128) * MODW + n;
#pragma unroll 16
        for (int kk = 0; kk < 128; ++kk) { const float wv = wp[(size_t)kk * MODW]; const LAS f32x4* sp = (const LAS f32x4*)(S + (F.wave * 128 + kk) * 36);
#pragma unroll
            for (int q = 0; q < 9; ++q) { const f32x4 s4 = sp[q];
#pragma unroll
                for (int i = 0; i < 4; ++i) acc[4 * q + i] += s4[i] * wv; } }
        __syncthreads();
        LAS float* red = (LAS float*)F.lds;
#pragma unroll
        for (int bb = 0; bb < 33; ++bb) red[(F.wave * 33 + bb) * 64 + F.lane] = acc[bb];
        __syncthreads();
        for (int bb = F.wave; bb < 33; bb += 8) { float s = bmod[l * MODW + n];
#pragma unroll
            for (int w2 = 0; w2 < 8; ++w2) s += red[(w2 * 33 + bb) * 64 + F.lane];
            MOD[((size_t)l * 33 + bb) * MODW + n] = s; }
        __syncthreads();
    }
    __syncthreads();
    LAS float* scr = (LAS float*)(F.lds + F.wave * 8448);
    const int gw = F.vcu * NWAVES + F.wave, NGW = F.G * NWAVES;
    bf16_t* WZ = (bf16_t*)(F.ws + WS_WZ); bf16_t* WV = (bf16_t*)(F.ws + WS_WV); bf16_t* WM = (bf16_t*)(F.ws + WS_WM); bf16_t* WOUT = (bf16_t*)(F.ws + WS_WOUT);
    bf16_t* WUP0 = (bf16_t*)(F.ws + WS_WUP0); bf16_t* WDN0 = (bf16_t*)(F.ws + WS_WDN0);
    { bf16_t* WEFF = (bf16_t*)(F.ws + WS_WM);
      for (int it = gw; it < 1024; it += NGW) { const int l = it >> 9, g = (it >> 7) & 3, nbk = (it >> 3) & 15, cbk = it & 7; const int n = nbk * 64 + F.lane, c0 = cbk * 16;
          const float* pw = F.in[9] + ((size_t)(l * 4 + g) * 128 + c0) * 128; const float* ps = F.in[10] + l * 512 + g * 128; const float* wpp = F.in[16] + ((size_t)l * 512 + g * 128) * 1024 + n;
#pragma unroll
          for (int q = 0; q < 8; ++q) { const int idx = q * 256 + 4 * F.lane; const f32x4 v = *(const f32x4*)(pw + idx), sc = *(const f32x4*)(ps + (idx & 127)); *(LAS f32x4*)(scr + idx) = v * sc; }
          LDS_WAIT(); asm volatile("" ::: "memory");
          float a[16];
#pragma unroll
          for (int i = 0; i < 16; ++i) a[i] = 0.f;
          for (int d0 = 0; d0 < 128; d0 += 32) { float wv[32];
#pragma unroll
              for (int d = 0; d < 32; ++d) wv[d] = wpp[(size_t)(d0 + d) * 1024];
#pragma unroll
              for (int d = 0; d < 32; ++d)
#pragma unroll
                  for (int i = 0; i < 16; ++i) a[i] += scr[i * 128 + d0 + d] * wv[d]; }
          u32x4 o0, o1; o0.x = cvtpk(a[0], a[1]); o0.y = cvtpk(a[2], a[3]); o0.z = cvtpk(a[4], a[5]); o0.w = cvtpk(a[6], a[7]);
          o1.x = cvtpk(a[8], a[9]); o1.y = cvtpk(a[10], a[11]); o1.z = cvtpk(a[12], a[13]); o1.w = cvtpk(a[14], a[15]);
          bf16_t* dst = WEFF + ((size_t)l * 1024 + n) * MAP + g * 128 + c0; *(u32x4*)dst = o0; *(u32x4*)(dst + 8) = o1;
          LDS_WAIT(); asm volatile("" ::: "memory"); } }
    constexpr int I_IN = 16 * 176, I_SQ = 16 * 32, I_UP = 16 * 86, I_DN = 43 * 32;
    constexpr int NITEMS = 2 * I_IN + 4 * I_SQ + 2 * I_UP + I_DN;
    for (int it = (gw + (NGW > 1024 ? NGW - 1024 : 0)) % NGW; it < NITEMS; it += NGW) {
        int r = it;
        if (r < 2 * I_IN) { const int l = r / I_IN; r -= l * I_IN; const int kb = r / 176, nb = r % 176, n0 = nb * 32;
            const float* W = F.in[8] + (size_t)l * 1024 * 5632;
            if (n0 < 2560) tr_item(W, 5632, kb * 64, n0, WZ + (size_t)l * 4608 * 1024, 1024, 0, 0, n0 >= 512, scr, F.lane);
            else if (n0 < 3584) tr_item(W, 5632, kb * 64, n0, WV + (size_t)l * 1024 * 1024, 1024, -2560, 0, false, scr, F.lane);
            else tr_item(W, 5632, kb * 64, n0, WZ + (size_t)l * 4608 * 1024, 1024, -1024, 0, false, scr, F.lane);
            continue; }
        r -= 2 * I_IN;
        if (r < 4 * I_SQ) { const int q = r / I_SQ; r -= q * I_SQ; const int l = q & 1; const int kb = r / 32, nb = r % 32;
            const float* W = (q < 2 ? F.in[17] : F.in[18]) + (size_t)l * 1024 * 1024;
            if (q < 2) tr_item(W, 1024, kb * 64, nb * 32, WM + (size_t)l * 1024 * MAP, MAP, 0, 512, false, scr, F.lane);
            else tr_item(W, 1024, kb * 64, nb * 32, WOUT + (size_t)l * 1024 * 1024, 1024, 0, 0, false, scr, F.lane);
            continue; }
        r -= 4 * I_SQ;
        if (r < 2 * I_UP) { const int q = r / I_UP; r -= q * I_UP; const int kb = r / 86, nb = r % 86, n0 = nb * 32;
            const float* W = q ? F.in[20] : F.in[19];
            tr_item(W, FF, kb * 64, n0, WUP0, 1024, (n0 >> 7) * 256 + q * 128 - (n0 & ~127), 0, false, scr, F.lane); continue; }
        r -= 2 * I_UP;
        { const int kb = r / 32, nb = r % 32; tr_item(F.in[21], 1024, kb * 64, nb * 32, WDN0, FFP, 0, 0, false, scr, F.lane); }
    }
    { const int gt = F.vcu * NTHR + F.tid, NT = F.G * NTHR;
      for (int i = gt; i < 128 * 128; i += NT) { const int rr = i >> 7, cc = i & 127; const int row = 21 * 256 + (rr < 64 ? 64 + rr : 192 + (rr - 64)); *(u32x4*)(WUP0 + (size_t)row * 1024 + cc * 8) = (u32x4){0u, 0u, 0u, 0u}; }
      for (int i = gt; i < 1024 * 8; i += NT) { const int row = i >> 3, cc = i & 7; *(u32x4*)(WDN0 + (size_t)row * FFP + FF + cc * 8) = (u32x4){0u, 0u, 0u, 0u}; } }
    if (blockIdx.x == 0) {
        float* COS = (float*)(F.ws + WS_TAB); float* SIN = COS + 1024; float* LAMV = SIN + 1024;
        for (int idx = F.tid; idx < 1024; idx += NTHR) { const int pos = idx >> 4, i = idx & 15; const float inv = powf(10000.f, -(float)i * (2.0f / 32.0f)); const float ang = (float)pos * inv;
            COS[idx] = cosf(ang); SIN[idx] = sinf(ang); }
        if (F.wave == 1) {
            for (int l = 0; l < 2; ++l) { const float d1 = wave_sum(F.in[11][l * 64 + F.lane] * F.in[12][l * 64 + F.lane], F.lane), d2 = wave_sum(F.in[13][l * 64 + F.lane] * F.in[14][l * 64 + F.lane], F.lane);
                const float lam0 = 0.8f - 0.6f * expf(-0.3f * (float)l);
                if (F.lane == 0) { LAMV[2 * l] = expf(d1) - expf(d2) + lam0; LAMV[2 * l + 1] = 1.f - lam0; } }
        }
    }
}

constexpr size_t XPITCH = 4096;
template <bool SRC16>
__device__ __forceinline__ void phase_normmod(Frame F, const void* lat_, const void* ctx_, const float* g, const float* mod, int soff, bool do_ctx, bf16_t* H, const bf16_t* oadd = nullptr, void* latdst_ = nullptr, void* ctxdst_ = nullptr) {
    const char* lat = (const char*)lat_; const char* ctx = (const char*)ctx_; char* latdst = (char*)latdst_; char* ctxdst = (char*)ctxdst_;
    F.tid = opaque_tid(F.wave0); F.lane = F.tid & 63; F.wave = __builtin_amdgcn_readfirstlane(F.tid >> 6);
    const int gw = F.vcu * NWAVES + F.wave, NGW = F.G * NWAVES;
    const int per = (((NTOK + NGW - 1) / NGW) + 3) & ~3;
    const int r0 = gw * per, r1 = min(r0 + per, NTOK);
    int cur_bb = -1; f32x4 gs[4], sh[4];
#pragma unroll
    for (int q = 0; q < 4; ++q) { gs[q] = (f32x4){0.f, 0.f, 0.f, 0.f}; sh[q] = gs[q]; }
    for (int r = r0; r < r1; r += 4) {
        const int b = r / LTOK, j = r - b * LTOK; const bool isc = j < CTXL;
        if (isc && !do_ctx) continue;
        const int bb = isc ? 32 : b;
        if (bb != cur_bb) { cur_bb = bb; const float* mv = mod + (size_t)bb * MODW + soff;
#pragma unroll
            for (int q = 0; q < 4; ++q) { const int cidx = 4 * F.lane + 256 * q; const f32x4 gg = *(const f32x4*)(g + cidx), sc = *(const f32x4*)(mv + 1024 + cidx); gs[q] = gg * (sc + 1.f); sh[q] = *(const f32x4*)(mv + cidx); } }
        const char* src = isc ? ctx + ((size_t)b * CTXL + j) * XPITCH : lat + ((size_t)b * SEQ + (j - CTXL)) * XPITCH;
        f32x4 v[4][4]; float s[4];
        if (SRC16) {
            u32x2 xv[4][4];
#pragma unroll
            for (int i = 0; i < 4; ++i)
#pragma unroll
                for (int q = 0; q < 4; ++q) xv[i][q] = RLD((const u32x2*)(src + (size_t)i * XPITCH) + F.lane + 64 * q);
#pragma unroll
            for (int i = 0; i < 4; ++i)
#pragma unroll
                for (int q = 0; q < 4; ++q) v[i][q] = (f32x4){bflo(xv[i][q].x), bfhi(xv[i][q].x), bflo(xv[i][q].y), bfhi(xv[i][q].y)};
        } else {
#pragma unroll
            for (int i = 0; i < 4; ++i)
#pragma unroll
                for (int q = 0; q < 4; ++q) v[i][q] = RLD((const f32x4*)(src + (size_t)i * XPITCH) + F.lane + 64 * q);
        }
        if (oadd) {
            u32x2 ov[4][4];
#pragma unroll
            for (int i = 0; i < 4; ++i)
#pragma unroll
                for (int q = 0; q < 4; ++q) ov[i][q] = RLD((const u32x2*)(oadd + (size_t)(r + i) * D) + F.lane + 64 * q);
            char* dst = isc ? ctxdst + ((size_t)b * CTXL + j) * XPITCH : latdst + ((size_t)b * SEQ + (j - CTXL)) * XPITCH;
#pragma unroll
            for (int i = 0; i < 4; ++i)
#pragma unroll
                for (int q = 0; q < 4; ++q) { v[i][q] += (f32x4){bflo(ov[i][q].x), bfhi(ov[i][q].x), bflo(ov[i][q].y), bfhi(ov[i][q].y)};
                    u32x2 xo; xo.x = cvtpk(v[i][q][0], v[i][q][1]); xo.y = cvtpk(v[i][q][2], v[i][q][3]); RST((u32x2*)(dst + (size_t)i * XPITCH) + F.lane + 64 * q, xo); }
        }
#pragma unroll
        for (int i = 0; i < 4; ++i) { float a = 0.f;
#pragma unroll
            for (int q = 0; q < 4; ++q) a += (v[i][q][0] * v[i][q][0] + v[i][q][1] * v[i][q][1]) + (v[i][q][2] * v[i][q][2] + v[i][q][3] * v[i][q][3]);
            s[i] = a; }
#pragma unroll
        for (int o = 1; o < 64; o <<= 1)
#pragma unroll
            for (int i = 0; i < 4; ++i) s[i] += shx(s[i], o, F.lane);
#pragma unroll
        for (int i = 0; i < 4; ++i) { const float rstd = rsqrtf(s[i] * (1.f / D) + EPS); u32x2* o8 = (u32x2*)(H + (size_t)(r + i) * D) + F.lane;
#pragma unroll
            for (int q = 0; q < 4; ++q) { const f32x4 y = v[i][q] * rstd * gs[q] + sh[q]; u32x2 o; o.x = cvtpk(y[0], y[1]); o.y = cvtpk(y[2], y[3]); o8[64 * q] = o; } }
    }
}

__device__ __forceinline__ void pool_unpack(const u32x4 w, float (&v)[8]) { v[0] = bflo(w.x); v[1] = bfhi(w.x); v[2] = bflo(w.y); v[3] = bfhi(w.y); v[4] = bflo(w.z); v[5] = bfhi(w.z); v[6] = bflo(w.w); v[7] = bfhi(w.w); }
__device__ __forceinline__ void phase_pool(Frame F, const bf16_t* U, bf16_t* M, bool do_ctx) {
    F.tid = opaque_tid(F.wave0); F.lane = F.tid & 63; F.wave = __builtin_amdgcn_readfirstlane(F.tid >> 6);
    const int gw = F.vcu * NWAVES + F.wave, NGW = F.G * NWAVES;
    const int per = (((NTOK + NGW - 1) / NGW) + 3) & ~3;
    const int r0 = gw * per, r1 = min(r0 + per, NTOK);
    const int half = 1 << (F.lane >> 4);
    float S[8];
#pragma unroll
    for (int q = 0; q < 8; ++q) S[q] = 0.f;
    bool need_init = true;
    for (int r = r0; r < r1; r += 4) {
        const int b = r / LTOK, j = r - b * LTOK; const bool isc = j < CTXL;
        if (isc && !do_ctx) { need_init = true; continue; }
        const int L = isc ? CTXL : SEQ, t = isc ? j : j - CTXL; const size_t base = (size_t)b * LTOK + (isc ? 0 : CTXL);
        const bf16_t* Ul = U + base * 512 + 8 * F.lane;
        u32x4 wc[4], wi[4], wo[4];
#pragma unroll
        for (int i = 0; i < 4; ++i) { wc[i] = *(const u32x4*)(Ul + (size_t)(t + i) * 512); wi[i] = *(const u32x4*)(Ul + (size_t)min(t + i + half, L - 1) * 512); wo[i] = *(const u32x4*)(Ul + (size_t)max(t + i - half, 0) * 512); }
        if (need_init || t == 0) {
            need_init = false;
            const int lo = max(t - half, 0), hi = min(t + half, L);
            u32x4 w[16];
#pragma unroll
            for (int k = 0; k < 16; ++k) { const int tt = min(max(t - 8 + k, 0), L - 1); w[k] = *(const u32x4*)(Ul + (size_t)tt * 512); }
#pragma unroll
            for (int q = 0; q < 8; ++q) S[q] = 0.f;
#pragma unroll
            for (int k = 0; k < 16; ++k) { const int tt = t - 8 + k; const float mk = (tt >= lo && tt < hi) ? 1.f : 0.f; float v[8]; pool_unpack(w[k], v);
#pragma unroll
                for (int q = 0; q < 8; ++q) S[q] += mk * v[q]; }
        }
#pragma unroll
        for (int i = 0; i < 4; ++i) {
            const int ti = t + i, lo = max(ti - half, 0), hi = min(ti + half, L);
            const float ic = 1.f / (float)(hi - lo);
            float c[8], vi[8], vo[8]; pool_unpack(wc[i], c); pool_unpack(wi[i], vi); pool_unpack(wo[i], vo);
            u32x4 o; o.x = cvtpk(S[0] * ic - c[0], S[1] * ic - c[1]); o.y = cvtpk(S[2] * ic - c[2], S[3] * ic - c[3]);
            o.z = cvtpk(S[4] * ic - c[4], S[5] * ic - c[5]); o.w = cvtpk(S[6] * ic - c[6], S[7] * ic - c[7]);
            *(u32x4*)(M + (size_t)(r + i) * MAP + 8 * F.lane) = o;
            const float mi = (ti + half < L) ? 1.f : 0.f, mo = (ti - half >= 0) ? 1.f : 0.f;
#pragma unroll
            for (int q = 0; q < 8; ++q) S[q] = (S[q] + mi * vi[q]) - mo * vo[q];
        }
    }
}

__device__ __forceinline__ void phase_router(Frame F, char* x1, const float* g, const float* mod, bf16_t* H, const bf16_t* oadd) {
    F.tid = opaque_tid(F.wave0); F.lane = F.tid & 63; F.wave = __builtin_amdgcn_readfirstlane(F.tid >> 6);
    LAS float* WR = (LAS float*)F.lds;
    LAS float* LG = (LAS float*)(F.lds + 32768);
    LAS int* LCNT = (LAS int*)(F.lds + 32768 + 8192);
    unsigned* LIST = (unsigned*)(F.ws + WS_LIST); float* WTS = (float*)(F.ws + WS_WTS);
    for (int i = F.tid; i < 8192; i += NTHR) WR[i] = F.in[22][i];
    for (int ch = blockIdx.x; ch < NLAT / 256; ch += F.G) {
        if (F.tid < 16) LCNT[F.tid] = 0;
        __syncthreads();
        const int bch = (ch * 256) >> 11;
        f32x4 gs[4], sh[4];
        { const float* mv = mod + (size_t)bch * MODW + 3 * D;
#pragma unroll
          for (int q = 0; q < 4; ++q) { const int cidx = 4 * F.lane + 256 * q; const f32x4 gg = *(const f32x4*)(g + cidx), sc = *(const f32x4*)(mv + 1024 + cidx); gs[q] = gg * (sc + 1.f); sh[q] = *(const f32x4*)(mv + cidx); } }
        u32x2 vn[2][4], on[2][4];
#define RT_LOAD(rb_) do { const int _t0 = ch * 256 + F.wave * 32 + (rb_); const bf16_t* _or = oadd + ((size_t)bch * LTOK + CTXL + (_t0 & 2047)) * D; \
            _Pragma("unroll") for (int i = 0; i < 2; ++i) _Pragma("unroll") for (int q = 0; q < 4; ++q) { vn[i][q] = RLD((const u32x2*)(x1 + (size_t)(_t0 + i) * XPITCH) + F.lane + 64 * q); on[i][q] = RLD((const u32x2*)(_or + (size_t)i * D) + F.lane + 64 * q); } } while (0)
        RT_LOAD(0);
        for (int rb = 0; rb < 32; rb += 2) {
            const int rr0 = F.wave * 32 + rb, tok0 = ch * 256 + rr0;
            f32x4 v[2][4]; float s[2];
#pragma unroll
            for (int i = 0; i < 2; ++i)
#pragma unroll
                for (int q = 0; q < 4; ++q) v[i][q] = (f32x4){bflo(vn[i][q].x) + bflo(on[i][q].x), bfhi(vn[i][q].x) + bfhi(on[i][q].x), bflo(vn[i][q].y) + bflo(on[i][q].y), bfhi(vn[i][q].y) + bfhi(on[i][q].y)};
            if (rb + 2 < 32) RT_LOAD(rb + 2);
#pragma unroll
            for (int i = 0; i < 2; ++i)
#pragma unroll
                for (int q = 0; q < 4; ++q) { u32x2 xo; xo.x = cvtpk(v[i][q][0], v[i][q][1]); xo.y = cvtpk(v[i][q][2], v[i][q][3]); RST((u32x2*)(x1 + (size_t)(tok0 + i) * XPITCH) + F.lane + 64 * q, xo); }
#pragma unroll
            for (int i = 0; i < 2; ++i) { float a = 0.f;
#pragma unroll
                for (int q = 0; q < 4; ++q) a += (v[i][q][0] * v[i][q][0] + v[i][q][1] * v[i][q][1]) + (v[i][q][2] * v[i][q][2] + v[i][q][3] * v[i][q][3]);
                s[i] = a; }
#pragma unroll
            for (int o = 1; o < 64; o <<= 1)
#pragma unroll
                for (int i = 0; i < 2; ++i) s[i] += shx(s[i], o, F.lane);
#pragma unroll
            for (int i = 0; i < 2; ++i) {
                const int tok = tok0 + i; const float rstd = rsqrtf(s[i] * (1.f / D) + EPS);
                u32x2* o8 = (u32x2*)(H + ((size_t)bch * LTOK + CTXL + (tok & 2047)) * D) + F.lane;
                float lg[8];
#pragma unroll
                for (int e = 0; e < 8; ++e) lg[e] = 0.f;
#pragma unroll
                for (int q = 0; q < 4; ++q) { const int cidx = 4 * F.lane + 256 * q;
                    const f32x4 y = v[i][q] * rstd * gs[q] + sh[q];
                    u32x2 o; o.x = cvtpk(y[0], y[1]); o.y = cvtpk(y[2], y[3]); o8[64 * q] = o;
#pragma unroll
                    for (int k = 0; k < 4; ++k) { const LAS f32x4* wr = (const LAS f32x4*)(WR + (cidx + k) * 8); const f32x4 w0 = wr[0], w1 = wr[1];
                        lg[0] += y[k] * w0[0]; lg[1] += y[k] * w0[1]; lg[2] += y[k] * w0[2]; lg[3] += y[k] * w0[3]; lg[4] += y[k] * w1[0]; lg[5] += y[k] * w1[1]; lg[6] += y[k] * w1[2]; lg[7] += y[k] * w1[3]; } }
                const bool b0 = F.lane & 1, b1 = F.lane & 2, b2 = F.lane & 4;
                float a4[4], a2[2], a1;
#pragma unroll
                for (int j = 0; j < 4; ++j) { const float keep = b0 ? lg[4 + j] : lg[j], send = b0 ? lg[j] : lg[4 + j]; a4[j] = keep + shx(send, 1, F.lane); }
#pragma unroll
                for (int j = 0; j < 2; ++j) { const float keep = b1 ? a4[2 + j] : a4[j], send = b1 ? a4[j] : a4[2 + j]; a2[j] = keep + shx(send, 2, F.lane); }
                { const float keep = b2 ? a2[1] : a2[0], send = b2 ? a2[0] : a2[1]; a1 = keep + shx(send, 4, F.lane); }
                a1 += shx(a1, 8, F.lane); a1 += shx(a1, 16, F.lane); a1 += shx(a1, 32, F.lane);
                if (F.lane < 8) LG[(rr0 + i) * 8 + ((F.lane & 1) * 4 + (F.lane & 2) + ((F.lane >> 2) & 1))] = a1;
            }
        }
#undef RT_LOAD
        __syncthreads();
        int e1 = 0, e2 = 0, i1 = 0, i2 = 0; float w1 = 0.f, w2 = 0.f;
        if (F.tid < 256) {
            const f32x4 l0 = *(const LAS f32x4*)(LG + F.tid * 8), l1 = *(const LAS f32x4*)(LG + F.tid * 8 + 4);
            const float lg[8] = {l0[0], l0[1], l0[2], l0[3], l1[0], l1[1], l1[2], l1[3]};
            float v1 = lg[0];
#pragma unroll
            for (int e = 1; e < 8; ++e) if (lg[e] > v1) { v1 = lg[e]; e1 = e; }
            float v2 = -3.0e38f;
#pragma unroll
            for (int e = 0; e < 8; ++e) if (e != e1 && lg[e] > v2) { v2 = lg[e]; e2 = e; }
            const float p2 = expf(v2 - v1); w1 = 1.f / (1.f + p2); w2 = p2 * w1;
            i1 = atomicAdd((int*)&LCNT[e1], 1); i2 = atomicAdd((int*)&LCNT[e2], 1); }
        __syncthreads();
        if (F.tid < 8) LCNT[8 + F.tid] = (int)__hip_atomic_fetch_add(F.ctl + CW_CNT + 64 * F.tid, (unsigned)LCNT[F.tid], __ATOMIC_RELAXED, __HIP_MEMORY_SCOPE_AGENT);
        __syncthreads();
        if (F.tid < 256) { const unsigned tok = (unsigned)(ch * 256 + F.tid);
            LIST[(size_t)e1 * NLAT + LCNT[8 + e1] + i1] = tok * 2u; LIST[(size_t)e2 * NLAT + LCNT[8 + e2] + i2] = tok * 2u + 1u;
            WTS[tok * 2u] = w1; WTS[tok * 2u + 1u] = w2; }
        __syncthreads();
    }
    __syncthreads();
    LAS float* scr = (LAS float*)(F.lds + F.wave * 8448);
    const int gw = F.vcu * NWAVES + F.wave, NGW = F.G * NWAVES;
    bf16_t* WUPE = (bf16_t*)(F.ws + WS_WUPE); bf16_t* WDNE = (bf16_t*)(F.ws + WS_WDNE);
    constexpr int I_E = 16 * 44, I_D = 22 * 32;
    for (int it = gw; it < NE * (2 * I_E + I_D); it += NGW) {
        const int e = it / (2 * I_E + I_D); int r = it - e * (2 * I_E + I_D);
        if (r < 2 * I_E) { const int q = r / I_E; r -= q * I_E; const int kb = r / 44, nb = r % 44, n0 = nb * 32;
            const float* W = (q ? F.in[24] : F.in[23]) + (size_t)e * 1024 * FFE;
            tr_item(W, FFE, kb * 64, n0, WUPE + (size_t)e * 2816 * 1024, 1024, (n0 >> 7) * 256 + q * 128 - (n0 & ~127), 0, false, scr, F.lane); }
        else { r -= 2 * I_E; const int kb = r / 32, nb = r % 32;
            tr_item(F.in[25] + (size_t)e * FFE * 1024, 1024, kb * 64, nb * 32, WDNE + (size_t)e * 1024 * FFE, FFE, 0, 0, false, scr, F.lane); }
    }
}

__device__ __forceinline__ void phase_final(Frame F, float* x, const bf16_t* YM, const float* mod, const float* fg) {
    F.tid = opaque_tid(F.wave0); F.lane = F.tid & 63; F.wave = __builtin_amdgcn_readfirstlane(F.tid >> 6);
    const int gw = F.vcu * NWAVES + F.wave, NGW = F.G * NWAVES;
    const int per = (((NLAT + NGW - 1) / NGW) + 1) & ~1;
    const int t0 = gw * per, t1 = min(t0 + per, NLAT);
    if (t0 >= t1) return;
    f32x4 fgv[4], gg[4]; int cur_b = -1;
#pragma unroll
    for (int q = 0; q < 4; ++q) { fgv[q] = *(const f32x4*)(fg + 4 * F.lane + 256 * q); gg[q] = (f32x4){0.f, 0.f, 0.f, 0.f}; }
    u32x2 xb[2][4], ya[2][4], yc[2][4];
#define FIN_LOAD(tk) do { _Pragma("unroll") for (int i = 0; i < 2; ++i) _Pragma("unroll") for (int q = 0; q < 4; ++q) { \
            xb[i][q] = RLD((const u32x2*)((const char*)x + (size_t)((tk) + i) * XPITCH) + F.lane + 64 * q); \
            ya[i][q] = RLD((const u32x2*)(YM + (size_t)((tk) + i) * D) + F.lane + 64 * q); yc[i][q] = RLD((const u32x2*)(YM + ((size_t)NLAT + (tk) + i) * D) + F.lane + 64 * q); } } while (0)
    FIN_LOAD(t0);
    for (int tok = t0; tok < t1; tok += 2) {
        const int b = tok >> 11;
        if (b != cur_b) { cur_b = b; const float* gate = mod + (size_t)b * MODW + 5 * D;
#pragma unroll
            for (int q = 0; q < 4; ++q) gg[q] = *(const f32x4*)(gate + 4 * F.lane + 256 * q); }
        f32x4 xv[2][4]; float s[2];
#pragma unroll
        for (int i = 0; i < 2; ++i) { float a = 0.f;
#pragma unroll
            for (int q = 0; q < 4; ++q) {
                const f32x4 yy = (f32x4){bflo(ya[i][q].x) + bflo(yc[i][q].x), bfhi(ya[i][q].x) + bfhi(yc[i][q].x), bflo(ya[i][q].y) + bflo(yc[i][q].y), bfhi(ya[i][q].y) + bfhi(yc[i][q].y)};
                xv[i][q] = (f32x4){bflo(xb[i][q].x), bfhi(xb[i][q].x), bflo(xb[i][q].y), bfhi(xb[i][q].y)} + gg[q] * yy; a += (xv[i][q][0] * xv[i][q][0] + xv[i][q][1] * xv[i][q][1]) + (xv[i][q][2] * xv[i][q][2] + xv[i][q][3] * xv[i][q][3]); }
            s[i] = a; }
        if (tok + 2 < t1) FIN_LOAD(tok + 2);
#pragma unroll
        for (int o = 1; o < 64; o <<= 1)
#pragma unroll
            for (int i = 0; i < 2; ++i) s[i] += shx(s[i], o, F.lane);
#pragma unroll
        for (int i = 0; i < 2; ++i) { const float rstd = rsqrtf(s[i] * (1.f / D) + EPS);
#pragma unroll
            for (int q = 0; q < 4; ++q) RST((f32x4*)(x + (size_t)(tok + i) * D) + F.lane + 64 * q, xv[i][q] * rstd * fgv[q]); }
    }
#undef FIN_LOAD
}

struct Args { const float* in[27]; float* out; unsigned char* ws; int ph_lo, ph_hi; };
__global__ void __launch_bounds__(NTHR, 2) dit_fwd(Args args) {
    extern __shared__ __attribute__((aligned(16))) unsigned char lds_raw[];
    LAS unsigned char* const ldsb = (LAS unsigned char*)lds_raw;
    const int WAVE = __builtin_amdgcn_readfirstlane((int)threadIdx.x >> 6);
    volatile LAS unsigned* xbw = (volatile LAS unsigned*)(ldsb + LDS_CTRL);
    if (threadIdx.x < 4) xbw[threadIdx.x] = 0u;
    __syncthreads();
    volatile LAS unsigned long long* tsl = (volatile LAS unsigned long long*)(ldsb + LDS_CTRL + 64);
    if (args.ph_hi - args.ph_lo > 1) (void)xcd_barrier_post((unsigned*)(args.ws + WS_CTL) + CW_BAR, xbw);
#ifndef SITE_MASK
#define SITE_MASK 0xFFFFFFFFu
#endif
#define SITE(n) (((SITE_MASK) >> (n)) & 1u)
#define IN(k) (args.ph_lo <= (k) && (k) < args.ph_hi)
#define STAMP(k) do { if (PROBE_MASK != 0u && blockIdx.x == 0 && opaque_tid(WAVE) == 0) tsl[(k)] = __builtin_amdgcn_s_memrealtime(); } while (0)
#define SEAM(k) do { if (IN(k) && IN((k) + 1)) { XcdBarrier _b; _b.bar = (unsigned*)(args.ws + WS_CTL) + CW_BAR; _b.x = xb_xcc_id(); _b.st = xbw; xcd_barrier(_b); } STAMP((k) + 1); } while (0)

#define WSBASE() size_t _wz = 0; asm volatile("" : "+s"(_wz)); unsigned char* ws = args.ws + _wz; float* MOD = (float*)(ws + WS_MOD); (void)MOD; \
    Frame F; F.lds = ldsb; F.ws = ws; F.ctl = (unsigned*)(ws + WS_CTL); F.in = args.in; F.out = args.out + _wz; F.wave0 = WAVE; F.tid = 0; F.lane = 0; F.wave = 0; \
    F.G = gridDim.x; { const int bx = blockIdx.x; F.vcu = (F.G % 8 == 0) ? (bx % 8) * (F.G / 8) + bx / 8 : bx; } const int c = (int)blockIdx.x; (void)c
#define P_COS ((const float*)(ws + WS_TAB))
#define P_SIN (P_COS + 1024)
#define P_LAMV (P_SIN + 1024)
#define P_XC ((float*)(ws + WS_XC))
#define P_H ((bf16_t*)(ws + WS_H))
#define P_U ((bf16_t*)(ws + WS_U))
#define P_Q ((bf16_t*)(ws + WS_Q))
#define P_KB ((bf16_t*)(ws + WS_K))
#define P_VT ((bf16_t*)(ws + WS_VT))
#define P_G ((unsigned char*)(ws + WS_G))
#define P_MA ((bf16_t*)(ws + WS_MA))
#define P_Y ((bf16_t*)(ws + WS_Y))
#define P_HID ((bf16_t*)(ws + WS_HID))
#define P_HIDM ((bf16_t*)(ws + WS_HIDM))
#define P_YM ((bf16_t*)(ws + WS_YM))

    if (PROBE_MASK != 0u && threadIdx.x == 0) { tsl[20] = 0; tsl[21] = 0; tsl[22] = 0; tsl[23] = 0; }
    STAMP(0);
    if (SITE(0) && IN(0)) { WSBASE(); phase_prologue(F); } SEAM(0);
    if (SITE(1) && IN(1)) { WSBASE(); phase_normmod<false>(F, F.in[0], F.in[2], F.in[6], MOD, 0, true, P_H); } SEAM(1);

    for (int l = 0; l < 2; ++l) {
        const int pb = 2 + 8 * l; const bool last = (l == 1);
        if (SITE(2) && IN(pb)) { WSBASE();
            ZSched S; S.init(F.G, c, last ? 1 : 0, P_H, ws + WS_WZ + (size_t)l * 9 * MiB, ws + WS_WV + (size_t)l * 2 * MiB);
            ZEpi E{P_U, P_Q, P_KB, P_G, P_VT, P_COS, P_SIN};
            pg8::gemm_phase(F.lds, WAVE, 1024, S, E);
        } SEAM(pb);
        if (SITE(3) && IN(pb + 1)) { WSBASE();
            phase_pool(F, P_U, P_MA, !last);
            const float lam = P_LAMV[2 * l], osc = P_LAMV[2 * l + 1]; const float* subg = F.in[15] + l * VD;
            bf16x8 qf[4];
            for (int i = 0;; ++i) { const int Lf = i * F.G + F.vcu; if (Lf >= NB * NH * 16) break; const int L = REV_ORDER ? NB * NH * 16 - 1 - Lf : Lf; const int bh = L >> 4, qt = L & 15, b = bh >> 3, h = bh & 7;
                const int Lfn = Lf + F.G; const bool hn = Lfn < NB * NH * 16; const int Ln = REV_ORDER ? NB * NH * 16 - 1 - Lfn : Lfn; const int nbh = Ln >> 4, nqt = Ln & 15, nb = nbh >> 3, nh = nbh & 7;
                att::attn_unit(F.lds, P_Q, P_KB, P_VT, P_MA, b, h, (size_t)b * LTOK + CTXL + qt * 128, 36, lam, osc, subg, qf, XUP ? i == 0 : true, XUP ? hn : false, nb, nh, (size_t)nb * LTOK + CTXL + nqt * 128, WAVE); }
            if (!last) for (int i = 0;; ++i) { const int L = i * F.G + F.vcu; if (L >= NB * NH * 2) break; const int bh = L >> 1, qt = L & 1, b = bh >> 3, h = bh & 7;
                const int Ln = L + F.G; const bool hn = Ln < NB * NH * 2; const int nbh = Ln >> 1, nqt = Ln & 1, nb = nbh >> 3, nh = nbh & 7;
                att::attn_unit(F.lds, P_Q, P_KB, P_VT, P_MA, b, h, (size_t)b * LTOK + qt * 128, 4, lam, osc, subg, qf, XUP ? i == 0 : true, XUP ? hn : false, nb, nh, (size_t)nb * LTOK + nqt * 128, WAVE); }
        } SEAM(pb + 1);
        if (SITE(4) && IN(pb + 2)) { WSBASE();
            MergeSched S; S.init(F.G, c, last ? 1 : 0, P_MA, ws + WS_WM + (size_t)l * 3 * MiB); MergeEpi E{P_Y, P_G}; pg8::gemm_phase(F.lds, WAVE, MAP, S, E);
        } SEAM(pb + 2);
        if (SITE(5) && IN(pb + 3)) { WSBASE();
            PlainSched S; S.init(F.G, c, last ? 1 : 0, 4, P_Y, ws + WS_WOUT + (size_t)l * 2 * MiB, 1024, REV_ORDER);
            OEpi E{P_Q, MOD + (size_t)l * 33 * MODW, 2 * D};
            pg8::gemm_phase(F.lds, WAVE, 1024, S, E);
        } SEAM(pb + 3);
        if (!last) {
            if (SITE(6) && IN(pb + 4)) { WSBASE(); phase_normmod<false>(F, F.in[0], F.in[2], F.in[7], MOD, 3 * D, true, P_H, P_Q, F.out, P_XC); } SEAM(pb + 4);
            if (SITE(7) && IN(pb + 5)) { WSBASE(); PlainSched S; S.init(F.G, c, 0, 22, P_H, ws + WS_WUP0, 1024); UpEpi E{P_HID, FFP}; pg8::gemm_phase(F.lds, WAVE, 1024, S, E); } SEAM(pb + 5);
            if (SITE(8) && IN(pb + 6)) { WSBASE(); PlainSched S; S.init(F.G, c, 0, 4, P_HID, ws + WS_WDN0, FFP, REV_ORDER); OEpi E{(bf16_t*)P_G, MOD, 5 * D}; pg8::gemm_phase(F.lds, WAVE, FFP, S, E); } SEAM(pb + 6);
            if (SITE(9) && IN(pb + 7)) { WSBASE(); phase_normmod<true>(F, F.out, P_XC, F.in[6] + D, MOD + (size_t)33 * MODW, 0, true, P_H, (const bf16_t*)P_G, F.out, P_XC); } SEAM(pb + 7);
        } else {
            if (SITE(10) && IN(pb + 4)) { WSBASE(); phase_router(F, (char*)F.out, F.in[7] + D, MOD + (size_t)33 * MODW, P_H, P_Q); } SEAM(pb + 4);
            if (SITE(12) && IN(pb + 5)) { WSBASE(); MoeInfo mi; mi.load(F.ctl); MoeSched S; S.init(F.G, c, 11, P_H, ws + WS_WUPE, 1024, 2816, mi); S.gather = 1; S.LIST = (const unsigned*)(ws + WS_LIST); UpEpi E{P_HIDM, FFE}; pg8::gemm_phase<true>(F.lds, WAVE, 1024, S, E); } SEAM(pb + 5);
            if (SITE(13) && IN(pb + 6)) { WSBASE(); MoeInfo mi; mi.load(F.ctl); MoeSched S; S.init(F.G, c, 4, P_HIDM, ws + WS_WDNE, FFE, 1024, mi); S.rev = REV_ORDER;
                MoeDownEpi E{P_YM, (const unsigned*)(ws + WS_LIST), (const float*)(ws + WS_WTS), mi}; pg8::gemm_phase(F.lds, WAVE, FFE, S, E); } SEAM(pb + 6);
            if (SITE(14) && IN(pb + 7)) { WSBASE(); phase_final(F, F.out, P_YM, MOD + (size_t)33 * MODW, F.in[26]); }
            if (PROBE_MASK != 0u && blockIdx.x == 0) { __syncthreads(); if (threadIdx.x == 0) { const unsigned long long tend = __builtin_amdgcn_s_memrealtime(); unsigned long long dly = 0;
                for (int k = 0; k < N_PHASES; ++k) if ((PROBE_MASK >> k) & 1u) dly += (k == N_PHASES - 1 ? tend : tsl[k + 1]) - tsl[k];
                if ((PROBE_MASK >> 20) & 1u) dly += tsl[20];
                if ((PROBE_MASK >> 21) & 1u) dly += tsl[21];
                if ((PROBE_MASK >> 22) & 1u) dly += tsl[22];
                if ((PROBE_MASK >> 23) & 1u) dly += tsl[23];
                while (__builtin_amdgcn_s_memrealtime() - tend < dly) __builtin_amdgcn_s_sleep(8); } }
        }
    }
#undef IN
#undef SEAM
}

extern "C" void kernel_launch(void* const* d_in, const int* in_sizes, int n_in, void* d_out, int out_size, void* d_ws, size_t ws_size, hipStream_t stream) {
    static int grid = 0;
    if (grid == 0) {
        if (n_in != 27 || ws_size < WS_END) { fprintf(stderr, "kernel_launch: unexpected n_in %d or ws %zu\n", n_in, ws_size); grid = -1; return; }
        int dev = 0, cus = 0;
        if (hipGetDevice(&dev) != hipSuccess || hipDeviceGetAttribute(&cus, hipDeviceAttributeMultiprocessorCount, dev) != hipSuccess) { grid = -1; return; }
        if (hipFuncSetAttribute((const void*)dit_fwd, hipFuncAttributeMaxDynamicSharedMemorySize, LDS_BYTES) != hipSuccess) { fprintf(stderr, "kernel_launch: hipFuncSetAttribute failed\n"); grid = -1; return; }
        (void)hipGetLastError();
        grid = cus;
    }
    if (grid < 0) return;
    (void)hipMemsetAsync((char*)d_ws + WS_CTL, 0, CTL_ZERO_BYTES, stream);
    Args a{};
    for (int i = 0; i < 27; ++i) a.in[i] = (const float*)d_in[i];
    a.out = (float*)d_out; a.ws = (unsigned char*)d_ws;
#if MK_ONE_LAUNCH
    a.ph_lo = 0; a.ph_hi = N_PHASES;
    hipLaunchKernelGGL(dit_fwd, dim3(grid), dim3(NTHR), LDS_BYTES, stream, a);
#else
    for (int p = 0; p < N_PHASES; ++p) { a.ph_lo = p; a.ph_hi = p + 1; hipLaunchKernelGGL(dit_fwd, dim3(grid), dim3(NTHR), LDS_BYTES, stream, a); }
#endif
}
```

```cpp
#include <hip/hip_runtime.h>
#include <cstdio>
#include <cstdint>

#define LAS __attribute__((address_space(3)))
#define GAS __attribute__((address_space(1)))
typedef unsigned short bf16_t;
typedef short bf16x8 __attribute__((ext_vector_type(8)));
typedef float f32x4 __attribute__((ext_vector_type(4)));
typedef float f32x16 __attribute__((ext_vector_type(16)));
typedef unsigned u32x4 __attribute__((ext_vector_type(4)));
typedef unsigned u32x2 __attribute__((ext_vector_type(2)));
typedef float f32x2_t __attribute__((ext_vector_type(2)));
typedef __bf16 bf16x2_t __attribute__((ext_vector_type(2)));

#ifndef PROBE_MASK
#define PROBE_MASK 0u
#endif
#ifndef PG8_ALIGN
#define PG8_ALIGN 1
#endif
#ifndef ATT_PRIO
#define ATT_PRIO 0
#ifndef ATT_STATIC
#define ATT_STATIC 1
#endif
#ifndef REV_ORDER
#define REV_ORDER 1
#endif
#ifndef ROW_NT
#define ROW_NT 1
#endif
#endif
#ifndef XUP
#define XUP 0
#endif
#ifndef GEMM_STAGGER
#define GEMM_STAGGER 0
#endif
#ifndef MK_ONE_LAUNCH
#define MK_ONE_LAUNCH 1
#endif

constexpr int D = 1024, NB = 32, SEQ = 2048, CTXL = 256, LTOK = SEQ + CTXL, NTOK = NB * LTOK, NRT = NTOK / 256;
constexpr int NLAT = NB * SEQ;
constexpr int NH = 8, VD = 128;
constexpr int FF = 2752, FFP = 2816, NE = 8, FFE = 1408;
constexpr int MODW = 6 * D;
constexpr float EPS = 1e-6f;
constexpr float LOG2E = 1.4426950408889634f, LN2 = 0.6931471805599453f;
constexpr float QSCALE = 0.125f * LOG2E;
constexpr int NWAVES = 8, NTHR = 512;

constexpr size_t MiB = 1u << 20;
constexpr size_t WS_CTL = 0, CTL_ZERO_BYTES = 65536;
constexpr size_t WS_MOD = 65536;
constexpr size_t WS_TAB = 1703936;
constexpr size_t WS_XC = 2 * MiB;
constexpr size_t WS_W = 34 * MiB;
constexpr size_t WS_WZ = WS_W, WS_WV = WS_W + 18 * MiB, WS_WM = WS_W + 22 * MiB, WS_WOUT = WS_W + 28 * MiB, WS_WUP0 = WS_W + 32 * MiB, WS_WDN0 = WS_W + 43 * MiB;
constexpr size_t WS_H = 83 * MiB, WS_MA = 83 * MiB, WS_U = 299 * MiB, WS_Q = 371 * MiB, WS_K = 515 * MiB, WS_VT = 659 * MiB, WS_G = 803 * MiB, WS_O2B = 982 * MiB, WS_END = 998 * MiB;
constexpr size_t WS_Y = WS_K, WS_HID = WS_U;
constexpr size_t WS_YM = 299 * MiB, WS_HIDM = 555 * MiB, WS_WUPE = 913 * MiB, WS_WDNE = 957 * MiB, WS_LIST = 979 * MiB, WS_WTS = 981 * MiB;
constexpr int MAP = 1536;
static_assert(WS_WDN0 + (size_t)D * FFP * 2 <= WS_H, "weights");
static_assert(WS_MA + (size_t)NTOK * MAP * 2 <= WS_U && WS_G + (size_t)NTOK * 2048 <= WS_END, "ma / g");
static_assert(WS_HID + (size_t)NTOK * FFP * 2 <= WS_END, "hid");
static_assert(WS_YM + (size_t)2 * NLAT * D * 2 <= WS_HIDM && WS_HIDM + (size_t)133120 * FFE * 2 <= WS_WUPE && WS_WTS + (size_t)NLAT * 8 <= WS_END, "moe");
constexpr int CW_BAR = 1024, CW_CNT = 8192, CW_KMX = 9216;

constexpr int N_PHASES = 18;
constexpr int SPLIT_TILES = 32, SPLIT_ROWS = SPLIT_TILES * 256;
constexpr int LDS_BYTES = 163840;
constexpr int LDS_CTRL = LDS_BYTES - 256;

__device__ __forceinline__ unsigned cvtpk(float lo, float hi) { f32x2_t v = {lo, hi}; bf16x2_t b = __builtin_convertvector(v, bf16x2_t); return __builtin_bit_cast(unsigned, b); }
__device__ __forceinline__ float bflo(unsigned w) { return __uint_as_float(w << 16); }
__device__ __forceinline__ float bfhi(unsigned w) { return __uint_as_float(w & 0xffff0000u); }
__device__ __forceinline__ u32x4 pack8(const f32x4 a, const f32x4 b) { u32x4 w; w.x = cvtpk(a[0], a[1]); w.y = cvtpk(a[2], a[3]); w.z = cvtpk(b[0], b[1]); w.w = cvtpk(b[2], b[3]); return w; }
__device__ __forceinline__ float shx(float v, int o, int lane) { return __int_as_float(__builtin_amdgcn_ds_bpermute((lane ^ o) << 2, __float_as_int(v))); }
__device__ __forceinline__ float wave_sum(float v, int lane) {
#pragma unroll
    for (int o = 1; o < 64; o <<= 1) v += shx(v, o, lane);
    return v;
}
__device__ __forceinline__ float pair_sum(float v) { auto rr = __builtin_amdgcn_permlane32_swap(__float_as_uint(v), __float_as_uint(v), false, false); return __uint_as_float(rr[0]) + __uint_as_float(rr[1]); }
__device__ __forceinline__ float pair_max(float v) { auto rr = __builtin_amdgcn_permlane32_swap(__float_as_uint(v), __float_as_uint(v), false, false); return fmaxf(__uint_as_float(rr[0]), __uint_as_float(rr[1])); }
__device__ __forceinline__ float gate255(float t) { return __builtin_amdgcn_rcpf(__builtin_fmaf(__builtin_amdgcn_exp2f(t), 1.f / 255.f, 1.f / 255.f)); }
__device__ __forceinline__ float fast_sigmoid(float x) { return __builtin_amdgcn_rcpf(1.f + __builtin_amdgcn_exp2f(-LOG2E * x)); }
#define LDS_WAIT() asm volatile("s_waitcnt lgkmcnt(0)" ::: "memory")
__device__ __forceinline__ int opaque_tid(int wave) { unsigned z = 0u; asm volatile("" : "+v"(z)); return (wave << 6) | (int)__builtin_amdgcn_mbcnt_hi(~0u, __builtin_amdgcn_mbcnt_lo(~0u, z)); }

#define XB_TMO      128
#define XB_XCNT(j)  (256  + 64 * (j))
#define XB_XSUB(j)  (1280 + 64 * (j))
#define XB_XGEN(j)  (2304 + 64 * (j))
#define XB_TOP      3328
#define XB_TOPGEN   3392
#define XCD_BAR_WORDS 3456
#define XB_SPIN_CAP (1u << 22)
__device__ __forceinline__ unsigned xb_ld(unsigned* p)              { return __hip_atomic_load(p, __ATOMIC_RELAXED, __HIP_MEMORY_SCOPE_AGENT); }
__device__ __forceinline__ unsigned xb_add(unsigned* p, unsigned v) { return __hip_atomic_fetch_add(p, v, __ATOMIC_RELAXED, __HIP_MEMORY_SCOPE_AGENT); }
__device__ __forceinline__ unsigned xb_xcc_id() { return (unsigned)__builtin_amdgcn_s_getreg((3 << 11) | 20) & 0xFu; }
#define XB_SPIN(cond, bar) do { unsigned _sp = 0; while (cond) { __builtin_amdgcn_s_sleep(1); \
    if ((++_sp & 255u) == 0u) { if (xb_ld(&(bar)[XB_TMO])) break; if (_sp > XB_SPIN_CAP) { atomicAdd(&(bar)[XB_TMO], 1u); break; } } } } while (0)
struct XcdBarrier { unsigned* bar; unsigned x; volatile LAS unsigned* st; };
__device__ __forceinline__ XcdBarrier xcd_barrier_post(unsigned* bar, volatile LAS unsigned* st) {
    XcdBarrier b; b.bar = bar; b.x = xb_xcc_id(); b.st = st;
    if (threadIdx.x == 0) (void)xb_add(&bar[XB_XCNT(b.x)], 1u);
    return b;
}
__device__ __forceinline__ void xcd_barrier_complete(unsigned* bar, unsigned x, unsigned& nloc, unsigned& nx) {
    const unsigned G = gridDim.x * gridDim.y * gridDim.z;
    unsigned sum, cnt, mine, sp = 0u;
    for (;;) {
        sum = 0u; cnt = 0u; mine = 0u;
#pragma unroll
        for (unsigned j = 0; j < 16; ++j) { const unsigned c = xb_ld(&bar[XB_XCNT(j)]); sum += c; cnt += (c > 0u) ? 1u : 0u; mine = (j == x) ? c : mine; }
        if (sum == G) break;
        __builtin_amdgcn_s_sleep(1);
        if ((++sp & 255u) == 0u) { if (xb_ld(&bar[XB_TMO])) break; if (sp > XB_SPIN_CAP) { atomicAdd(&bar[XB_TMO], 1u); break; } }
    }
    nloc = mine > 0u ? mine : 1u; nx = cnt > 0u ? cnt : 1u;
}
__device__ __forceinline__ void xcd_barrier(const XcdBarrier& b) {
    asm volatile("s_waitcnt vmcnt(0)" ::: "memory");
    __syncthreads();
    if (threadIdx.x == 0) {
        unsigned* bar = b.bar;
        __builtin_amdgcn_s_waitcnt(0);
        unsigned nloc = b.st[0], nx = b.st[1];
        if (nloc == 0u) { xcd_barrier_complete(bar, b.x, nloc, nx); b.st[0] = nloc; b.st[1] = nx; }
        const unsigned old = xb_add(&bar[XB_XSUB(b.x)], 1u);
        const unsigned gen = old / nloc;
        if (old + 1u == (gen + 1u) * nloc) {
            __builtin_amdgcn_fence(__ATOMIC_RELEASE, "agent");
            asm volatile("s_waitcnt vmcnt(0)" ::: "memory");
            const unsigned og = xb_add(&bar[XB_TOP], 1u);
            const unsigned tg = og / nx;
            if (og + 1u == (tg + 1u) * nx) xb_add(&bar[XB_TOPGEN], 1u);
            else XB_SPIN(xb_ld(&bar[XB_TOPGEN]) == tg, bar);
            __builtin_amdgcn_fence(__ATOMIC_ACQUIRE, "agent");
            xb_add(&bar[XB_XGEN(b.x)], 1u);
            asm volatile("s_waitcnt vmcnt(0)" ::: "memory");
        } else {
            XB_SPIN(xb_ld(&bar[XB_XGEN(b.x)]) == gen, bar);
            __builtin_amdgcn_fence(__ATOMIC_ACQUIRE, "agent");
            asm volatile("s_waitcnt vmcnt(0)" ::: "memory");
        }
    }
    __syncthreads();
}

namespace pg8 {
constexpr int BM = 256, BK = 64, HALF = 128, HTB = HALF * BK * 2, NXCD = 8, WGM = 8;
__host__ __device__ __forceinline__ int lds_byte(int r, int c) { const int st = (r >> 4) * 2 + (c >> 5), rr = r & 15, cc = c & 31, ob = rr * 64 + cc * 2; return st * 1024 + (ob ^ (((ob >> 9) & 1) << 5)); }
__host__ __device__ __forceinline__ void stage_rc(int b, int& R, int& C) { const int st = b / 1024, sb = b % 1024, swz = sb ^ (((sb >> 9) & 1) << 5); R = (st >> 1) * 16 + swz / 64; C = (st & 1) * 32 + (swz % 64) / 2; }
__host__ __device__ __forceinline__ int perm32(int rho) { const int n = rho >> 4, i = rho & 15; return 8 * (i >> 2) + 4 * n + (i & 3); }
struct Unit { int pm, pn, kind; };
struct GridMap {
    int nM, nN, nwg;
    __device__ __forceinline__ void init(int nM_, int nN_) { nM = nM_; nN = nN_; nwg = nM_ * nN_; }
    __device__ __forceinline__ void map(int L, int& pm, int& pn) const {
        int wgid = L; { const int q = nwg / NXCD, r = nwg % NXCD, xcd = wgid % NXCD, off = wgid / NXCD; wgid = (xcd < r ? xcd * (q + 1) : r * (q + 1) + (xcd - r) * q) + off; }
        const int nig = WGM * nN, gid = wgid / nig, fm = gid * WGM, gsz = (nM - fm) < WGM ? (nM - fm) : WGM;
        pm = fm + ((wgid % nig) % gsz); pn = (wgid % nig) / gsz;
    }
};
template <bool GATHER = false, class Epi, class Sched>
__device__ __forceinline__ void gemm_phase(LAS unsigned char* lds, const int wv, const int K, const Sched& S, const Epi& E) {
    const int tid = opaque_tid(wv), wid = __builtin_amdgcn_readfirstlane(tid >> 6), lane = tid & 63, wr = wid >> 2, wc = wid & 3, fr = lane & 15, fq = lane >> 4;
    int nt = K / BK;
    unsigned voffA[2], voffB[2]; int RA[2];
#pragma unroll
    for (int i = 0; i < 2; ++i) { int R, C; stage_rc(tid * 16 + i * 8192, R, C); const int Rb = (R & ~31) + perm32(R & 31); RA[i] = R;
        voffA[i] = GATHER ? (unsigned)C * 2u : (unsigned)(R * K + C) * 2u; voffB[i] = (unsigned)(Rb * K + C) * 2u; }
    unsigned gC[2][2] = {{0u, 0u}, {0u, 0u}}, gN[2][2] = {{0u, 0u}, {0u, 0u}};
    const size_t kstep = (size_t)(BK * 2);
    const size_t hstep = (size_t)HALF * K * 2;
    const unsigned ldsw = (unsigned)wid * 1024u;
    const int aoff = lds_byte(wr * 64 + fr, fq * 8), boff = lds_byte(wc * 32 + fr, fq * 8);
#define PG8_SA(b, h) (((b) * 2 + (h)) * HTB)
#define PG8_SB(b, h) ((4 + (b) * 2 + (h)) * HTB)
#define PG8_STAGE(bufoff, gbase, voff) do { _Pragma("unroll") for (int _i = 0; _i < 2; ++_i) \
        __builtin_amdgcn_global_load_lds((const unsigned*)((const char*)(gbase) + (voff)[_i]), (LAS unsigned*)(lds + (bufoff) + ldsw + _i * 8192), 16, 0, 0); } while (0)
#define PG8_STAGE2(bufoff, gbase, o0, o1) do { \
        __builtin_amdgcn_global_load_lds((const unsigned*)((const char*)(gbase) + (o0)), (LAS unsigned*)(lds + (bufoff) + ldsw), 16, 0, 0); \
        __builtin_amdgcn_global_load_lds((const unsigned*)((const char*)(gbase) + (o1)), (LAS unsigned*)(lds + (bufoff) + ldsw + 8192), 16, 0, 0); } while (0)
#define PG8_LDA(dst, b, h) do { _Pragma("unroll") for (int m = 0; m < 4; ++m) _Pragma("unroll") for (int k = 0; k < 2; ++k) dst[m][k] = *(const LAS bf16x8*)(lds + PG8_SA(b, h) + aoff + m * 2048 + k * 1024); } while (0)
#define PG8_LDB(dst, b, h) do { _Pragma("unroll") for (int n = 0; n < 2; ++n) _Pragma("unroll") for (int k = 0; k < 2; ++k) dst[n][k] = *(const LAS bf16x8*)(lds + PG8_SB(b, h) + boff + n * 2048 + k * 1024); } while (0)
#define PG8_MMA(ai, bj, At, Bt) do { __builtin_amdgcn_s_setprio(1); _Pragma("unroll") for (int m = 0; m < 4; ++m) _Pragma("unroll") for (int n = 0; n < 2; ++n) _Pragma("unroll") for (int k = 0; k < 2; ++k) \
        acc[ai][bj][m][n] = __builtin_amdgcn_mfma_f32_16x16x32_bf16(Bt[n][k], At[m][k], acc[ai][bj][m][n], 0, 0, 0); __builtin_amdgcn_s_setprio(0); } while (0)
#define PG8_WAIT_V(n) asm volatile("s_waitcnt vmcnt(" #n ")" ::: "memory")
#define PG8_WAIT_L(n) asm volatile("s_waitcnt lgkmcnt(" #n ")" ::: "memory")
#define PG8_BAR __builtin_amdgcn_s_barrier()
#define PG8_SCHED __builtin_amdgcn_sched_barrier(0)
#define PG8_ITER(t) do { \
            const bool last = (t == nt - 2); \
            const char* a1 = cA + (size_t)(t + 1) * kstep; \
            const char* a2 = (last ? nA : cA + (size_t)(t + 2) * kstep); const char* b2 = last ? nB : cB + (size_t)(t + 2) * kstep; \
            const char* a3 = a2 + kstep; const char* b3 = b2 + kstep; \
            unsigned s00 = 0u, s01 = 0u, s10 = 0u, s11 = 0u; \
            if constexpr (GATHER) { s00 = last ? gN[0][0] : gC[0][0]; s01 = last ? gN[0][1] : gC[0][1]; s10 = last ? gN[1][0] : gC[1][0]; s11 = last ? gN[1][1] : gC[1][1]; } \
            PG8_LDB(B0, 0, 0); PG8_LDB(B1, 0, 1); PG8_SCHED; PG8_LDA(At, 0, 0); \
            if constexpr (GATHER) PG8_STAGE2(PG8_SA(1, 1), a1, gC[1][0], gC[1][1]); else PG8_STAGE(PG8_SA(1, 1), a1 + hstep, voffA); \
            PG8_WAIT_V(8); \
            PG8_WAIT_L(0); PG8_BAR; PG8_MMA(0, 0, At, B0); PG8_MMA(0, 1, At, B1); PG8_BAR; PG8_SCHED; \
            PG8_LDA(At, 0, 1); PG8_STAGE(PG8_SB(0, 0), b2, voffB); PG8_STAGE(PG8_SB(0, 1), b2 + hstep, voffB); \
            if constexpr (GATHER) PG8_STAGE2(PG8_SA(0, 0), a2, s00, s01); else PG8_STAGE(PG8_SA(0, 0), a2, voffA); \
            PG8_WAIT_V(8); \
            PG8_WAIT_L(0); PG8_BAR; PG8_MMA(1, 0, At, B0); PG8_MMA(1, 1, At, B1); PG8_BAR; PG8_SCHED; \
            PG8_LDB(B0, 1, 0); PG8_LDB(B1, 1, 1); PG8_SCHED; PG8_LDA(At, 1, 0); \
            if constexpr (GATHER) PG8_STAGE2(PG8_SA(0, 1), a2, s10, s11); else PG8_STAGE(PG8_SA(0, 1), a2 + hstep, voffA); \
            PG8_WAIT_V(8); PG8_WAIT_L(0); PG8_BAR; PG8_MMA(0, 0, At, B0); PG8_MMA(0, 1, At, B1); PG8_BAR; PG8_SCHED; \
            PG8_LDA(At, 1, 1); PG8_STAGE(PG8_SB(1, 0), b3, voffB); PG8_STAGE(PG8_SB(1, 1), b3 + hstep, voffB); \
            if constexpr (GATHER) PG8_STAGE2(PG8_SA(1, 0), a3, s00, s01); else PG8_STAGE(PG8_SA(1, 0), a3, voffA); \
            PG8_WAIT_V(8); PG8_WAIT_L(0); PG8_BAR; PG8_MMA(1, 0, At, B0); PG8_MMA(1, 1, At, B1); PG8_BAR; PG8_SCHED; \
        } while (0)
    Unit cur, nxt; int ui = 0;
    if (!S.next(0, cur)) return;
#if GEMM_STAGGER
    if (blockIdx.x & 1) { const unsigned long long t0s = __builtin_amdgcn_s_memrealtime(); const unsigned long long dl = ((unsigned long long)K * GEMM_STAGGER) >> 4;
        while (__builtin_amdgcn_s_memrealtime() - t0s < dl) __builtin_amdgcn_s_sleep(16); }
#endif
    f32x4 acc[2][2][4][2];
#pragma unroll
    for (int a = 0; a < 2; ++a)
#pragma unroll
        for (int b = 0; b < 2; ++b)
#pragma unroll
            for (int m = 0; m < 4; ++m)
#pragma unroll
                for (int n = 0; n < 2; ++n) acc[a][b][m][n] = (f32x4){0.f, 0.f, 0.f, 0.f};
    bf16x8 At[4][2], B0[2][2], B1[2][2];
    const char* cA = S.abase(cur); const char* cB = S.bbase(cur);
    if constexpr (Sched::VAR_NT) nt = S.ktiles(cur);
    if constexpr (GATHER) {
#pragma unroll
        for (int h = 0; h < 2; ++h)
#pragma unroll
            for (int i = 0; i < 2; ++i) gC[h][i] = S.grow(cur, h * HALF + RA[i]) + voffA[i];
    }
    PG8_STAGE(PG8_SB(0, 0), cB, voffB); PG8_STAGE(PG8_SB(0, 1), cB + hstep, voffB);
    if constexpr (GATHER) { PG8_STAGE2(PG8_SA(0, 0), cA, gC[0][0], gC[0][1]); PG8_STAGE2(PG8_SA(0, 1), cA, gC[1][0], gC[1][1]); }
    else { PG8_STAGE(PG8_SA(0, 0), cA, voffA); PG8_STAGE(PG8_SA(0, 1), cA + hstep, voffA); }
    if (wr == 1) PG8_BAR;
    PG8_WAIT_V(2); PG8_BAR;
    PG8_STAGE(PG8_SB(1, 0), cB + kstep, voffB);
    if constexpr (GATHER) PG8_STAGE2(PG8_SA(1, 0), cA + kstep, gC[0][0], gC[0][1]); else PG8_STAGE(PG8_SA(1, 0), cA + kstep, voffA);
    PG8_STAGE(PG8_SB(1, 1), cB + hstep + kstep, voffB);
    PG8_WAIT_V(6); PG8_BAR;
    for (;;) {
        const bool has_next = S.next(ui + 1, nxt);
        const char* nA = has_next ? S.abase(nxt) : cA; const char* nB = has_next ? S.bbase(nxt) : cB;
        if constexpr (GATHER) {
#pragma unroll
            for (int h = 0; h < 2; ++h)
#pragma unroll
                for (int i = 0; i < 2; ++i) gN[h][i] = has_next ? S.grow(nxt, h * HALF + RA[i]) + voffA[i] : gC[h][i];
        }
        for (int t = 0; t < nt; t += 2) PG8_ITER(t);
        if (PG8_ALIGN) { if (wr == 0) PG8_BAR; }
#if PROBE_MASK
        const unsigned long long _te0 = __builtin_amdgcn_s_memrealtime();
#endif
        bool keep = false;
        if constexpr (Epi::CHAINED) { if (cur.kind == 0) { E.mid(acc, cur, wr, wc, fr, fq); keep = true; } else E(acc, cur, wr, wc, fr, fq); } else E(acc, cur, wr, wc, fr, fq);
#if PROBE_MASK
        if (blockIdx.x == 0 && tid == 0) { asm volatile("s_waitcnt vmcnt(0)" ::: "memory"); volatile LAS unsigned long long* pacc = (volatile LAS unsigned long long*)(lds + LDS_CTRL + 64) + 21; *pacc = *pacc + (__builtin_amdgcn_s_memrealtime() - _te0); }
#endif
        if (!has_next) break;
        if (!keep) {
#pragma unroll
        for (int a = 0; a < 2; ++a)
#pragma unroll
            for (int b = 0; b < 2; ++b)
#pragma unroll
                for (int m = 0; m < 4; ++m)
#pragma unroll
                    for (int n = 0; n < 2; ++n) acc[a][b][m][n] = (f32x4){0.f, 0.f, 0.f, 0.f};
        }
        cur = nxt; cA = nA; cB = nB; ++ui;
        if constexpr (Sched::VAR_NT) nt = S.ktiles(cur);
        if constexpr (GATHER) { gC[0][0] = gN[0][0]; gC[0][1] = gN[0][1]; gC[1][0] = gN[1][0]; gC[1][1] = gN[1][1]; }
        if (PG8_ALIGN) { if (wr == 1) PG8_BAR; }
    }
    PG8_WAIT_V(0);
    if (!PG8_ALIGN) { if (wr == 0) PG8_BAR; }
    PG8_BAR;
#undef PG8_SA
#undef PG8_SB
#undef PG8_STAGE
#undef PG8_STAGE2
#undef PG8_ITER
#undef PG8_LDA
#undef PG8_LDB
#undef PG8_MMA
#undef PG8_WAIT_V
#undef PG8_WAIT_L
#undef PG8_BAR
#undef PG8_SCHED
}
}
using pg8::Unit;
typedef const f32x4 (&AccRef)[2][2][4][2];

struct Frame {
    LAS unsigned char* lds;
    unsigned char* ws;
    unsigned* ctl;
    const float* const* in;
    float* out;
    int tid, lane, wave, vcu, G, wave0;
};

#if ROW_NT
#define RLD(p) __builtin_nontemporal_load(p)
#define RST(p, v) __builtin_nontemporal_store((v), (p))
#else
#define RLD(p) (*(p))
#define RST(p, v) (*(p) = (v))
#endif
#ifndef EPI_NT
#define EPI_NT 0u
#endif
template <unsigned BIT, class T> __device__ __forceinline__ void epi_st(T* p, const T v) { if constexpr ((EPI_NT & BIT) != 0u) __builtin_nontemporal_store(v, p); else *p = v; }
constexpr size_t TS1024 = (size_t)256 * 1024 * 2;

struct ZSched {
    static constexpr bool VAR_NT = false;
    int G, c, last, n0, n1; const char *H, *WZ, *WV; pg8::GridMap g0, g1, g2;
    __device__ __forceinline__ void init(int G_, int c_, int last_, const void* H_, const void* WZ_, const void* WV_) {
        G = G_; c = c_; last = last_; H = (const char*)H_; WZ = (const char*)WZ_; WV = (const char*)WV_;
        if (last) { g0.init(256, 18); g1.init(32, 4); } else { g0.init(NRT, 18); g1.init(0, 4); }
        g2.init(4, NRT); n0 = g0.nwg; n1 = g1.nwg;
    }
    __device__ __forceinline__ bool next(int i, Unit& u) const {
        int L = i * G + c, a, b;
        if (L < n0) { g0.map(L, a, b); u.kind = 0; u.pm = last ? (a >> 3) * 9 + 1 + (a & 7) : a; u.pn = b; return true; }
        L -= n0;
        if (L < n1) { g1.map(L, a, b); u.kind = 0; u.pm = a * 9; u.pn = 6 + b; return true; }
        L -= n1;
        if (L < g2.nwg) { g2.map(L, a, b); u.kind = 1; u.pm = a; u.pn = b; return true; }
        return false;
    }
    __device__ __forceinline__ const char* abase(const Unit& u) const { return (u.kind ? WV : H) + (size_t)u.pm * TS1024; }
    __device__ __forceinline__ const char* bbase(const Unit& u) const { return (u.kind ? H : WZ) + (size_t)u.pn * TS1024; }
};
struct ZEpi {
    static constexpr bool CHAINED = false;
    bf16_t *U, *Q, *KB; unsigned char* G; bf16_t* VT; const float *COS, *SIN; unsigned* KMX;
    __device__ __forceinline__ void operator()(AccRef acc, const Unit& u, int wr, int wc, int fr, int fq) const {
        if (u.kind == 1) {
            const int b = u.pn / 9, jt = u.pn - b * 9;
            bf16_t* base = VT + ((size_t)b * 1024 + u.pm * 256 + wr * 64 + fr) * LTOK + jt * 256 + wc * 32 + 8 * fq;
#pragma unroll
            for (int ai = 0; ai < 2; ++ai)
#pragma unroll
                for (int m = 0; m < 4; ++m) { bf16_t* rowp = base + (size_t)(ai * 128 + m * 16) * LTOK;
#pragma unroll
                    for (int bj = 0; bj < 2; ++bj) epi_st<1u>((u32x4*)(rowp + bj * 128), pack8(acc[ai][bj][m][0], acc[ai][bj][m][1])); }
            return;
        }
        const int pn = u.pn; const size_t row0 = (size_t)u.pm * 256 + wr * 64 + fr; const int cin = wc * 32 + 8 * fq;
        if (pn < 2) {
#pragma unroll
            for (int ai = 0; ai < 2; ++ai)
#pragma unroll
                for (int m = 0; m < 4; ++m) { bf16_t* rowp = U + (row0 + ai * 128 + m * 16) * 512 + pn * 256 + cin;
#pragma unroll
                    for (int bj = 0; bj < 2; ++bj) epi_st<2u>((u32x4*)(rowp + bj * 128), pack8(acc[ai][bj][m][0], acc[ai][bj][m][1])); }
        } else if (pn < 10) {
            const bool isq = pn < 6; bf16_t* dst = isq ? Q : KB; const int ct = isq ? pn - 2 : pn - 6;
            const int jt = u.pm % 9; const bool lat = jt != 0; const int axis = wc & 1;
            float kmx[2] = {0.f, 0.f};
#pragma unroll
            for (int ai = 0; ai < 2; ++ai) {
                f32x4 c4[4], s4[4];
#pragma unroll
                for (int m = 0; m < 4; ++m) { const int pos = axis ? (16 * m + fr) : (((jt - 1) * 4 + 2 * ai + wr) & 63);
                    c4[m] = *(const f32x4*)(COS + pos * 16 + 4 * fq); s4[m] = *(const f32x4*)(SIN + pos * 16 + 4 * fq);
                    if (!lat) { c4[m] = (f32x4){1.f, 1.f, 1.f, 1.f}; s4[m] = (f32x4){0.f, 0.f, 0.f, 0.f}; } }
                asm volatile("" ::: "memory");
#pragma unroll
                for (int m = 0; m < 4; ++m) {
                    bf16_t* rowp = dst + (row0 + ai * 128 + m * 16) * 1024 + ct * 256 + cin;
#pragma unroll
                    for (int bj = 0; bj < 2; ++bj) { const f32x4 a = acc[ai][bj][m][0], b = acc[ai][bj][m][1];
                        const f32x4 ra = a * c4[m] - b * s4[m], rb = a * s4[m] + b * c4[m];
                        if (ATT_STATIC && !isq) { float q2 = (ra[0] * ra[0] + ra[1] * ra[1]) + (ra[2] * ra[2] + ra[3] * ra[3]) + (rb[0] * rb[0] + rb[1] * rb[1]) + (rb[2] * rb[2] + rb[3] * rb[3]);
                            q2 += shx(q2, 16, fq * 16 + fr); q2 += shx(q2, 32, fq * 16 + fr); kmx[bj] = fmaxf(kmx[bj], q2); }
                        epi_st<4u>((u32x4*)(rowp + bj * 128), pack8(ra, rb)); }
                }
                asm volatile("" ::: "memory");
            }
            if (ATT_STATIC && !isq) {
#pragma unroll
                for (int bj = 0; bj < 2; ++bj) { float v = kmx[bj];
#pragma unroll
                    for (int o = 1; o < 16; o <<= 1) v = fmaxf(v, shx(v, o, fq * 16 + fr));
                    if (fq * 16 + fr == 0) __hip_atomic_fetch_max(KMX + (((u.pm / 9) * 8 + 2 * ct + bj) * 2 + (wc >> 1)) * 2 + (wc & 1), __float_as_uint(v), __ATOMIC_RELAXED, __HIP_MEMORY_SCOPE_AGENT); } }
        } else {
            const int ct = pn - 10;
#pragma unroll
            for (int ai = 0; ai < 2; ++ai)
#pragma unroll
                for (int m = 0; m < 4; ++m) { unsigned char* rowp = G + (row0 + ai * 128 + m * 16) * 2048 + ct * 256 + cin;
#pragma unroll
                    for (int bj = 0; bj < 2; ++bj) { const f32x4 a = acc[ai][bj][m][0], b = acc[ai][bj][m][1]; u32x2 o; o.x = 0u; o.y = 0u;
#pragma unroll
                        for (int j = 0; j < 4; ++j) { o.x = __builtin_amdgcn_cvt_pk_u8_f32(gate255(a[j]), j, o.x); o.y = __builtin_amdgcn_cvt_pk_u8_f32(gate255(b[j]), j, o.y); }
                        epi_st<8u>((u32x2*)(rowp + bj * 128), o); } }
        }
    }
};

struct PlainSched {
    static constexpr bool VAR_NT = false;
    int G, c, latonly, rev; const char *A, *B; size_t ats, bts; pg8::GridMap g;
    __device__ __forceinline__ void init(int G_, int c_, int latonly_, int nN, const void* A_, const void* B_, int K, int rev_ = 0) {
        G = G_; c = c_; latonly = latonly_; rev = rev_; A = (const char*)A_; B = (const char*)B_; ats = bts = (size_t)256 * K * 2; g.init(latonly_ ? 256 : NRT, nN);
    }
    __device__ __forceinline__ bool next(int i, Unit& u) const {
        int L = i * G + c; if (L >= g.nwg) return false; if (rev) L = g.nwg - 1 - L; int a, b; g.map(L, a, b);
        u.kind = 0; u.pm = latonly ? (a >> 3) * 9 + 1 + (a & 7) : a; u.pn = b; return true;
    }
    __device__ __forceinline__ const char* abase(const Unit& u) const { return A + (size_t)u.pm * ats; }
    __device__ __forceinline__ const char* bbase(const Unit& u) const { return B + (size_t)u.pn * bts; }
};
struct MergeSched {
    static constexpr bool VAR_NT = true;
    int G, c, latonly; const char *A, *B; pg8::GridMap g;
    __device__ __forceinline__ void init(int G_, int c_, int latonly_, const void* A_, const void* B_) { G = G_; c = c_; latonly = latonly_; A = (const char*)A_; B = (const char*)B_; g.init(latonly_ ? 256 : NRT, 4); }
    __device__ __forceinline__ bool next(int i, Unit& u) const {
        const int L = (i >> 1) * G + c; if (L >= g.nwg) return false; int a, b; g.map(L, a, b);
        u.kind = i & 1; u.pm = latonly ? (a >> 3) * 9 + 1 + (a & 7) : a; u.pn = b; return true;
    }
    __device__ __forceinline__ int ktiles(const Unit& u) const { return u.kind ? 16 : 8; }
    __device__ __forceinline__ const char* abase(const Unit& u) const { return A + (size_t)u.pm * ((size_t)256 * MAP * 2) + (u.kind ? 1024 : 0); }
    __device__ __forceinline__ const char* bbase(const Unit& u) const { return B + (size_t)u.pn * ((size_t)256 * MAP * 2) + (u.kind ? 1024 : 0); }
};
struct DownSplitSched {
    static constexpr bool VAR_NT = true;
    int G, c; const char *A, *B; pg8::GridMap g;
    __device__ __forceinline__ void init(int G_, int c_, const void* A_, const void* B_) { G = G_; c = c_; A = (const char*)A_; B = (const char*)B_; g.init(NRT - SPLIT_TILES, 4); }
    __device__ __forceinline__ bool next(int i, Unit& u) const {
        int L = i * G + c;
        if (L < g.nwg) { int a, b; g.map(g.nwg - 1 - L, a, b); u.kind = 0; u.pm = a + SPLIT_TILES; u.pn = b; return true; }
        L -= g.nwg; if (L >= SPLIT_TILES * 8) return false;
        u.kind = 1 + (L & 1); u.pn = (L >> 1) & 3; u.pm = L >> 3; return true;
    }
    __device__ __forceinline__ int ktiles(const Unit& u) const { return u.kind ? FFP / 128 : FFP / 64; }
    __device__ __forceinline__ const char* abase(const Unit& u) const { return A + (size_t)u.pm * ((size_t)256 * FFP * 2) + (u.kind == 2 ? FFP : 0); }
    __device__ __forceinline__ const char* bbase(const Unit& u) const { return B + (size_t)u.pn * ((size_t)256 * FFP * 2) + (u.kind == 2 ? FFP : 0); }
};
__device__ __forceinline__ void unpack8(const u32x4 w, f32x4& a, f32x4& b) { a = (f32x4){bflo(w.x), bfhi(w.x), bflo(w.y), bfhi(w.y)}; b = (f32x4){bflo(w.z), bfhi(w.z), bflo(w.w), bfhi(w.w)}; }
__device__ __forceinline__ f32x4 ub4(unsigned w) { return (f32x4){(float)(w & 255u), (float)((w >> 8) & 255u), (float)((w >> 16) & 255u), (float)(w >> 24)}; }
struct MergeEpi {
    static constexpr bool CHAINED = true;
    bf16_t* O; const unsigned char* Gt;
    __device__ __forceinline__ void mid(f32x4 (&acc)[2][2][4][2], const Unit& u, int wr, int wc, int fr, int fq) const {
        const unsigned loff = (unsigned)((wr * 64 + fr) * 2048 + wc * 32 + 8 * fq);
#pragma unroll
        for (int ai = 0; ai < 2; ++ai) {
            u32x2 wp[4][2], wa[4][2];
#pragma unroll
            for (int m = 0; m < 4; ++m) { const unsigned char* gp = Gt + (size_t)(u.pm * 256 + ai * 128 + m * 16) * 2048 + u.pn * 256;
#pragma unroll
                for (int bj = 0; bj < 2; ++bj) { wp[m][bj] = *(const u32x2*)(gp + loff + bj * 128); wa[m][bj] = *(const u32x2*)(gp + loff + 1024 + bj * 128); } }
#pragma unroll
            for (int m = 0; m < 4; ++m)
#pragma unroll
                for (int bj = 0; bj < 2; ++bj) { const f32x4 p0 = ub4(wp[m][bj].x), p1 = ub4(wp[m][bj].y), a0 = ub4(wa[m][bj].x), a1 = ub4(wa[m][bj].y);
#pragma unroll
                    for (int j = 0; j < 4; ++j) { acc[ai][bj][m][0][j] *= p0[j] * __builtin_amdgcn_rcpf(fmaxf(a0[j], 1e-9f)); acc[ai][bj][m][1][j] *= p1[j] * __builtin_amdgcn_rcpf(fmaxf(a1[j], 1e-9f)); } }
        }
    }
    __device__ __forceinline__ void operator()(AccRef acc, const Unit& u, int wr, int wc, int fr, int fq) const {
        const unsigned cpart = (unsigned)(wc * 32 + 8 * fq), rpart = (unsigned)((wr * 64 + fr) * 2048);
        const unsigned loffg = rpart + cpart, loffy = rpart + 2u * cpart;
        u32x2 wa[2][4][2];
#pragma unroll
        for (int ai = 0; ai < 2; ++ai)
#pragma unroll
            for (int m = 0; m < 4; ++m) { const unsigned char* gp = Gt + (size_t)(u.pm * 256 + ai * 128 + m * 16) * 2048 + 1024 + u.pn * 256;
#pragma unroll
                for (int bj = 0; bj < 2; ++bj) wa[ai][m][bj] = *(const u32x2*)(gp + loffg + bj * 128); }
        asm volatile("" ::: "memory");
#pragma unroll
        for (int ai = 0; ai < 2; ++ai)
#pragma unroll
            for (int m = 0; m < 4; ++m) { char* op = (char*)(O + (size_t)(u.pm * 256 + ai * 128 + m * 16) * 1024 + u.pn * 256);
#pragma unroll
                for (int bj = 0; bj < 2; ++bj) { f32x4 a0 = ub4(wa[ai][m][bj].x), a1 = ub4(wa[ai][m][bj].y);
#pragma unroll
                    for (int j = 0; j < 4; ++j) { a0[j] = fmaxf(a0[j], 1e-9f) * (1.f / 255.f); a1[j] = fmaxf(a1[j], 1e-9f) * (1.f / 255.f); }
                    epi_st<16u>((u32x4*)(op + loffy + bj * 256), pack8(a0 * acc[ai][bj][m][0], a1 * acc[ai][bj][m][1])); } }
    }
};
struct ResEpi {
    static constexpr bool CHAINED = false;
    const float *latsrc, *ctxsrc; float *latdst, *ctxdst; const float* mod; int goff;
    __device__ __forceinline__ void operator()(AccRef acc, const Unit& u, int wr, int wc, int fr, int fq) const {
        const int b = u.pm / 9, jt = u.pm - b * 9;
        const size_t rb = jt ? ((size_t)b * SEQ + (jt - 1) * 256) : (size_t)b * CTXL;
        const float* src = (jt ? latsrc : ctxsrc) + (rb + wr * 64 + fr) * D; float* dst = (jt ? latdst : ctxdst) + (rb + wr * 64 + fr) * D;
        const float* gate = mod + (size_t)(jt ? b : 32) * MODW + goff;
        const int col0 = u.pn * 256 + wc * 32 + 8 * fq;
        f32x4 gv[2][2];
#pragma unroll
        for (int bj = 0; bj < 2; ++bj)
#pragma unroll
            for (int n = 0; n < 2; ++n) gv[bj][n] = *(const f32x4*)(gate + col0 + bj * 128 + 4 * n);
#pragma unroll
        for (int ai = 0; ai < 2; ++ai) {
            f32x4 x[4][2][2];
#pragma unroll
            for (int m = 0; m < 4; ++m)
#pragma unroll
                for (int bj = 0; bj < 2; ++bj)
#pragma unroll
                    for (int n = 0; n < 2; ++n) x[m][bj][n] = *(const f32x4*)(src + (size_t)(ai * 128 + m * 16) * D + col0 + bj * 128 + 4 * n);
            asm volatile("" ::: "memory");
#pragma unroll
            for (int m = 0; m < 4; ++m)
#pragma unroll
                for (int bj = 0; bj < 2; ++bj)
#pragma unroll
                    for (int n = 0; n < 2; ++n) epi_st<32u>((f32x4*)(dst + (size_t)(ai * 128 + m * 16) * D + col0 + bj * 128 + 4 * n), x[m][bj][n] + gv[bj][n] * acc[ai][bj][m][n]);
            asm volatile("" ::: "memory");
        }
    }
};
struct OEpi {
    static constexpr bool CHAINED = false;
    bf16_t* O; bf16_t* OB = nullptr;
    __device__ __forceinline__ void operator()(AccRef acc, const Unit& u, int wr, int wc, int fr, int fq) const {
        const int col0 = u.pn * 256 + wc * 32 + 8 * fq;
        bf16_t* base = (u.kind == 2 ? OB : O) + ((size_t)u.pm * 256 + wr * 64 + fr) * D + col0;
#pragma unroll
        for (int ai = 0; ai < 2; ++ai)
#pragma unroll
            for (int m = 0; m < 4; ++m)
#pragma unroll
                for (int bj = 0; bj < 2; ++bj) epi_st<32u>((u32x4*)(base + (size_t)(ai * 128 + m * 16) * D + bj * 128), pack8(acc[ai][bj][m][0], acc[ai][bj][m][1]));
    }
};
struct UpEpi {
    static constexpr bool CHAINED = false;
    bf16_t* O; int ld;
    __device__ __forceinline__ void operator()(AccRef acc, const Unit& u, int wr, int wc, int fr, int fq) const {
        const size_t row0 = (size_t)u.pm * 256 + wr * 64 + fr; const int col0 = u.pn * 128 + wc * 32 + 8 * fq;
#pragma unroll
        for (int ai = 0; ai < 2; ++ai)
#pragma unroll
            for (int m = 0; m < 4; ++m) { f32x4 v[2];
#pragma unroll
                for (int n = 0; n < 2; ++n) { const f32x4 g = acc[ai][0][m][n], w = acc[ai][1][m][n];
#pragma unroll
                    for (int j = 0; j < 4; ++j) v[n][j] = (g[j] * w[j]) * __builtin_amdgcn_rcpf(1.f + __builtin_amdgcn_exp2f(g[j])); }
                epi_st<64u>((u32x4*)(O + (row0 + ai * 128 + m * 16) * ld + col0), pack8(v[0], v[1])); }
    }
};
struct MoeInfo {
    int cnt[NE], tb[NE + 1];
    __device__ __forceinline__ void load(const unsigned* cw) {
        int t = 0;
#pragma unroll
        for (int e = 0; e < NE; ++e) { const int c = __builtin_amdgcn_readfirstlane((int)__hip_atomic_load(cw + CW_CNT + 64 * e, __ATOMIC_RELAXED, __HIP_MEMORY_SCOPE_AGENT)); cnt[e] = c; tb[e] = t; t += (c + 255) >> 8; }
        tb[NE] = t;
    }
    __device__ __forceinline__ void lookup(int rt, int& e, int& t0, int& ce) const { e = 0; t0 = 0; ce = cnt[0];
#pragma unroll
        for (int k = 1; k < NE; ++k) { const bool ge = rt >= tb[k]; e = ge ? k : e; t0 = ge ? tb[k] : t0; ce = ge ? cnt[k] : ce; } }
};
struct MoeSched {
    static constexpr bool VAR_NT = false;
    int G, c, nN, gather, rev; const char *A, *B; const unsigned* LIST; size_t ats, bts, bes; MoeInfo mi; pg8::GridMap g;
    __device__ __forceinline__ void init(int G_, int c_, int nN_, const void* A_, const void* B_, int K, int Nrows, const MoeInfo& mi_) {
        G = G_; c = c_; nN = nN_; gather = 0; rev = 0; LIST = nullptr; A = (const char*)A_; B = (const char*)B_; ats = bts = (size_t)256 * K * 2; bes = (size_t)Nrows * K * 2; mi = mi_; g.init(mi_.tb[NE], nN_);
    }
    __device__ __forceinline__ bool next(int i, Unit& u) const {
        int L = i * G + c; if (L >= g.nwg) return false; if (rev) L = g.nwg - 1 - L; int a, b; g.map(L, a, b); u.pm = a; u.pn = b; int t0, ce; mi.lookup(a, u.kind, t0, ce); return true;
    }
    __device__ __forceinline__ const char* abase(const Unit& u) const { return gather ? A : A + (size_t)u.pm * ats; }
    __device__ __forceinline__ const char* bbase(const Unit& u) const { return B + (size_t)u.kind * bes + (size_t)u.pn * bts; }
    __device__ __forceinline__ unsigned grow(const Unit& u, int row) const { int e, t0, ce; mi.lookup(u.pm, e, t0, ce); const int slot = (u.pm - t0) * 256 + row;
        unsigned tok = 0u; if (slot < ce) tok = LIST[(size_t)e * NLAT + slot] >> 1;
        return ((tok >> 11) * (unsigned)LTOK + (unsigned)CTXL + (tok & 2047u)) * (unsigned)(D * 2); }
};
struct MoeDownEpi {
    static constexpr bool CHAINED = false;
    bf16_t* YM; const unsigned* LIST; const float* WTS; MoeInfo mi;
    __device__ __forceinline__ void operator()(AccRef acc, const Unit& u, int wr, int wc, int fr, int fq) const {
        int e, t0, ce; mi.lookup(u.pm, e, t0, ce); const int slot0 = (u.pm - t0) * 256 + wr * 64 + fr;
        const int col0 = u.pn * 256 + wc * 32 + 8 * fq;
        unsigned ent[2][4]; float wt[2][4];
#pragma unroll
        for (int ai = 0; ai < 2; ++ai)
#pragma unroll
            for (int m = 0; m < 4; ++m) { const int slot = slot0 + ai * 128 + m * 16; ent[ai][m] = slot < ce ? LIST[(size_t)e * NLAT + slot] : 0xffffffffu; }
#pragma unroll
        for (int ai = 0; ai < 2; ++ai)
#pragma unroll
            for (int m = 0; m < 4; ++m) wt[ai][m] = ent[ai][m] != 0xffffffffu ? WTS[ent[ai][m]] : 0.f;
        asm volatile("" ::: "memory");
#pragma unroll
        for (int ai = 0; ai < 2; ++ai)
#pragma unroll
            for (int m = 0; m < 4; ++m) {
                if (ent[ai][m] != 0xffffffffu) { const unsigned en = ent[ai][m]; const float w8 = wt[ai][m];
                    bf16_t* rowp = YM + ((size_t)(en & 1u) * NLAT + (en >> 1)) * D + col0;
#pragma unroll
                    for (int bj = 0; bj < 2; ++bj) epi_st<128u>((u32x4*)(rowp + bj * 128), pack8(acc[ai][bj][m][0] * w8, acc[ai][bj][m][1] * w8)); } }
    }
};

namespace att {
constexpr int BUFB = 32768, EXCH = 65536;
constexpr float THR = 6.f;
#define ATT_SBAR() __builtin_amdgcn_sched_barrier(0)
#define ATT_MFMA(a, b, c) __builtin_amdgcn_mfma_f32_32x32x16_bf16(a, b, c, 0, 0, 0)
#define ATT_SYNC() asm volatile("s_waitcnt vmcnt(0) lgkmcnt(0)\n\ts_barrier" ::: "memory")
__device__ __forceinline__ void attn_unit(LAS unsigned char* lds, const bf16_t* Q, const bf16_t* K, const bf16_t* VT, bf16_t* AY, int b, int h, size_t qrow0, int nkt, float lam, float osc, const float* subg, const unsigned* kmx,
                                          bf16x8 (&qf)[4], bool first, bool has_next, int nb, int nh, size_t nqrow0, int wv) {
    const int tid = opaque_tid(wv), lane = tid & 63, ql = lane & 31, hh = lane >> 5; const int w = __builtin_amdgcn_readfirstlane(tid >> 6); const int map = w >> 2, qb = w & 3;
    const size_t qrow = qrow0 + 32 * qb + ql;
    if (ATT_PRIO && w >= 4) __builtin_amdgcn_s_setprio(1);
#if PROBE_MASK
    unsigned long long att_wait = 0, att_b = 0, att_a = 0;
#endif
    if (first) {
#pragma unroll
        for (int ks = 0; ks < 4; ++ks) qf[ks] = *(const bf16x8*)(Q + qrow * 1024 + (h * 2 + map) * 64 + 16 * ks + 8 * hh);
    }
    const int prow = lane >> 3, pc = lane & 7;
    const int krow = 8 * w + prow, kc = pc ^ ((krow >> 1) & 7);
    const bf16_t* ksrc0 = K + ((size_t)b * LTOK + krow) * 1024 + (h * 2) * 64 + kc * 8;
    const bf16_t* ksrc1 = ksrc0 + 64;
    const int e0 = 16 * w + prow, e1 = e0 + 8;
    const bf16_t* vsrc0 = VT + ((size_t)b * 1024 + h * 128 + e0) * LTOK + (pc ^ ((e0 >> 1) & 7)) * 8;
    const bf16_t* vsrc1 = VT + ((size_t)b * 1024 + h * 128 + e1) * LTOK + (pc ^ ((e1 >> 1) & 7)) * 8;
#define ATT_DMA_K(t, BO) do { \
        __builtin_amdgcn_global_load_lds((const unsigned*)(ksrc0 + (size_t)(t) * 64 * 1024), (LAS unsigned*)(lds + (BO) + w * 1024), 16, 0, 0); \
        __builtin_amdgcn_global_load_lds((const unsigned*)(ksrc1 + (size_t)(t) * 64 * 1024), (LAS unsigned*)(lds + (BO) + 8192 + w * 1024), 16, 0, 0); } while (0)
#define ATT_DMA_K0(t, BO) __builtin_amdgcn_global_load_lds((const unsigned*)(ksrc0 + (size_t)(t) * 64 * 1024), (LAS unsigned*)(lds + (BO) + w * 1024), 16, 0, 0)
#define ATT_DMA_K1(t, BO) __builtin_amdgcn_global_load_lds((const unsigned*)(ksrc1 + (size_t)(t) * 64 * 1024), (LAS unsigned*)(lds + (BO) + 8192 + w * 1024), 16, 0, 0)
#define ATT_DMA_V0(t, BO) __builtin_amdgcn_global_load_lds((const unsigned*)(vsrc0 + (size_t)(t) * 64), (LAS unsigned*)(lds + (BO) + 16384 + w * 2048), 16, 0, 0)
#define ATT_DMA_V1(t, BO) __builtin_amdgcn_global_load_lds((const unsigned*)(vsrc1 + (size_t)(t) * 64), (LAS unsigned*)(lds + (BO) + 16384 + w * 2048 + 1024), 16, 0, 0)
#define ATT_DMA_V(t, BO) do { \
        __builtin_amdgcn_global_load_lds((const unsigned*)(vsrc0 + (size_t)(t) * 64), (LAS unsigned*)(lds + (BO) + 16384 + w * 2048), 16, 0, 0); \
        __builtin_amdgcn_global_load_lds((const unsigned*)(vsrc1 + (size_t)(t) * 64), (LAS unsigned*)(lds + (BO) + 16384 + w * 2048 + 1024), 16, 0, 0); } while (0)
    const int rp = (ql & ~12) | ((ql & 4) << 1) | ((ql & 8) >> 1);
    const int xk = (rp >> 1) & 7, xv = (ql >> 1) & 7;
    const LAS unsigned char* kbase = lds + map * 8192 + rp * 128;
    const LAS unsigned char* vbase = lds + 16384 + ql * 128;
    const unsigned kaddr0 = (unsigned)(uintptr_t)kbase, vaddr0 = (unsigned)(uintptr_t)vbase;
    int kof[4], vof[4];
#pragma unroll
    for (int i = 0; i < 4; ++i) { kof[i] = ((2 * i + hh) ^ xk) << 4; vof[i] = ((2 * i + hh) ^ xv) << 4; }
#define ATT_KRD(i, RB) (*(const LAS bf16x8*)(kbase + (RB) + ((i) >> 2) * 4096 + kof[(i) & 3]))
#define ATT_VRD(g, RB) (*(const LAS bf16x8*)(vbase + (RB) + ((g) >> 2) * 4096 + vof[(g) & 3]))
    const f32x16 Z16 = (f32x16){0.f, 0.f, 0.f, 0.f, 0.f, 0.f, 0.f, 0.f, 0.f, 0.f, 0.f, 0.f, 0.f, 0.f, 0.f, 0.f};
    f32x16 O[4];
#pragma unroll
    for (int i = 0; i < 4; ++i) O[i] = Z16;
    f32x16 negm = Z16, S0, S1;
    float lrun = 0.f, ral = 1.f; bool resc = false;
    bf16x8 kf[8]; u32x4 pA[4], pB[4];
#define ATT_QK() do { \
        S0 = ATT_MFMA(kf[0], qf[0], negm); S1 = ATT_MFMA(kf[4], qf[0], negm); \
        S0 = ATT_MFMA(kf[1], qf[1], S0);   S1 = ATT_MFMA(kf[5], qf[1], S1); \
        S0 = ATT_MFMA(kf[2], qf[2], S0);   S1 = ATT_MFMA(kf[6], qf[2], S1); \
        S0 = ATT_MFMA(kf[3], qf[3], S0);   S1 = ATT_MFMA(kf[7], qf[3], S1); } while (0)
#define ATT_QKD(t) do { \
        S0 = ATT_MFMA(kf[0], qf[0], negm); if ((t) + 3 < nkt) ATT_DMA_K0((t) + 3, ATT_BUF((t) + 3)); ATT_SBAR(); \
        S1 = ATT_MFMA(kf[4], qf[0], negm); if ((t) + 3 < nkt) ATT_DMA_K1((t) + 3, ATT_BUF((t) + 3)); ATT_SBAR(); \
        S0 = ATT_MFMA(kf[1], qf[1], S0);   ATT_DMA_V0((t) + 1, ATT_BUF((t) + 1)); ATT_SBAR(); \
        S1 = ATT_MFMA(kf[5], qf[1], S1);   ATT_DMA_V1((t) + 1, ATT_BUF((t) + 1)); ATT_SBAR(); \
        S0 = ATT_MFMA(kf[2], qf[2], S0);   if ((t) + 4 < nkt) ATT_DMA_K0((t) + 4, ATT_BUF(t)); ATT_SBAR(); \
        S1 = ATT_MFMA(kf[6], qf[2], S1);   if ((t) + 4 < nkt) ATT_DMA_K1((t) + 4, ATT_BUF(t)); ATT_SBAR(); \
        S0 = ATT_MFMA(kf[3], qf[3], S0);   ATT_DMA_V0((t) + 2, ATT_BUF((t) + 2)); ATT_SBAR(); \
        S1 = ATT_MFMA(kf[7], qf[3], S1);   ATT_DMA_V1((t) + 2, ATT_BUF((t) + 2)); ATT_SBAR(); } while (0)
#define ATT_ROWMAX(mx) do { float _a = fmaxf(S0[0], S1[0]), _b = fmaxf(S0[1], S1[1]); \
        _Pragma("unroll") for (int r = 2; r < 16; r += 2) { _a = fmaxf(_a, fmaxf(S0[r], S1[r])); _b = fmaxf(_b, fmaxf(S0[r + 1], S1[r + 1])); } \
        mx = pair_max(fmaxf(_a, _b)); } while (0)
#define ATT_IMAX3(a, b, c) max(max((a), (b)), (c))
#define ATT_SI(i) __float_as_int(ATT_SV(i))
#define ATT_ROWMAXI(mx) do { int _a = ATT_IMAX3(ATT_SI(0), ATT_SI(1), ATT_SI(2)), _b = ATT_IMAX3(ATT_SI(3), ATT_SI(4), ATT_SI(5)); \
        _a = ATT_IMAX3(_a, ATT_SI(6), ATT_SI(7)); _b = ATT_IMAX3(_b, ATT_SI(8), ATT_SI(9)); _a = ATT_IMAX3(_a, ATT_SI(10), ATT_SI(11)); _b = ATT_IMAX3(_b, ATT_SI(12), ATT_SI(13)); \
        _a = ATT_IMAX3(_a, ATT_SI(14), ATT_SI(15)); _b = ATT_IMAX3(_b, ATT_SI(16), ATT_SI(17)); _a = ATT_IMAX3(_a, ATT_SI(18), ATT_SI(19)); _b = ATT_IMAX3(_b, ATT_SI(20), ATT_SI(21)); \
        _a = ATT_IMAX3(_a, ATT_SI(22), ATT_SI(23)); _b = ATT_IMAX3(_b, ATT_SI(24), ATT_SI(25)); _a = ATT_IMAX3(_a, ATT_SI(26), ATT_SI(27)); _b = ATT_IMAX3(_b, ATT_SI(28), ATT_SI(29)); \
        _a = ATT_IMAX3(_a, ATT_SI(30), ATT_SI(31)); _a = max(_a, _b); \
        auto _rr = __builtin_amdgcn_permlane32_swap((unsigned)_a, (unsigned)_a, false, false); mx = __int_as_float(max((int)_rr[0], (int)_rr[1])); } while (0)
#define ATT_DECIDE() do { if (ATT_STATIC) break; float mx; ATT_ROWMAXI(mx); \
        if (__any(mx > THR)) { const float dl = fmaxf(mx, 0.f); \
            _Pragma("unroll") for (int r = 0; r < 16; ++r) { S0[r] -= dl; S1[r] -= dl; negm[r] -= dl; } \
            ral = __builtin_amdgcn_exp2f(-dl); lrun *= ral; resc = true; } } while (0)
#define ATT_SV(i) ((i) < 16 ? S0[(i) & 15] : S1[(i) & 15])
#define ATT_EXP2(g, PN) do { const float _e0 = __builtin_amdgcn_exp2f(ATT_SV(2 * (g))), _e1 = __builtin_amdgcn_exp2f(ATT_SV(2 * (g) + 1)); ls += _e0; ls += _e1; unsigned _w = cvtpk(_e0, _e1); asm volatile("" : "+v"(_w), "+v"(ls)); PN[(g) >> 2][(g) & 3] = _w; } while (0)
#define ATT_DSRD(dst, addr, off) asm volatile("ds_read_b128 %0, %1 offset:%2" : "=v"(dst) : "v"(addr), "i"(off))
#define ATT_NW(g, DOK) ((DOK) ? ((g) <= 8 ? 2 : (g) == 9 ? 3 : (g) == 10 ? 4 : (g) <= 13 ? 5 : (g) == 14 ? 4 : 3) : ((g) <= 13 ? 2 : (g) == 14 ? 1 : 0))
#define ATT_GAPB(g, VC, VL, PP, PN, DOK) do { \
        asm volatile("s_waitcnt lgkmcnt(%1)" : "+v"(VC) : "i"(ATT_NW(g, DOK))); \
        O[(g) >> 2] = ATT_MFMA(VC, __builtin_bit_cast(bf16x8, PP[(g) & 3]), O[(g) >> 2]); \
        if ((g) + 3 < 16) ATT_DSRD(VL, va[((g) + 3) & 3], (((g) + 3) >> 2) * 4096); \
        if ((DOK) && (g) >= 8) ATT_DSRD(kf[(g) - 8], ka[((g) - 8) & 3], (((g) - 8) >> 2) * 4096); \
        ATT_EXP2(g, PN); ATT_SBAR(); } while (0)
#define ATT_PHASEB(RBK, RB, PP, PN, DOK) do { float ls = 0.f; unsigned va[4], ka[4]; \
        _Pragma("unroll") for (int _c = 0; _c < 4; ++_c) { va[_c] = vaddr0 + (unsigned)(RB) + (unsigned)vof[_c]; ka[_c] = kaddr0 + (unsigned)(RBK) + (unsigned)kof[_c]; } \
        bf16x8 v0, v1, v2, v3; ATT_DSRD(v0, va[0], 0); ATT_DSRD(v1, va[1], 0); ATT_DSRD(v2, va[2], 0); ATT_SBAR(); \
        ATT_GAPB(0, v0, v3, PP, PN, DOK); ATT_GAPB(1, v1, v0, PP, PN, DOK); ATT_GAPB(2, v2, v1, PP, PN, DOK); ATT_GAPB(3, v3, v2, PP, PN, DOK); \
        ATT_GAPB(4, v0, v3, PP, PN, DOK); ATT_GAPB(5, v1, v0, PP, PN, DOK); ATT_GAPB(6, v2, v1, PP, PN, DOK); ATT_GAPB(7, v3, v2, PP, PN, DOK); \
        ATT_GAPB(8, v0, v3, PP, PN, DOK); ATT_GAPB(9, v1, v0, PP, PN, DOK); ATT_GAPB(10, v2, v1, PP, PN, DOK); ATT_GAPB(11, v3, v2, PP, PN, DOK); \
        ATT_GAPB(12, v0, v3, PP, PN, DOK); ATT_GAPB(13, v1, v0, PP, PN, DOK); ATT_GAPB(14, v2, v1, PP, PN, DOK); ATT_GAPB(15, v3, v2, PP, PN, DOK); \
        if (DOK) { asm volatile("s_waitcnt lgkmcnt(0)" : "+v"(kf[0]), "+v"(kf[1]), "+v"(kf[2]), "+v"(kf[3]), "+v"(kf[4]), "+v"(kf[5]), "+v"(kf[6]), "+v"(kf[7])); ATT_SBAR(); } \
        lrun += ls; } while (0)
#define ATT_RESC() do { if (ATT_STATIC) break; if (resc) { _Pragma("unroll") for (int i = 0; i < 4; ++i) _Pragma("unroll") for (int r = 0; r < 16; ++r) O[i][r] *= ral; resc = false; } } while (0)
#define ATT_BUF(j) (((j) & 3) * BUFB)
#if PROBE_MASK
#define ATT_TB0() const unsigned long long _tb0 = __builtin_amdgcn_s_memrealtime(); asm volatile("s_waitcnt lgkmcnt(0)" ::: "memory")
#define ATT_TB1() const unsigned long long _tb1 = __builtin_amdgcn_s_memrealtime(); att_b += _tb1 - _tb0
#define ATT_TB2() asm volatile("" : "+v"(S0), "+v"(S1)); att_a += __builtin_amdgcn_s_memrealtime() - _tb1
#else
#define ATT_TB0() do {} while (0)
#define ATT_TB1() do {} while (0)
#define ATT_TB2() do {} while (0)
#endif
#if PROBE_MASK
#define ATT_SYNCN(N) do { const unsigned long long _t0 = __builtin_amdgcn_s_memrealtime(); asm volatile("s_waitcnt vmcnt(" #N ") lgkmcnt(0)\n\ts_barrier" ::: "memory"); att_wait += __builtin_amdgcn_s_memrealtime() - _t0; } while (0)
#else
#define ATT_SYNCN(N) asm volatile("s_waitcnt vmcnt(" #N ") lgkmcnt(0)\n\ts_barrier" ::: "memory")
#endif
#define ATT_STEP(t, PP, PN) do { \
        ATT_TB0(); { const int rbk = ATT_BUF((t) + 1), rbv = ATT_BUF((t) - 1); ATT_PHASEB(rbk, rbv, PP, PN, true); } ATT_RESC(); ATT_TB1(); ATT_QK(); ATT_DECIDE(); ATT_TB2(); } while (0)
#define ATT_STEPD(t, PP, PN) do { \
        ATT_TB0(); { const int rbk = ATT_BUF((t) + 1), rbv = ATT_BUF((t) - 1); ATT_PHASEB(rbk, rbv, PP, PN, true); } ATT_RESC(); ATT_TB1(); ATT_QKD(t); ATT_DECIDE(); ATT_TB2(); } while (0)

    if (first) { ATT_DMA_K(0, 0); ATT_DMA_K(1, BUFB); ATT_DMA_V(0, 0); ATT_DMA_V(1, BUFB); }
    ATT_DMA_K(2, 2 * BUFB); ATT_DMA_K(3, 3 * BUFB);
    ATT_SYNCN(4);
#pragma unroll
    for (int i = 0; i < 8; ++i) kf[i] = ATT_KRD(i, 0);
    if (ATT_STATIC) {
        float qq = 0.f;
#pragma unroll
        for (int ks = 0; ks < 4; ++ks) { const u32x4 w4 = __builtin_bit_cast(u32x4, qf[ks]);
            qq += (bflo(w4.x) * bflo(w4.x) + bfhi(w4.x) * bfhi(w4.x)) + (bflo(w4.y) * bflo(w4.y) + bfhi(w4.y) * bfhi(w4.y)) + (bflo(w4.z) * bflo(w4.z) + bfhi(w4.z) * bfhi(w4.z)) + (bflo(w4.w) * bflo(w4.w) + bfhi(w4.w) * bfhi(w4.w)); }
        qq = pair_sum(qq);
        const float k2 = __uint_as_float(__hip_atomic_load(kmx + 2 * map, __ATOMIC_RELAXED, __HIP_MEMORY_SCOPE_AGENT)) + __uint_as_float(__hip_atomic_load(kmx + 2 * map + 1, __ATOMIC_RELAXED, __HIP_MEMORY_SCOPE_AGENT));
        const float ub = __builtin_sqrtf(qq * k2) * 1.01f + 0.015625f;
#pragma unroll
        for (int r = 0; r < 16; ++r) negm[r] = -ub;
    }
    ATT_QK();
    if (!ATT_STATIC) { float mx; ATT_ROWMAX(mx);
#pragma unroll
      for (int r = 0; r < 16; ++r) { S0[r] -= mx; S1[r] -= mx; negm[r] = -mx; } }
    { float ls = 0.f;
#pragma unroll
      for (int i = 0; i < 8; ++i) kf[i] = ATT_KRD(i, BUFB);
#define ATT_E0(g) ATT_EXP2(g, pA)
      ATT_E0(0); ATT_E0(1); ATT_E0(2); ATT_E0(3); ATT_E0(4); ATT_E0(5); ATT_E0(6); ATT_E0(7); ATT_E0(8); ATT_E0(9); ATT_E0(10); ATT_E0(11); ATT_E0(12); ATT_E0(13); ATT_E0(14); ATT_E0(15);
#undef ATT_E0
      lrun += ls; }
    ATT_QK(); ATT_DECIDE();
    for (int t = 1; t < nkt - 1; t += 2) {
        ATT_SYNCN(0);
        ATT_STEPD(t, pA, pB);
        ATT_STEP(t + 1, pB, pA);
    }
    ATT_SYNCN(0);
    if (has_next) {
        const size_t nqrow = nqrow0 + 32 * qb + ql;
#pragma unroll
        for (int ks = 0; ks < 4; ++ks) qf[ks] = *(const bf16x8*)(Q + nqrow * 1024 + (nh * 2 + map) * 64 + 16 * ks + 8 * hh);
        const bf16_t* nk0 = K + ((size_t)nb * LTOK + krow) * 1024 + (nh * 2) * 64 + kc * 8;
        const bf16_t* nv0 = VT + ((size_t)nb * 1024 + nh * 128 + e0) * LTOK + (pc ^ ((e0 >> 1) & 7)) * 8;
        const bf16_t* nv1 = VT + ((size_t)nb * 1024 + nh * 128 + e1) * LTOK + (pc ^ ((e1 >> 1) & 7)) * 8;
#pragma unroll
        for (int j = 0; j < 2; ++j) {
            __builtin_amdgcn_global_load_lds((const unsigned*)(nk0 + (size_t)j * 64 * 1024), (LAS unsigned*)(lds + j * BUFB + w * 1024), 16, 0, 0);
            __builtin_amdgcn_global_load_lds((const unsigned*)(nk0 + 64 + (size_t)j * 64 * 1024), (LAS unsigned*)(lds + j * BUFB + 8192 + w * 1024), 16, 0, 0);
            __builtin_amdgcn_global_load_lds((const unsigned*)(nv0 + (size_t)j * 64), (LAS unsigned*)(lds + j * BUFB + 16384 + w * 2048), 16, 0, 0);
            __builtin_amdgcn_global_load_lds((const unsigned*)(nv1 + (size_t)j * 64), (LAS unsigned*)(lds + j * BUFB + 16384 + w * 2048 + 1024), 16, 0, 0); }
    }
    { const int rbv = ATT_BUF(nkt - 2); ATT_PHASEB(0, rbv, pA, pB, false); } ATT_RESC();
    { const int rbv = ATT_BUF(nkt - 1); bf16x8 v0 = ATT_VRD(0, rbv), v1 = ATT_VRD(1, rbv), v2;
#define ATT_GF(g, VC, VL) do { O[(g) >> 2] = ATT_MFMA(VC, __builtin_bit_cast(bf16x8, pB[(g) & 3]), O[(g) >> 2]); if ((g) + 2 < 16) VL = ATT_VRD((g) + 2, rbv); } while (0)
      ATT_GF(0, v0, v2); ATT_GF(1, v1, v0); ATT_GF(2, v2, v1); ATT_GF(3, v0, v2); ATT_GF(4, v1, v0); ATT_GF(5, v2, v1); ATT_GF(6, v0, v2); ATT_GF(7, v1, v0);
      ATT_GF(8, v2, v1); ATT_GF(9, v0, v2); ATT_GF(10, v1, v0); ATT_GF(11, v2, v1); ATT_GF(12, v0, v2); ATT_GF(13, v1, v0); ATT_GF(14, v2, v1); ATT_GF(15, v0, v2);
#undef ATT_GF
    }
    asm volatile("s_waitcnt lgkmcnt(0)\n\ts_barrier" ::: "memory");
    const float inv = 1.f / pair_sum(lrun);
    f32x4 sgv[4][4];
    if (map == 0) {
#pragma unroll
        for (int i = 0; i < 4; ++i)
#pragma unroll
            for (int g = 0; g < 4; ++g) sgv[i][g] = *(const f32x4*)(subg + 32 * i + 8 * g + 4 * hh);
    }
    LAS float* ex = (LAS float*)(lds + EXCH) + (size_t)qb * 4096 + lane;
    if (map == 1) {
#pragma unroll
        for (int i = 0; i < 4; ++i)
#pragma unroll
            for (int r = 0; r < 16; ++r) ex[(i * 16 + r) * 64] = O[i][r] * inv;
    }
    asm volatile("s_waitcnt lgkmcnt(0)\n\ts_barrier" ::: "memory");
    if (map == 0) {
        float ss = 0.f;
#pragma unroll
        for (int i = 0; i < 4; ++i)
#pragma unroll
            for (int r = 0; r < 16; ++r) { const float y = O[i][r] * inv - lam * ex[(i * 16 + r) * 64]; O[i][r] = y; ss += y * y; }
        ss = pair_sum(ss);
        const float rs = rsqrtf(ss * (1.f / VD) + EPS) * osc;
        bf16_t* orow = AY + qrow * MAP + 512 + h * 128;
#pragma unroll
        for (int i = 0; i < 4; ++i)
#pragma unroll
            for (int g = 0; g < 4; ++g) { const int e = 32 * i + 8 * g + 4 * hh; const f32x4 gv = sgv[i][g];
                u32x2 o; o.x = cvtpk(O[i][4 * g] * rs * gv[0], O[i][4 * g + 1] * rs * gv[1]); o.y = cvtpk(O[i][4 * g + 2] * rs * gv[2], O[i][4 * g + 3] * rs * gv[3]);
                *(u32x2*)(orow + e) = o; }
    }
    asm volatile("s_waitcnt lgkmcnt(0)\n\ts_barrier" ::: "memory");
    if (ATT_PRIO && w >= 4) __builtin_amdgcn_s_setprio(0);
#if PROBE_MASK
    if (blockIdx.x == 0 && tid == 0) { volatile LAS unsigned long long* acc = (volatile LAS unsigned long long*)(lds + LDS_CTRL + 64) + 20; acc[0] = acc[0] + att_wait; acc[2] = acc[2] + att_b; acc[3] = acc[3] + att_a; }
#endif
#undef ATT_DMA_K
#undef ATT_DMA_V
#undef ATT_KRD
#undef ATT_VRD
#undef ATT_QK
#undef ATT_ROWMAX
#undef ATT_DECIDE
#undef ATT_IMAX3
#undef ATT_SI
#undef ATT_ROWMAXI
#undef ATT_SV
#undef ATT_EXP2
#undef ATT_GAPB
#undef ATT_DSRD
#undef ATT_NW
#undef ATT_PHASEB
#undef ATT_RESC
#undef ATT_STEP
#undef ATT_STEPD
#undef ATT_QKD
#undef ATT_BUF
#undef ATT_TB0
#undef ATT_TB1
#undef ATT_TB2
#undef ATT_SYNCN
}
#undef ATT_SBAR
#undef ATT_MFMA
#undef ATT_SYNC
}

__device__ __forceinline__ void tr_item(const float* W, int ldw, int k0, int n0, bf16_t* WT, int ldt, int drow0, int dcol0, bool rope, LAS float* scr, int lane, float wsc = 1.f) {
    { f32x4 v[8];
#pragma unroll
      for (int j = 0; j < 8; ++j) v[j] = RLD((const f32x4*)(W + (size_t)(k0 + 8 * j + (lane >> 3)) * ldw + n0 + 4 * (lane & 7)));
#pragma unroll
      for (int j = 0; j < 8; ++j) { LAS float* d = scr + (8 * j + (lane >> 3)) * 33 + 4 * (lane & 7); d[0] = v[j][0] * wsc; d[1] = v[j][1] * wsc; d[2] = v[j][2] * wsc; d[3] = v[j][3] * wsc; } }
    LDS_WAIT(); asm volatile("" ::: "memory");
    const int c = lane & 7;
#pragma unroll
    for (int j = 0; j < 4; ++j) { const int n = (lane >> 3) + 8 * j; const LAS float* s = scr + (8 * c) * 33 + n;
        u32x4 o; o.x = cvtpk(s[0 * 33], s[1 * 33]); o.y = cvtpk(s[2 * 33], s[3 * 33]); o.z = cvtpk(s[4 * 33], s[5 * 33]); o.w = cvtpk(s[6 * 33], s[7 * 33]);
        const int dn = rope ? (8 * ((n >> 2) & 3) + 4 * (n >> 4) + (n & 3)) : n;
        *(u32x4*)(WT + (size_t)(drow0 + n0 + dn) * ldt + dcol0 + k0 + 8 * c) = o; }
    LDS_WAIT(); asm volatile("" ::: "memory");
}

__device__ __forceinline__ void phase_prologue(Frame F) {
    F.tid = opaque_tid(F.wave0); F.lane = F.tid & 63; F.wave = __builtin_amdgcn_readfirstlane(F.tid >> 6);
    const float* c = F.in[1]; const float* cctx = F.in[3]; const float* wmod = F.in[4]; const float* bmod = F.in[5];
    float* MOD = (float*)(F.ws + WS_MOD);
    for (int cb = blockIdx.x; cb < 192; cb += F.G) {
        LAS float* S = (LAS float*)F.lds;
        for (int bb = F.wave; bb < 36; bb += NWAVES) {
            const float* src = bb < 32 ? c + bb * 1024 : cctx;
#pragma unroll 4
            for (int k = F.lane; k < 1024; k += 64) { const float v = bb <= 32 ? src[k] : 0.f; S[k * 36 + bb] = v / (1.f + expf(-v)); } }
        __syncthreads();
        const int l = cb / 96, n = (cb % 96) * 64 + F.lane;
        float acc[36];
#pragma unroll
        for (int i = 0; i < 36; ++i) acc[i] = 0.f;
        const float* wp = wmod + ((size_t)l * 1024 + F.wave * 128) * MODW + n;
#pragma unroll 32
        for (int kk = 0; kk < 128; ++kk) { const float wv = wp[(size_t)kk * MODW]; const LAS f32x4* sp = (const LAS f32x4*)(S + (F.wave * 128 + kk) * 36);
#pragma unroll
            for (int q = 0; q < 9; ++q) { const f32x4 s4 = sp[q];
#pragma unroll
                for (int i = 0; i < 4; ++i) acc[4 * q + i] += s4[i] * wv; } }
        __syncthreads();
        LAS float* red = (LAS float*)F.lds;
#pragma unroll
        for (int bb = 0; bb < 33; ++bb) red[(F.wave * 33 + bb) * 64 + F.lane] = acc[bb];
        __syncthreads();
        for (int bb = F.wave; bb < 33; bb += 8) { float s = bmod[l * MODW + n];
#pragma unroll
            for (int w2 = 0; w2 < 8; ++w2) s += red[(w2 * 33 + bb) * 64 + F.lane];
            MOD[((size_t)l * 33 + bb) * MODW + n] = s; }
        __syncthreads();
    }
    __syncthreads();
    LAS float* scr = (LAS float*)(F.lds + F.wave * 8448);
    const int gw = F.vcu * NWAVES + F.wave, NGW = F.G * NWAVES;
    bf16_t* WZ = (bf16_t*)(F.ws + WS_WZ); bf16_t* WV = (bf16_t*)(F.ws + WS_WV); bf16_t* WM = (bf16_t*)(F.ws + WS_WM); bf16_t* WOUT = (bf16_t*)(F.ws + WS_WOUT);
    bf16_t* WUP0 = (bf16_t*)(F.ws + WS_WUP0); bf16_t* WDN0 = (bf16_t*)(F.ws + WS_WDN0);
    { bf16_t* WEFF = (bf16_t*)(F.ws + WS_WM);
      for (int it = gw; it < 1024; it += NGW) { const int l = it >> 9, g = (it >> 7) & 3, nbk = (it >> 3) & 15, cbk = it & 7; const int n = nbk * 64 + F.lane, c0 = cbk * 16;
          const float* pw = F.in[9] + ((size_t)(l * 4 + g) * 128 + c0) * 128; const float* ps = F.in[10] + l * 512 + g * 128; const float* wpp = F.in[16] + ((size_t)l * 512 + g * 128) * 1024 + n;
#pragma unroll
          for (int q = 0; q < 8; ++q) { const int idx = q * 256 + 4 * F.lane; const f32x4 v = *(const f32x4*)(pw + idx), sc = *(const f32x4*)(ps + (idx & 127)); *(LAS f32x4*)(scr + idx) = v * sc; }
          LDS_WAIT(); asm volatile("" ::: "memory");
          float a[16];
#pragma unroll
          for (int i = 0; i < 16; ++i) a[i] = 0.f;
          for (int d0 = 0; d0 < 128; d0 += 32) { float wv[32];
#pragma unroll
              for (int d = 0; d < 32; ++d) wv[d] = wpp[(size_t)(d0 + d) * 1024];
#pragma unroll
              for (int d = 0; d < 32; ++d)
#pragma unroll
                  for (int i = 0; i < 16; ++i) a[i] += scr[i * 128 + d0 + d] * wv[d]; }
          u32x4 o0, o1; o0.x = cvtpk(a[0], a[1]); o0.y = cvtpk(a[2], a[3]); o0.z = cvtpk(a[4], a[5]); o0.w = cvtpk(a[6], a[7]);
          o1.x = cvtpk(a[8], a[9]); o1.y = cvtpk(a[10], a[11]); o1.z = cvtpk(a[12], a[13]); o1.w = cvtpk(a[14], a[15]);
          bf16_t* dst = WEFF + ((size_t)l * 1024 + n) * MAP + g * 128 + c0; *(u32x4*)dst = o0; *(u32x4*)(dst + 8) = o1;
          LDS_WAIT(); asm volatile("" ::: "memory"); } }
    constexpr int I_IN = 16 * 176, I_SQ = 16 * 32, I_UP = 16 * 86, I_DN = 43 * 32;
    constexpr int NITEMS = 2 * I_IN + 4 * I_SQ + 2 * I_UP + I_DN;
    for (int it = (gw + (NGW > 1024 ? NGW - 1024 : 0)) % NGW; it < NITEMS; it += NGW) {
        int r = it;
        if (r < 2 * I_IN) { const int l = r / I_IN; r -= l * I_IN; const int kb = r / 176, nb = r % 176, n0 = nb * 32;
            const float* W = F.in[8] + (size_t)l * 1024 * 5632;
            if (n0 < 2560) tr_item(W, 5632, kb * 64, n0, WZ + (size_t)l * 4608 * 1024, 1024, 0, 0, n0 >= 512, scr, F.lane, (n0 >= 512 && n0 < 1536) ? QSCALE : 1.f);
            else if (n0 < 3584) tr_item(W, 5632, kb * 64, n0, WV + (size_t)l * 1024 * 1024, 1024, -2560, 0, false, scr, F.lane);
            else tr_item(W, 5632, kb * 64, n0, WZ + (size_t)l * 4608 * 1024, 1024, -1024, 0, false, scr, F.lane, -LOG2E);
            continue; }
        r -= 2 * I_IN;
        if (r < 4 * I_SQ) { const int q = r / I_SQ; r -= q * I_SQ; const int l = q & 1; const int kb = r / 32, nb = r % 32;
            const float* W = (q < 2 ? F.in[17] : F.in[18]) + (size_t)l * 1024 * 1024;
            if (q < 2) tr_item(W, 1024, kb * 64, nb * 32, WM + (size_t)l * 1024 * MAP, MAP, 0, 512, false, scr, F.lane);
            else tr_item(W, 1024, kb * 64, nb * 32, WOUT + (size_t)l * 1024 * 1024, 1024, 0, 0, false, scr, F.lane);
            continue; }
        r -= 4 * I_SQ;
        if (r < 2 * I_UP) { const int q = r / I_UP; r -= q * I_UP; const int kb = r / 86, nb = r % 86, n0 = nb * 32;
            const float* W = q ? F.in[20] : F.in[19];
            tr_item(W, FF, kb * 64, n0, WUP0, 1024, (n0 >> 7) * 256 + q * 128 - (n0 & ~127), 0, false, scr, F.lane, q ? -LN2 : -LOG2E); continue; }
        r -= 2 * I_UP;
        { const int kb = r / 32, nb = r % 32; tr_item(F.in[21], 1024, kb * 64, nb * 32, WDN0, FFP, 0, 0, false, scr, F.lane); }
    }
    { const int gt = F.vcu * NTHR + F.tid, NT = F.G * NTHR;
      for (int i = gt; i < 128 * 128; i += NT) { const int rr = i >> 7, cc = i & 127; const int row = 21 * 256 + (rr < 64 ? 64 + rr : 192 + (rr - 64)); *(u32x4*)(WUP0 + (size_t)row * 1024 + cc * 8) = (u32x4){0u, 0u, 0u, 0u}; }
      for (int i = gt; i < 1024 * 8; i += NT) { const int row = i >> 3, cc = i & 7; *(u32x4*)(WDN0 + (size_t)row * FFP + FF + cc * 8) = (u32x4){0u, 0u, 0u, 0u}; } }
    if (blockIdx.x == 0) {
        float* COS = (float*)(F.ws + WS_TAB); float* SIN = COS + 1024; float* LAMV = SIN + 1024;
        for (int idx = F.tid; idx < 1024; idx += NTHR) { const int pos = idx >> 4, i = idx & 15; const float inv = powf(10000.f, -(float)i * (2.0f / 32.0f)); const float ang = (float)pos * inv;
            COS[idx] = cosf(ang); SIN[idx] = sinf(ang); }
        if (F.wave == 1) {
            for (int l = 0; l < 2; ++l) { const float d1 = wave_sum(F.in[11][l * 64 + F.lane] * F.in[12][l * 64 + F.lane], F.lane), d2 = wave_sum(F.in[13][l * 64 + F.lane] * F.in[14][l * 64 + F.lane], F.lane);
                const float lam0 = 0.8f - 0.6f * expf(-0.3f * (float)l);
                if (F.lane == 0) { LAMV[2 * l] = expf(d1) - expf(d2) + lam0; LAMV[2 * l + 1] = 1.f - lam0; } }
        }
    }
}

constexpr size_t XPITCH = 4096;
template <bool SRC16>
__device__ __forceinline__ void phase_normmod(Frame F, const void* lat_, const void* ctx_, const float* g, const float* mod, int soff, bool do_ctx, bf16_t* H, const bf16_t* oadd = nullptr, void* latdst_ = nullptr, void* ctxdst_ = nullptr, const bf16_t* oadd2 = nullptr, const float* ogate = nullptr) {
    const char* lat = (const char*)lat_; const char* ctx = (const char*)ctx_; char* latdst = (char*)latdst_; char* ctxdst = (char*)ctxdst_;
    F.tid = opaque_tid(F.wave0); F.lane = F.tid & 63; F.wave = __builtin_amdgcn_readfirstlane(F.tid >> 6);
    const int gw = F.vcu * NWAVES + F.wave, NGW = F.G * NWAVES;
    const int per = (((NTOK + NGW - 1) / NGW) + 3) & ~3;
    const int r0 = gw * per, r1 = min(r0 + per, NTOK);
    int cur_bb = -1; f32x4 gs[4], sh[4], og[4];
#pragma unroll
    for (int q = 0; q < 4; ++q) { gs[q] = (f32x4){0.f, 0.f, 0.f, 0.f}; sh[q] = gs[q]; og[q] = gs[q]; }
    for (int r = r0; r < r1; r += 4) {
        const int b = r / LTOK, j = r - b * LTOK; const bool isc = j < CTXL;
        if (isc && !do_ctx) continue;
        const int bb = isc ? 32 : b;
        if (bb != cur_bb) { cur_bb = bb; const float* mv = mod + (size_t)bb * MODW + soff;
#pragma unroll
            for (int q = 0; q < 4; ++q) { const int cidx = 4 * F.lane + 256 * q; const f32x4 gg = *(const f32x4*)(g + cidx), sc = *(const f32x4*)(mv + 1024 + cidx); gs[q] = gg * (sc + 1.f); sh[q] = *(const f32x4*)(mv + cidx); if (oadd) og[q] = *(const f32x4*)(ogate + (size_t)bb * MODW + cidx); } }
        const char* src = isc ? ctx + ((size_t)b * CTXL + j) * XPITCH : lat + ((size_t)b * SEQ + (j - CTXL)) * XPITCH;
        f32x4 v[4][4]; float s[4];
        if (SRC16) {
            u32x2 xv[4][4];
#pragma unroll
            for (int i = 0; i < 4; ++i)
#pragma unroll
                for (int q = 0; q < 4; ++q) xv[i][q] = RLD((const u32x2*)(src + (size_t)i * XPITCH) + F.lane + 64 * q);
#pragma unroll
            for (int i = 0; i < 4; ++i)
#pragma unroll
                for (int q = 0; q < 4; ++q) v[i][q] = (f32x4){bflo(xv[i][q].x), bfhi(xv[i][q].x), bflo(xv[i][q].y), bfhi(xv[i][q].y)};
        } else {
#pragma unroll
            for (int i = 0; i < 4; ++i)
#pragma unroll
                for (int q = 0; q < 4; ++q) v[i][q] = RLD((const f32x4*)(src + (size_t)i * XPITCH) + F.lane + 64 * q);
        }
        if (oadd) {
            u32x2 ov[4][4];
#pragma unroll
            for (int i = 0; i < 4; ++i)
#pragma unroll
                for (int q = 0; q < 4; ++q) ov[i][q] = RLD((const u32x2*)(oadd + (size_t)(r + i) * D) + F.lane + 64 * q);
            if (oadd2 && r < SPLIT_ROWS) {
                u32x2 ow[4][4];
#pragma unroll
                for (int i = 0; i < 4; ++i)
#pragma unroll
                    for (int q = 0; q < 4; ++q) ow[i][q] = RLD((const u32x2*)(oadd2 + (size_t)(r + i) * D) + F.lane + 64 * q);
#pragma unroll
                for (int i = 0; i < 4; ++i)
#pragma unroll
                    for (int q = 0; q < 4; ++q) v[i][q] += og[q] * (f32x4){bflo(ow[i][q].x), bfhi(ow[i][q].x), bflo(ow[i][q].y), bfhi(ow[i][q].y)};
            }
            char* dst = isc ? ctxdst + ((size_t)b * CTXL + j) * XPITCH : latdst + ((size_t)b * SEQ + (j - CTXL)) * XPITCH;
#pragma unroll
            for (int i = 0; i < 4; ++i)
#pragma unroll
                for (int q = 0; q < 4; ++q) { v[i][q] += og[q] * (f32x4){bflo(ov[i][q].x), bfhi(ov[i][q].x), bflo(ov[i][q].y), bfhi(ov[i][q].y)};
                    u32x2 xo; xo.x = cvtpk(v[i][q][0], v[i][q][1]); xo.y = cvtpk(v[i][q][2], v[i][q][3]); RST((u32x2*)(dst + (size_t)i * XPITCH) + F.lane + 64 * q, xo); }
        }
#pragma unroll
        for (int i = 0; i < 4; ++i) { float a = 0.f;
#pragma unroll
            for (int q = 0; q < 4; ++q) a += (v[i][q][0] * v[i][q][0] + v[i][q][1] * v[i][q][1]) + (v[i][q][2] * v[i][q][2] + v[i][q][3] * v[i][q][3]);
            s[i] = a; }
#pragma unroll
        for (int o = 1; o < 64; o <<= 1)
#pragma unroll
            for (int i = 0; i < 4; ++i) s[i] += shx(s[i], o, F.lane);
#pragma unroll
        for (int i = 0; i < 4; ++i) { const float rstd = rsqrtf(s[i] * (1.f / D) + EPS); u32x2* o8 = (u32x2*)(H + (size_t)(r + i) * D) + F.lane;
#pragma unroll
            for (int q = 0; q < 4; ++q) { const f32x4 y = v[i][q] * rstd * gs[q] + sh[q]; u32x2 o; o.x = cvtpk(y[0], y[1]); o.y = cvtpk(y[2], y[3]); o8[64 * q] = o; } }
    }
}

__device__ __forceinline__ void pool_unpack(const u32x4 w, float (&v)[8]) { v[0] = bflo(w.x); v[1] = bfhi(w.x); v[2] = bflo(w.y); v[3] = bfhi(w.y); v[4] = bflo(w.z); v[5] = bfhi(w.z); v[6] = bflo(w.w); v[7] = bfhi(w.w); }
__device__ __forceinline__ void phase_pool(Frame F, const bf16_t* U, bf16_t* M, bool do_ctx) {
    F.tid = opaque_tid(F.wave0); F.lane = F.tid & 63; F.wave = __builtin_amdgcn_readfirstlane(F.tid >> 6);
    const int gw = F.vcu * NWAVES + F.wave, NGW = F.G * NWAVES;
    const int per = (((NTOK + NGW - 1) / NGW) + 3) & ~3;
    const int r0 = gw * per, r1 = min(r0 + per, NTOK);
    const int half = 1 << (F.lane >> 4);
    float S[8];
#pragma unroll
    for (int q = 0; q < 8; ++q) S[q] = 0.f;
    bool need_init = true;
    for (int r = r0; r < r1; r += 4) {
        const int b = r / LTOK, j = r - b * LTOK; const bool isc = j < CTXL;
        if (isc && !do_ctx) { need_init = true; continue; }
        const int L = isc ? CTXL : SEQ, t = isc ? j : j - CTXL; const size_t base = (size_t)b * LTOK + (isc ? 0 : CTXL);
        const bf16_t* Ul = U + base * 512 + 8 * F.lane;
        u32x4 wc[4], wi[4], wo[4];
#pragma unroll
        for (int i = 0; i < 4; ++i) { wc[i] = *(const u32x4*)(Ul + (size_t)(t + i) * 512); wi[i] = *(const u32x4*)(Ul + (size_t)min(t + i + half, L - 1) * 512); wo[i] = *(const u32x4*)(Ul + (size_t)max(t + i - half, 0) * 512); }
        if (need_init || t == 0) {
            need_init = false;
            const int lo = max(t - half, 0), hi = min(t + half, L);
            u32x4 w[16];
#pragma unroll
            for (int k = 0; k < 16; ++k) { const int tt = min(max(t - 8 + k, 0), L - 1); w[k] = *(const u32x4*)(Ul + (size_t)tt * 512); }
#pragma unroll
            for (int q = 0; q < 8; ++q) S[q] = 0.f;
#pragma unroll
            for (int k = 0; k < 16; ++k) { const int tt = t - 8 + k; const float mk = (tt >= lo && tt < hi) ? 1.f : 0.f; float v[8]; pool_unpack(w[k], v);
#pragma unroll
                for (int q = 0; q < 8; ++q) S[q] += mk * v[q]; }
        }
#pragma unroll
        for (int i = 0; i < 4; ++i) {
            const int ti = t + i, lo = max(ti - half, 0), hi = min(ti + half, L);
            const float ic = 1.f / (float)(hi - lo);
            float c[8], vi[8], vo[8]; pool_unpack(wc[i], c); pool_unpack(wi[i], vi); pool_unpack(wo[i], vo);
            u32x4 o; o.x = cvtpk(S[0] * ic - c[0], S[1] * ic - c[1]); o.y = cvtpk(S[2] * ic - c[2], S[3] * ic - c[3]);
            o.z = cvtpk(S[4] * ic - c[4], S[5] * ic - c[5]); o.w = cvtpk(S[6] * ic - c[6], S[7] * ic - c[7]);
            *(u32x4*)(M + (size_t)(r + i) * MAP + 8 * F.lane) = o;
            const float mi = (ti + half < L) ? 1.f : 0.f, mo = (ti - half >= 0) ? 1.f : 0.f;
#pragma unroll
            for (int q = 0; q < 8; ++q) S[q] = (S[q] + mi * vi[q]) - mo * vo[q];
        }
    }
}

__device__ __forceinline__ void phase_router(Frame F, char* x1, const float* g, const float* mod, bf16_t* H, const bf16_t* oadd) {
    F.tid = opaque_tid(F.wave0); F.lane = F.tid & 63; F.wave = __builtin_amdgcn_readfirstlane(F.tid >> 6);
    LAS float* WR = (LAS float*)F.lds;
    LAS float* LG = (LAS float*)(F.lds + 32768);
    LAS int* LCNT = (LAS int*)(F.lds + 32768 + 8192);
    unsigned* LIST = (unsigned*)(F.ws + WS_LIST); float* WTS = (float*)(F.ws + WS_WTS);
    for (int i = F.tid; i < 8192; i += NTHR) WR[i] = F.in[22][i];
    for (int ch = blockIdx.x; ch < NLAT / 256; ch += F.G) {
        if (F.tid < 16) LCNT[F.tid] = 0;
        __syncthreads();
        const int bch = (ch * 256) >> 11;
        f32x4 gs[4], sh[4], og[4];
        { const float* mv = mod + (size_t)bch * MODW + 3 * D;
#pragma unroll
          for (int q = 0; q < 4; ++q) { const int cidx = 4 * F.lane + 256 * q; const f32x4 gg = *(const f32x4*)(g + cidx), sc = *(const f32x4*)(mv + 1024 + cidx); gs[q] = gg * (sc + 1.f); sh[q] = *(const f32x4*)(mv + cidx); og[q] = *(const f32x4*)(mod + (size_t)bch * MODW + 2 * D + cidx); } }
        u32x2 vn[2][4], on[2][4];
#define RT_LOAD(rb_) do { const int _t0 = ch * 256 + F.wave * 32 + (rb_); const bf16_t* _or = oadd + ((size_t)bch * LTOK + CTXL + (_t0 & 2047)) * D; \
            _Pragma("unroll") for (int i = 0; i < 2; ++i) _Pragma("unroll") for (int q = 0; q < 4; ++q) { vn[i][q] = RLD((const u32x2*)(x1 + (size_t)(_t0 + i) * XPITCH) + F.lane + 64 * q); on[i][q] = RLD((const u32x2*)(_or + (size_t)i * D) + F.lane + 64 * q); } } while (0)
        RT_LOAD(0);
        for (int rb = 0; rb < 32; rb += 2) {
            const int rr0 = F.wave * 32 + rb, tok0 = ch * 256 + rr0;
            f32x4 v[2][4]; float s[2];
#pragma unroll
            for (int i = 0; i < 2; ++i)
#pragma unroll
                for (int q = 0; q < 4; ++q) v[i][q] = (f32x4){bflo(vn[i][q].x), bfhi(vn[i][q].x), bflo(vn[i][q].y), bfhi(vn[i][q].y)} + og[q] * (f32x4){bflo(on[i][q].x), bfhi(on[i][q].x), bflo(on[i][q].y), bfhi(on[i][q].y)};
            if (rb + 2 < 32) RT_LOAD(rb + 2);
#pragma unroll
            for (int i = 0; i < 2; ++i)
#pragma unroll
                for (int q = 0; q < 4; ++q) { u32x2 xo; xo.x = cvtpk(v[i][q][0], v[i][q][1]); xo.y = cvtpk(v[i][q][2], v[i][q][3]); RST((u32x2*)(x1 + (size_t)(tok0 + i) * XPITCH) + F.lane + 64 * q, xo); }
#pragma unroll
            for (int i = 0; i < 2; ++i) { float a = 0.f;
#pragma unroll
                for (int q = 0; q < 4; ++q) a += (v[i][q][0] * v[i][q][0] + v[i][q][1] * v[i][q][1]) + (v[i][q][2] * v[i][q][2] + v[i][q][3] * v[i][q][3]);
                s[i] = a; }
#pragma unroll
            for (int o = 1; o < 64; o <<= 1)
#pragma unroll
                for (int i = 0; i < 2; ++i) s[i] += shx(s[i], o, F.lane);
#pragma unroll
            for (int i = 0; i < 2; ++i) {
                const int tok = tok0 + i; const float rstd = rsqrtf(s[i] * (1.f / D) + EPS);
                u32x2* o8 = (u32x2*)(H + ((size_t)bch * LTOK + CTXL + (tok & 2047)) * D) + F.lane;
                float lg[8];
#pragma unroll
                for (int e = 0; e < 8; ++e) lg[e] = 0.f;
#pragma unroll
                for (int q = 0; q < 4; ++q) { const int cidx = 4 * F.lane + 256 * q;
                    const f32x4 y = v[i][q] * rstd * gs[q] + sh[q];
                    u32x2 o; o.x = cvtpk(y[0], y[1]); o.y = cvtpk(y[2], y[3]); o8[64 * q] = o;
#pragma unroll
                    for (int k = 0; k < 4; ++k) { const LAS f32x4* wr = (const LAS f32x4*)(WR + (cidx + k) * 8); const f32x4 w0 = wr[0], w1 = wr[1];
                        lg[0] += y[k] * w0[0]; lg[1] += y[k] * w0[1]; lg[2] += y[k] * w0[2]; lg[3] += y[k] * w0[3]; lg[4] += y[k] * w1[0]; lg[5] += y[k] * w1[1]; lg[6] += y[k] * w1[2]; lg[7] += y[k] * w1[3]; } }
                const bool b0 = F.lane & 1, b1 = F.lane & 2, b2 = F.lane & 4;
                float a4[4], a2[2], a1;
#pragma unroll
                for (int j = 0; j < 4; ++j) { const float keep = b0 ? lg[4 + j] : lg[j], send = b0 ? lg[j] : lg[4 + j]; a4[j] = keep + shx(send, 1, F.lane); }
#pragma unroll
                for (int j = 0; j < 2; ++j) { const float keep = b1 ? a4[2 + j] : a4[j], send = b1 ? a4[j] : a4[2 + j]; a2[j] = keep + shx(send, 2, F.lane); }
                { const float keep = b2 ? a2[1] : a2[0], send = b2 ? a2[0] : a2[1]; a1 = keep + shx(send, 4, F.lane); }
                a1 += shx(a1, 8, F.lane); a1 += shx(a1, 16, F.lane); a1 += shx(a1, 32, F.lane);
                if (F.lane < 8) LG[(rr0 + i) * 8 + ((F.lane & 1) * 4 + (F.lane & 2) + ((F.lane >> 2) & 1))] = a1;
            }
        }
#undef RT_LOAD
        __syncthreads();
        int e1 = 0, e2 = 0, i1 = 0, i2 = 0; float w1 = 0.f, w2 = 0.f;
        if (F.tid < 256) {
            const f32x4 l0 = *(const LAS f32x4*)(LG + F.tid * 8), l1 = *(const LAS f32x4*)(LG + F.tid * 8 + 4);
            const float lg[8] = {l0[0], l0[1], l0[2], l0[3], l1[0], l1[1], l1[2], l1[3]};
            float v1 = lg[0];
#pragma unroll
            for (int e = 1; e < 8; ++e) if (lg[e] > v1) { v1 = lg[e]; e1 = e; }
            float v2 = -3.0e38f;
#pragma unroll
            for (int e = 0; e < 8; ++e) if (e != e1 && lg[e] > v2) { v2 = lg[e]; e2 = e; }
            const float p2 = expf(v2 - v1); w1 = 1.f / (1.f + p2); w2 = p2 * w1;
            i1 = atomicAdd((int*)&LCNT[e1], 1); i2 = atomicAdd((int*)&LCNT[e2], 1); }
        __syncthreads();
        if (F.tid < 8) LCNT[8 + F.tid] = (int)__hip_atomic_fetch_add(F.ctl + CW_CNT + 64 * F.tid, (unsigned)LCNT[F.tid], __ATOMIC_RELAXED, __HIP_MEMORY_SCOPE_AGENT);
        __syncthreads();
        if (F.tid < 256) { const unsigned tok = (unsigned)(ch * 256 + F.tid);
            LIST[(size_t)e1 * NLAT + LCNT[8 + e1] + i1] = tok * 2u; LIST[(size_t)e2 * NLAT + LCNT[8 + e2] + i2] = tok * 2u + 1u;
            WTS[tok * 2u] = w1; WTS[tok * 2u + 1u] = w2; }
        __syncthreads();
    }
    __syncthreads();
    LAS float* scr = (LAS float*)(F.lds + F.wave * 8448);
    const int gw = F.vcu * NWAVES + F.wave, NGW = F.G * NWAVES;
    bf16_t* WUPE = (bf16_t*)(F.ws + WS_WUPE); bf16_t* WDNE = (bf16_t*)(F.ws + WS_WDNE);
    constexpr int I_E = 16 * 44, I_D = 22 * 32;
    for (int it = gw; it < NE * (2 * I_E + I_D); it += NGW) {
        const int e = it / (2 * I_E + I_D); int r = it - e * (2 * I_E + I_D);
        if (r < 2 * I_E) { const int q = r / I_E; r -= q * I_E; const int kb = r / 44, nb = r % 44, n0 = nb * 32;
            const float* W = (q ? F.in[24] : F.in[23]) + (size_t)e * 1024 * FFE;
            tr_item(W, FFE, kb * 64, n0, WUPE + (size_t)e * 2816 * 1024, 1024, (n0 >> 7) * 256 + q * 128 - (n0 & ~127), 0, false, scr, F.lane, q ? -LN2 : -LOG2E); }
        else { r -= 2 * I_E; const int kb = r / 32, nb = r % 32;
            tr_item(F.in[25] + (size_t)e * FFE * 1024, 1024, kb * 64, nb * 32, WDNE + (size_t)e * 1024 * FFE, FFE, 0, 0, false, scr, F.lane); }
    }
}

__device__ __forceinline__ void phase_final(Frame F, float* x, const bf16_t* YM, const float* mod, const float* fg) {
    F.tid = opaque_tid(F.wave0); F.lane = F.tid & 63; F.wave = __builtin_amdgcn_readfirstlane(F.tid >> 6);
    const int gw = F.vcu * NWAVES + F.wave, NGW = F.G * NWAVES;
    const int per = (((NLAT + NGW - 1) / NGW) + 1) & ~1;
    const int t0 = gw * per, t1 = min(t0 + per, NLAT);
    if (t0 >= t1) return;
    f32x4 fgv[4], gg[4]; int cur_b = -1;
#pragma unroll
    for (int q = 0; q < 4; ++q) { fgv[q] = *(const f32x4*)(fg + 4 * F.lane + 256 * q); gg[q] = (f32x4){0.f, 0.f, 0.f, 0.f}; }
    u32x2 xb[2][4], ya[2][4], yc[2][4];
#define FIN_LOAD(tk) do { _Pragma("unroll") for (int i = 0; i < 2; ++i) _Pragma("unroll") for (int q = 0; q < 4; ++q) { \
            xb[i][q] = RLD((const u32x2*)((const char*)x + (size_t)((tk) + i) * XPITCH) + F.lane + 64 * q); \
            ya[i][q] = RLD((const u32x2*)(YM + (size_t)((tk) + i) * D) + F.lane + 64 * q); yc[i][q] = RLD((const u32x2*)(YM + ((size_t)NLAT + (tk) + i) * D) + F.lane + 64 * q); } } while (0)
    FIN_LOAD(t0);
    for (int tok = t0; tok < t1; tok += 2) {
        const int b = tok >> 11;
        if (b != cur_b) { cur_b = b; const float* gate = mod + (size_t)b * MODW + 5 * D;
#pragma unroll
            for (int q = 0; q < 4; ++q) gg[q] = *(const f32x4*)(gate + 4 * F.lane + 256 * q); }
        f32x4 xv[2][4]; float s[2];
#pragma unroll
        for (int i = 0; i < 2; ++i) { float a = 0.f;
#pragma unroll
            for (int q = 0; q < 4; ++q) {
                const f32x4 yy = (f32x4){bflo(ya[i][q].x) + bflo(yc[i][q].x), bfhi(ya[i][q].x) + bfhi(yc[i][q].x), bflo(ya[i][q].y) + bflo(yc[i][q].y), bfhi(ya[i][q].y) + bfhi(yc[i][q].y)};
                xv[i][q] = (f32x4){bflo(xb[i][q].x), bfhi(xb[i][q].x), bflo(xb[i][q].y), bfhi(xb[i][q].y)} + gg[q] * yy; a += (xv[i][q][0] * xv[i][q][0] + xv[i][q][1] * xv[i][q][1]) + (xv[i][q][2] * xv[i][q][2] + xv[i][q][3] * xv[i][q][3]); }
            s[i] = a; }
        if (tok + 2 < t1) FIN_LOAD(tok + 2);
#pragma unroll
        for (int o = 1; o < 64; o <<= 1)
#pragma unroll
            for (int i = 0; i < 2; ++i) s[i] += shx(s[i], o, F.lane);
#pragma unroll
        for (int i = 0; i < 2; ++i) { const float rstd = rsqrtf(s[i] * (1.f / D) + EPS);
#pragma unroll
            for (int q = 0; q < 4; ++q) RST((f32x4*)(x + (size_t)(tok + i) * D) + F.lane + 64 * q, xv[i][q] * rstd * fgv[q]); }
    }
#undef FIN_LOAD
}

struct Args { const float* in[27]; float* out; unsigned char* ws; int ph_lo, ph_hi; };
__global__ void __launch_bounds__(NTHR, 2) dit_fwd(Args args) {
    extern __shared__ __attribute__((aligned(16))) unsigned char lds_raw[];
    LAS unsigned char* const ldsb = (LAS unsigned char*)lds_raw;
    const int WAVE = __builtin_amdgcn_readfirstlane((int)threadIdx.x >> 6);
    volatile LAS unsigned* xbw = (volatile LAS unsigned*)(ldsb + LDS_CTRL);
    if (threadIdx.x < 4) xbw[threadIdx.x] = 0u;
    __syncthreads();
    volatile LAS unsigned long long* tsl = (volatile LAS unsigned long long*)(ldsb + LDS_CTRL + 64);
    if (args.ph_hi - args.ph_lo > 1) (void)xcd_barrier_post((unsigned*)(args.ws + WS_CTL) + CW_BAR, xbw);
#ifndef SITE_MASK
#define SITE_MASK 0xFFFFFFFFu
#endif
#define SITE(n) (((SITE_MASK) >> (n)) & 1u)
#define IN(k) (args.ph_lo <= (k) && (k) < args.ph_hi)
#define STAMP(k) do { if (PROBE_MASK != 0u && blockIdx.x == 0 && opaque_tid(WAVE) == 0) tsl[(k)] = __builtin_amdgcn_s_memrealtime(); } while (0)
#define SEAM(k) do { if (IN(k) && IN((k) + 1)) { XcdBarrier _b; _b.bar = (unsigned*)(args.ws + WS_CTL) + CW_BAR; _b.x = xb_xcc_id(); _b.st = xbw; xcd_barrier(_b); } STAMP((k) + 1); } while (0)

#define WSBASE() size_t _wz = 0; asm volatile("" : "+s"(_wz)); unsigned char* ws = args.ws + _wz; float* MOD = (float*)(ws + WS_MOD); (void)MOD; \
    Frame F; F.lds = ldsb; F.ws = ws; F.ctl = (unsigned*)(ws + WS_CTL); F.in = args.in; F.out = args.out + _wz; F.wave0 = WAVE; F.tid = 0; F.lane = 0; F.wave = 0; \
    F.G = gridDim.x; { const int bx = blockIdx.x; F.vcu = (F.G % 8 == 0) ? (bx % 8) * (F.G / 8) + bx / 8 : bx; } const int c = (int)blockIdx.x; (void)c
#define P_COS ((const float*)(ws + WS_TAB))
#define P_SIN (P_COS + 1024)
#define P_LAMV (P_SIN + 1024)
#define P_XC ((float*)(ws + WS_XC))
#define P_H ((bf16_t*)(ws + WS_H))
#define P_U ((bf16_t*)(ws + WS_U))
#define P_Q ((bf16_t*)(ws + WS_Q))
#define P_KB ((bf16_t*)(ws + WS_K))
#define P_VT ((bf16_t*)(ws + WS_VT))
#define P_G ((unsigned char*)(ws + WS_G))
#define P_MA ((bf16_t*)(ws + WS_MA))
#define P_Y ((bf16_t*)(ws + WS_Y))
#define P_HID ((bf16_t*)(ws + WS_HID))
#define P_HIDM ((bf16_t*)(ws + WS_HIDM))
#define P_YM ((bf16_t*)(ws + WS_YM))

    if (PROBE_MASK != 0u && threadIdx.x == 0) { tsl[20] = 0; tsl[21] = 0; tsl[22] = 0; tsl[23] = 0; }
    STAMP(0);
    if (SITE(0) && IN(0)) { WSBASE(); phase_prologue(F); } SEAM(0);
    if (SITE(1) && IN(1)) { WSBASE(); phase_normmod<false>(F, F.in[0], F.in[2], F.in[6], MOD, 0, true, P_H); } SEAM(1);

    for (int l = 0; l < 2; ++l) {
        const int pb = 2 + 8 * l; const bool last = (l == 1);
        if (SITE(2) && IN(pb)) { WSBASE();
            ZSched S; S.init(F.G, c, last ? 1 : 0, P_H, ws + WS_WZ + (size_t)l * 9 * MiB, ws + WS_WV + (size_t)l * 2 * MiB);
            ZEpi E{P_U, P_Q, P_KB, P_G, P_VT, P_COS, P_SIN, F.ctl + CW_KMX + l * 1024};
            pg8::gemm_phase(F.lds, WAVE, 1024, S, E);
        } SEAM(pb);
        if (SITE(3) && IN(pb + 1)) { WSBASE();
            phase_pool(F, P_U, P_MA, !last);
            const float lam = P_LAMV[2 * l], osc = P_LAMV[2 * l + 1]; const float* subg = F.in[15] + l * VD;
            bf16x8 qf[4];
            for (int i = 0;; ++i) { const int Lf = i * F.G + F.vcu; if (Lf >= NB * NH * 16) break; const int L = REV_ORDER ? NB * NH * 16 - 1 - Lf : Lf; const int bh = L >> 4, qt = L & 15, b = bh >> 3, h = bh & 7;
                const int Lfn = Lf + F.G; const bool hn = Lfn < NB * NH * 16; const int Ln = REV_ORDER ? NB * NH * 16 - 1 - Lfn : Lfn; const int nbh = Ln >> 4, nqt = Ln & 15, nb = nbh >> 3, nh = nbh & 7;
                att::attn_unit(F.lds, P_Q, P_KB, P_VT, P_MA, b, h, (size_t)b * LTOK + CTXL + qt * 128, 36, lam, osc, subg, F.ctl + CW_KMX + l * 1024 + (b * 8 + h) * 4, qf, XUP ? i == 0 : true, XUP ? hn : false, nb, nh, (size_t)nb * LTOK + CTXL + nqt * 128, WAVE); }
            if (!last) for (int i = 0;; ++i) { const int L = i * F.G + F.vcu; if (L >= NB * NH * 2) break; const int bh = L >> 1, qt = L & 1, b = bh >> 3, h = bh & 7;
                const int Ln = L + F.G; const bool hn = Ln < NB * NH * 2; const int nbh = Ln >> 1, nqt = Ln & 1, nb = nbh >> 3, nh = nbh & 7;
                att::attn_unit(F.lds, P_Q, P_KB, P_VT, P_MA, b, h, (size_t)b * LTOK + qt * 128, 4, lam, osc, subg, F.ctl + CW_KMX + l * 1024 + (b * 8 + h) * 4, qf, XUP ? i == 0 : true, XUP ? hn : false, nb, nh, (size_t)nb * LTOK + nqt * 128, WAVE); }
        } SEAM(pb + 1);
        if (SITE(4) && IN(pb + 2)) { WSBASE();
            MergeSched S; S.init(F.G, c, last ? 1 : 0, P_MA, ws + WS_WM + (size_t)l * 3 * MiB); MergeEpi E{P_Y, P_G}; pg8::gemm_phase(F.lds, WAVE, MAP, S, E);
        } SEAM(pb + 2);
        if (SITE(5) && IN(pb + 3)) { WSBASE();
            PlainSched S; S.init(F.G, c, last ? 1 : 0, 4, P_Y, ws + WS_WOUT + (size_t)l * 2 * MiB, 1024, REV_ORDER);
            OEpi E{P_Q};
            pg8::gemm_phase(F.lds, WAVE, 1024, S, E);
        } SEAM(pb + 3);
        if (!last) {
            if (SITE(6) && IN(pb + 4)) { WSBASE(); phase_normmod<false>(F, F.in[0], F.in[2], F.in[7], MOD, 3 * D, true, P_H, P_Q, F.out, P_XC, nullptr, MOD + 2 * D); } SEAM(pb + 4);
            if (SITE(7) && IN(pb + 5)) { WSBASE(); PlainSched S; S.init(F.G, c, 0, 22, P_H, ws + WS_WUP0, 1024); UpEpi E{P_HID, FFP}; pg8::gemm_phase(F.lds, WAVE, 1024, S, E); } SEAM(pb + 5);
            if (SITE(8) && IN(pb + 6)) { WSBASE(); DownSplitSched S; S.init(F.G, c, P_HID, ws + WS_WDN0); OEpi E{(bf16_t*)P_G, (bf16_t*)(ws + WS_O2B)}; pg8::gemm_phase(F.lds, WAVE, FFP, S, E); } SEAM(pb + 6);
            if (SITE(9) && IN(pb + 7)) { WSBASE(); phase_normmod<true>(F, F.out, P_XC, F.in[6] + D, MOD + (size_t)33 * MODW, 0, true, P_H, (const bf16_t*)P_G, F.out, P_XC, (const bf16_t*)(ws + WS_O2B), MOD + 5 * D); } SEAM(pb + 7);
        } else {
            if (SITE(10) && IN(pb + 4)) { WSBASE(); phase_router(F, (char*)F.out, F.in[7] + D, MOD + (size_t)33 * MODW, P_H, P_Q); } SEAM(pb + 4);
            if (SITE(12) && IN(pb + 5)) { WSBASE(); MoeInfo mi; mi.load(F.ctl); MoeSched S; S.init(F.G, c, 11, P_H, ws + WS_WUPE, 1024, 2816, mi); S.gather = 1; S.LIST = (const unsigned*)(ws + WS_LIST); UpEpi E{P_HIDM, FFE}; pg8::gemm_phase<true>(F.lds, WAVE, 1024, S, E); } SEAM(pb + 5);
            if (SITE(13) && IN(pb + 6)) { WSBASE(); MoeInfo mi; mi.load(F.ctl); MoeSched S; S.init(F.G, c, 4, P_HIDM, ws + WS_WDNE, FFE, 1024, mi); S.rev = REV_ORDER;
                MoeDownEpi E{P_YM, (const unsigned*)(ws + WS_LIST), (const float*)(ws + WS_WTS), mi}; pg8::gemm_phase(F.lds, WAVE, FFE, S, E); } SEAM(pb + 6);
            if (SITE(14) && IN(pb + 7)) { WSBASE(); phase_final(F, F.out, P_YM, MOD + (size_t)33 * MODW, F.in[26]); }
            if (PROBE_MASK != 0u && blockIdx.x == 0) { __syncthreads(); if (threadIdx.x == 0) { const unsigned long long tend = __builtin_amdgcn_s_memrealtime(); unsigned long long dly = 0;
                for (int k = 0; k < N_PHASES; ++k) if ((PROBE_MASK >> k) & 1u) dly += (k == N_PHASES - 1 ? tend : tsl[k + 1]) - tsl[k];
                if ((PROBE_MASK >> 20) & 1u) dly += tsl[20];
                if ((PROBE_MASK >> 21) & 1u) dly += tsl[21];
                if ((PROBE_MASK >> 22) & 1u) dly += tsl[22];
                if ((PROBE_MASK >> 23) & 1u) dly += tsl[23];
                while (__builtin_amdgcn_s_memrealtime() - tend < dly) __builtin_amdgcn_s_sleep(8); } }
        }
    }
#undef IN
#undef SEAM
}

extern "C" void kernel_launch(void* const* d_in, const int* in_sizes, int n_in, void* d_out, int out_size, void* d_ws, size_t ws_size, hipStream_t stream) {
    static int grid = 0;
    if (grid == 0) {
        if (n_in != 27 || ws_size < WS_END) { fprintf(stderr, "kernel_launch: unexpected n_in %d or ws %zu\n", n_in, ws_size); grid = -1; return; }
        int dev = 0, cus = 0;
        if (hipGetDevice(&dev) != hipSuccess || hipDeviceGetAttribute(&cus, hipDeviceAttributeMultiprocessorCount, dev) != hipSuccess) { grid = -1; return; }
        if (hipFuncSetAttribute((const void*)dit_fwd, hipFuncAttributeMaxDynamicSharedMemorySize, LDS_BYTES) != hipSuccess) { fprintf(stderr, "kernel_launch: hipFuncSetAttribute failed\n"); grid = -1; return; }
        (void)hipGetLastError();
        grid = cus;
    }
    if (grid < 0) return;
    (void)hipMemsetAsync((char*)d_ws + WS_CTL, 0, CTL_ZERO_BYTES, stream);
    Args a{};
    for (int i = 0; i < 27; ++i) a.in[i] = (const float*)d_in[i];
    a.out = (float*)d_out; a.ws = (unsigned char*)d_ws;
#if MK_ONE_LAUNCH
    a.ph_lo = 0; a.ph_hi = N_PHASES;
    hipLaunchKernelGGL(dit_fwd, dim3(grid), dim3(NTHR), LDS_BYTES, stream, a);
#else
    for (int p = 0; p < N_PHASES; ++p) { a.ph_lo = p; a.ph_hi = p + 1; hipLaunchKernelGGL(dit_fwd, dim3(grid), dim3(NTHR), LDS_BYTES, stream, a); }
#endif
}
```
